# Optimizing an MI355X kernel written in HIP

```python
import math
import jax, jax.numpy as jnp
from jax import lax
import numpy as np

D_MODEL = 1024
BATCH = 8
SEQ = 2048
DEPTH = 2

CTX_LEN = 256
GRID_W = 64
D_S5 = D_MODEL // 2
S5_GROUP = 16
S5_GROUPS = D_S5 // S5_GROUP
S5_STATE = 64
D_SC = D_MODEL // 4
SC_WIDTH = 3
D_CF = D_MODEL // 4
CF_WIDTH = 31
SPLITS = (D_S5, D_S5 + D_SC, D_S5 + 2 * D_SC, D_S5 + 3 * D_SC, D_S5 + 3 * D_SC + D_CF)
D_IN = D_S5 + 3 * D_SC + 2 * D_CF
N_GROUPS = 4
EXP_PER_GROUP = 4
N_EXPERTS = N_GROUPS * EXP_PER_GROUP
D_EXPERT = D_MODEL // 4
TOP_K = 2
DN_ALPHA = (2 * DEPTH) ** 0.25
DN_BETA = (8 * DEPTH) ** -0.25
LN_EPS = 1e-5

kernel_name = 'hybrid_s5_conv_conformer_hmoe_diffusion'


def layer_norm(x, g, b):
    xf = x.astype(jnp.float32)
    mu = jnp.mean(xf, -1, keepdims=True)
    var = jnp.mean(jnp.square(xf - mu), -1, keepdims=True)
    return ((xf - mu) * lax.rsqrt(var + LN_EPS) * g.astype(jnp.float32) + b.astype(jnp.float32)).astype(x.dtype)


def modulate(x, shift, scale):
    return x * (1 + scale) + shift


def dwconv_seq(x, w):
    k = w.shape[0]
    p = (k - 1) // 2
    return lax.conv_general_dilated(x, w[:, None, :].astype(x.dtype), (1,), [(p, p)],
                                    dimension_numbers=('NWC', 'WIO', 'NWC'),
                                    feature_group_count=x.shape[-1])


def dwconv_grid(x, w):
    kh, kw = w.shape[0], w.shape[1]
    return lax.conv_general_dilated(x, w[:, :, None, :].astype(x.dtype), (1, 1),
                                    [((kh - 1) // 2, (kh - 1) // 2), ((kw - 1) // 2, (kw - 1) // 2)],
                                    dimension_numbers=('NHWC', 'HWIO', 'NHWC'),
                                    feature_group_count=x.shape[-1])


def _linear_combine(e1, e2):
    a1, b1 = e1
    a2, b2 = e2
    return a2 * a1, a2 * b1 + b2


def linear_scan(lam_bar, bu):
    a = jnp.broadcast_to(lam_bar, (1,) + bu.shape[1:])
    _, h = lax.associative_scan(_linear_combine, (a, bu), axis=1)
    return h


def zoh(a_re, a_im, log_dt, b_re, b_im):
    f32 = jnp.float32
    lam = lax.complex(a_re.astype(f32), a_im.astype(f32))
    dt = jnp.exp(log_dt.astype(f32))[:, None]
    lam_bar = jnp.exp(lam * dt)
    b = lax.complex(b_re.astype(f32), b_im.astype(f32))
    b_bar = ((lam_bar - 1.0) / lam)[..., None] * b
    return lam_bar, b_bar


def s5_mixer(u, uc, a_re, a_im, log_dt, b_re, b_im, c_re, c_im, d_skip, w_glu, b_glu, ctx_out):
    f32 = jnp.float32
    bsz, seq, _ = u.shape
    n_ctx = uc.shape[1]
    ug = u.astype(f32).reshape(bsz, seq, S5_GROUPS, S5_GROUP)
    ucg = uc.astype(f32).reshape(bsz, n_ctx, S5_GROUPS, S5_GROUP)
    d = d_skip.astype(f32)
    y = d * u.astype(f32)
    yc = d * uc.astype(f32) if ctx_out else None
    for direction in range(2):
        lam_bar, b_bar = zoh(a_re[direction], a_im[direction], log_dt[direction],
                             b_re[direction], b_im[direction])
        c_mat = lax.complex(c_re[direction].astype(f32), c_im[direction].astype(f32))
        bu_c = jnp.einsum('bsgn,gpn->bsgp', ucg, b_bar)
        bu = jnp.einsum('bsgn,gpn->bsgp', ug, b_bar)
        if direction == 1:
            bu_c = jnp.flip(bu_c, 1)
            bu = jnp.flip(bu, 1)
        h_c = linear_scan(lam_bar, bu_c)
        bu = bu.at[:, 0].add(lam_bar * h_c[:, -1])
        h = linear_scan(lam_bar, bu)
        if direction == 1:
            h = jnp.flip(h, 1)
        y = y + jnp.real(jnp.einsum('bsgp,gnp->bsgn', h, c_mat)).reshape(bsz, seq, D_S5)
        if ctx_out:
            if direction == 1:
                h_c = jnp.flip(h_c, 1)
            yc = yc + jnp.real(jnp.einsum('bsgp,gnp->bsgn', h_c, c_mat)).reshape(bsz, n_ctx, D_S5)
    wg = w_glu.astype(f32)
    bg = b_glu.astype(f32)

    def glu(t):
        t = jax.nn.gelu(t)
        return t * jax.nn.sigmoid(t @ wg + bg)

    y = glu(y).astype(u.dtype)
    yc = glu(yc).astype(uc.dtype) if ctx_out else None
    return y, yc


def mixer_sublayer(h, hc, rows, w_in, s5_a_re, s5_a_im, s5_log_dt, s5_b_re, s5_b_im, s5_c_re, s5_c_im,
                   s5_d, w_glu, b_glu, w_sc, w_dw, b_dw, ln_cf_g, ln_cf_b, w_o, ctx_out):
    bsz, seq, _ = h.shape
    z = h @ w_in
    u, b_g, c_g, v, g_a, g_b = jnp.split(z, list(SPLITS), axis=-1)
    zc = hc @ (w_in if ctx_out else w_in[:, :D_S5])
    y_s5, yc_s5 = s5_mixer(u, zc[..., :D_S5], s5_a_re, s5_a_im, s5_log_dt, s5_b_re, s5_b_im,
                           s5_c_re, s5_c_im, s5_d, w_glu, b_glu, ctx_out)
    y_sc = b_g * dwconv_grid((c_g * v).reshape(bsz, rows, GRID_W, D_SC), w_sc[None]).reshape(bsz, seq, D_SC)
    t = dwconv_grid((g_a * jax.nn.sigmoid(g_b)).reshape(bsz, rows, GRID_W, D_CF),
                    w_dw[:, None]).reshape(bsz, seq, D_CF) + b_dw
    y_cf = jax.nn.silu(layer_norm(t, ln_cf_g, ln_cf_b))
    y = jnp.concatenate([y_s5, y_sc, y_cf], axis=-1) @ w_o
    if not ctx_out:
        return y, None
    _, bc_g, cc_g, vc, gc_a, gc_b = jnp.split(zc, list(SPLITS), axis=-1)
    yc_sc = bc_g * dwconv_seq(cc_g * vc, w_sc)
    tc = dwconv_seq(gc_a * jax.nn.sigmoid(gc_b), w_dw) + b_dw
    yc_cf = jax.nn.silu(layer_norm(tc, ln_cf_g, ln_cf_b))
    yc = jnp.concatenate([yc_s5, yc_sc, yc_cf], axis=-1) @ w_o
    return y, yc


def hier_moe(h, w_rg, b_rg, w_rexp, b_rexp, w_gate, w_up, w_down):
    f32 = jnp.float32
    hf = h.astype(f32)
    g_logits = hf @ w_rg.astype(f32) + b_rg.astype(f32)
    g_idx = jnp.argmax(g_logits, axis=-1)
    g_w = jnp.take_along_axis(jax.nn.softmax(g_logits, axis=-1), g_idx[..., None], axis=-1)
    e_logits = (hf @ w_rexp.astype(f32) + b_rexp.astype(f32)).reshape(
        h.shape[:-1] + (N_GROUPS, EXP_PER_GROUP))
    e_logits = jnp.take_along_axis(e_logits, g_idx[..., None, None], axis=-2)[..., 0, :]
    top_v, top_i = lax.top_k(e_logits, TOP_K)
    comb = g_w * jax.nn.softmax(top_v, axis=-1)
    expert = g_idx[..., None] * EXP_PER_GROUP + top_i
    weights = jnp.sum(jax.nn.one_hot(expert, N_EXPERTS, dtype=f32) * comb[..., None], axis=-2)
    gate = jnp.einsum('bsd,edf->bsef', h, w_gate)
    up = jnp.einsum('bsd,edf->bsef', h, w_up)
    act = jax.nn.silu(gate) * up * weights[..., None].astype(h.dtype)
    return jnp.einsum('bsef,efd->bsd', act, w_down)


def setup_inputs(seed: int = 0) -> dict:
    key = jax.random.key(seed)
    keys = jax.random.split(key, 40)
    counter = iter(range(40))
    f32 = jnp.float32

    def nrm(shape, scale):
        return scale * jax.random.normal(keys[next(counter)], shape, f32)

    L, D = DEPTH, D_MODEL
    G, P, N = S5_GROUPS, S5_STATE, S5_GROUP
    a_im0 = jnp.pi * jnp.arange(P, dtype=f32)
    return {
        'x': nrm((BATCH, SEQ, D), 1.0),
        'c': nrm((BATCH, D), 1.0),
        'ctx': nrm((BATCH, CTX_LEN, D), 1.0),
        'c_ctx': nrm((D,), 1.0),
        'w_mod': nrm((L, D, 6 * D), 0.5 * D ** -0.5),
        'b_mod': nrm((L, 6 * D), 0.02),
        'w_in': nrm((L, D, D_IN), D ** -0.5),
        's5_a_re': -0.5 * (1.0 + nrm((L, 2, G, P), 0.02)),
        's5_a_im': a_im0 + nrm((L, 2, G, P), 0.01),
        's5_log_dt': jax.random.uniform(keys[next(counter)], (L, 2, G), f32,
                                        math.log(1e-3), math.log(1e-1)),
        's5_b_re': nrm((L, 2, G, P, N), (2 * N) ** -0.5),
        's5_b_im': nrm((L, 2, G, P, N), (2 * N) ** -0.5),
        's5_c_re': nrm((L, 2, G, N, P), 0.5),
        's5_c_im': nrm((L, 2, G, N, P), 0.5),
        's5_d': nrm((L, D_S5), 1.0),
        'w_glu': nrm((L, D_S5, D_S5), D_S5 ** -0.5),
        'b_glu': nrm((L, D_S5), 0.02),
        'w_sc': nrm((L, SC_WIDTH, D_SC), SC_WIDTH ** -0.5),
        'w_dw': nrm((L, CF_WIDTH, D_CF), CF_WIDTH ** -0.5),
        'b_dw': nrm((L, D_CF), 0.02),
        'ln_cf_g': 1.0 + nrm((L, D_CF), 0.02),
        'ln_cf_b': nrm((L, D_CF), 0.02),
        'w_o': nrm((L, D, D), DN_BETA * D ** -0.5),
        'ln1_g': 1.0 + nrm((L, D), 0.02),
        'ln1_b': nrm((L, D), 0.02),
        'w_rg': nrm((L, D, N_GROUPS), D ** -0.5),
        'b_rg': nrm((L, N_GROUPS), 0.01),
        'w_rexp': nrm((L, D, N_EXPERTS), D ** -0.5),
        'b_rexp': nrm((L, N_EXPERTS), 0.01),
        'w_gate': nrm((L, N_EXPERTS, D, D_EXPERT), D ** -0.5),
        'w_up': nrm((L, N_EXPERTS, D, D_EXPERT), D ** -0.5),
        'w_down': nrm((L, N_EXPERTS, D_EXPERT, D), DN_BETA * D_EXPERT ** -0.5),
        'ln2_g': 1.0 + nrm((L, D), 0.02),
        'ln2_b': nrm((L, D), 0.02),
    }


def reference(x, c, ctx, c_ctx, w_mod, b_mod, w_in, s5_a_re, s5_a_im, s5_log_dt, s5_b_re, s5_b_im,
              s5_c_re, s5_c_im, s5_d, w_glu, b_glu, w_sc, w_dw, b_dw, ln_cf_g, ln_cf_b, w_o,
              ln1_g, ln1_b, w_rg, b_rg, w_rexp, b_rexp, w_gate, w_up, w_down, ln2_g, ln2_b):
    rows = x.shape[1] // GRID_W
    x_lat, x_ctx = x, ctx
    for l in range(DEPTH):
        last = l == DEPTH - 1
        mod = (jax.nn.silu(c) @ w_mod[l] + b_mod[l])[:, None, :]
        mod_c = jax.nn.silu(c_ctx) @ w_mod[l] + b_mod[l]
        sh1, sc1, g1, sh2, sc2, g2 = jnp.split(mod, 6, axis=-1)
        sh1c, sc1c, g1c, sh2c, sc2c, g2c = jnp.split(mod_c, 6, axis=-1)
        y, yc = mixer_sublayer(modulate(x_lat, sh1, sc1), modulate(x_ctx, sh1c, sc1c), rows, w_in[l],
                               s5_a_re[l], s5_a_im[l], s5_log_dt[l], s5_b_re[l], s5_b_im[l],
                               s5_c_re[l], s5_c_im[l], s5_d[l], w_glu[l], b_glu[l], w_sc[l], w_dw[l],
                               b_dw[l], ln_cf_g[l], ln_cf_b[l], w_o[l], not last)
        x_lat = layer_norm(DN_ALPHA * x_lat + g1 * y, ln1_g[l], ln1_b[l])
        if not last:
            x_ctx = layer_norm(DN_ALPHA * x_ctx + g1c * yc, ln1_g[l], ln1_b[l])
            f_ctx = hier_moe(modulate(x_ctx, sh2c, sc2c), w_rg[l], b_rg[l], w_rexp[l], b_rexp[l],
                             w_gate[l], w_up[l], w_down[l])
            x_ctx = layer_norm(DN_ALPHA * x_ctx + g2c * f_ctx, ln2_g[l], ln2_b[l])
        f = hier_moe(modulate(x_lat, sh2, sc2), w_rg[l], b_rg[l], w_rexp[l], b_rexp[l],
                     w_gate[l], w_up[l], w_down[l])
        x_lat = layer_norm(DN_ALPHA * x_lat + g2 * f, ln2_g[l], ln2_b[l])
    return x_lat
```

```cpp
#include <hip/hip_runtime.h>
#include <hip/hip_cooperative_groups.h>
#include <cstdio>
#include <cstdint>
namespace cg = cooperative_groups;

#ifndef FUSED
#define FUSED 0
#endif

typedef unsigned short bf16_t;
typedef __attribute__((ext_vector_type(8))) short bf16x8;
typedef __attribute__((ext_vector_type(16))) float f32x16;

constexpr int D = 1024, NB = 8, SEQ = 2048, CTX = 256;
constexpr int NLAT = NB * SEQ, NCTX = NB * CTX, NROW = NLAT + NCTX;
constexpr int DIN = 1792, DS5 = 512, NG = 32, PS = 64;
constexpr int TCH = 16, NT = 256;
constexpr int NCOL = NROW / TCH;
constexpr int NCOL_LAT = NLAT / TCH;
constexpr int CH_LAT = SEQ / TCH, CH_CTX = CTX / TCH;
constexpr int NSTEP = CH_LAT + CH_CTX;
constexpr int NSEG = 8, SEGLEN = NSTEP / NSEG;
constexpr int NCLS = 24, LISTCAP = NROW;
constexpr int MAXMT = NROW / 128 + NCLS;
constexpr int KSPLIT_MOD = 16;
constexpr float LN_EPS = 1e-5f;
constexpr float DN_ALPHA = 1.4142135623730951f;
constexpr int NPOW = 18;

constexpr size_t AL(size_t x) { return (x + 255) & ~(size_t)255; }
constexpr size_t SZ_WT_IN = (size_t)2 * DIN * D * 2;
constexpr size_t SZ_WT_GLU = (size_t)2 * 512 * 512 * 2;
constexpr size_t SZ_WT_O = (size_t)2 * D * D * 2;
constexpr size_t SZ_WT_GU = (size_t)2 * 16 * 512 * 1024 * 2;
constexpr size_t SZ_WT_DN = (size_t)2 * 16 * 1024 * 256 * 2;
constexpr size_t SZ_MOD = (size_t)2 * 9 * 6144 * 4;
constexpr size_t SZ_LAMPOW = (size_t)2 * 2 * NG * PS * NPOW * 8;
constexpr size_t SZ_BBAR = (size_t)2 * 2 * NG * PS * 16 * 8;
constexpr size_t SZ_KFULL = (size_t)2 * NG * 31 * 256 * 4;
constexpr size_t SZ_M1 = (size_t)2 * NG * 256 * 256 * 2;
constexpr size_t SZ_W2 = (size_t)2 * NG * 256 * 512 * 2;
constexpr size_t SZ_HB = (size_t)NROW * D * 2;
constexpr size_t SZ_UG = (size_t)NG * NROW * 16 * 2;
constexpr size_t SZ_ZR = (size_t)NROW * 1280 * 2;
constexpr size_t SZ_S = (size_t)NG * NCOL * 256 * 4;
constexpr size_t SZ_RCTX = (size_t)NCTX * D * 4;
constexpr size_t SZ_CNT = 256 * 4;
constexpr size_t SZ_LIST = (size_t)NCLS * LISTCAP * 4;
constexpr size_t SZ_LW = (size_t)NCLS * LISTCAP * 8;

constexpr size_t OFF_WT_IN = 0;
constexpr size_t OFF_WT_GLU = OFF_WT_IN + AL(SZ_WT_IN);
constexpr size_t OFF_WT_O = OFF_WT_GLU + AL(SZ_WT_GLU);
constexpr size_t OFF_WT_GU = OFF_WT_O + AL(SZ_WT_O);
constexpr size_t OFF_WT_DN = OFF_WT_GU + AL(SZ_WT_GU);
constexpr size_t OFF_MOD = OFF_WT_DN + AL(SZ_WT_DN);
constexpr size_t OFF_LAMPOW = OFF_MOD + AL(SZ_MOD);
constexpr size_t OFF_BBAR = OFF_LAMPOW + AL(SZ_LAMPOW);
constexpr size_t OFF_KFULL = OFF_BBAR + AL(SZ_BBAR);
constexpr size_t OFF_M1 = OFF_KFULL + AL(SZ_KFULL);
constexpr size_t OFF_W2 = OFF_M1 + AL(SZ_M1);
constexpr size_t OFF_HB = OFF_W2 + AL(SZ_W2);
constexpr size_t OFF_UG = OFF_HB + AL(SZ_HB);
constexpr size_t OFF_ZR = OFF_UG + AL(SZ_UG);
constexpr size_t OFF_S = OFF_ZR + AL(SZ_ZR);
constexpr size_t OFF_RCTX = OFF_S + AL(SZ_S);
constexpr size_t OFF_CNT = OFF_RCTX + AL(SZ_RCTX);
constexpr size_t OFF_LIST = OFF_CNT + AL(SZ_CNT);
constexpr size_t OFF_LW = OFF_LIST + AL(SZ_LIST);
constexpr size_t WS_END = OFF_LW + AL(SZ_LW);
static_assert((size_t)KSPLIT_MOD * 2 * 9 * 6144 * 4 <= SZ_ZR, "modp alias");
static_assert((size_t)NG * NCOL * 256 * 2 <= SZ_ZR, "hprev alias");
static_assert((size_t)NROW * 512 * 2 <= SZ_S && (size_t)MAXMT * 128 * 512 * 2 <= SZ_S, "Y/act alias");
static_assert(WS_END <= (size_t)256 * 1024 * 1024, "workspace over 256 MiB");

constexpr int LDS_BYTES = 81920;

struct Params {
    const float* in[34];
    float* out;
    unsigned char* ws;
};

__device__ __forceinline__ unsigned f2bf(float f) { unsigned u = __float_as_uint(f); u += 0x7fffu + ((u >> 16) & 1u); return u >> 16; }
__device__ __forceinline__ float bf2f(unsigned h) { return __uint_as_float(h << 16); }
__device__ __forceinline__ unsigned pack2(float a, float b) { return f2bf(a) | (f2bf(b) << 16); }
__device__ __forceinline__ float bflo(unsigned w) { return __uint_as_float(w << 16); }
__device__ __forceinline__ float bfhi(unsigned w) { return __uint_as_float(w & 0xffff0000u); }
__device__ __forceinline__ float wave_sum(float v) {
#pragma unroll
    for (int o = 32; o >= 1; o >>= 1) v += __shfl_xor(v, o);
    return v;
}
__device__ __forceinline__ float sigmoidf_(float x) { return 1.0f / (1.0f + __expf(-x)); }
__device__ __forceinline__ float siluf_(float x) { return x / (1.0f + __expf(-x)); }
__device__ __forceinline__ float gelu_tanh(float x) {
    const float z = 0.7978845608028654f * (x + 0.044715f * x * x * x);
    const float e = __expf(2.0f * z);
    const float t = 1.0f - 2.0f / (1.0f + e);
    return 0.5f * x * (1.0f + t);
}
__device__ __forceinline__ int modrow(int row) { return row < NLAT ? (row >> 11) : 8; }

struct Src4 { const bf16_t* p0[4]; const bf16_t* p1[4]; int split; };

template <class EPI>
__device__ __forceinline__ void gemm128(unsigned char* lds, const Src4& A, const Src4& B, const int K, const EPI& epi) {
    const int tid = threadIdx.x, lane = tid & 63, wid = tid >> 6, wm = wid >> 1, wn = wid & 1;
    const int lr = tid >> 3, lc = tid & 7;
    const int wofs = lr * 128 + ((lc ^ ((lr >> 1) & 7)) << 4);
    const int l31 = lane & 31, hh = lane >> 5, sw = (l31 >> 1) & 7;
    const int xbase = (wm * 64 + l31) * 128, wbase = 16384 + (wn * 64 + l31) * 128;
    f32x16 acc[2][2];
#pragma unroll
    for (int i = 0; i < 2; ++i)
#pragma unroll
        for (int j = 0; j < 2; ++j)
#pragma unroll
            for (int e = 0; e < 16; ++e) acc[i][j][e] = 0.f;
    uint4 ra[4], rb[4];
    const int nk = K >> 6;
#define G_LOAD(kt_) do { const int k_ = (kt_) * 64; \
        _Pragma("unroll") for (int j = 0; j < 4; ++j) { ra[j] = *(const uint4*)(k_ < A.split ? A.p0[j] + k_ : A.p1[j] + (k_ - A.split)); } \
        _Pragma("unroll") for (int j = 0; j < 4; ++j) { rb[j] = *(const uint4*)(k_ < B.split ? B.p0[j] + k_ : B.p1[j] + (k_ - B.split)); } } while (0)
#define G_WRITE(bufo_) do { \
        _Pragma("unroll") for (int j = 0; j < 4; ++j) { *(uint4*)(lds + (bufo_) + wofs + j * 4096) = ra[j]; *(uint4*)(lds + (bufo_) + 16384 + wofs + j * 4096) = rb[j]; } } while (0)
    G_LOAD(0); G_WRITE(0); __syncthreads();
    for (int kt = 0; kt < nk; ++kt) {
        const int buf = (kt & 1) * 32768;
        if (kt + 1 < nk) G_LOAD(kt + 1);
#pragma unroll
        for (int ks = 0; ks < 4; ++ks) {
            const int co = ((ks * 2 + hh) ^ sw) << 4;
            const bf16x8 x0 = *(const bf16x8*)(lds + buf + xbase + co);
            const bf16x8 x1 = *(const bf16x8*)(lds + buf + xbase + 4096 + co);
            const bf16x8 w0 = *(const bf16x8*)(lds + buf + wbase + co);
            const bf16x8 w1 = *(const bf16x8*)(lds + buf + wbase + 4096 + co);
            acc[0][0] = __builtin_amdgcn_mfma_f32_32x32x16_bf16(w0, x0, acc[0][0], 0, 0, 0);
            acc[0][1] = __builtin_amdgcn_mfma_f32_32x32x16_bf16(w1, x0, acc[0][1], 0, 0, 0);
            acc[1][0] = __builtin_amdgcn_mfma_f32_32x32x16_bf16(w0, x1, acc[1][0], 0, 0, 0);
            acc[1][1] = __builtin_amdgcn_mfma_f32_32x32x16_bf16(w1, x1, acc[1][1], 0, 0, 0);
        }
        if (kt + 1 < nk) G_WRITE(((kt + 1) & 1) * 32768);
        __syncthreads();
    }
#undef G_LOAD
#undef G_WRITE
    epi(acc, wm * 64 + l31, wn * 64 + hh * 4);
}

__device__ __forceinline__ void src_plain(Src4& s, const bf16_t* base, int row0, int ld) {
    const int lr = threadIdx.x >> 3, lc = threadIdx.x & 7;
#pragma unroll
    for (int j = 0; j < 4; ++j) { s.p0[j] = base + (size_t)(row0 + lr + 32 * j) * ld + lc * 8; s.p1[j] = s.p0[j]; }
    s.split = 1 << 30;
}
__device__ __forceinline__ void src_split(Src4& s, const bf16_t* base0, int ld0, const bf16_t* base1, int ld1, int row0, int split) {
    const int lr = threadIdx.x >> 3, lc = threadIdx.x & 7;
#pragma unroll
    for (int j = 0; j < 4; ++j) { s.p0[j] = base0 + (size_t)(row0 + lr + 32 * j) * ld0 + lc * 8; s.p1[j] = base1 + (size_t)(row0 + lr + 32 * j) * ld1 + lc * 8; }
    s.split = split;
}

#define ACC_FOREACH(acc, r0, c0, ...) \
    _Pragma("unroll") for (int mt_ = 0; mt_ < 2; ++mt_) \
    _Pragma("unroll") for (int nt_ = 0; nt_ < 2; ++nt_) \
    _Pragma("unroll") for (int q_ = 0; q_ < 4; ++q_) { \
        const int rl = (r0) + mt_ * 32, cl = (c0) + nt_ * 32 + q_ * 8; \
        const float v0 = acc[mt_][nt_][q_ * 4 + 0], v1 = acc[mt_][nt_][q_ * 4 + 1], v2 = acc[mt_][nt_][q_ * 4 + 2], v3 = acc[mt_][nt_][q_ * 4 + 3]; \
        __VA_ARGS__ }

struct WS {
    unsigned char* b;
    __device__ bf16_t* wt_in(int l) const { return (bf16_t*)(b + OFF_WT_IN) + (size_t)l * DIN * D; }
    __device__ bf16_t* wt_glu(int l) const { return (bf16_t*)(b + OFF_WT_GLU) + (size_t)l * 512 * 512; }
    __device__ bf16_t* wt_o(int l) const { return (bf16_t*)(b + OFF_WT_O) + (size_t)l * D * D; }
    __device__ bf16_t* wt_gu(int l, int e) const { return (bf16_t*)(b + OFF_WT_GU) + (size_t)(l * 16 + e) * 512 * 1024; }
    __device__ bf16_t* wt_dn(int l, int e) const { return (bf16_t*)(b + OFF_WT_DN) + (size_t)(l * 16 + e) * 1024 * 256; }
    __device__ float* mod(int l) const { return (float*)(b + OFF_MOD) + (size_t)l * 9 * 6144; }
    __device__ float* modp() const { return (float*)(b + OFF_ZR); }
    __device__ float2* lampow(int l, int d, int g) const { return (float2*)(b + OFF_LAMPOW) + (size_t)((l * 2 + d) * NG + g) * PS * NPOW; }
    __device__ float2* bbar(int l, int d, int g) const { return (float2*)(b + OFF_BBAR) + (size_t)((l * 2 + d) * NG + g) * PS * 16; }
    __device__ float* kfull(int l, int g) const { return (float*)(b + OFF_KFULL) + (size_t)(l * NG + g) * 31 * 256; }
    __device__ bf16_t* m1(int l, int g) const { return (bf16_t*)(b + OFF_M1) + (size_t)(l * NG + g) * 256 * 256; }
    __device__ bf16_t* w2(int l, int g) const { return (bf16_t*)(b + OFF_W2) + (size_t)(l * NG + g) * 256 * 512; }
    __device__ bf16_t* hb() const { return (bf16_t*)(b + OFF_HB); }
    __device__ bf16_t* ug() const { return (bf16_t*)(b + OFF_UG); }
    __device__ bf16_t* zr() const { return (bf16_t*)(b + OFF_ZR); }
    __device__ bf16_t* hprev() const { return (bf16_t*)(b + OFF_ZR); }
    __device__ float* S() const { return (float*)(b + OFF_S); }
    __device__ bf16_t* Y() const { return (bf16_t*)(b + OFF_S); }
    __device__ bf16_t* act() const { return (bf16_t*)(b + OFF_S); }
    __device__ float* rctx() const { return (float*)(b + OFF_RCTX); }
    __device__ int* cnt(int l) const { return (int*)(b + OFF_CNT) + l * 32; }
    __device__ int* list() const { return (int*)(b + OFF_LIST); }
    __device__ float2* lw() const { return (float2*)(b + OFF_LW); }
};
__device__ __forceinline__ float* Rrow(const Params& p, int row) {
    return row < NLAT ? p.out + (size_t)row * D : (float*)(p.ws + OFF_RCTX) + (size_t)(row - NLAT) * D;
}

__device__ __forceinline__ void transpose_tile(unsigned char* lds, const float* src, int ldsrc, int k0, int n0, bf16_t* dst, int lddst, int rowmode) {
    float* tile = (float*)lds;
    const int tid = threadIdx.x;
    __syncthreads();
#pragma unroll
    for (int pass = 0; pass < 4; ++pass) {
        const int k = pass * 16 + (tid >> 4), n4 = (tid & 15) * 4;
        const float4 v = *(const float4*)(src + (size_t)(k0 + k) * ldsrc + n0 + n4);
        tile[k * 65 + n4 + 0] = v.x; tile[k * 65 + n4 + 1] = v.y; tile[k * 65 + n4 + 2] = v.z; tile[k * 65 + n4 + 3] = v.w;
    }
    __syncthreads();
#pragma unroll
    for (int t2 = 0; t2 < 2; ++t2) {
        const int task = tid + t2 * 256, n = task & 63, kc = task >> 6;
        float f[8];
#pragma unroll
        for (int i = 0; i < 8; ++i) f[i] = tile[(kc * 8 + i) * 65 + n];
        const int ng = n0 + n;
        int drow = ng;
        if (rowmode == 1) drow = ((ng >> 3) << 4) + (ng & 7);
        else if (rowmode == 2) drow = ((ng >> 3) << 4) + 8 + (ng & 7);
        uint4 o; o.x = pack2(f[0], f[1]); o.y = pack2(f[2], f[3]); o.z = pack2(f[4], f[5]); o.w = pack2(f[6], f[7]);
        *(uint4*)(dst + (size_t)drow * lddst + k0 + kc * 8) = o;
    }
}

__device__ __forceinline__ void phase_pro_a(const Params& p, unsigned char* lds) {
    const WS w{p.ws};
    const int tid = threadIdx.x;
    if (blockIdx.x == 0 && tid < 64) ((int*)(p.ws + OFF_CNT))[tid] = 0;
    constexpr int N_MOD = 2 * 6 * KSPLIT_MOD, N_TAB = 32, N_WT = 2 * 3840;
    for (int it = blockIdx.x; it < N_MOD + N_TAB + N_WT; it += gridDim.x) {
        if (it < N_MOD) {
            const int l = it / (6 * KSPLIT_MOD), rem = it % (6 * KSPLIT_MOD), cb = rem / KSPLIT_MOD, ks = rem % KSPLIT_MOD;
            float* sc = (float*)lds;
            __syncthreads();
            for (int i = tid; i < 9 * 64; i += 256) {
                const int r = i >> 6, kk = i & 63, k = ks * 64 + kk;
                const float cv = r < 8 ? p.in[1][r * D + k] : p.in[3][k];
                sc[i] = siluf_(cv);
            }
            __syncthreads();
            float acc[9][4];
#pragma unroll
            for (int r = 0; r < 9; ++r) { acc[r][0] = acc[r][1] = acc[r][2] = acc[r][3] = 0.f; }
            const float* wm = p.in[4] + ((size_t)l * D + ks * 64) * 6144 + cb * 1024 + tid * 4;
#pragma unroll 8
            for (int kk = 0; kk < 64; ++kk) {
                const float4 v = *(const float4*)(wm + (size_t)kk * 6144);
#pragma unroll
                for (int r = 0; r < 9; ++r) { const float s = sc[r * 64 + kk]; acc[r][0] += s * v.x; acc[r][1] += s * v.y; acc[r][2] += s * v.z; acc[r][3] += s * v.w; }
            }
            float* mp = w.modp() + ((size_t)(ks * 2 + l) * 9) * 6144 + cb * 1024 + tid * 4;
#pragma unroll
            for (int r = 0; r < 9; ++r) *(float4*)(mp + (size_t)r * 6144) = make_float4(acc[r][0], acc[r][1], acc[r][2], acc[r][3]);
        } else if (it < N_MOD + N_TAB) {
            const int id = (it - N_MOD) * 256 + tid;
            const int pp = id & 63, g = (id >> 6) & 31, d = (id >> 11) & 1, l = id >> 12;
            const int i3 = (l * 2 + d) * NG + g;
            const double dt = exp((double)p.in[9][i3]);
            const double are = (double)p.in[7][i3 * PS + pp], aim = (double)p.in[8][i3 * PS + pp];
            float2* lp = w.lampow(l, d, g) + pp * NPOW;
            double lbr = 0, lbi = 0;
            for (int k = 0; k < NPOW; ++k) {
                const double kk = (k == 17) ? (double)(TCH * SEGLEN) : (double)k;
                const double mag = exp(kk * are * dt);
                double s, c; sincos(kk * aim * dt, &s, &c);
                lp[k] = make_float2((float)(mag * c), (float)(mag * s));
                if (k == 1) { lbr = mag * c; lbi = mag * s; }
            }
            const double nr = lbr - 1.0, ni = lbi, den = are * are + aim * aim;
            const double cr = (nr * are + ni * aim) / den, ci = (ni * are - nr * aim) / den;
            float2* bb = w.bbar(l, d, g) + pp * 16;
            for (int n = 0; n < 16; ++n) {
                const double br = (double)p.in[10][(size_t)(i3 * PS + pp) * 16 + n], bi = (double)p.in[11][(size_t)(i3 * PS + pp) * 16 + n];
                bb[n] = make_float2((float)(cr * br - ci * bi), (float)(cr * bi + ci * br));
            }
        } else {
            int t = it - N_MOD - N_TAB;
            const int l = t / 3840; t %= 3840;
            if (t < 448) { const int kt = t / 28, nt = t % 28; transpose_tile(lds, p.in[6] + (size_t)l * D * DIN, DIN, kt * 64, nt * 64, w.wt_in(l), D, 0); }
            else if (t < 512) { t -= 448; const int kt = t / 8, nt = t % 8; transpose_tile(lds, p.in[15] + (size_t)l * 512 * 512, 512, kt * 64, nt * 64, w.wt_glu(l), 512, 0); }
            else if (t < 768) { t -= 512; const int kt = t / 16, nt = t % 16; transpose_tile(lds, p.in[22] + (size_t)l * D * D, D, kt * 64, nt * 64, w.wt_o(l), D, 0); }
            else if (t < 1792) { t -= 768; const int e = t / 64, r = t % 64, kt = r / 4, nt = r % 4; transpose_tile(lds, p.in[29] + (size_t)(l * 16 + e) * D * 256, 256, kt * 64, nt * 64, w.wt_gu(l, e), D, 1); }
            else if (t < 2816) { t -= 1792; const int e = t / 64, r = t % 64, kt = r / 4, nt = r % 4; transpose_tile(lds, p.in[30] + (size_t)(l * 16 + e) * D * 256, 256, kt * 64, nt * 64, w.wt_gu(l, e), D, 2); }
            else { t -= 2816; const int e = t / 64, r = t % 64, kt = r / 16, nt = r % 16; transpose_tile(lds, p.in[31] + (size_t)(l * 16 + e) * 256 * D, D, kt * 64, nt * 64, w.wt_dn(l, e), 256, 0); }
        }
    }
}

__device__ __forceinline__ void phase_pro_b(const Params& p) {
    const WS w{p.ws};
    const int gt = blockIdx.x * 256 + threadIdx.x, gs = gridDim.x * 256;
    for (int i = gt; i < 2 * 9 * 6144; i += gs) {
        const int l = i / (9 * 6144), n = i % 6144;
        float s = p.in[5][l * 6144 + n];
        const float* mp = w.modp() + i;
#pragma unroll
        for (int ks = 0; ks < KSPLIT_MOD; ++ks) s += mp[(size_t)ks * 2 * 9 * 6144];
        ((float*)(p.ws + OFF_MOD))[i] = s;
    }
    for (int i = gt; i < 2 * NG * 31 * 256; i += gs) {
        const int ni = i & 15, no = (i >> 4) & 15, ti = (i >> 8) % 31, lg = i / (31 * 256), g = lg & 31, l = lg >> 5;
        const int tau = ti - 15;
        float s = 0.f;
#pragma unroll
        for (int d = 0; d < 2; ++d) {
            if ((d == 0 && tau < 0) || (d == 1 && tau > 0)) continue;
            const int at = tau < 0 ? -tau : tau;
            const float2* lp = w.lampow(l, d, g);
            const float2* bb = w.bbar(l, d, g);
            const float* cre = p.in[12] + ((size_t)((l * 2 + d) * NG + g) * 16 + no) * PS;
            const float* cim = p.in[13] + ((size_t)((l * 2 + d) * NG + g) * 16 + no) * PS;
            for (int pp = 0; pp < PS; ++pp) {
                const float2 L = lp[pp * NPOW + at], Bv = bb[pp * 16 + ni];
                const float er = L.x * Bv.x - L.y * Bv.y, ei = L.x * Bv.y + L.y * Bv.x;
                s += cre[pp] * er - cim[pp] * ei;
            }
        }
        if (tau == 0 && no == ni) s += p.in[14][l * DS5 + g * 16 + no];
        ((float*)(p.ws + OFF_KFULL))[i] = s;
    }
    for (int i = gt; i < 2 * NG * 256 * 32; i += gs) {
        const int c8 = i & 31, row = (i >> 5) & 255, lg = i >> 13, g = lg & 31, l = lg >> 5;
        const int d = row >> 7, pp = (row & 127) >> 1, c = row & 1, j = c8 >> 1, n0 = (c8 & 1) * 8;
        const int e = d == 0 ? (TCH - 1 - j) : j;
        const float2 L = w.lampow(l, d, g)[pp * NPOW + e];
        const float2* bb = w.bbar(l, d, g) + pp * 16 + n0;
        float f[8];
#pragma unroll
        for (int n = 0; n < 8; ++n) { const float2 Bv = bb[n]; f[n] = c == 0 ? (L.x * Bv.x - L.y * Bv.y) : (L.x * Bv.y + L.y * Bv.x); }
        uint4 o; o.x = pack2(f[0], f[1]); o.y = pack2(f[2], f[3]); o.z = pack2(f[4], f[5]); o.w = pack2(f[6], f[7]);
        *(uint4*)(w.m1(l, g) + (size_t)row * 256 + c8 * 8) = o;
    }
}

__device__ __forceinline__ void phase_pro_c(const Params& p) {
    const WS w{p.ws};
    const int gt = blockIdx.x * 256 + threadIdx.x, gs = gridDim.x * 256;
    for (int i = gt; i < 2 * NG * 256 * 64; i += gs) {
        const int c8 = i & 63, r = (i >> 6) & 255, lg = i >> 14, g = lg & 31, l = lg >> 5;
        const int jo = r >> 4, no = r & 15;
        float f[8];
        if (c8 < 32) {
            const int ji = c8 >> 1, n0 = (c8 & 1) * 8;
            const float* kf = w.kfull(l, g) + ((size_t)(jo - ji + 15) * 16 + no) * 16 + n0;
#pragma unroll
            for (int n = 0; n < 8; ++n) f[n] = kf[n];
        } else {
            const int kk = (c8 - 32) * 8, d = kk >> 7, p0 = (kk & 127) >> 1;
            const int e = d == 0 ? (jo + 1) : (TCH - jo);
            const float* cre = p.in[12] + ((size_t)((l * 2 + d) * NG + g) * 16 + no) * PS;
            const float* cim = p.in[13] + ((size_t)((l * 2 + d) * NG + g) * 16 + no) * PS;
            const float2* lp = w.lampow(l, d, g);
#pragma unroll
            for (int q = 0; q < 4; ++q) {
                const int pp = p0 + q;
                const float2 L = lp[pp * NPOW + e];
                const float cr = cre[pp], ci = cim[pp];
                f[2 * q] = cr * L.x - ci * L.y;
                f[2 * q + 1] = -(cr * L.y + ci * L.x);
            }
        }
        uint4 o; o.x = pack2(f[0], f[1]); o.y = pack2(f[2], f[3]); o.z = pack2(f[4], f[5]); o.w = pack2(f[6], f[7]);
        *(uint4*)(w.w2(l, g) + (size_t)r * 512 + c8 * 8) = o;
    }
    const float* md = w.mod(0);
    for (int i = gt; i < NROW * 128; i += gs) {
        const int row = i >> 7, c8 = (i & 127) * 8, m = modrow(row);
        const float* xs = row < NLAT ? p.in[0] + (size_t)row * D : p.in[2] + (size_t)(row - NLAT) * D;
        const float4 a = *(const float4*)(xs + c8), b = *(const float4*)(xs + c8 + 4);
        const float* sh = md + (size_t)m * 6144 + c8; const float* sc = sh + 1024;
        const float4 s0 = *(const float4*)sh, s1 = *(const float4*)(sh + 4), c0 = *(const float4*)sc, c1 = *(const float4*)(sc + 4);
        uint4 o;
        o.x = pack2(a.x * (1.f + c0.x) + s0.x, a.y * (1.f + c0.y) + s0.y);
        o.y = pack2(a.z * (1.f + c0.z) + s0.z, a.w * (1.f + c0.w) + s0.w);
        o.z = pack2(b.x * (1.f + c1.x) + s1.x, b.y * (1.f + c1.y) + s1.y);
        o.w = pack2(b.z * (1.f + c1.z) + s1.z, b.w * (1.f + c1.w) + s1.w);
        *(uint4*)(w.hb() + (size_t)row * D + c8) = o;
    }
}

struct EpiInproj {
    bf16_t* ug; bf16_t* zr; int m0, n0;
    __device__ __forceinline__ void operator()(const f32x16 (&acc)[2][2], int r0, int c0) const {
        ACC_FOREACH(acc, r0, c0, {
            const int row = m0 + rl, col = n0 + cl;
            uint2 o; o.x = pack2(v0, v1); o.y = pack2(v2, v3);
            if (col < DS5) *(uint2*)(ug + ((size_t)(col >> 4) * NROW + row) * 16 + (col & 15)) = o;
            else *(uint2*)(zr + (size_t)row * 1280 + (col - DS5)) = o;
        })
    }
};
__device__ __forceinline__ void phase_inproj(const Params& p, unsigned char* lds, int l) {
    const WS w{p.ws};
    const int nfull = (l == 0 ? 144 : 128) * 14, ntile = nfull + (l == 0 ? 0 : 16 * 4);
    for (int t = blockIdx.x; t < ntile; t += gridDim.x) {
        int mt, nt;
        if (t < nfull) { mt = t / 14; nt = t % 14; } else { mt = 128 + (t - nfull) / 4; nt = (t - nfull) % 4; }
        Src4 A, B;
        src_plain(A, w.hb(), mt * 128, D);
        src_plain(B, w.wt_in(l), nt * 128, D);
        EpiInproj e{w.ug(), w.zr(), mt * 128, nt * 128};
        gemm128(lds, A, B, D, e);
    }
}

struct EpiS1 {
    float* S; int m0, n0;
    __device__ __forceinline__ void operator()(const f32x16 (&acc)[2][2], int r0, int c0) const {
        ACC_FOREACH(acc, r0, c0, {
            *(float4*)(S + (size_t)(m0 + rl) * 256 + n0 + cl) = make_float4(v0, v1, v2, v3);
        })
    }
};

__device__ __forceinline__ void conv_sc(const Params& p, int l, int nrows) {
    const WS w{p.ws};
    const float* wsc = p.in[17] + (size_t)l * 3 * 256;
    const int gt = blockIdx.x * 256 + threadIdx.x, gs = gridDim.x * 256;
    for (int i = gt; i < nrows * 32; i += gs) {
        const int row = i >> 5, c8 = (i & 31) * 8;
        int pos, len;
        if (row < NLAT) { pos = row & 63; len = 64; } else { pos = (row - NLAT) & 255; len = 256; }
        const bf16_t* zr = w.zr() + (size_t)row * 1280;
        float accv[8];
#pragma unroll
        for (int e = 0; e < 8; ++e) accv[e] = 0.f;
#pragma unroll
        for (int j = -1; j <= 1; ++j) {
            if (pos + j < 0 || pos + j >= len) continue;
            const uint4 cg = *(const uint4*)(zr + (ptrdiff_t)j * 1280 + 256 + c8);
            const uint4 vv = *(const uint4*)(zr + (ptrdiff_t)j * 1280 + 512 + c8);
            const float4 wa = *(const float4*)(wsc + (j + 1) * 256 + c8), wb = *(const float4*)(wsc + (j + 1) * 256 + c8 + 4);
            accv[0] += wa.x * bflo(cg.x) * bflo(vv.x); accv[1] += wa.y * bfhi(cg.x) * bfhi(vv.x);
            accv[2] += wa.z * bflo(cg.y) * bflo(vv.y); accv[3] += wa.w * bfhi(cg.y) * bfhi(vv.y);
            accv[4] += wb.x * bflo(cg.z) * bflo(vv.z); accv[5] += wb.y * bfhi(cg.z) * bfhi(vv.z);
            accv[6] += wb.z * bflo(cg.w) * bflo(vv.w); accv[7] += wb.w * bfhi(cg.w) * bfhi(vv.w);
        }
        const uint4 bg = *(const uint4*)(zr + c8);
        uint4 o;
        o.x = pack2(accv[0] * bflo(bg.x), accv[1] * bfhi(bg.x));
        o.y = pack2(accv[2] * bflo(bg.y), accv[3] * bfhi(bg.y));
        o.z = pack2(accv[4] * bflo(bg.z), accv[5] * bfhi(bg.z));
        o.w = pack2(accv[6] * bflo(bg.w), accv[7] * bfhi(bg.w));
        *(uint4*)(w.hb() + (size_t)row * D + 512 + c8) = o;
    }
}

__device__ __forceinline__ void conv_cf(const Params& p, unsigned char* lds, int l, bool with_ctx) {
    const WS w{p.ws};
    float* P = (float*)lds;
    const int tid = threadIdx.x, lane = tid & 63, wid = tid >> 6;
    const float* wdw = p.in[18] + (size_t)l * 31 * 256;
    const float4 bdw = *(const float4*)(p.in[19] + l * 256 + lane * 4);
    const float4 lg = *(const float4*)(p.in[20] + l * 256 + lane * 4);
    const float4 lb = *(const float4*)(p.in[21] + l * 256 + lane * 4);
    const int nitem = 256 + (with_ctx ? 64 : 0);
    for (int it = blockIdx.x; it < nitem; it += gridDim.x) {
        const bool lat = it < 256;
        int b, base, nslot, sstride, s0 = 0;
        if (lat) { b = it >> 5; base = b * SEQ + (it & 31) * 2; nslot = 64; sstride = 2; }
        else { const int j = it - 256; b = j >> 3; s0 = (j & 7) * 32; base = NLAT + b * CTX; nslot = 62; sstride = 1; }
        __syncthreads();
        for (int task = tid; task < 64 * 32; task += 256) {
            const int slot = task >> 5, c8 = (task & 31) * 8;
            int row; bool valid = true;
            if (lat) row = base + (slot >> 1) * 64 + (slot & 1);
            else { const int s = s0 - 15 + slot; valid = (slot < nslot) && s >= 0 && s < CTX; row = base + s; }
            float f[8];
            if (valid) {
                const bf16_t* zr = w.zr() + (size_t)row * 1280;
                const uint4 ga = *(const uint4*)(zr + 768 + c8), gb = *(const uint4*)(zr + 1024 + c8);
                f[0] = bflo(ga.x) * sigmoidf_(bflo(gb.x)); f[1] = bfhi(ga.x) * sigmoidf_(bfhi(gb.x));
                f[2] = bflo(ga.y) * sigmoidf_(bflo(gb.y)); f[3] = bfhi(ga.y) * sigmoidf_(bfhi(gb.y));
                f[4] = bflo(ga.z) * sigmoidf_(bflo(gb.z)); f[5] = bfhi(ga.z) * sigmoidf_(bfhi(gb.z));
                f[6] = bflo(ga.w) * sigmoidf_(bflo(gb.w)); f[7] = bfhi(ga.w) * sigmoidf_(bfhi(gb.w));
            } else {
#pragma unroll
                for (int e = 0; e < 8; ++e) f[e] = 0.f;
            }
            *(float4*)(P + slot * 256 + c8) = make_float4(f[0], f[1], f[2], f[3]);
            *(float4*)(P + slot * 256 + c8 + 4) = make_float4(f[4], f[5], f[6], f[7]);
        }
        __syncthreads();
        const int nout = lat ? 64 : 32;
        for (int o = wid; o < nout; o += 4) {
            float4 a = bdw;
            int row;
            if (lat) {
                const int r = o >> 1, i = o & 1;
                row = base + r * 64 + i;
                for (int k = 0; k < 31; ++k) {
                    const int rr = r + k - 15;
                    if (rr < 0 || rr >= 32) continue;
                    const float4 wv = *(const float4*)(wdw + k * 256 + lane * 4);
                    const float4 pv = *(const float4*)(P + (rr * 2 + i) * 256 + lane * 4);
                    a.x += wv.x * pv.x; a.y += wv.y * pv.y; a.z += wv.z * pv.z; a.w += wv.w * pv.w;
                }
            } else {
                row = base + s0 + o;
                for (int k = 0; k < 31; ++k) {
                    const float4 wv = *(const float4*)(wdw + k * 256 + lane * 4);
                    const float4 pv = *(const float4*)(P + (o + k) * 256 + lane * 4);
                    a.x += wv.x * pv.x; a.y += wv.y * pv.y; a.z += wv.z * pv.z; a.w += wv.w * pv.w;
                }
            }
            const float mean = wave_sum(a.x + a.y + a.z + a.w) * (1.0f / 256.0f);
            const float dx = a.x - mean, dy = a.y - mean, dz = a.z - mean, dw = a.w - mean;
            const float var = wave_sum(dx * dx + dy * dy + dz * dz + dw * dw) * (1.0f / 256.0f);
            const float rs = rsqrtf(var + LN_EPS);
            const float y0 = siluf_(dx * rs * lg.x + lb.x), y1 = siluf_(dy * rs * lg.y + lb.y), y2 = siluf_(dz * rs * lg.z + lb.z), y3 = siluf_(dw * rs * lg.w + lb.w);
            uint2 ov; ov.x = pack2(y0, y1); ov.y = pack2(y2, y3);
            *(uint2*)(w.hb() + (size_t)row * D + 768 + lane * 4) = ov;
        }
    }
}

__device__ __forceinline__ void phase_s1(const Params& p, unsigned char* lds, int l) {
    const WS w{p.ws};
    const int ntile = NG * 9 * 2;
    for (int t = blockIdx.x; t < ntile; t += gridDim.x) {
        const int g = t / 18, r = t % 18, mt = r >> 1, nt = r & 1;
        Src4 A, B;
        src_plain(A, w.ug() + (size_t)g * NROW * 16, mt * 128, 256);
        src_plain(B, w.m1(l, g), nt * 128, 256);
        EpiS1 e{w.S() + (size_t)g * NCOL * 256, mt * 128, nt * 128};
        gemm128(lds, A, B, 256, e);
    }
    conv_sc(p, l, l == 0 ? NROW : NLAT);
    conv_cf(p, lds, l, l == 0);
}

__device__ __forceinline__ int chunk_col(int d, int b, int step) {
    if (step < CH_CTX) { const int c = d == 0 ? step : (CH_CTX - 1 - step); return NCOL_LAT + b * CH_CTX + c; }
    const int s = step - CH_CTX; const int c = d == 0 ? s : (CH_LAT - 1 - s); return b * CH_LAT + c;
}
__device__ __forceinline__ void phase_s2(const Params& p, unsigned char* lds, int l) {
    const WS w{p.ws};
    float2* Fs = (float2*)lds;
    const int tid = threadIdx.x, seg = tid >> 5, pl = tid & 31;
    for (int it = blockIdx.x; it < NG * 2 * NB * 2; it += gridDim.x) {
        const int ph = it & 1, b = (it >> 1) & 7, d = (it >> 4) & 1, g = it >> 5;
        const int pp = ph * 32 + pl;
        const float2 A = w.lampow(l, d, g)[pp * NPOW + 16], A18 = w.lampow(l, d, g)[pp * NPOW + 17];
        const float* S = w.S() + (size_t)g * NCOL * 256 + d * 128 + 2 * pp;
        bf16_t* Hp = w.hprev() + (size_t)g * NCOL * 256 + d * 128 + 2 * pp;
        float2 s[SEGLEN];
#pragma unroll
        for (int i = 0; i < SEGLEN; ++i) s[i] = *(const float2*)(S + (size_t)chunk_col(d, b, seg * SEGLEN + i) * 256);
        float2 F = make_float2(0.f, 0.f);
#pragma unroll
        for (int i = 0; i < SEGLEN; ++i) { const float fr = A.x * F.x - A.y * F.y + s[i].x, fi = A.x * F.y + A.y * F.x + s[i].y; F.x = fr; F.y = fi; }
        __syncthreads();
        Fs[seg * 32 + pl] = F;
        __syncthreads();
        float2 H = make_float2(0.f, 0.f);
        for (int q = 0; q < seg; ++q) { const float2 f = Fs[q * 32 + pl]; const float hr = A18.x * H.x - A18.y * H.y + f.x, hi = A18.x * H.y + A18.y * H.x + f.y; H.x = hr; H.y = hi; }
#pragma unroll
        for (int i = 0; i < SEGLEN; ++i) {
            *(unsigned*)(Hp + (size_t)chunk_col(d, b, seg * SEGLEN + i) * 256) = pack2(H.x, H.y);
            const float hr = A.x * H.x - A.y * H.y + s[i].x, hi = A.x * H.y + A.y * H.x + s[i].y; H.x = hr; H.y = hi;
        }
    }
}

struct EpiS3 {
    bf16_t* Y; int m0, n0, g;
    __device__ __forceinline__ void operator()(const f32x16 (&acc)[2][2], int r0, int c0) const {
        ACC_FOREACH(acc, r0, c0, {
            const int col = n0 + cl, tok = (m0 + rl) * TCH + (col >> 4);
            uint2 o; o.x = pack2(gelu_tanh(v0), gelu_tanh(v1)); o.y = pack2(gelu_tanh(v2), gelu_tanh(v3));
            *(uint2*)(Y + (size_t)tok * DS5 + g * 16 + (col & 15)) = o;
        })
    }
};
__device__ __forceinline__ void phase_s3(const Params& p, unsigned char* lds, int l) {
    const WS w{p.ws};
    const int nmt = l == 0 ? 9 : 8, ntile = NG * nmt * 2;
    for (int t = blockIdx.x; t < ntile; t += gridDim.x) {
        const int g = t / (nmt * 2), r = t % (nmt * 2), mt = r >> 1, nt = r & 1;
        Src4 A, B;
        src_split(A, w.ug() + (size_t)g * NROW * 16, 256, w.hprev() + (size_t)g * NCOL * 256, 256, mt * 128, 256);
        src_plain(B, w.w2(l, g), nt * 128, 512);
        EpiS3 e{w.Y(), mt * 128, nt * 128, g};
        gemm128(lds, A, B, 512, e);
    }
}

struct EpiGlu {
    const bf16_t* Y; bf16_t* hb; const float* bg; int m0, n0;
    __device__ __forceinline__ void operator()(const f32x16 (&acc)[2][2], int r0, int c0) const {
        ACC_FOREACH(acc, r0, c0, {
            const int row = m0 + rl, col = n0 + cl;
            const uint2 t = *(const uint2*)(Y + (size_t)row * DS5 + col);
            const float4 b = *(const float4*)(bg + col);
            uint2 o;
            o.x = pack2(bflo(t.x) * sigmoidf_(v0 + b.x), bfhi(t.x) * sigmoidf_(v1 + b.y));
            o.y = pack2(bflo(t.y) * sigmoidf_(v2 + b.z), bfhi(t.y) * sigmoidf_(v3 + b.w));
            *(uint2*)(hb + (size_t)row * D + col) = o;
        })
    }
};
__device__ __forceinline__ void phase_glu(const Params& p, unsigned char* lds, int l) {
    const WS w{p.ws};
    const int nmt = l == 0 ? 144 : 128, ntile = nmt * 4;
    for (int t = blockIdx.x; t < ntile; t += gridDim.x) {
        const int mt = t >> 2, nt = t & 3;
        Src4 A, B;
        src_plain(A, w.Y(), mt * 128, DS5);
        src_plain(B, w.wt_glu(l), nt * 128, 512);
        EpiGlu e{w.Y(), w.hb(), p.in[16] + l * DS5, mt * 128, nt * 128};
        gemm128(lds, A, B, 512, e);
    }
}

struct EpiOut {
    const Params* p; const float* mod; int l, m0, n0;
    __device__ __forceinline__ void operator()(const f32x16 (&acc)[2][2], int r0, int c0) const {
        ACC_FOREACH(acc, r0, c0, {
            const int row = m0 + rl, col = n0 + cl, m = modrow(row);
            const float4 g1 = *(const float4*)(mod + (size_t)m * 6144 + 2048 + col);
            float* R = Rrow(*p, row) + col;
            const float* res = l == 0 ? (row < NLAT ? p->in[0] + (size_t)row * D + col : p->in[2] + (size_t)(row - NLAT) * D + col) : R;
            const float4 x = *(const float4*)res;
            *(float4*)R = make_float4(DN_ALPHA * x.x + g1.x * v0, DN_ALPHA * x.y + g1.y * v1, DN_ALPHA * x.z + g1.z * v2, DN_ALPHA * x.w + g1.w * v3);
        })
    }
};
__device__ __forceinline__ void phase_outproj(const Params& p, unsigned char* lds, int l) {
    const WS w{p.ws};
    const int nmt = l == 0 ? 144 : 128, ntile = nmt * 8;
    for (int t = blockIdx.x; t < ntile; t += gridDim.x) {
        const int mt = t >> 3, nt = t & 7;
        Src4 A, B;
        src_plain(A, w.hb(), mt * 128, D);
        src_plain(B, w.wt_o(l), nt * 128, D);
        EpiOut e{&p, w.mod(l), l, mt * 128, nt * 128};
        gemm128(lds, A, B, D, e);
    }
}

__device__ __forceinline__ void phase_ln1(const Params& p, unsigned char* lds, int l) {
    const WS w{p.ws};
    const int tid = threadIdx.x, lane = tid & 63, wid = tid >> 6;
    float* wl = (float*)lds;
    __syncthreads();
    for (int i = tid; i < 1024 * 20; i += 256) {
        const int k = i / 20, o = i % 20;
        const float v = o < 4 ? p.in[25][((size_t)l * D + k) * 4 + o] : p.in[27][((size_t)l * D + k) * 16 + (o - 4)];
        const int s = ((k >> 8) * 4 + (k & 3)) * 64 + ((k >> 2) & 63);
        wl[((o >> 2) * 1024 + s) * 4 + (o & 3)] = v;
    }
    __syncthreads();
    const int nrows = l == 0 ? NROW : NLAT;
    const float* md = w.mod(l);
    const float* lng = p.in[23] + l * D; const float* lnb = p.in[24] + l * D;
    for (int row = blockIdx.x * 4 + wid; row < nrows; row += gridDim.x * 4) {
        float* R = Rrow(p, row);
        const int m = modrow(row);
        float h[16];
        float4 v[4];
#pragma unroll
        for (int i = 0; i < 4; ++i) v[i] = *(const float4*)(R + i * 256 + lane * 4);
        float s = 0.f;
#pragma unroll
        for (int i = 0; i < 4; ++i) s += (v[i].x + v[i].y) + (v[i].z + v[i].w);
        const float mean = wave_sum(s) * (1.0f / 1024.0f);
        float q = 0.f;
#pragma unroll
        for (int i = 0; i < 4; ++i) { const float a = v[i].x - mean, b = v[i].y - mean, c = v[i].z - mean, d = v[i].w - mean; q += (a * a + b * b) + (c * c + d * d); }
        const float rs = rsqrtf(wave_sum(q) * (1.0f / 1024.0f) + LN_EPS);
#pragma unroll
        for (int i = 0; i < 4; ++i) {
            const int col = i * 256 + lane * 4;
            const float4 g = *(const float4*)(lng + col), b = *(const float4*)(lnb + col);
            const float4 sh = *(const float4*)(md + (size_t)m * 6144 + 3072 + col), sc = *(const float4*)(md + (size_t)m * 6144 + 4096 + col);
            float4 x;
            x.x = (v[i].x - mean) * rs * g.x + b.x; x.y = (v[i].y - mean) * rs * g.y + b.y; x.z = (v[i].z - mean) * rs * g.z + b.z; x.w = (v[i].w - mean) * rs * g.w + b.w;
            *(float4*)(R + col) = x;
            h[i * 4 + 0] = x.x * (1.f + sc.x) + sh.x; h[i * 4 + 1] = x.y * (1.f + sc.y) + sh.y; h[i * 4 + 2] = x.z * (1.f + sc.z) + sh.z; h[i * 4 + 3] = x.w * (1.f + sc.w) + sh.w;
            uint2 o; o.x = pack2(h[i * 4 + 0], h[i * 4 + 1]); o.y = pack2(h[i * 4 + 2], h[i * 4 + 3]);
            *(uint2*)(w.hb() + (size_t)row * D + col) = o;
        }
        float mylg = 0.f;
#pragma unroll 1
        for (int o4 = 0; o4 < 5; ++o4) {
            float a0 = 0.f, a1 = 0.f, a2 = 0.f, a3 = 0.f;
#pragma unroll
            for (int e = 0; e < 16; ++e) {
                const float4 wv = *(const float4*)(wl + ((o4 * 1024) + e * 64 + lane) * 4);
                a0 += h[e] * wv.x; a1 += h[e] * wv.y; a2 += h[e] * wv.z; a3 += h[e] * wv.w;
            }
            a0 = wave_sum(a0); a1 = wave_sum(a1); a2 = wave_sum(a2); a3 = wave_sum(a3);
            if (lane == o4 * 4 + 0) mylg = a0;
            if (lane == o4 * 4 + 1) mylg = a1;
            if (lane == o4 * 4 + 2) mylg = a2;
            if (lane == o4 * 4 + 3) mylg = a3;
        }
        float lg[20];
#pragma unroll
        for (int i = 0; i < 20; ++i) lg[i] = __shfl(mylg, i);
        if (lane == 0) {
            float gl[4];
#pragma unroll
            for (int i = 0; i < 4; ++i) gl[i] = lg[i] + p.in[26][l * 4 + i];
            int gi = 0; float gm = gl[0];
#pragma unroll
            for (int i = 1; i < 4; ++i) if (gl[i] > gm) { gm = gl[i]; gi = i; }
            float den = 0.f;
#pragma unroll
            for (int i = 0; i < 4; ++i) den += __expf(gl[i] - gm);
            const float gw = 1.0f / den;
            float el[4];
#pragma unroll
            for (int i = 0; i < 4; ++i) {
                float t = lg[4 + i];
                if (gi == 1) t = lg[8 + i]; else if (gi == 2) t = lg[12 + i]; else if (gi == 3) t = lg[16 + i];
                el[i] = t + p.in[28][l * 16 + gi * 4 + i];
            }
            int i1 = 0; float m1 = el[0];
#pragma unroll
            for (int i = 1; i < 4; ++i) if (el[i] > m1) { m1 = el[i]; i1 = i; }
            int i2 = -1; float m2 = -3.0e38f;
#pragma unroll
            for (int i = 0; i < 4; ++i) if (i != i1 && el[i] > m2) { m2 = el[i]; i2 = i; }
            const float e2 = __expf(m2 - m1);
            const float w1 = gw / (1.0f + e2), w2 = gw * e2 / (1.0f + e2);
            const int lo = i1 < i2 ? i1 : i2, hi = i1 < i2 ? i2 : i1;
            const float wlo = i1 < i2 ? w1 : w2, whi = i1 < i2 ? w2 : w1;
            const int pair = lo == 0 ? (hi - 1) : (lo == 1 ? (hi + 1) : 5);
            const int cls = gi * 6 + pair;
            const int pos = atomicAdd(w.cnt(l) + cls, 1);
            w.list()[(size_t)cls * LISTCAP + pos] = row;
            w.lw()[(size_t)cls * LISTCAP + pos] = make_float2(wlo, whi);
        }
    }
}

__device__ __forceinline__ void cls_experts(int cls, int& elo, int& ehi) {
    const int g = cls / 6, pr = cls % 6;
    const int lo = pr < 3 ? 0 : (pr < 5 ? 1 : 2);
    const int hi = pr < 3 ? pr + 1 : (pr < 5 ? pr - 1 : 3);
    elo = g * 4 + lo; ehi = g * 4 + hi;
}

struct EpiGU {
    bf16_t* act; const float2* lw; int cnt, pos0, orow0, half, fcol0;
    __device__ __forceinline__ void operator()(const f32x16 (&acc)[2][2], int r0, int c0) const {
        const int hh4 = c0 & 4, wn64 = c0 & 64;
#pragma unroll
        for (int mt = 0; mt < 2; ++mt) {
            const int rl = r0 + mt * 32, pos = pos0 + rl;
            float wt = 0.f;
            if (pos < cnt) { const float2 ww = lw[pos]; wt = half ? ww.y : ww.x; }
#pragma unroll
            for (int nt = 0; nt < 2; ++nt)
#pragma unroll
                for (int qp = 0; qp < 2; ++qp) {
                    const int f = fcol0 + ((wn64 + nt * 32) >> 1) + qp * 8 + hh4;
                    const int qg = qp * 2, qu = qp * 2 + 1;
                    const float a0 = siluf_(acc[mt][nt][qg * 4 + 0]) * acc[mt][nt][qu * 4 + 0] * wt;
                    const float a1 = siluf_(acc[mt][nt][qg * 4 + 1]) * acc[mt][nt][qu * 4 + 1] * wt;
                    const float a2 = siluf_(acc[mt][nt][qg * 4 + 2]) * acc[mt][nt][qu * 4 + 2] * wt;
                    const float a3 = siluf_(acc[mt][nt][qg * 4 + 3]) * acc[mt][nt][qu * 4 + 3] * wt;
                    uint2 o; o.x = pack2(a0, a1); o.y = pack2(a2, a3);
                    *(uint2*)(act + (size_t)(orow0 + rl) * 512 + half * 256 + f) = o;
                }
        }
    }
};
__device__ __forceinline__ void phase_moe_gu(const Params& p, unsigned char* lds, int l) {
    const WS w{p.ws};
    int ntl[NCLS]; int tot = 0;
#pragma unroll
    for (int c = 0; c < NCLS; ++c) { ntl[c] = (w.cnt(l)[c] + 127) >> 7; tot += ntl[c]; }
    const int ntile = tot * 8;
    const int lr = threadIdx.x >> 3, lc = threadIdx.x & 7;
    for (int t = blockIdx.x; t < ntile; t += gridDim.x) {
        const int mg = t >> 3, nt = t & 7;
        int cls = 0, mt = 0, run = 0;
#pragma unroll
        for (int c = 0; c < NCLS; ++c) { if (mg >= run && mg < run + ntl[c]) { cls = c; mt = mg - run; } run += ntl[c]; }
        const int cnt = w.cnt(l)[cls];
        int elo, ehi; cls_experts(cls, elo, ehi);
        const int half = nt >> 2, e = half ? ehi : elo;
        const int* lst = w.list() + (size_t)cls * LISTCAP;
        Src4 A, B;
#pragma unroll
        for (int j = 0; j < 4; ++j) {
            int pos = mt * 128 + lr + 32 * j; if (pos >= cnt) pos = 0;
            const int tok = lst[pos];
            A.p0[j] = w.hb() + (size_t)tok * D + lc * 8; A.p1[j] = A.p0[j];
        }
        A.split = 1 << 30;
        src_plain(B, w.wt_gu(l, e), (nt & 3) * 128, D);
        EpiGU ep{w.act(), w.lw() + (size_t)cls * LISTCAP, cnt, mt * 128, mg * 128, half, (nt & 3) * 64};
        gemm128(lds, A, B, D, ep);
    }
}

struct EpiDown {
    const Params* p; const float* mod; const int* lst; int cnt, pos0, n0;
    __device__ __forceinline__ void operator()(const f32x16 (&acc)[2][2], int r0, int c0) const {
#pragma unroll
        for (int mt = 0; mt < 2; ++mt) {
            const int pos = pos0 + r0 + mt * 32;
            if (pos < cnt) {
                const int row = lst[pos], m = modrow(row);
                float* R = Rrow(*p, row);
#pragma unroll
                for (int nt = 0; nt < 2; ++nt)
#pragma unroll
                    for (int q = 0; q < 4; ++q) {
                        const int col = n0 + c0 + nt * 32 + q * 8;
                        const float4 g2 = *(const float4*)(mod + (size_t)m * 6144 + 5120 + col);
                        const float4 x = *(const float4*)(R + col);
                        *(float4*)(R + col) = make_float4(DN_ALPHA * x.x + g2.x * acc[mt][nt][q * 4 + 0], DN_ALPHA * x.y + g2.y * acc[mt][nt][q * 4 + 1],
                                                          DN_ALPHA * x.z + g2.z * acc[mt][nt][q * 4 + 2], DN_ALPHA * x.w + g2.w * acc[mt][nt][q * 4 + 3]);
                    }
            }
        }
    }
};
__device__ __forceinline__ void phase_moe_dn(const Params& p, unsigned char* lds, int l) {
    const WS w{p.ws};
    int ntl[NCLS]; int tot = 0;
#pragma unroll
    for (int c = 0; c < NCLS; ++c) { ntl[c] = (w.cnt(l)[c] + 127) >> 7; tot += ntl[c]; }
    const int ntile = tot * 8;
    for (int t = blockIdx.x; t < ntile; t += gridDim.x) {
        const int mg = t >> 3, nt = t & 7;
        int cls = 0, mt = 0, run = 0;
#pragma unroll
        for (int c = 0; c < NCLS; ++c) { if (mg >= run && mg < run + ntl[c]) { cls = c; mt = mg - run; } run += ntl[c]; }
        const int cnt = w.cnt(l)[cls];
        int elo, ehi; cls_experts(cls, elo, ehi);
        Src4 A, B;
        src_plain(A, w.act(), mg * 128, 512);
        src_split(B, w.wt_dn(l, elo), 256, w.wt_dn(l, ehi), 256, nt * 128, 256);
        EpiDown ep{&p, w.mod(l), w.list() + (size_t)cls * LISTCAP, cnt, mt * 128, nt * 128};
        gemm128(lds, A, B, 512, ep);
    }
}

__device__ __forceinline__ void phase_ln2(const Params& p, int l) {
    const WS w{p.ws};
    const int tid = threadIdx.x, lane = tid & 63, wid = tid >> 6;
    const int nrows = l == 0 ? NROW : NLAT;
    const float* lng = p.in[32] + l * D; const float* lnb = p.in[33] + l * D;
    const float* mdn = w.mod(1);
    for (int row = blockIdx.x * 4 + wid; row < nrows; row += gridDim.x * 4) {
        float* R = Rrow(p, row);
        const int m = modrow(row);
        float4 v[4];
#pragma unroll
        for (int i = 0; i < 4; ++i) v[i] = *(const float4*)(R + i * 256 + lane * 4);
        float s = 0.f;
#pragma unroll
        for (int i = 0; i < 4; ++i) s += (v[i].x + v[i].y) + (v[i].z + v[i].w);
        const float mean = wave_sum(s) * (1.0f / 1024.0f);
        float q = 0.f;
#pragma unroll
        for (int i = 0; i < 4; ++i) { const float a = v[i].x - mean, b = v[i].y - mean, c = v[i].z - mean, d = v[i].w - mean; q += (a * a + b * b) + (c * c + d * d); }
        const float rs = rsqrtf(wave_sum(q) * (1.0f / 1024.0f) + LN_EPS);
#pragma unroll
        for (int i = 0; i < 4; ++i) {
            const int col = i * 256 + lane * 4;
            const float4 g = *(const float4*)(lng + col), b = *(const float4*)(lnb + col);
            float4 x;
            x.x = (v[i].x - mean) * rs * g.x + b.x; x.y = (v[i].y - mean) * rs * g.y + b.y; x.z = (v[i].z - mean) * rs * g.z + b.z; x.w = (v[i].w - mean) * rs * g.w + b.w;
            *(float4*)(R + col) = x;
            if (l == 0) {
                const float4 sh = *(const float4*)(mdn + (size_t)m * 6144 + col), sc = *(const float4*)(mdn + (size_t)m * 6144 + 1024 + col);
                uint2 o; o.x = pack2(x.x * (1.f + sc.x) + sh.x, x.y * (1.f + sc.y) + sh.y); o.y = pack2(x.z * (1.f + sc.z) + sh.z, x.w * (1.f + sc.w) + sh.w);
                *(uint2*)(w.hb() + (size_t)row * D + col) = o;
            }
        }
    }
}

constexpr int NPHASE = 3 + 2 * 10;
__global__ void __launch_bounds__(256, 2) mega(Params p, int ph_lo, int ph_hi) {
    __shared__ __attribute__((aligned(16))) unsigned char lds[LDS_BYTES];
    cg::grid_group grid = cg::this_grid();
#define RUN(idx, ...) if (ph_lo <= (idx) && (idx) < ph_hi) { __VA_ARGS__; if ((idx) + 1 < ph_hi) grid.sync(); }
    RUN(0, phase_pro_a(p, lds))
    RUN(1, phase_pro_b(p))
    RUN(2, phase_pro_c(p))
#define LAYER(l) \
    RUN(3 + 10 * l + 0, phase_inproj(p, lds, l)) \
    RUN(3 + 10 * l + 1, phase_s1(p, lds, l)) \
    RUN(3 + 10 * l + 2, phase_s2(p, lds, l)) \
    RUN(3 + 10 * l + 3, phase_s3(p, lds, l)) \
    RUN(3 + 10 * l + 4, phase_glu(p, lds, l)) \
    RUN(3 + 10 * l + 5, phase_outproj(p, lds, l)) \
    RUN(3 + 10 * l + 6, phase_ln1(p, lds, l)) \
    RUN(3 + 10 * l + 7, phase_moe_gu(p, lds, l)) \
    RUN(3 + 10 * l + 8, phase_moe_dn(p, lds, l)) \
    RUN(3 + 10 * l + 9, phase_ln2(p, l))
    LAYER(0)
    LAYER(1)
#undef LAYER
#undef RUN
}

extern "C" void kernel_launch(void* const* d_in, const int* in_sizes, int n_in, void* d_out, int out_size, void* d_ws, size_t ws_size, hipStream_t stream) {
    static int grid_blocks = 0;
    if (grid_blocks == 0) {
        if (n_in != 34 || out_size != NLAT * D || ws_size < WS_END) {
            fprintf(stderr, "kernel_launch: unexpected shapes (n_in %d out %d ws %zu need %zu)\n", n_in, out_size, ws_size, (size_t)WS_END);
            grid_blocks = -1; return;
        }
        int dev = 0, cus = 0, per_cu = 0;
        hipGetDevice(&dev);
        hipDeviceGetAttribute(&cus, hipDeviceAttributeMultiprocessorCount, dev);
        hipOccupancyMaxActiveBlocksPerMultiprocessor(&per_cu, (const void*)mega, 256, 0);
        if (per_cu < 1) per_cu = 1;
        if (per_cu > 2) per_cu = 2;
        grid_blocks = cus * per_cu;
        fprintf(stderr, "kernel_launch: cus %d per_cu %d grid %d ws need %zu have %zu\n", cus, per_cu, grid_blocks, (size_t)WS_END, ws_size);
    }
    if (grid_blocks < 0) return;
    Params p{};
    for (int i = 0; i < 34; ++i) p.in[i] = (const float*)d_in[i];
    p.out = (float*)d_out; p.ws = (unsigned char*)d_ws;
#if FUSED
    int lo = 0, hi = NPHASE;
    void* args[] = {&p, &lo, &hi};
    hipError_t e = hipLaunchCooperativeKernel((const void*)mega, dim3(grid_blocks), dim3(256), args, 0, stream);
    if (e != hipSuccess) fprintf(stderr, "cooperative launch failed: %s (grid %d)\n", hipGetErrorString(e), grid_blocks);
#else
    for (int ph = 0; ph < NPHASE; ++ph) hipLaunchKernelGGL(mega, dim3(grid_blocks), dim3(256), 0, stream, p, ph, ph + 1);
#endif
}
```

```cpp
#include <hip/hip_runtime.h>
#include <hip/hip_cooperative_groups.h>
#include <cstdio>
#include <cstdint>
namespace cg = cooperative_groups;

#ifndef FUSED
#define FUSED 1
#endif

typedef unsigned short bf16_t;
typedef __attribute__((ext_vector_type(8))) short bf16x8;
typedef __attribute__((ext_vector_type(16))) float f32x16;

constexpr int D = 1024, NB = 8, SEQ = 2048, CTX = 256;
constexpr int NLAT = NB * SEQ, NCTX = NB * CTX, NROW = NLAT + NCTX;
constexpr int DIN = 1792, DS5 = 512, NG = 32, PS = 64;
constexpr int TCH = 16, NT = 256;
constexpr int NCOL = NROW / TCH;
constexpr int NCOL_LAT = NLAT / TCH;
constexpr int CH_LAT = SEQ / TCH, CH_CTX = CTX / TCH;
constexpr int NSTEP = CH_LAT + CH_CTX;
constexpr int NSEG = 8, SEGLEN = NSTEP / NSEG;
constexpr int NCLS = 24, LISTCAP = NROW;
constexpr int MAXMT = NROW / 128 + NCLS;
constexpr int KSPLIT_MOD = 16;
constexpr float LN_EPS = 1e-5f;
constexpr float DN_ALPHA = 1.4142135623730951f;
constexpr int NPOW = 18;

constexpr size_t AL(size_t x) { return (x + 255) & ~(size_t)255; }
constexpr size_t SZ_WT_IN = (size_t)2 * DIN * D * 2;
constexpr size_t SZ_WT_GLU = (size_t)2 * 512 * 512 * 2;
constexpr size_t SZ_WT_O = (size_t)2 * D * D * 2;
constexpr size_t SZ_WT_GU = (size_t)2 * 16 * 512 * 1024 * 2;
constexpr size_t SZ_WT_DN = (size_t)2 * 16 * 1024 * 256 * 2;
constexpr size_t SZ_MOD = (size_t)2 * 9 * 6144 * 4;
constexpr size_t SZ_LAMPOW = (size_t)2 * 2 * NG * PS * NPOW * 8;
constexpr size_t SZ_BBAR = (size_t)2 * 2 * NG * PS * 16 * 8;
constexpr size_t SZ_KFULL = (size_t)2 * NG * 31 * 256 * 4;
constexpr size_t SZ_M1 = (size_t)2 * NG * 256 * 256 * 2;
constexpr size_t SZ_W2 = (size_t)2 * NG * 256 * 512 * 2;
constexpr size_t SZ_HB = (size_t)NROW * D * 2;
constexpr size_t SZ_UG = (size_t)NG * NROW * 16 * 2;
constexpr size_t SZ_ZR = (size_t)NROW * 1280 * 2;
constexpr size_t SZ_S = (size_t)NG * NCOL * 256 * 4;
constexpr size_t SZ_RCTX = (size_t)NCTX * D * 4;
constexpr size_t SZ_CNT = 256 * 4;
constexpr size_t SZ_LIST = (size_t)NCLS * LISTCAP * 4;
constexpr size_t SZ_LW = (size_t)NCLS * LISTCAP * 8;

constexpr size_t OFF_WT_IN = 0;
constexpr size_t OFF_WT_GLU = OFF_WT_IN + AL(SZ_WT_IN);
constexpr size_t OFF_WT_O = OFF_WT_GLU + AL(SZ_WT_GLU);
constexpr size_t OFF_WT_GU = OFF_WT_O + AL(SZ_WT_O);
constexpr size_t OFF_WT_DN = OFF_WT_GU + AL(SZ_WT_GU);
constexpr size_t OFF_MOD = OFF_WT_DN + AL(SZ_WT_DN);
constexpr size_t OFF_LAMPOW = OFF_MOD + AL(SZ_MOD);
constexpr size_t OFF_BBAR = OFF_LAMPOW + AL(SZ_LAMPOW);
constexpr size_t OFF_KFULL = OFF_BBAR + AL(SZ_BBAR);
constexpr size_t OFF_M1 = OFF_KFULL + AL(SZ_KFULL);
constexpr size_t OFF_W2 = OFF_M1 + AL(SZ_M1);
constexpr size_t OFF_HB = OFF_W2 + AL(SZ_W2);
constexpr size_t OFF_UG = OFF_HB + AL(SZ_HB);
constexpr size_t OFF_ZR = OFF_UG + AL(SZ_UG);
constexpr size_t OFF_S = OFF_ZR + AL(SZ_ZR);
constexpr size_t OFF_RCTX = OFF_S + AL(SZ_S);
constexpr size_t OFF_CNT = OFF_RCTX + AL(SZ_RCTX);
constexpr size_t OFF_LIST = OFF_CNT + AL(SZ_CNT);
constexpr size_t OFF_LW = OFF_LIST + AL(SZ_LIST);
constexpr size_t WS_END = OFF_LW + AL(SZ_LW);
static_assert((size_t)KSPLIT_MOD * 2 * 9 * 6144 * 4 <= SZ_ZR, "modp alias");
static_assert((size_t)NG * NCOL * 256 * 2 <= SZ_ZR, "hprev alias");
static_assert((size_t)NROW * 512 * 2 <= SZ_S && (size_t)MAXMT * 128 * 512 * 2 <= SZ_S, "Y/act alias");
static_assert(WS_END <= (size_t)256 * 1024 * 1024, "workspace over 256 MiB");

constexpr int LDS_BYTES = 81920;

struct Params {
    const float* in[34];
    float* out;
    unsigned char* ws;
};

__device__ __forceinline__ unsigned f2bf(float f) { unsigned u = __float_as_uint(f); u += 0x7fffu + ((u >> 16) & 1u); return u >> 16; }
__device__ __forceinline__ float bf2f(unsigned h) { return __uint_as_float(h << 16); }
__device__ __forceinline__ unsigned pack2(float a, float b) { return f2bf(a) | (f2bf(b) << 16); }
__device__ __forceinline__ float bflo(unsigned w) { return __uint_as_float(w << 16); }
__device__ __forceinline__ float bfhi(unsigned w) { return __uint_as_float(w & 0xffff0000u); }
__device__ __forceinline__ float wave_sum(float v) {
#pragma unroll
    for (int o = 32; o >= 1; o >>= 1) v += __shfl_xor(v, o);
    return v;
}
__device__ __forceinline__ float sigmoidf_(float x) { return 1.0f / (1.0f + __expf(-x)); }
__device__ __forceinline__ float siluf_(float x) { return x / (1.0f + __expf(-x)); }
__device__ __forceinline__ float gelu_tanh(float x) {
    const float z = 0.7978845608028654f * (x + 0.044715f * x * x * x);
    const float e = __expf(2.0f * z);
    const float t = 1.0f - 2.0f / (1.0f + e);
    return 0.5f * x * (1.0f + t);
}
__device__ __forceinline__ int modrow(int row) { return row < NLAT ? (row >> 11) : 8; }

struct Src4 { const bf16_t* p0[4]; const bf16_t* p1[4]; int split; };

template <class EPI>
__device__ __forceinline__ void gemm128(unsigned char* lds, const Src4& A, const Src4& B, const int K, const EPI& epi) {
    const int tid = threadIdx.x, lane = tid & 63, wid = tid >> 6, wm = wid >> 1, wn = wid & 1;
    const int lr = tid >> 3, lc = tid & 7;
    const int wofs = lr * 128 + ((lc ^ ((lr >> 1) & 7)) << 4);
    const int l31 = lane & 31, hh = lane >> 5, sw = (l31 >> 1) & 7;
    const int xbase = (wm * 64 + l31) * 128, wbase = 16384 + (wn * 64 + l31) * 128;
    f32x16 acc[2][2];
#pragma unroll
    for (int i = 0; i < 2; ++i)
#pragma unroll
        for (int j = 0; j < 2; ++j)
#pragma unroll
            for (int e = 0; e < 16; ++e) acc[i][j][e] = 0.f;
    uint4 ra[4], rb[4];
    const int nk = K >> 6;
#define G_LOAD(kt_) do { const int k_ = (kt_) * 64; \
        _Pragma("unroll") for (int j = 0; j < 4; ++j) { ra[j] = *(const uint4*)(k_ < A.split ? A.p0[j] + k_ : A.p1[j] + (k_ - A.split)); } \
        _Pragma("unroll") for (int j = 0; j < 4; ++j) { rb[j] = *(const uint4*)(k_ < B.split ? B.p0[j] + k_ : B.p1[j] + (k_ - B.split)); } } while (0)
#define G_WRITE(bufo_) do { \
        _Pragma("unroll") for (int j = 0; j < 4; ++j) { *(uint4*)(lds + (bufo_) + wofs + j * 4096) = ra[j]; *(uint4*)(lds + (bufo_) + 16384 + wofs + j * 4096) = rb[j]; } } while (0)
    G_LOAD(0); G_WRITE(0); __syncthreads();
    for (int kt = 0; kt < nk; ++kt) {
        const int buf = (kt & 1) * 32768;
        if (kt + 1 < nk) G_LOAD(kt + 1);
#pragma unroll
        for (int ks = 0; ks < 4; ++ks) {
            const int co = ((ks * 2 + hh) ^ sw) << 4;
            const bf16x8 x0 = *(const bf16x8*)(lds + buf + xbase + co);
            const bf16x8 x1 = *(const bf16x8*)(lds + buf + xbase + 4096 + co);
            const bf16x8 w0 = *(const bf16x8*)(lds + buf + wbase + co);
            const bf16x8 w1 = *(const bf16x8*)(lds + buf + wbase + 4096 + co);
            acc[0][0] = __builtin_amdgcn_mfma_f32_32x32x16_bf16(w0, x0, acc[0][0], 0, 0, 0);
            acc[0][1] = __builtin_amdgcn_mfma_f32_32x32x16_bf16(w1, x0, acc[0][1], 0, 0, 0);
            acc[1][0] = __builtin_amdgcn_mfma_f32_32x32x16_bf16(w0, x1, acc[1][0], 0, 0, 0);
            acc[1][1] = __builtin_amdgcn_mfma_f32_32x32x16_bf16(w1, x1, acc[1][1], 0, 0, 0);
        }
        if (kt + 1 < nk) G_WRITE(((kt + 1) & 1) * 32768);
        __syncthreads();
    }
#undef G_LOAD
#undef G_WRITE
    epi(acc, wm * 64 + l31, wn * 64 + hh * 4);
}

__device__ __forceinline__ void src_plain(Src4& s, const bf16_t* base, int row0, int ld) {
    const int lr = threadIdx.x >> 3, lc = threadIdx.x & 7;
#pragma unroll
    for (int j = 0; j < 4; ++j) { s.p0[j] = base + (size_t)(row0 + lr + 32 * j) * ld + lc * 8; s.p1[j] = s.p0[j]; }
    s.split = 1 << 30;
}
__device__ __forceinline__ void src_split(Src4& s, const bf16_t* base0, int ld0, const bf16_t* base1, int ld1, int row0, int split) {
    const int lr = threadIdx.x >> 3, lc = threadIdx.x & 7;
#pragma unroll
    for (int j = 0; j < 4; ++j) { s.p0[j] = base0 + (size_t)(row0 + lr + 32 * j) * ld0 + lc * 8; s.p1[j] = base1 + (size_t)(row0 + lr + 32 * j) * ld1 + lc * 8; }
    s.split = split;
}

#define ACC_FOREACH(acc, r0, c0, ...) \
    _Pragma("unroll") for (int mt_ = 0; mt_ < 2; ++mt_) \
    _Pragma("unroll") for (int nt_ = 0; nt_ < 2; ++nt_) \
    _Pragma("unroll") for (int q_ = 0; q_ < 4; ++q_) { \
        const int rl = (r0) + mt_ * 32, cl = (c0) + nt_ * 32 + q_ * 8; \
        const float v0 = acc[mt_][nt_][q_ * 4 + 0], v1 = acc[mt_][nt_][q_ * 4 + 1], v2 = acc[mt_][nt_][q_ * 4 + 2], v3 = acc[mt_][nt_][q_ * 4 + 3]; \
        __VA_ARGS__ }

struct WS {
    unsigned char* b;
    __device__ bf16_t* wt_in(int l) const { return (bf16_t*)(b + OFF_WT_IN) + (size_t)l * DIN * D; }
    __device__ bf16_t* wt_glu(int l) const { return (bf16_t*)(b + OFF_WT_GLU) + (size_t)l * 512 * 512; }
    __device__ bf16_t* wt_o(int l) const { return (bf16_t*)(b + OFF_WT_O) + (size_t)l * D * D; }
    __device__ bf16_t* wt_gu(int l, int e) const { return (bf16_t*)(b + OFF_WT_GU) + (size_t)(l * 16 + e) * 512 * 1024; }
    __device__ bf16_t* wt_dn(int l, int e) const { return (bf16_t*)(b + OFF_WT_DN) + (size_t)(l * 16 + e) * 1024 * 256; }
    __device__ float* mod(int l) const { return (float*)(b + OFF_MOD) + (size_t)l * 9 * 6144; }
    __device__ float* modp() const { return (float*)(b + OFF_ZR); }
    __device__ float2* lampow(int l, int d, int g) const { return (float2*)(b + OFF_LAMPOW) + (size_t)((l * 2 + d) * NG + g) * PS * NPOW; }
    __device__ float2* bbar(int l, int d, int g) const { return (float2*)(b + OFF_BBAR) + (size_t)((l * 2 + d) * NG + g) * PS * 16; }
    __device__ float* kfull(int l, int g) const { return (float*)(b + OFF_KFULL) + (size_t)(l * NG + g) * 31 * 256; }
    __device__ bf16_t* m1(int l, int g) const { return (bf16_t*)(b + OFF_M1) + (size_t)(l * NG + g) * 256 * 256; }
    __device__ bf16_t* w2(int l, int g) const { return (bf16_t*)(b + OFF_W2) + (size_t)(l * NG + g) * 256 * 512; }
    __device__ bf16_t* hb() const { return (bf16_t*)(b + OFF_HB); }
    __device__ bf16_t* ug() const { return (bf16_t*)(b + OFF_UG); }
    __device__ bf16_t* zr() const { return (bf16_t*)(b + OFF_ZR); }
    __device__ bf16_t* hprev() const { return (bf16_t*)(b + OFF_ZR); }
    __device__ float* S() const { return (float*)(b + OFF_S); }
    __device__ bf16_t* Y() const { return (bf16_t*)(b + OFF_S); }
    __device__ bf16_t* act() const { return (bf16_t*)(b + OFF_S); }
    __device__ float* rctx() const { return (float*)(b + OFF_RCTX); }
    __device__ int* cnt(int l) const { return (int*)(b + OFF_CNT) + l * 32; }
    __device__ int* list() const { return (int*)(b + OFF_LIST); }
    __device__ float2* lw() const { return (float2*)(b + OFF_LW); }
};
__device__ __forceinline__ float* Rrow(const Params& p, int row) {
    return row < NLAT ? p.out + (size_t)row * D : (float*)(p.ws + OFF_RCTX) + (size_t)(row - NLAT) * D;
}

__device__ __forceinline__ void transpose_tile(unsigned char* lds, const float* src, int ldsrc, int k0, int n0, bf16_t* dst, int lddst, int rowmode) {
    float* tile = (float*)lds;
    const int tid = threadIdx.x;
    __syncthreads();
#pragma unroll
    for (int pass = 0; pass < 4; ++pass) {
        const int k = pass * 16 + (tid >> 4), n4 = (tid & 15) * 4;
        const float4 v = *(const float4*)(src + (size_t)(k0 + k) * ldsrc + n0 + n4);
        tile[k * 65 + n4 + 0] = v.x; tile[k * 65 + n4 + 1] = v.y; tile[k * 65 + n4 + 2] = v.z; tile[k * 65 + n4 + 3] = v.w;
    }
    __syncthreads();
#pragma unroll
    for (int t2 = 0; t2 < 2; ++t2) {
        const int task = tid + t2 * 256, n = task & 63, kc = task >> 6;
        float f[8];
#pragma unroll
        for (int i = 0; i < 8; ++i) f[i] = tile[(kc * 8 + i) * 65 + n];
        const int ng = n0 + n;
        int drow = ng;
        if (rowmode == 1) drow = ((ng >> 3) << 4) + (ng & 7);
        else if (rowmode == 2) drow = ((ng >> 3) << 4) + 8 + (ng & 7);
        uint4 o; o.x = pack2(f[0], f[1]); o.y = pack2(f[2], f[3]); o.z = pack2(f[4], f[5]); o.w = pack2(f[6], f[7]);
        *(uint4*)(dst + (size_t)drow * lddst + k0 + kc * 8) = o;
    }
}

__device__ __forceinline__ void phase_pro_a(const Params& p, unsigned char* lds) {
    const WS w{p.ws};
    const int tid = threadIdx.x;
    if (blockIdx.x == 0 && tid < 64) ((int*)(p.ws + OFF_CNT))[tid] = 0;
    constexpr int N_MOD = 2 * 6 * KSPLIT_MOD, N_TAB = 32, N_WT = 2 * 3840;
    for (int it = blockIdx.x; it < N_MOD + N_TAB + N_WT; it += gridDim.x) {
        if (it < N_MOD) {
            const int l = it / (6 * KSPLIT_MOD), rem = it % (6 * KSPLIT_MOD), cb = rem / KSPLIT_MOD, ks = rem % KSPLIT_MOD;
            float* sc = (float*)lds;
            __syncthreads();
            for (int i = tid; i < 9 * 64; i += 256) {
                const int r = i >> 6, kk = i & 63, k = ks * 64 + kk;
                const float cv = r < 8 ? p.in[1][r * D + k] : p.in[3][k];
                sc[i] = siluf_(cv);
            }
            __syncthreads();
            float acc[9][4];
#pragma unroll
            for (int r = 0; r < 9; ++r) { acc[r][0] = acc[r][1] = acc[r][2] = acc[r][3] = 0.f; }
            const float* wm = p.in[4] + ((size_t)l * D + ks * 64) * 6144 + cb * 1024 + tid * 4;
#pragma unroll 8
            for (int kk = 0; kk < 64; ++kk) {
                const float4 v = *(const float4*)(wm + (size_t)kk * 6144);
#pragma unroll
                for (int r = 0; r < 9; ++r) { const float s = sc[r * 64 + kk]; acc[r][0] += s * v.x; acc[r][1] += s * v.y; acc[r][2] += s * v.z; acc[r][3] += s * v.w; }
            }
            float* mp = w.modp() + ((size_t)(ks * 2 + l) * 9) * 6144 + cb * 1024 + tid * 4;
#pragma unroll
            for (int r = 0; r < 9; ++r) *(float4*)(mp + (size_t)r * 6144) = make_float4(acc[r][0], acc[r][1], acc[r][2], acc[r][3]);
        } else if (it < N_MOD + N_TAB) {
            const int id = (it - N_MOD) * 256 + tid;
            const int pp = id & 63, g = (id >> 6) & 31, d = (id >> 11) & 1, l = id >> 12;
            const int i3 = (l * 2 + d) * NG + g;
            const double dt = exp((double)p.in[9][i3]);
            const double are = (double)p.in[7][i3 * PS + pp], aim = (double)p.in[8][i3 * PS + pp];
            float2* lp = w.lampow(l, d, g) + pp * NPOW;
            double lbr = 0, lbi = 0;
            for (int k = 0; k < NPOW; ++k) {
                const double kk = (k == 17) ? (double)(TCH * SEGLEN) : (double)k;
                const double mag = exp(kk * are * dt);
                double s, c; sincos(kk * aim * dt, &s, &c);
                lp[k] = make_float2((float)(mag * c), (float)(mag * s));
                if (k == 1) { lbr = mag * c; lbi = mag * s; }
            }
            const double nr = lbr - 1.0, ni = lbi, den = are * are + aim * aim;
            const double cr = (nr * are + ni * aim) / den, ci = (ni * are - nr * aim) / den;
            float2* bb = w.bbar(l, d, g) + pp * 16;
            for (int n = 0; n < 16; ++n) {
                const double br = (double)p.in[10][(size_t)(i3 * PS + pp) * 16 + n], bi = (double)p.in[11][(size_t)(i3 * PS + pp) * 16 + n];
                bb[n] = make_float2((float)(cr * br - ci * bi), (float)(cr * bi + ci * br));
            }
        } else {
            int t = it - N_MOD - N_TAB;
            const int l = t / 3840; t %= 3840;
            if (t < 448) { const int kt = t / 28, nt = t % 28; transpose_tile(lds, p.in[6] + (size_t)l * D * DIN, DIN, kt * 64, nt * 64, w.wt_in(l), D, 0); }
            else if (t < 512) { t -= 448; const int kt = t / 8, nt = t % 8; transpose_tile(lds, p.in[15] + (size_t)l * 512 * 512, 512, kt * 64, nt * 64, w.wt_glu(l), 512, 0); }
            else if (t < 768) { t -= 512; const int kt = t / 16, nt = t % 16; transpose_tile(lds, p.in[22] + (size_t)l * D * D, D, kt * 64, nt * 64, w.wt_o(l), D, 0); }
            else if (t < 1792) { t -= 768; const int e = t / 64, r = t % 64, kt = r / 4, nt = r % 4; transpose_tile(lds, p.in[29] + (size_t)(l * 16 + e) * D * 256, 256, kt * 64, nt * 64, w.wt_gu(l, e), D, 1); }
            else if (t < 2816) { t -= 1792; const int e = t / 64, r = t % 64, kt = r / 4, nt = r % 4; transpose_tile(lds, p.in[30] + (size_t)(l * 16 + e) * D * 256, 256, kt * 64, nt * 64, w.wt_gu(l, e), D, 2); }
            else { t -= 2816; const int e = t / 64, r = t % 64, kt = r / 16, nt = r % 16; transpose_tile(lds, p.in[31] + (size_t)(l * 16 + e) * 256 * D, D, kt * 64, nt * 64, w.wt_dn(l, e), 256, 0); }
        }
    }
}

__device__ __forceinline__ void phase_pro_b(const Params& p) {
    const WS w{p.ws};
    const int gt = blockIdx.x * 256 + threadIdx.x, gs = gridDim.x * 256;
    for (int i = gt; i < 2 * 9 * 6144; i += gs) {
        const int l = i / (9 * 6144), n = i % 6144;
        float s = p.in[5][l * 6144 + n];
        const float* mp = w.modp() + i;
#pragma unroll
        for (int ks = 0; ks < KSPLIT_MOD; ++ks) s += mp[(size_t)ks * 2 * 9 * 6144];
        ((float*)(p.ws + OFF_MOD))[i] = s;
    }
    for (int i = gt; i < 2 * NG * 31 * 256; i += gs) {
        const int ni = i & 15, no = (i >> 4) & 15, ti = (i >> 8) % 31, lg = i / (31 * 256), g = lg & 31, l = lg >> 5;
        const int tau = ti - 15;
        float s = 0.f;
#pragma unroll
        for (int d = 0; d < 2; ++d) {
            if ((d == 0 && tau < 0) || (d == 1 && tau > 0)) continue;
            const int at = tau < 0 ? -tau : tau;
            const float2* lp = w.lampow(l, d, g);
            const float2* bb = w.bbar(l, d, g);
            const float* cre = p.in[12] + ((size_t)((l * 2 + d) * NG + g) * 16 + no) * PS;
            const float* cim = p.in[13] + ((size_t)((l * 2 + d) * NG + g) * 16 + no) * PS;
            for (int pp = 0; pp < PS; ++pp) {
                const float2 L = lp[pp * NPOW + at], Bv = bb[pp * 16 + ni];
                const float er = L.x * Bv.x - L.y * Bv.y, ei = L.x * Bv.y + L.y * Bv.x;
                s += cre[pp] * er - cim[pp] * ei;
            }
        }
        if (tau == 0 && no == ni) s += p.in[14][l * DS5 + g * 16 + no];
        ((float*)(p.ws + OFF_KFULL))[i] = s;
    }
    for (int i = gt; i < 2 * NG * 256 * 32; i += gs) {
        const int c8 = i & 31, row = (i >> 5) & 255, lg = i >> 13, g = lg & 31, l = lg >> 5;
        const int d = row >> 7, pp = (row & 127) >> 1, c = row & 1, j = c8 >> 1, n0 = (c8 & 1) * 8;
        const int e = d == 0 ? (TCH - 1 - j) : j;
        const float2 L = w.lampow(l, d, g)[pp * NPOW + e];
        const float2* bb = w.bbar(l, d, g) + pp * 16 + n0;
        float f[8];
#pragma unroll
        for (int n = 0; n < 8; ++n) { const float2 Bv = bb[n]; f[n] = c == 0 ? (L.x * Bv.x - L.y * Bv.y) : (L.x * Bv.y + L.y * Bv.x); }
        uint4 o; o.x = pack2(f[0], f[1]); o.y = pack2(f[2], f[3]); o.z = pack2(f[4], f[5]); o.w = pack2(f[6], f[7]);
        *(uint4*)(w.m1(l, g) + (size_t)row * 256 + c8 * 8) = o;
    }
}

__device__ __forceinline__ void phase_pro_c(const Params& p) {
    const WS w{p.ws};
    const int gt = blockIdx.x * 256 + threadIdx.x, gs = gridDim.x * 256;
    for (int i = gt; i < 2 * NG * 256 * 64; i += gs) {
        const int c8 = i & 63, r = (i >> 6) & 255, lg = i >> 14, g = lg & 31, l = lg >> 5;
        const int jo = r >> 4, no = r & 15;
        float f[8];
        if (c8 < 32) {
            const int ji = c8 >> 1, n0 = (c8 & 1) * 8;
            const float* kf = w.kfull(l, g) + ((size_t)(jo - ji + 15) * 16 + no) * 16 + n0;
#pragma unroll
            for (int n = 0; n < 8; ++n) f[n] = kf[n];
        } else {
            const int kk = (c8 - 32) * 8, d = kk >> 7, p0 = (kk & 127) >> 1;
            const int e = d == 0 ? (jo + 1) : (TCH - jo);
            const float* cre = p.in[12] + ((size_t)((l * 2 + d) * NG + g) * 16 + no) * PS;
            const float* cim = p.in[13] + ((size_t)((l * 2 + d) * NG + g) * 16 + no) * PS;
            const float2* lp = w.lampow(l, d, g);
#pragma unroll
            for (int q = 0; q < 4; ++q) {
                const int pp = p0 + q;
                const float2 L = lp[pp * NPOW + e];
                const float cr = cre[pp], ci = cim[pp];
                f[2 * q] = cr * L.x - ci * L.y;
                f[2 * q + 1] = -(cr * L.y + ci * L.x);
            }
        }
        uint4 o; o.x = pack2(f[0], f[1]); o.y = pack2(f[2], f[3]); o.z = pack2(f[4], f[5]); o.w = pack2(f[6], f[7]);
        *(uint4*)(w.w2(l, g) + (size_t)r * 512 + c8 * 8) = o;
    }
    const float* md = w.mod(0);
    for (int i = gt; i < NROW * 128; i += gs) {
        const int row = i >> 7, c8 = (i & 127) * 8, m = modrow(row);
        const float* xs = row < NLAT ? p.in[0] + (size_t)row * D : p.in[2] + (size_t)(row - NLAT) * D;
        const float4 a = *(const float4*)(xs + c8), b = *(const float4*)(xs + c8 + 4);
        const float* sh = md + (size_t)m * 6144 + c8; const float* sc = sh + 1024;
        const float4 s0 = *(const float4*)sh, s1 = *(const float4*)(sh + 4), c0 = *(const float4*)sc, c1 = *(const float4*)(sc + 4);
        uint4 o;
        o.x = pack2(a.x * (1.f + c0.x) + s0.x, a.y * (1.f + c0.y) + s0.y);
        o.y = pack2(a.z * (1.f + c0.z) + s0.z, a.w * (1.f + c0.w) + s0.w);
        o.z = pack2(b.x * (1.f + c1.x) + s1.x, b.y * (1.f + c1.y) + s1.y);
        o.w = pack2(b.z * (1.f + c1.z) + s1.z, b.w * (1.f + c1.w) + s1.w);
        *(uint4*)(w.hb() + (size_t)row * D + c8) = o;
    }
}

struct EpiInproj {
    bf16_t* ug; bf16_t* zr; int m0, n0;
    __device__ __forceinline__ void operator()(const f32x16 (&acc)[2][2], int r0, int c0) const {
        ACC_FOREACH(acc, r0, c0, {
            const int row = m0 + rl, col = n0 + cl;
            uint2 o; o.x = pack2(v0, v1); o.y = pack2(v2, v3);
            if (col < DS5) *(uint2*)(ug + ((size_t)(col >> 4) * NROW + row) * 16 + (col & 15)) = o;
            else *(uint2*)(zr + (size_t)row * 1280 + (col - DS5)) = o;
        })
    }
};
__device__ __forceinline__ void phase_inproj(const Params& p, unsigned char* lds, int l) {
    const WS w{p.ws};
    const int nfull = (l == 0 ? 144 : 128) * 14, ntile = nfull + (l == 0 ? 0 : 16 * 4);
    for (int t = blockIdx.x; t < ntile; t += gridDim.x) {
        int mt, nt;
        if (t < nfull) { mt = t / 14; nt = t % 14; } else { mt = 128 + (t - nfull) / 4; nt = (t - nfull) % 4; }
        Src4 A, B;
        src_plain(A, w.hb(), mt * 128, D);
        src_plain(B, w.wt_in(l), nt * 128, D);
        EpiInproj e{w.ug(), w.zr(), mt * 128, nt * 128};
        gemm128(lds, A, B, D, e);
    }
}

struct EpiS1 {
    float* S; int m0, n0;
    __device__ __forceinline__ void operator()(const f32x16 (&acc)[2][2], int r0, int c0) const {
        ACC_FOREACH(acc, r0, c0, {
            *(float4*)(S + (size_t)(m0 + rl) * 256 + n0 + cl) = make_float4(v0, v1, v2, v3);
        })
    }
};

__device__ __forceinline__ void conv_sc(const Params& p, int l, int nrows) {
    const WS w{p.ws};
    const float* wsc = p.in[17] + (size_t)l * 3 * 256;
    const int gt = blockIdx.x * 256 + threadIdx.x, gs = gridDim.x * 256;
    for (int i = gt; i < nrows * 32; i += gs) {
        const int row = i >> 5, c8 = (i & 31) * 8;
        int pos, len;
        if (row < NLAT) { pos = row & 63; len = 64; } else { pos = (row - NLAT) & 255; len = 256; }
        const bf16_t* zr = w.zr() + (size_t)row * 1280;
        float accv[8];
#pragma unroll
        for (int e = 0; e < 8; ++e) accv[e] = 0.f;
#pragma unroll
        for (int j = -1; j <= 1; ++j) {
            if (pos + j < 0 || pos + j >= len) continue;
            const uint4 cg = *(const uint4*)(zr + (ptrdiff_t)j * 1280 + 256 + c8);
            const uint4 vv = *(const uint4*)(zr + (ptrdiff_t)j * 1280 + 512 + c8);
            const float4 wa = *(const float4*)(wsc + (j + 1) * 256 + c8), wb = *(const float4*)(wsc + (j + 1) * 256 + c8 + 4);
            accv[0] += wa.x * bflo(cg.x) * bflo(vv.x); accv[1] += wa.y * bfhi(cg.x) * bfhi(vv.x);
            accv[2] += wa.z * bflo(cg.y) * bflo(vv.y); accv[3] += wa.w * bfhi(cg.y) * bfhi(vv.y);
            accv[4] += wb.x * bflo(cg.z) * bflo(vv.z); accv[5] += wb.y * bfhi(cg.z) * bfhi(vv.z);
            accv[6] += wb.z * bflo(cg.w) * bflo(vv.w); accv[7] += wb.w * bfhi(cg.w) * bfhi(vv.w);
        }
        const uint4 bg = *(const uint4*)(zr + c8);
        uint4 o;
        o.x = pack2(accv[0] * bflo(bg.x), accv[1] * bfhi(bg.x));
        o.y = pack2(accv[2] * bflo(bg.y), accv[3] * bfhi(bg.y));
        o.z = pack2(accv[4] * bflo(bg.z), accv[5] * bfhi(bg.z));
        o.w = pack2(accv[6] * bflo(bg.w), accv[7] * bfhi(bg.w));
        *(uint4*)(w.hb() + (size_t)row * D + 512 + c8) = o;
    }
}

__device__ __forceinline__ void conv_cf(const Params& p, unsigned char* lds, int l, bool with_ctx) {
    const WS w{p.ws};
    float* P = (float*)lds;
    const int tid = threadIdx.x, lane = tid & 63, wid = tid >> 6;
    const float* wdw = p.in[18] + (size_t)l * 31 * 256;
    const float4 bdw = *(const float4*)(p.in[19] + l * 256 + lane * 4);
    const float4 lg = *(const float4*)(p.in[20] + l * 256 + lane * 4);
    const float4 lb = *(const float4*)(p.in[21] + l * 256 + lane * 4);
    const int nitem = 256 + (with_ctx ? 64 : 0);
    for (int it = blockIdx.x; it < nitem; it += gridDim.x) {
        const bool lat = it < 256;
        int b, base, nslot, sstride, s0 = 0;
        if (lat) { b = it >> 5; base = b * SEQ + (it & 31) * 2; nslot = 64; sstride = 2; }
        else { const int j = it - 256; b = j >> 3; s0 = (j & 7) * 32; base = NLAT + b * CTX; nslot = 62; sstride = 1; }
        __syncthreads();
        for (int task = tid; task < 64 * 32; task += 256) {
            const int slot = task >> 5, c8 = (task & 31) * 8;
            int row; bool valid = true;
            if (lat) row = base + (slot >> 1) * 64 + (slot & 1);
            else { const int s = s0 - 15 + slot; valid = (slot < nslot) && s >= 0 && s < CTX; row = base + s; }
            float f[8];
            if (valid) {
                const bf16_t* zr = w.zr() + (size_t)row * 1280;
                const uint4 ga = *(const uint4*)(zr + 768 + c8), gb = *(const uint4*)(zr + 1024 + c8);
                f[0] = bflo(ga.x) * sigmoidf_(bflo(gb.x)); f[1] = bfhi(ga.x) * sigmoidf_(bfhi(gb.x));
                f[2] = bflo(ga.y) * sigmoidf_(bflo(gb.y)); f[3] = bfhi(ga.y) * sigmoidf_(bfhi(gb.y));
                f[4] = bflo(ga.z) * sigmoidf_(bflo(gb.z)); f[5] = bfhi(ga.z) * sigmoidf_(bfhi(gb.z));
                f[6] = bflo(ga.w) * sigmoidf_(bflo(gb.w)); f[7] = bfhi(ga.w) * sigmoidf_(bfhi(gb.w));
            } else {
#pragma unroll
                for (int e = 0; e < 8; ++e) f[e] = 0.f;
            }
            *(float4*)(P + slot * 256 + c8) = make_float4(f[0], f[1], f[2], f[3]);
            *(float4*)(P + slot * 256 + c8 + 4) = make_float4(f[4], f[5], f[6], f[7]);
        }
        __syncthreads();
        const int nout = lat ? 64 : 32;
        for (int o = wid; o < nout; o += 4) {
            float4 a = bdw;
            int row;
            if (lat) {
                const int r = o >> 1, i = o & 1;
                row = base + r * 64 + i;
                for (int k = 0; k < 31; ++k) {
                    const int rr = r + k - 15;
                    if (rr < 0 || rr >= 32) continue;
                    const float4 wv = *(const float4*)(wdw + k * 256 + lane * 4);
                    const float4 pv = *(const float4*)(P + (rr * 2 + i) * 256 + lane * 4);
                    a.x += wv.x * pv.x; a.y += wv.y * pv.y; a.z += wv.z * pv.z; a.w += wv.w * pv.w;
                }
            } else {
                row = base + s0 + o;
                for (int k = 0; k < 31; ++k) {
                    const float4 wv = *(const float4*)(wdw + k * 256 + lane * 4);
                    const float4 pv = *(const float4*)(P + (o + k) * 256 + lane * 4);
                    a.x += wv.x * pv.x; a.y += wv.y * pv.y; a.z += wv.z * pv.z; a.w += wv.w * pv.w;
                }
            }
            const float mean = wave_sum(a.x + a.y + a.z + a.w) * (1.0f / 256.0f);
            const float dx = a.x - mean, dy = a.y - mean, dz = a.z - mean, dw = a.w - mean;
            const float var = wave_sum(dx * dx + dy * dy + dz * dz + dw * dw) * (1.0f / 256.0f);
            const float rs = rsqrtf(var + LN_EPS);
            const float y0 = siluf_(dx * rs * lg.x + lb.x), y1 = siluf_(dy * rs * lg.y + lb.y), y2 = siluf_(dz * rs * lg.z + lb.z), y3 = siluf_(dw * rs * lg.w + lb.w);
            uint2 ov; ov.x = pack2(y0, y1); ov.y = pack2(y2, y3);
            *(uint2*)(w.hb() + (size_t)row * D + 768 + lane * 4) = ov;
        }
    }
}

__device__ __forceinline__ void phase_s1(const Params& p, unsigned char* lds, int l) {
    const WS w{p.ws};
    const int ntile = NG * 9 * 2;
    for (int t = blockIdx.x; t < ntile; t += gridDim.x) {
        const int g = t / 18, r = t % 18, mt = r >> 1, nt = r & 1;
        Src4 A, B;
        src_plain(A, w.ug() + (size_t)g * NROW * 16, mt * 128, 256);
        src_plain(B, w.m1(l, g), nt * 128, 256);
        EpiS1 e{w.S() + (size_t)g * NCOL * 256, mt * 128, nt * 128};
        gemm128(lds, A, B, 256, e);
    }
    conv_sc(p, l, l == 0 ? NROW : NLAT);
    conv_cf(p, lds, l, l == 0);
}

__device__ __forceinline__ int chunk_col(int d, int b, int step) {
    if (step < CH_CTX) { const int c = d == 0 ? step : (CH_CTX - 1 - step); return NCOL_LAT + b * CH_CTX + c; }
    const int s = step - CH_CTX; const int c = d == 0 ? s : (CH_LAT - 1 - s); return b * CH_LAT + c;
}
__device__ __forceinline__ void phase_s2(const Params& p, unsigned char* lds, int l) {
    const WS w{p.ws};
    float2* Fs = (float2*)lds;
    const int tid = threadIdx.x, seg = tid >> 5, pl = tid & 31;
    for (int it = blockIdx.x; it < NG * 2 * NB * 2; it += gridDim.x) {
        const int ph = it & 1, b = (it >> 1) & 7, d = (it >> 4) & 1, g = it >> 5;
        const int pp = ph * 32 + pl;
        const float2 A = w.lampow(l, d, g)[pp * NPOW + 16], A18 = w.lampow(l, d, g)[pp * NPOW + 17];
        const float* S = w.S() + (size_t)g * NCOL * 256 + d * 128 + 2 * pp;
        bf16_t* Hp = w.hprev() + (size_t)g * NCOL * 256 + d * 128 + 2 * pp;
        float2 s[SEGLEN];
#pragma unroll
        for (int i = 0; i < SEGLEN; ++i) s[i] = *(const float2*)(S + (size_t)chunk_col(d, b, seg * SEGLEN + i) * 256);
        float2 F = make_float2(0.f, 0.f);
#pragma unroll
        for (int i = 0; i < SEGLEN; ++i) { const float fr = A.x * F.x - A.y * F.y + s[i].x, fi = A.x * F.y + A.y * F.x + s[i].y; F.x = fr; F.y = fi; }
        __syncthreads();
        Fs[seg * 32 + pl] = F;
        __syncthreads();
        float2 H = make_float2(0.f, 0.f);
        for (int q = 0; q < seg; ++q) { const float2 f = Fs[q * 32 + pl]; const float hr = A18.x * H.x - A18.y * H.y + f.x, hi = A18.x * H.y + A18.y * H.x + f.y; H.x = hr; H.y = hi; }
#pragma unroll
        for (int i = 0; i < SEGLEN; ++i) {
            *(unsigned*)(Hp + (size_t)chunk_col(d, b, seg * SEGLEN + i) * 256) = pack2(H.x, H.y);
            const float hr = A.x * H.x - A.y * H.y + s[i].x, hi = A.x * H.y + A.y * H.x + s[i].y; H.x = hr; H.y = hi;
        }
    }
}

struct EpiS3 {
    bf16_t* Y; int m0, n0, g;
    __device__ __forceinline__ void operator()(const f32x16 (&acc)[2][2], int r0, int c0) const {
        ACC_FOREACH(acc, r0, c0, {
            const int col = n0 + cl, tok = (m0 + rl) * TCH + (col >> 4);
            uint2 o; o.x = pack2(gelu_tanh(v0), gelu_tanh(v1)); o.y = pack2(gelu_tanh(v2), gelu_tanh(v3));
            *(uint2*)(Y + (size_t)tok * DS5 + g * 16 + (col & 15)) = o;
        })
    }
};
__device__ __forceinline__ void phase_s3(const Params& p, unsigned char* lds, int l) {
    const WS w{p.ws};
    const int nmt = l == 0 ? 9 : 8, ntile = NG * nmt * 2;
    for (int t = blockIdx.x; t < ntile; t += gridDim.x) {
        const int g = t / (nmt * 2), r = t % (nmt * 2), mt = r >> 1, nt = r & 1;
        Src4 A, B;
        src_split(A, w.ug() + (size_t)g * NROW * 16, 256, w.hprev() + (size_t)g * NCOL * 256, 256, mt * 128, 256);
        src_plain(B, w.w2(l, g), nt * 128, 512);
        EpiS3 e{w.Y(), mt * 128, nt * 128, g};
        gemm128(lds, A, B, 512, e);
    }
}

struct EpiGlu {
    const bf16_t* Y; bf16_t* hb; const float* bg; int m0, n0;
    __device__ __forceinline__ void operator()(const f32x16 (&acc)[2][2], int r0, int c0) const {
        ACC_FOREACH(acc, r0, c0, {
            const int row = m0 + rl, col = n0 + cl;
            const uint2 t = *(const uint2*)(Y + (size_t)row * DS5 + col);
            const float4 b = *(const float4*)(bg + col);
            uint2 o;
            o.x = pack2(bflo(t.x) * sigmoidf_(v0 + b.x), bfhi(t.x) * sigmoidf_(v1 + b.y));
            o.y = pack2(bflo(t.y) * sigmoidf_(v2 + b.z), bfhi(t.y) * sigmoidf_(v3 + b.w));
            *(uint2*)(hb + (size_t)row * D + col) = o;
        })
    }
};
__device__ __forceinline__ void phase_glu(const Params& p, unsigned char* lds, int l) {
    const WS w{p.ws};
    const int nmt = l == 0 ? 144 : 128, ntile = nmt * 4;
    for (int t = blockIdx.x; t < ntile; t += gridDim.x) {
        const int mt = t >> 2, nt = t & 3;
        Src4 A, B;
        src_plain(A, w.Y(), mt * 128, DS5);
        src_plain(B, w.wt_glu(l), nt * 128, 512);
        EpiGlu e{w.Y(), w.hb(), p.in[16] + l * DS5, mt * 128, nt * 128};
        gemm128(lds, A, B, 512, e);
    }
}

struct EpiOut {
    const Params* p; const float* mod; int l, m0, n0;
    __device__ __forceinline__ void operator()(const f32x16 (&acc)[2][2], int r0, int c0) const {
        ACC_FOREACH(acc, r0, c0, {
            const int row = m0 + rl, col = n0 + cl, m = modrow(row);
            const float4 g1 = *(const float4*)(mod + (size_t)m * 6144 + 2048 + col);
            float* R = Rrow(*p, row) + col;
            const float* res = l == 0 ? (row < NLAT ? p->in[0] + (size_t)row * D + col : p->in[2] + (size_t)(row - NLAT) * D + col) : R;
            const float4 x = *(const float4*)res;
            *(float4*)R = make_float4(DN_ALPHA * x.x + g1.x * v0, DN_ALPHA * x.y + g1.y * v1, DN_ALPHA * x.z + g1.z * v2, DN_ALPHA * x.w + g1.w * v3);
        })
    }
};
__device__ __forceinline__ void phase_outproj(const Params& p, unsigned char* lds, int l) {
    const WS w{p.ws};
    const int nmt = l == 0 ? 144 : 128, ntile = nmt * 8;
    for (int t = blockIdx.x; t < ntile; t += gridDim.x) {
        const int mt = t >> 3, nt = t & 7;
        Src4 A, B;
        src_plain(A, w.hb(), mt * 128, D);
        src_plain(B, w.wt_o(l), nt * 128, D);
        EpiOut e{&p, w.mod(l), l, mt * 128, nt * 128};
        gemm128(lds, A, B, D, e);
    }
}

__device__ __forceinline__ void phase_ln1(const Params& p, unsigned char* lds, int l) {
    const WS w{p.ws};
    const int tid = threadIdx.x, lane = tid & 63, wid = tid >> 6;
    float* wl = (float*)lds;
    __syncthreads();
    for (int i = tid; i < 1024 * 20; i += 256) {
        const int k = i / 20, o = i % 20;
        const float v = o < 4 ? p.in[25][((size_t)l * D + k) * 4 + o] : p.in[27][((size_t)l * D + k) * 16 + (o - 4)];
        const int s = ((k >> 8) * 4 + (k & 3)) * 64 + ((k >> 2) & 63);
        wl[((o >> 2) * 1024 + s) * 4 + (o & 3)] = v;
    }
    __syncthreads();
    const int nrows = l == 0 ? NROW : NLAT;
    const float* md = w.mod(l);
    const float* lng = p.in[23] + l * D; const float* lnb = p.in[24] + l * D;
    for (int row = blockIdx.x * 4 + wid; row < nrows; row += gridDim.x * 4) {
        float* R = Rrow(p, row);
        const int m = modrow(row);
        float h[16];
        float4 v[4];
#pragma unroll
        for (int i = 0; i < 4; ++i) v[i] = *(const float4*)(R + i * 256 + lane * 4);
        float s = 0.f;
#pragma unroll
        for (int i = 0; i < 4; ++i) s += (v[i].x + v[i].y) + (v[i].z + v[i].w);
        const float mean = wave_sum(s) * (1.0f / 1024.0f);
        float q = 0.f;
#pragma unroll
        for (int i = 0; i < 4; ++i) { const float a = v[i].x - mean, b = v[i].y - mean, c = v[i].z - mean, d = v[i].w - mean; q += (a * a + b * b) + (c * c + d * d); }
        const float rs = rsqrtf(wave_sum(q) * (1.0f / 1024.0f) + LN_EPS);
#pragma unroll
        for (int i = 0; i < 4; ++i) {
            const int col = i * 256 + lane * 4;
            const float4 g = *(const float4*)(lng + col), b = *(const float4*)(lnb + col);
            const float4 sh = *(const float4*)(md + (size_t)m * 6144 + 3072 + col), sc = *(const float4*)(md + (size_t)m * 6144 + 4096 + col);
            float4 x;
            x.x = (v[i].x - mean) * rs * g.x + b.x; x.y = (v[i].y - mean) * rs * g.y + b.y; x.z = (v[i].z - mean) * rs * g.z + b.z; x.w = (v[i].w - mean) * rs * g.w + b.w;
            *(float4*)(R + col) = x;
            h[i * 4 + 0] = x.x * (1.f + sc.x) + sh.x; h[i * 4 + 1] = x.y * (1.f + sc.y) + sh.y; h[i * 4 + 2] = x.z * (1.f + sc.z) + sh.z; h[i * 4 + 3] = x.w * (1.f + sc.w) + sh.w;
            uint2 o; o.x = pack2(h[i * 4 + 0], h[i * 4 + 1]); o.y = pack2(h[i * 4 + 2], h[i * 4 + 3]);
            *(uint2*)(w.hb() + (size_t)row * D + col) = o;
        }
        float mylg = 0.f;
#pragma unroll 1
        for (int o4 = 0; o4 < 5; ++o4) {
            float a0 = 0.f, a1 = 0.f, a2 = 0.f, a3 = 0.f;
#pragma unroll
            for (int e = 0; e < 16; ++e) {
                const float4 wv = *(const float4*)(wl + ((o4 * 1024) + e * 64 + lane) * 4);
                a0 += h[e] * wv.x; a1 += h[e] * wv.y; a2 += h[e] * wv.z; a3 += h[e] * wv.w;
            }
            a0 = wave_sum(a0); a1 = wave_sum(a1); a2 = wave_sum(a2); a3 = wave_sum(a3);
            if (lane == o4 * 4 + 0) mylg = a0;
            if (lane == o4 * 4 + 1) mylg = a1;
            if (lane == o4 * 4 + 2) mylg = a2;
            if (lane == o4 * 4 + 3) mylg = a3;
        }
        float lg[20];
#pragma unroll
        for (int i = 0; i < 20; ++i) lg[i] = __shfl(mylg, i);
        if (lane == 0) {
            float gl[4];
#pragma unroll
            for (int i = 0; i < 4; ++i) gl[i] = lg[i] + p.in[26][l * 4 + i];
            int gi = 0; float gm = gl[0];
#pragma unroll
            for (int i = 1; i < 4; ++i) if (gl[i] > gm) { gm = gl[i]; gi = i; }
            float den = 0.f;
#pragma unroll
            for (int i = 0; i < 4; ++i) den += __expf(gl[i] - gm);
            const float gw = 1.0f / den;
            float el[4];
#pragma unroll
            for (int i = 0; i < 4; ++i) {
                float t = lg[4 + i];
                if (gi == 1) t = lg[8 + i]; else if (gi == 2) t = lg[12 + i]; else if (gi == 3) t = lg[16 + i];
                el[i] = t + p.in[28][l * 16 + gi * 4 + i];
            }
            int i1 = 0; float m1 = el[0];
#pragma unroll
            for (int i = 1; i < 4; ++i) if (el[i] > m1) { m1 = el[i]; i1 = i; }
            int i2 = -1; float m2 = -3.0e38f;
#pragma unroll
            for (int i = 0; i < 4; ++i) if (i != i1 && el[i] > m2) { m2 = el[i]; i2 = i; }
            const float e2 = __expf(m2 - m1);
            const float w1 = gw / (1.0f + e2), w2 = gw * e2 / (1.0f + e2);
            const int lo = i1 < i2 ? i1 : i2, hi = i1 < i2 ? i2 : i1;
            const float wlo = i1 < i2 ? w1 : w2, whi = i1 < i2 ? w2 : w1;
            const int pair = lo == 0 ? (hi - 1) : (lo == 1 ? (hi + 1) : 5);
            const int cls = gi * 6 + pair;
            const int pos = atomicAdd(w.cnt(l) + cls, 1);
            w.list()[(size_t)cls * LISTCAP + pos] = row;
            w.lw()[(size_t)cls * LISTCAP + pos] = make_float2(wlo, whi);
        }
    }
}

__device__ __forceinline__ void cls_experts(int cls, int& elo, int& ehi) {
    const int g = cls / 6, pr = cls % 6;
    const int lo = pr < 3 ? 0 : (pr < 5 ? 1 : 2);
    const int hi = pr < 3 ? pr + 1 : (pr < 5 ? pr - 1 : 3);
    elo = g * 4 + lo; ehi = g * 4 + hi;
}

struct EpiGU {
    bf16_t* act; const float2* lw; int cnt, pos0, orow0, half, fcol0;
    __device__ __forceinline__ void operator()(const f32x16 (&acc)[2][2], int r0, int c0) const {
        const int hh4 = c0 & 4, wn64 = c0 & 64;
#pragma unroll
        for (int mt = 0; mt < 2; ++mt) {
            const int rl = r0 + mt * 32, pos = pos0 + rl;
            float wt = 0.f;
            if (pos < cnt) { const float2 ww = lw[pos]; wt = half ? ww.y : ww.x; }
#pragma unroll
            for (int nt = 0; nt < 2; ++nt)
#pragma unroll
                for (int qp = 0; qp < 2; ++qp) {
                    const int f = fcol0 + ((wn64 + nt * 32) >> 1) + qp * 8 + hh4;
                    const int qg = qp * 2, qu = qp * 2 + 1;
                    const float a0 = siluf_(acc[mt][nt][qg * 4 + 0]) * acc[mt][nt][qu * 4 + 0] * wt;
                    const float a1 = siluf_(acc[mt][nt][qg * 4 + 1]) * acc[mt][nt][qu * 4 + 1] * wt;
                    const float a2 = siluf_(acc[mt][nt][qg * 4 + 2]) * acc[mt][nt][qu * 4 + 2] * wt;
                    const float a3 = siluf_(acc[mt][nt][qg * 4 + 3]) * acc[mt][nt][qu * 4 + 3] * wt;
                    uint2 o; o.x = pack2(a0, a1); o.y = pack2(a2, a3);
                    *(uint2*)(act + (size_t)(orow0 + rl) * 512 + half * 256 + f) = o;
                }
        }
    }
};
__device__ __forceinline__ void phase_moe_gu(const Params& p, unsigned char* lds, int l) {
    const WS w{p.ws};
    int ntl[NCLS]; int tot = 0;
#pragma unroll
    for (int c = 0; c < NCLS; ++c) { ntl[c] = (w.cnt(l)[c] + 127) >> 7; tot += ntl[c]; }
    const int ntile = tot * 8;
    const int lr = threadIdx.x >> 3, lc = threadIdx.x & 7;
    for (int t = blockIdx.x; t < ntile; t += gridDim.x) {
        const int mg = t >> 3, nt = t & 7;
        int cls = 0, mt = 0, run = 0;
#pragma unroll
        for (int c = 0; c < NCLS; ++c) { if (mg >= run && mg < run + ntl[c]) { cls = c; mt = mg - run; } run += ntl[c]; }
        const int cnt = w.cnt(l)[cls];
        int elo, ehi; cls_experts(cls, elo, ehi);
        const int half = nt >> 2, e = half ? ehi : elo;
        const int* lst = w.list() + (size_t)cls * LISTCAP;
        Src4 A, B;
#pragma unroll
        for (int j = 0; j < 4; ++j) {
            int pos = mt * 128 + lr + 32 * j; if (pos >= cnt) pos = 0;
            const int tok = lst[pos];
            A.p0[j] = w.hb() + (size_t)tok * D + lc * 8; A.p1[j] = A.p0[j];
        }
        A.split = 1 << 30;
        src_plain(B, w.wt_gu(l, e), (nt & 3) * 128, D);
        EpiGU ep{w.act(), w.lw() + (size_t)cls * LISTCAP, cnt, mt * 128, mg * 128, half, (nt & 3) * 64};
        gemm128(lds, A, B, D, ep);
    }
}

struct EpiDown {
    const Params* p; const float* mod; const int* lst; int cnt, pos0, n0;
    __device__ __forceinline__ void operator()(const f32x16 (&acc)[2][2], int r0, int c0) const {
#pragma unroll
        for (int mt = 0; mt < 2; ++mt) {
            const int pos = pos0 + r0 + mt * 32;
            if (pos < cnt) {
                const int row = lst[pos], m = modrow(row);
                float* R = Rrow(*p, row);
#pragma unroll
                for (int nt = 0; nt < 2; ++nt)
#pragma unroll
                    for (int q = 0; q < 4; ++q) {
                        const int col = n0 + c0 + nt * 32 + q * 8;
                        const float4 g2 = *(const float4*)(mod + (size_t)m * 6144 + 5120 + col);
                        const float4 x = *(const float4*)(R + col);
                        *(float4*)(R + col) = make_float4(DN_ALPHA * x.x + g2.x * acc[mt][nt][q * 4 + 0], DN_ALPHA * x.y + g2.y * acc[mt][nt][q * 4 + 1],
                                                          DN_ALPHA * x.z + g2.z * acc[mt][nt][q * 4 + 2], DN_ALPHA * x.w + g2.w * acc[mt][nt][q * 4 + 3]);
                    }
            }
        }
    }
};
__device__ __forceinline__ void phase_moe_dn(const Params& p, unsigned char* lds, int l) {
    const WS w{p.ws};
    int ntl[NCLS]; int tot = 0;
#pragma unroll
    for (int c = 0; c < NCLS; ++c) { ntl[c] = (w.cnt(l)[c] + 127) >> 7; tot += ntl[c]; }
    const int ntile = tot * 8;
    for (int t = blockIdx.x; t < ntile; t += gridDim.x) {
        const int mg = t >> 3, nt = t & 7;
        int cls = 0, mt = 0, run = 0;
#pragma unroll
        for (int c = 0; c < NCLS; ++c) { if (mg >= run && mg < run + ntl[c]) { cls = c; mt = mg - run; } run += ntl[c]; }
        const int cnt = w.cnt(l)[cls];
        int elo, ehi; cls_experts(cls, elo, ehi);
        Src4 A, B;
        src_plain(A, w.act(), mg * 128, 512);
        src_split(B, w.wt_dn(l, elo), 256, w.wt_dn(l, ehi), 256, nt * 128, 256);
        EpiDown ep{&p, w.mod(l), w.list() + (size_t)cls * LISTCAP, cnt, mt * 128, nt * 128};
        gemm128(lds, A, B, 512, ep);
    }
}

__device__ __forceinline__ void phase_ln2(const Params& p, int l) {
    const WS w{p.ws};
    const int tid = threadIdx.x, lane = tid & 63, wid = tid >> 6;
    const int nrows = l == 0 ? NROW : NLAT;
    const float* lng = p.in[32] + l * D; const float* lnb = p.in[33] + l * D;
    const float* mdn = w.mod(1);
    for (int row = blockIdx.x * 4 + wid; row < nrows; row += gridDim.x * 4) {
        float* R = Rrow(p, row);
        const int m = modrow(row);
        float4 v[4];
#pragma unroll
        for (int i = 0; i < 4; ++i) v[i] = *(const float4*)(R + i * 256 + lane * 4);
        float s = 0.f;
#pragma unroll
        for (int i = 0; i < 4; ++i) s += (v[i].x + v[i].y) + (v[i].z + v[i].w);
        const float mean = wave_sum(s) * (1.0f / 1024.0f);
        float q = 0.f;
#pragma unroll
        for (int i = 0; i < 4; ++i) { const float a = v[i].x - mean, b = v[i].y - mean, c = v[i].z - mean, d = v[i].w - mean; q += (a * a + b * b) + (c * c + d * d); }
        const float rs = rsqrtf(wave_sum(q) * (1.0f / 1024.0f) + LN_EPS);
#pragma unroll
        for (int i = 0; i < 4; ++i) {
            const int col = i * 256 + lane * 4;
            const float4 g = *(const float4*)(lng + col), b = *(const float4*)(lnb + col);
            float4 x;
            x.x = (v[i].x - mean) * rs * g.x + b.x; x.y = (v[i].y - mean) * rs * g.y + b.y; x.z = (v[i].z - mean) * rs * g.z + b.z; x.w = (v[i].w - mean) * rs * g.w + b.w;
            *(float4*)(R + col) = x;
            if (l == 0) {
                const float4 sh = *(const float4*)(mdn + (size_t)m * 6144 + col), sc = *(const float4*)(mdn + (size_t)m * 6144 + 1024 + col);
                uint2 o; o.x = pack2(x.x * (1.f + sc.x) + sh.x, x.y * (1.f + sc.y) + sh.y); o.y = pack2(x.z * (1.f + sc.z) + sh.z, x.w * (1.f + sc.w) + sh.w);
                *(uint2*)(w.hb() + (size_t)row * D + col) = o;
            }
        }
    }
}

constexpr int NPHASE = 3 + 2 * 10;
__global__ void __launch_bounds__(256, 2) mega(Params p, int ph_lo, int ph_hi) {
    __shared__ __attribute__((aligned(16))) unsigned char lds[LDS_BYTES];
    cg::grid_group grid = cg::this_grid();
#define RUN(idx, ...) if (ph_lo <= (idx) && (idx) < ph_hi) { __VA_ARGS__; if ((idx) + 1 < ph_hi) grid.sync(); }
    RUN(0, phase_pro_a(p, lds))
    RUN(1, phase_pro_b(p))
    RUN(2, phase_pro_c(p))
#define LAYER(l) \
    RUN(3 + 10 * l + 0, phase_inproj(p, lds, l)) \
    RUN(3 + 10 * l + 1, phase_s1(p, lds, l)) \
    RUN(3 + 10 * l + 2, phase_s2(p, lds, l)) \
    RUN(3 + 10 * l + 3, phase_s3(p, lds, l)) \
    RUN(3 + 10 * l + 4, phase_glu(p, lds, l)) \
    RUN(3 + 10 * l + 5, phase_outproj(p, lds, l)) \
    RUN(3 + 10 * l + 6, phase_ln1(p, lds, l)) \
    RUN(3 + 10 * l + 7, phase_moe_gu(p, lds, l)) \
    RUN(3 + 10 * l + 8, phase_moe_dn(p, lds, l)) \
    RUN(3 + 10 * l + 9, phase_ln2(p, l))
    LAYER(0)
    LAYER(1)
#undef LAYER
#undef RUN
}

extern "C" void kernel_launch(void* const* d_in, const int* in_sizes, int n_in, void* d_out, int out_size, void* d_ws, size_t ws_size, hipStream_t stream) {
    static int grid_blocks = 0;
    if (grid_blocks == 0) {
        if (n_in != 34 || out_size != NLAT * D || ws_size < WS_END) {
            fprintf(stderr, "kernel_launch: unexpected shapes (n_in %d out %d ws %zu need %zu)\n", n_in, out_size, ws_size, (size_t)WS_END);
            grid_blocks = -1; return;
        }
        int dev = 0, cus = 0, per_cu = 0;
        hipGetDevice(&dev);
        hipDeviceGetAttribute(&cus, hipDeviceAttributeMultiprocessorCount, dev);
        hipOccupancyMaxActiveBlocksPerMultiprocessor(&per_cu, (const void*)mega, 256, 0);
        if (per_cu < 1) per_cu = 1;
        if (per_cu > 2) per_cu = 2;
        grid_blocks = cus * per_cu;
        fprintf(stderr, "kernel_launch: cus %d per_cu %d grid %d ws need %zu have %zu\n", cus, per_cu, grid_blocks, (size_t)WS_END, ws_size);
    }
    if (grid_blocks < 0) return;
    Params p{};
    for (int i = 0; i < 34; ++i) p.in[i] = (const float*)d_in[i];
    p.out = (float*)d_out; p.ws = (unsigned char*)d_ws;
#if FUSED
    int lo = 0, hi = NPHASE;
    void* args[] = {&p, &lo, &hi};
    hipError_t e = hipLaunchCooperativeKernel((const void*)mega, dim3(grid_blocks), dim3(256), args, 0, stream);
    if (e != hipSuccess) fprintf(stderr, "cooperative launch failed: %s (grid %d)\n", hipGetErrorString(e), grid_blocks);
#else
    for (int ph = 0; ph < NPHASE; ++ph) hipLaunchKernelGGL(mega, dim3(grid_blocks), dim3(256), 0, stream, p, ph, ph + 1);
#endif
}
```

```cpp
#include <hip/hip_runtime.h>
#include <cstdio>
#include <cstdint>

#ifndef FUSED
#define FUSED 1
#endif

typedef unsigned short bf16_t;
typedef __attribute__((ext_vector_type(8))) short bf16x8;
typedef __attribute__((ext_vector_type(16))) float f32x16;

constexpr int D = 1024, NB = 8, SEQ = 2048, CTX = 256;
constexpr int NLAT = NB * SEQ, NCTX = NB * CTX, NROW = NLAT + NCTX;
constexpr int DIN = 1792, DS5 = 512, NG = 32, PS = 64;
constexpr int TCH = 16, NT = 256;
constexpr int NCOL = NROW / TCH;
constexpr int NCOL_LAT = NLAT / TCH;
constexpr int CH_LAT = SEQ / TCH, CH_CTX = CTX / TCH;
constexpr int NSTEP = CH_LAT + CH_CTX;
constexpr int NSEG = 8, SEGLEN = NSTEP / NSEG;
constexpr int NCLS = 24, LISTCAP = NROW;
constexpr int MAXMT = NROW / 128 + NCLS;
constexpr int KSPLIT_MOD = 16;
constexpr float LN_EPS = 1e-5f;
constexpr float DN_ALPHA = 1.4142135623730951f;
constexpr int NPOW = 18;

constexpr size_t AL(size_t x) { return (x + 255) & ~(size_t)255; }
constexpr size_t SZ_WT_IN = (size_t)2 * DIN * D * 2;
constexpr size_t SZ_WT_GLU = (size_t)2 * 512 * 512 * 2;
constexpr size_t SZ_WT_O = (size_t)2 * D * D * 2;
constexpr size_t SZ_WT_GU = (size_t)2 * 16 * 512 * 1024 * 2;
constexpr size_t SZ_WT_DN = (size_t)2 * 16 * 1024 * 256 * 2;
constexpr size_t SZ_MOD = (size_t)2 * 9 * 6144 * 4;
constexpr size_t SZ_LAMPOW = (size_t)2 * 2 * NG * PS * NPOW * 8;
constexpr size_t SZ_BBAR = (size_t)2 * 2 * NG * PS * 16 * 8;
constexpr size_t SZ_KFULL = (size_t)2 * NG * 31 * 256 * 4;
constexpr size_t SZ_M1 = (size_t)2 * NG * 256 * 256 * 2;
constexpr size_t SZ_W2 = (size_t)2 * NG * 256 * 512 * 2;
constexpr size_t SZ_HB = (size_t)NROW * D * 2;
constexpr size_t SZ_UG = (size_t)NG * NROW * 16 * 2;
constexpr size_t SZ_ZR = (size_t)NROW * 1280 * 2;
constexpr size_t SZ_S = (size_t)NG * NCOL * 256 * 4;
constexpr size_t SZ_RCTX = (size_t)NCTX * D * 4;
constexpr size_t SZ_CNT = 256 * 4;
constexpr size_t SZ_LIST = (size_t)NCLS * LISTCAP * 4;
constexpr size_t SZ_LW = (size_t)NCLS * LISTCAP * 8;

constexpr size_t OFF_WT_IN = 0;
constexpr size_t OFF_WT_GLU = OFF_WT_IN + AL(SZ_WT_IN);
constexpr size_t OFF_WT_O = OFF_WT_GLU + AL(SZ_WT_GLU);
constexpr size_t OFF_WT_GU = OFF_WT_O + AL(SZ_WT_O);
constexpr size_t OFF_WT_DN = OFF_WT_GU + AL(SZ_WT_GU);
constexpr size_t OFF_MOD = OFF_WT_DN + AL(SZ_WT_DN);
constexpr size_t OFF_LAMPOW = OFF_MOD + AL(SZ_MOD);
constexpr size_t OFF_BBAR = OFF_LAMPOW + AL(SZ_LAMPOW);
constexpr size_t OFF_KFULL = OFF_BBAR + AL(SZ_BBAR);
constexpr size_t OFF_M1 = OFF_KFULL + AL(SZ_KFULL);
constexpr size_t OFF_W2 = OFF_M1 + AL(SZ_M1);
constexpr size_t OFF_HB = OFF_W2 + AL(SZ_W2);
constexpr size_t OFF_UG = OFF_HB + AL(SZ_HB);
constexpr size_t OFF_ZR = OFF_UG + AL(SZ_UG);
constexpr size_t OFF_S = OFF_ZR + AL(SZ_ZR);
constexpr size_t OFF_RCTX = OFF_S + AL(SZ_S);
constexpr size_t OFF_CNT = OFF_RCTX + AL(SZ_RCTX);
constexpr size_t OFF_LIST = OFF_CNT + AL(SZ_CNT);
constexpr size_t OFF_LW = OFF_LIST + AL(SZ_LIST);
constexpr size_t OFF_BAR = OFF_LW + AL(SZ_LW);
constexpr size_t SZ_BAR = 3456 * 4;
constexpr size_t WS_END = OFF_BAR + AL(SZ_BAR);
static_assert((size_t)KSPLIT_MOD * 2 * 9 * 6144 * 4 <= SZ_ZR, "modp alias");
static_assert((size_t)NG * NCOL * 256 * 2 <= SZ_ZR, "hprev alias");
static_assert((size_t)NROW * 512 * 2 <= SZ_S && (size_t)MAXMT * 128 * 512 * 2 <= SZ_S, "Y/act alias");
static_assert(WS_END <= (size_t)256 * 1024 * 1024, "workspace over 256 MiB");

constexpr int LDS_BYTES = 81920;

struct Params {
    const float* in[34];
    float* out;
    unsigned char* ws;
};

__device__ __forceinline__ unsigned f2bf(float f) { unsigned u = __float_as_uint(f); u += 0x7fffu + ((u >> 16) & 1u); return u >> 16; }
__device__ __forceinline__ float bf2f(unsigned h) { return __uint_as_float(h << 16); }
__device__ __forceinline__ unsigned pack2(float a, float b) { return f2bf(a) | (f2bf(b) << 16); }
__device__ __forceinline__ float bflo(unsigned w) { return __uint_as_float(w << 16); }
__device__ __forceinline__ float bfhi(unsigned w) { return __uint_as_float(w & 0xffff0000u); }
__device__ __forceinline__ float wave_sum(float v) {
#pragma unroll
    for (int o = 32; o >= 1; o >>= 1) v += __shfl_xor(v, o);
    return v;
}
__device__ __forceinline__ float sigmoidf_(float x) { return 1.0f / (1.0f + __expf(-x)); }
__device__ __forceinline__ float siluf_(float x) { return x / (1.0f + __expf(-x)); }
__device__ __forceinline__ float gelu_tanh(float x) {
    const float z = 0.7978845608028654f * (x + 0.044715f * x * x * x);
    const float e = __expf(2.0f * z);
    const float t = 1.0f - 2.0f / (1.0f + e);
    return 0.5f * x * (1.0f + t);
}
__device__ __forceinline__ int modrow(int row) { return row < NLAT ? (row >> 11) : 8; }

struct Src4 { const bf16_t* p0[4]; const bf16_t* p1[4]; int split; };

template <class EPI>
__device__ __forceinline__ void gemm128(unsigned char* lds, const Src4& A, const Src4& B, const int K, const EPI& epi) {
    const int tid = threadIdx.x, lane = tid & 63, wid = tid >> 6, wm = wid >> 1, wn = wid & 1;
    const int lr = tid >> 3, lc = tid & 7;
    const int wofs = lr * 128 + ((lc ^ ((lr >> 1) & 7)) << 4);
    const int l31 = lane & 31, hh = lane >> 5, sw = (l31 >> 1) & 7;
    const int xbase = (wm * 64 + l31) * 128, wbase = 16384 + (wn * 64 + l31) * 128;
    f32x16 acc[2][2];
#pragma unroll
    for (int i = 0; i < 2; ++i)
#pragma unroll
        for (int j = 0; j < 2; ++j)
#pragma unroll
            for (int e = 0; e < 16; ++e) acc[i][j][e] = 0.f;
    uint4 ra[4], rb[4];
    const int nk = K >> 6;
#define G_LOAD(kt_) do { const int k_ = (kt_) * 64; \
        _Pragma("unroll") for (int j = 0; j < 4; ++j) { ra[j] = *(const uint4*)(k_ < A.split ? A.p0[j] + k_ : A.p1[j] + (k_ - A.split)); } \
        _Pragma("unroll") for (int j = 0; j < 4; ++j) { rb[j] = *(const uint4*)(k_ < B.split ? B.p0[j] + k_ : B.p1[j] + (k_ - B.split)); } } while (0)
#define G_WRITE(bufo_) do { \
        _Pragma("unroll") for (int j = 0; j < 4; ++j) { *(uint4*)(lds + (bufo_) + wofs + j * 4096) = ra[j]; *(uint4*)(lds + (bufo_) + 16384 + wofs + j * 4096) = rb[j]; } } while (0)
    G_LOAD(0); G_WRITE(0); __syncthreads();
    for (int kt = 0; kt < nk; ++kt) {
        const int buf = (kt & 1) * 32768;
        if (kt + 1 < nk) G_LOAD(kt + 1);
#pragma unroll
        for (int ks = 0; ks < 4; ++ks) {
            const int co = ((ks * 2 + hh) ^ sw) << 4;
            const bf16x8 x0 = *(const bf16x8*)(lds + buf + xbase + co);
            const bf16x8 x1 = *(const bf16x8*)(lds + buf + xbase + 4096 + co);
            const bf16x8 w0 = *(const bf16x8*)(lds + buf + wbase + co);
            const bf16x8 w1 = *(const bf16x8*)(lds + buf + wbase + 4096 + co);
            acc[0][0] = __builtin_amdgcn_mfma_f32_32x32x16_bf16(w0, x0, acc[0][0], 0, 0, 0);
            acc[0][1] = __builtin_amdgcn_mfma_f32_32x32x16_bf16(w1, x0, acc[0][1], 0, 0, 0);
            acc[1][0] = __builtin_amdgcn_mfma_f32_32x32x16_bf16(w0, x1, acc[1][0], 0, 0, 0);
            acc[1][1] = __builtin_amdgcn_mfma_f32_32x32x16_bf16(w1, x1, acc[1][1], 0, 0, 0);
        }
        if (kt + 1 < nk) G_WRITE(((kt + 1) & 1) * 32768);
        __syncthreads();
    }
#undef G_LOAD
#undef G_WRITE
    epi(acc, wm * 64 + l31, wn * 64 + hh * 4);
}

__device__ __forceinline__ void src_plain(Src4& s, const bf16_t* base, int row0, int ld) {
    const int lr = threadIdx.x >> 3, lc = threadIdx.x & 7;
#pragma unroll
    for (int j = 0; j < 4; ++j) { s.p0[j] = base + (size_t)(row0 + lr + 32 * j) * ld + lc * 8; s.p1[j] = s.p0[j]; }
    s.split = 1 << 30;
}
__device__ __forceinline__ void src_split(Src4& s, const bf16_t* base0, int ld0, const bf16_t* base1, int ld1, int row0, int split) {
    const int lr = threadIdx.x >> 3, lc = threadIdx.x & 7;
#pragma unroll
    for (int j = 0; j < 4; ++j) { s.p0[j] = base0 + (size_t)(row0 + lr + 32 * j) * ld0 + lc * 8; s.p1[j] = base1 + (size_t)(row0 + lr + 32 * j) * ld1 + lc * 8; }
    s.split = split;
}

#define ACC_FOREACH(acc, r0, c0, ...) \
    _Pragma("unroll") for (int mt_ = 0; mt_ < 2; ++mt_) \
    _Pragma("unroll") for (int nt_ = 0; nt_ < 2; ++nt_) \
    _Pragma("unroll") for (int q_ = 0; q_ < 4; ++q_) { \
        const int rl = (r0) + mt_ * 32, cl = (c0) + nt_ * 32 + q_ * 8; \
        const float v0 = acc[mt_][nt_][q_ * 4 + 0], v1 = acc[mt_][nt_][q_ * 4 + 1], v2 = acc[mt_][nt_][q_ * 4 + 2], v3 = acc[mt_][nt_][q_ * 4 + 3]; \
        __VA_ARGS__ }

struct WS {
    unsigned char* b;
    __device__ bf16_t* wt_in(int l) const { return (bf16_t*)(b + OFF_WT_IN) + (size_t)l * DIN * D; }
    __device__ bf16_t* wt_glu(int l) const { return (bf16_t*)(b + OFF_WT_GLU) + (size_t)l * 512 * 512; }
    __device__ bf16_t* wt_o(int l) const { return (bf16_t*)(b + OFF_WT_O) + (size_t)l * D * D; }
    __device__ bf16_t* wt_gu(int l, int e) const { return (bf16_t*)(b + OFF_WT_GU) + (size_t)(l * 16 + e) * 512 * 1024; }
    __device__ bf16_t* wt_dn(int l, int e) const { return (bf16_t*)(b + OFF_WT_DN) + (size_t)(l * 16 + e) * 1024 * 256; }
    __device__ float* mod(int l) const { return (float*)(b + OFF_MOD) + (size_t)l * 9 * 6144; }
    __device__ float* modp() const { return (float*)(b + OFF_ZR); }
    __device__ float2* lampow(int l, int d, int g) const { return (float2*)(b + OFF_LAMPOW) + (size_t)((l * 2 + d) * NG + g) * PS * NPOW; }
    __device__ float2* bbar(int l, int d, int g) const { return (float2*)(b + OFF_BBAR) + (size_t)((l * 2 + d) * NG + g) * PS * 16; }
    __device__ float* kfull(int l, int g) const { return (float*)(b + OFF_KFULL) + (size_t)(l * NG + g) * 31 * 256; }
    __device__ bf16_t* m1(int l, int g) const { return (bf16_t*)(b + OFF_M1) + (size_t)(l * NG + g) * 256 * 256; }
    __device__ bf16_t* w2(int l, int g) const { return (bf16_t*)(b + OFF_W2) + (size_t)(l * NG + g) * 256 * 512; }
    __device__ bf16_t* hb() const { return (bf16_t*)(b + OFF_HB); }
    __device__ bf16_t* ug() const { return (bf16_t*)(b + OFF_UG); }
    __device__ bf16_t* zr() const { return (bf16_t*)(b + OFF_ZR); }
    __device__ bf16_t* hprev() const { return (bf16_t*)(b + OFF_ZR); }
    __device__ float* S() const { return (float*)(b + OFF_S); }
    __device__ bf16_t* Y() const { return (bf16_t*)(b + OFF_S); }
    __device__ bf16_t* act() const { return (bf16_t*)(b + OFF_S); }
    __device__ float* rctx() const { return (float*)(b + OFF_RCTX); }
    __device__ int* cnt(int l) const { return (int*)(b + OFF_CNT) + l * 32; }
    __device__ int* list() const { return (int*)(b + OFF_LIST); }
    __device__ float2* lw() const { return (float2*)(b + OFF_LW); }
};
__device__ __forceinline__ float* Rrow(const Params& p, int row) {
    return row < NLAT ? p.out + (size_t)row * D : (float*)(p.ws + OFF_RCTX) + (size_t)(row - NLAT) * D;
}

__device__ __forceinline__ void transpose_tile(unsigned char* lds, const float* src, int ldsrc, int k0, int n0, bf16_t* dst, int lddst, int rowmode) {
    float* tile = (float*)lds;
    const int tid = threadIdx.x;
    __syncthreads();
#pragma unroll
    for (int pass = 0; pass < 4; ++pass) {
        const int k = pass * 16 + (tid >> 4), n4 = (tid & 15) * 4;
        const float4 v = *(const float4*)(src + (size_t)(k0 + k) * ldsrc + n0 + n4);
        tile[k * 65 + n4 + 0] = v.x; tile[k * 65 + n4 + 1] = v.y; tile[k * 65 + n4 + 2] = v.z; tile[k * 65 + n4 + 3] = v.w;
    }
    __syncthreads();
#pragma unroll
    for (int t2 = 0; t2 < 2; ++t2) {
        const int task = tid + t2 * 256, n = task & 63, kc = task >> 6;
        float f[8];
#pragma unroll
        for (int i = 0; i < 8; ++i) f[i] = tile[(kc * 8 + i) * 65 + n];
        const int ng = n0 + n;
        int drow = ng;
        if (rowmode == 1) drow = ((ng >> 3) << 4) + (ng & 7);
        else if (rowmode == 2) drow = ((ng >> 3) << 4) + 8 + (ng & 7);
        uint4 o; o.x = pack2(f[0], f[1]); o.y = pack2(f[2], f[3]); o.z = pack2(f[4], f[5]); o.w = pack2(f[6], f[7]);
        *(uint4*)(dst + (size_t)drow * lddst + k0 + kc * 8) = o;
    }
}

__device__ __forceinline__ void phase_pro_a(const Params& p, unsigned char* lds) {
    const WS w{p.ws};
    const int tid = threadIdx.x;
    if (blockIdx.x == 0 && tid < 64) ((int*)(p.ws + OFF_CNT))[tid] = 0;
    constexpr int N_MOD = 2 * 6 * KSPLIT_MOD, N_TAB = 32, N_WT = 2 * 3840;
    for (int it = blockIdx.x; it < N_MOD + N_TAB + N_WT; it += gridDim.x) {
        if (it < N_MOD) {
            const int l = it / (6 * KSPLIT_MOD), rem = it % (6 * KSPLIT_MOD), cb = rem / KSPLIT_MOD, ks = rem % KSPLIT_MOD;
            float* sc = (float*)lds;
            __syncthreads();
            for (int i = tid; i < 9 * 64; i += 256) {
                const int r = i >> 6, kk = i & 63, k = ks * 64 + kk;
                const float cv = r < 8 ? p.in[1][r * D + k] : p.in[3][k];
                sc[i] = siluf_(cv);
            }
            __syncthreads();
            float acc[9][4];
#pragma unroll
            for (int r = 0; r < 9; ++r) { acc[r][0] = acc[r][1] = acc[r][2] = acc[r][3] = 0.f; }
            const float* wm = p.in[4] + ((size_t)l * D + ks * 64) * 6144 + cb * 1024 + tid * 4;
#pragma unroll 8
            for (int kk = 0; kk < 64; ++kk) {
                const float4 v = *(const float4*)(wm + (size_t)kk * 6144);
#pragma unroll
                for (int r = 0; r < 9; ++r) { const float s = sc[r * 64 + kk]; acc[r][0] += s * v.x; acc[r][1] += s * v.y; acc[r][2] += s * v.z; acc[r][3] += s * v.w; }
            }
            float* mp = w.modp() + ((size_t)(ks * 2 + l) * 9) * 6144 + cb * 1024 + tid * 4;
#pragma unroll
            for (int r = 0; r < 9; ++r) *(float4*)(mp + (size_t)r * 6144) = make_float4(acc[r][0], acc[r][1], acc[r][2], acc[r][3]);
        } else if (it < N_MOD + N_TAB) {
            const int id = (it - N_MOD) * 256 + tid;
            const int pp = id & 63, g = (id >> 6) & 31, d = (id >> 11) & 1, l = id >> 12;
            const int i3 = (l * 2 + d) * NG + g;
            const double dt = exp((double)p.in[9][i3]);
            const double are = (double)p.in[7][i3 * PS + pp], aim = (double)p.in[8][i3 * PS + pp];
            float2* lp = w.lampow(l, d, g) + pp * NPOW;
            double lbr = 0, lbi = 0;
            for (int k = 0; k < NPOW; ++k) {
                const double kk = (k == 17) ? (double)(TCH * SEGLEN) : (double)k;
                const double mag = exp(kk * are * dt);
                double s, c; sincos(kk * aim * dt, &s, &c);
                lp[k] = make_float2((float)(mag * c), (float)(mag * s));
                if (k == 1) { lbr = mag * c; lbi = mag * s; }
            }
            const double nr = lbr - 1.0, ni = lbi, den = are * are + aim * aim;
            const double cr = (nr * are + ni * aim) / den, ci = (ni * are - nr * aim) / den;
            float2* bb = w.bbar(l, d, g) + pp * 16;
            for (int n = 0; n < 16; ++n) {
                const double br = (double)p.in[10][(size_t)(i3 * PS + pp) * 16 + n], bi = (double)p.in[11][(size_t)(i3 * PS + pp) * 16 + n];
                bb[n] = make_float2((float)(cr * br - ci * bi), (float)(cr * bi + ci * br));
            }
        } else {
            int t = it - N_MOD - N_TAB;
            const int l = t / 3840; t %= 3840;
            if (t < 448) { const int kt = t / 28, nt = t % 28; transpose_tile(lds, p.in[6] + (size_t)l * D * DIN, DIN, kt * 64, nt * 64, w.wt_in(l), D, 0); }
            else if (t < 512) { t -= 448; const int kt = t / 8, nt = t % 8; transpose_tile(lds, p.in[15] + (size_t)l * 512 * 512, 512, kt * 64, nt * 64, w.wt_glu(l), 512, 0); }
            else if (t < 768) { t -= 512; const int kt = t / 16, nt = t % 16; transpose_tile(lds, p.in[22] + (size_t)l * D * D, D, kt * 64, nt * 64, w.wt_o(l), D, 0); }
            else if (t < 1792) { t -= 768; const int e = t / 64, r = t % 64, kt = r / 4, nt = r % 4; transpose_tile(lds, p.in[29] + (size_t)(l * 16 + e) * D * 256, 256, kt * 64, nt * 64, w.wt_gu(l, e), D, 1); }
            else if (t < 2816) { t -= 1792; const int e = t / 64, r = t % 64, kt = r / 4, nt = r % 4; transpose_tile(lds, p.in[30] + (size_t)(l * 16 + e) * D * 256, 256, kt * 64, nt * 64, w.wt_gu(l, e), D, 2); }
            else { t -= 2816; const int e = t / 64, r = t % 64, kt = r / 16, nt = r % 16; transpose_tile(lds, p.in[31] + (size_t)(l * 16 + e) * 256 * D, D, kt * 64, nt * 64, w.wt_dn(l, e), 256, 0); }
        }
    }
}

__device__ __forceinline__ void phase_pro_b(const Params& p) {
    const WS w{p.ws};
    const int gt = blockIdx.x * 256 + threadIdx.x, gs = gridDim.x * 256;
    for (int i = gt; i < 2 * 9 * 6144; i += gs) {
        const int l = i / (9 * 6144), n = i % 6144;
        float s = p.in[5][l * 6144 + n];
        const float* mp = w.modp() + i;
#pragma unroll
        for (int ks = 0; ks < KSPLIT_MOD; ++ks) s += mp[(size_t)ks * 2 * 9 * 6144];
        ((float*)(p.ws + OFF_MOD))[i] = s;
    }
    for (int i = gt; i < 2 * NG * 31 * 256; i += gs) {
        const int ni = i & 15, no = (i >> 4) & 15, ti = (i >> 8) % 31, lg = i / (31 * 256), g = lg & 31, l = lg >> 5;
        const int tau = ti - 15;
        float s = 0.f;
#pragma unroll
        for (int d = 0; d < 2; ++d) {
            if ((d == 0 && tau < 0) || (d == 1 && tau > 0)) continue;
            const int at = tau < 0 ? -tau : tau;
            const float2* lp = w.lampow(l, d, g);
            const float2* bb = w.bbar(l, d, g);
            const float* cre = p.in[12] + ((size_t)((l * 2 + d) * NG + g) * 16 + no) * PS;
            const float* cim = p.in[13] + ((size_t)((l * 2 + d) * NG + g) * 16 + no) * PS;
            for (int pp = 0; pp < PS; ++pp) {
                const float2 L = lp[pp * NPOW + at], Bv = bb[pp * 16 + ni];
                const float er = L.x * Bv.x - L.y * Bv.y, ei = L.x * Bv.y + L.y * Bv.x;
                s += cre[pp] * er - cim[pp] * ei;
            }
        }
        if (tau == 0 && no == ni) s += p.in[14][l * DS5 + g * 16 + no];
        ((float*)(p.ws + OFF_KFULL))[i] = s;
    }
    for (int i = gt; i < 2 * NG * 256 * 32; i += gs) {
        const int c8 = i & 31, row = (i >> 5) & 255, lg = i >> 13, g = lg & 31, l = lg >> 5;
        const int d = row >> 7, pp = (row & 127) >> 1, c = row & 1, j = c8 >> 1, n0 = (c8 & 1) * 8;
        const int e = d == 0 ? (TCH - 1 - j) : j;
        const float2 L = w.lampow(l, d, g)[pp * NPOW + e];
        const float2* bb = w.bbar(l, d, g) + pp * 16 + n0;
        float f[8];
#pragma unroll
        for (int n = 0; n < 8; ++n) { const float2 Bv = bb[n]; f[n] = c == 0 ? (L.x * Bv.x - L.y * Bv.y) : (L.x * Bv.y + L.y * Bv.x); }
        uint4 o; o.x = pack2(f[0], f[1]); o.y = pack2(f[2], f[3]); o.z = pack2(f[4], f[5]); o.w = pack2(f[6], f[7]);
        *(uint4*)(w.m1(l, g) + (size_t)row * 256 + c8 * 8) = o;
    }
}

__device__ __forceinline__ void phase_pro_c(const Params& p) {
    const WS w{p.ws};
    const int gt = blockIdx.x * 256 + threadIdx.x, gs = gridDim.x * 256;
    for (int i = gt; i < 2 * NG * 256 * 64; i += gs) {
        const int c8 = i & 63, r = (i >> 6) & 255, lg = i >> 14, g = lg & 31, l = lg >> 5;
        const int jo = r >> 4, no = r & 15;
        float f[8];
        if (c8 < 32) {
            const int ji = c8 >> 1, n0 = (c8 & 1) * 8;
            const float* kf = w.kfull(l, g) + ((size_t)(jo - ji + 15) * 16 + no) * 16 + n0;
#pragma unroll
            for (int n = 0; n < 8; ++n) f[n] = kf[n];
        } else {
            const int kk = (c8 - 32) * 8, d = kk >> 7, p0 = (kk & 127) >> 1;
            const int e = d == 0 ? (jo + 1) : (TCH - jo);
            const float* cre = p.in[12] + ((size_t)((l * 2 + d) * NG + g) * 16 + no) * PS;
            const float* cim = p.in[13] + ((size_t)((l * 2 + d) * NG + g) * 16 + no) * PS;
            const float2* lp = w.lampow(l, d, g);
#pragma unroll
            for (int q = 0; q < 4; ++q) {
                const int pp = p0 + q;
                const float2 L = lp[pp * NPOW + e];
                const float cr = cre[pp], ci = cim[pp];
                f[2 * q] = cr * L.x - ci * L.y;
                f[2 * q + 1] = -(cr * L.y + ci * L.x);
            }
        }
        uint4 o; o.x = pack2(f[0], f[1]); o.y = pack2(f[2], f[3]); o.z = pack2(f[4], f[5]); o.w = pack2(f[6], f[7]);
        *(uint4*)(w.w2(l, g) + (size_t)r * 512 + c8 * 8) = o;
    }
    const float* md = w.mod(0);
    for (int i = gt; i < NROW * 128; i += gs) {
        const int row = i >> 7, c8 = (i & 127) * 8, m = modrow(row);
        const float* xs = row < NLAT ? p.in[0] + (size_t)row * D : p.in[2] + (size_t)(row - NLAT) * D;
        const float4 a = *(const float4*)(xs + c8), b = *(const float4*)(xs + c8 + 4);
        const float* sh = md + (size_t)m * 6144 + c8; const float* sc = sh + 1024;
        const float4 s0 = *(const float4*)sh, s1 = *(const float4*)(sh + 4), c0 = *(const float4*)sc, c1 = *(const float4*)(sc + 4);
        uint4 o;
        o.x = pack2(a.x * (1.f + c0.x) + s0.x, a.y * (1.f + c0.y) + s0.y);
        o.y = pack2(a.z * (1.f + c0.z) + s0.z, a.w * (1.f + c0.w) + s0.w);
        o.z = pack2(b.x * (1.f + c1.x) + s1.x, b.y * (1.f + c1.y) + s1.y);
        o.w = pack2(b.z * (1.f + c1.z) + s1.z, b.w * (1.f + c1.w) + s1.w);
        *(uint4*)(w.hb() + (size_t)row * D + c8) = o;
    }
}

struct EpiInproj {
    bf16_t* ug; bf16_t* zr; int m0, n0;
    __device__ __forceinline__ void operator()(const f32x16 (&acc)[2][2], int r0, int c0) const {
        ACC_FOREACH(acc, r0, c0, {
            const int row = m0 + rl, col = n0 + cl;
            uint2 o; o.x = pack2(v0, v1); o.y = pack2(v2, v3);
            if (col < DS5) *(uint2*)(ug + ((size_t)(col >> 4) * NROW + row) * 16 + (col & 15)) = o;
            else *(uint2*)(zr + (size_t)row * 1280 + (col - DS5)) = o;
        })
    }
};
__device__ __forceinline__ void phase_inproj(const Params& p, unsigned char* lds, int l) {
    const WS w{p.ws};
    const int nfull = (l == 0 ? 144 : 128) * 14, ntile = nfull + (l == 0 ? 0 : 16 * 4);
    for (int t = blockIdx.x; t < ntile; t += gridDim.x) {
        int mt, nt;
        if (t < nfull) { mt = t / 14; nt = t % 14; } else { mt = 128 + (t - nfull) / 4; nt = (t - nfull) % 4; }
        Src4 A, B;
        src_plain(A, w.hb(), mt * 128, D);
        src_plain(B, w.wt_in(l), nt * 128, D);
        EpiInproj e{w.ug(), w.zr(), mt * 128, nt * 128};
        gemm128(lds, A, B, D, e);
    }
}

struct EpiS1 {
    float* S; int m0, n0;
    __device__ __forceinline__ void operator()(const f32x16 (&acc)[2][2], int r0, int c0) const {
        ACC_FOREACH(acc, r0, c0, {
            *(float4*)(S + (size_t)(m0 + rl) * 256 + n0 + cl) = make_float4(v0, v1, v2, v3);
        })
    }
};

__device__ __forceinline__ void conv_sc(const Params& p, int l, int nrows) {
    const WS w{p.ws};
    const float* wsc = p.in[17] + (size_t)l * 3 * 256;
    const int gt = blockIdx.x * 256 + threadIdx.x, gs = gridDim.x * 256;
    for (int i = gt; i < nrows * 32; i += gs) {
        const int row = i >> 5, c8 = (i & 31) * 8;
        int pos, len;
        if (row < NLAT) { pos = row & 63; len = 64; } else { pos = (row - NLAT) & 255; len = 256; }
        const bf16_t* zr = w.zr() + (size_t)row * 1280;
        float accv[8];
#pragma unroll
        for (int e = 0; e < 8; ++e) accv[e] = 0.f;
#pragma unroll
        for (int j = -1; j <= 1; ++j) {
            if (pos + j < 0 || pos + j >= len) continue;
            const uint4 cg = *(const uint4*)(zr + (ptrdiff_t)j * 1280 + 256 + c8);
            const uint4 vv = *(const uint4*)(zr + (ptrdiff_t)j * 1280 + 512 + c8);
            const float4 wa = *(const float4*)(wsc + (j + 1) * 256 + c8), wb = *(const float4*)(wsc + (j + 1) * 256 + c8 + 4);
            accv[0] += wa.x * bflo(cg.x) * bflo(vv.x); accv[1] += wa.y * bfhi(cg.x) * bfhi(vv.x);
            accv[2] += wa.z * bflo(cg.y) * bflo(vv.y); accv[3] += wa.w * bfhi(cg.y) * bfhi(vv.y);
            accv[4] += wb.x * bflo(cg.z) * bflo(vv.z); accv[5] += wb.y * bfhi(cg.z) * bfhi(vv.z);
            accv[6] += wb.z * bflo(cg.w) * bflo(vv.w); accv[7] += wb.w * bfhi(cg.w) * bfhi(vv.w);
        }
        const uint4 bg = *(const uint4*)(zr + c8);
        uint4 o;
        o.x = pack2(accv[0] * bflo(bg.x), accv[1] * bfhi(bg.x));
        o.y = pack2(accv[2] * bflo(bg.y), accv[3] * bfhi(bg.y));
        o.z = pack2(accv[4] * bflo(bg.z), accv[5] * bfhi(bg.z));
        o.w = pack2(accv[6] * bflo(bg.w), accv[7] * bfhi(bg.w));
        *(uint4*)(w.hb() + (size_t)row * D + 512 + c8) = o;
    }
}

__device__ __forceinline__ void conv_cf(const Params& p, unsigned char* lds, int l, bool with_ctx) {
    const WS w{p.ws};
    float* P = (float*)lds;
    const int tid = threadIdx.x, lane = tid & 63, wid = tid >> 6;
    const float* wdw = p.in[18] + (size_t)l * 31 * 256;
    const float4 bdw = *(const float4*)(p.in[19] + l * 256 + lane * 4);
    const float4 lg = *(const float4*)(p.in[20] + l * 256 + lane * 4);
    const float4 lb = *(const float4*)(p.in[21] + l * 256 + lane * 4);
    const int nitem = 256 + (with_ctx ? 64 : 0);
    for (int it = blockIdx.x; it < nitem; it += gridDim.x) {
        const bool lat = it < 256;
        int b, base, nslot, sstride, s0 = 0;
        if (lat) { b = it >> 5; base = b * SEQ + (it & 31) * 2; nslot = 64; sstride = 2; }
        else { const int j = it - 256; b = j >> 3; s0 = (j & 7) * 32; base = NLAT + b * CTX; nslot = 62; sstride = 1; }
        __syncthreads();
        for (int task = tid; task < 64 * 32; task += 256) {
            const int slot = task >> 5, c8 = (task & 31) * 8;
            int row; bool valid = true;
            if (lat) row = base + (slot >> 1) * 64 + (slot & 1);
            else { const int s = s0 - 15 + slot; valid = (slot < nslot) && s >= 0 && s < CTX; row = base + s; }
            float f[8];
            if (valid) {
                const bf16_t* zr = w.zr() + (size_t)row * 1280;
                const uint4 ga = *(const uint4*)(zr + 768 + c8), gb = *(const uint4*)(zr + 1024 + c8);
                f[0] = bflo(ga.x) * sigmoidf_(bflo(gb.x)); f[1] = bfhi(ga.x) * sigmoidf_(bfhi(gb.x));
                f[2] = bflo(ga.y) * sigmoidf_(bflo(gb.y)); f[3] = bfhi(ga.y) * sigmoidf_(bfhi(gb.y));
                f[4] = bflo(ga.z) * sigmoidf_(bflo(gb.z)); f[5] = bfhi(ga.z) * sigmoidf_(bfhi(gb.z));
                f[6] = bflo(ga.w) * sigmoidf_(bflo(gb.w)); f[7] = bfhi(ga.w) * sigmoidf_(bfhi(gb.w));
            } else {
#pragma unroll
                for (int e = 0; e < 8; ++e) f[e] = 0.f;
            }
            *(float4*)(P + slot * 256 + c8) = make_float4(f[0], f[1], f[2], f[3]);
            *(float4*)(P + slot * 256 + c8 + 4) = make_float4(f[4], f[5], f[6], f[7]);
        }
        __syncthreads();
        const int nout = lat ? 64 : 32;
        for (int o = wid; o < nout; o += 4) {
            float4 a = bdw;
            int row;
            if (lat) {
                const int r = o >> 1, i = o & 1;
                row = base + r * 64 + i;
                for (int k = 0; k < 31; ++k) {
                    const int rr = r + k - 15;
                    if (rr < 0 || rr >= 32) continue;
                    const float4 wv = *(const float4*)(wdw + k * 256 + lane * 4);
                    const float4 pv = *(const float4*)(P + (rr * 2 + i) * 256 + lane * 4);
                    a.x += wv.x * pv.x; a.y += wv.y * pv.y; a.z += wv.z * pv.z; a.w += wv.w * pv.w;
                }
            } else {
                row = base + s0 + o;
                for (int k = 0; k < 31; ++k) {
                    const float4 wv = *(const float4*)(wdw + k * 256 + lane * 4);
                    const float4 pv = *(const float4*)(P + (o + k) * 256 + lane * 4);
                    a.x += wv.x * pv.x; a.y += wv.y * pv.y; a.z += wv.z * pv.z; a.w += wv.w * pv.w;
                }
            }
            const float mean = wave_sum(a.x + a.y + a.z + a.w) * (1.0f / 256.0f);
            const float dx = a.x - mean, dy = a.y - mean, dz = a.z - mean, dw = a.w - mean;
            const float var = wave_sum(dx * dx + dy * dy + dz * dz + dw * dw) * (1.0f / 256.0f);
            const float rs = rsqrtf(var + LN_EPS);
            const float y0 = siluf_(dx * rs * lg.x + lb.x), y1 = siluf_(dy * rs * lg.y + lb.y), y2 = siluf_(dz * rs * lg.z + lb.z), y3 = siluf_(dw * rs * lg.w + lb.w);
            uint2 ov; ov.x = pack2(y0, y1); ov.y = pack2(y2, y3);
            *(uint2*)(w.hb() + (size_t)row * D + 768 + lane * 4) = ov;
        }
    }
}

__device__ __forceinline__ void phase_s1(const Params& p, unsigned char* lds, int l) {
    const WS w{p.ws};
    const int ntile = NG * 9 * 2;
    for (int t = blockIdx.x; t < ntile; t += gridDim.x) {
        const int g = t / 18, r = t % 18, mt = r >> 1, nt = r & 1;
        Src4 A, B;
        src_plain(A, w.ug() + (size_t)g * NROW * 16, mt * 128, 256);
        src_plain(B, w.m1(l, g), nt * 128, 256);
        EpiS1 e{w.S() + (size_t)g * NCOL * 256, mt * 128, nt * 128};
        gemm128(lds, A, B, 256, e);
    }
    conv_sc(p, l, l == 0 ? NROW : NLAT);
    conv_cf(p, lds, l, l == 0);
}

__device__ __forceinline__ int chunk_col(int d, int b, int step) {
    if (step < CH_CTX) { const int c = d == 0 ? step : (CH_CTX - 1 - step); return NCOL_LAT + b * CH_CTX + c; }
    const int s = step - CH_CTX; const int c = d == 0 ? s : (CH_LAT - 1 - s); return b * CH_LAT + c;
}
__device__ __forceinline__ void phase_s2(const Params& p, unsigned char* lds, int l) {
    const WS w{p.ws};
    float2* Fs = (float2*)lds;
    const int tid = threadIdx.x, seg = tid >> 5, pl = tid & 31;
    for (int it = blockIdx.x; it < NG * 2 * NB * 2; it += gridDim.x) {
        const int ph = it & 1, b = (it >> 1) & 7, d = (it >> 4) & 1, g = it >> 5;
        const int pp = ph * 32 + pl;
        const float2 A = w.lampow(l, d, g)[pp * NPOW + 16], A18 = w.lampow(l, d, g)[pp * NPOW + 17];
        const float* S = w.S() + (size_t)g * NCOL * 256 + d * 128 + 2 * pp;
        bf16_t* Hp = w.hprev() + (size_t)g * NCOL * 256 + d * 128 + 2 * pp;
        float2 s[SEGLEN];
#pragma unroll
        for (int i = 0; i < SEGLEN; ++i) s[i] = *(const float2*)(S + (size_t)chunk_col(d, b, seg * SEGLEN + i) * 256);
        float2 F = make_float2(0.f, 0.f);
#pragma unroll
        for (int i = 0; i < SEGLEN; ++i) { const float fr = A.x * F.x - A.y * F.y + s[i].x, fi = A.x * F.y + A.y * F.x + s[i].y; F.x = fr; F.y = fi; }
        __syncthreads();
        Fs[seg * 32 + pl] = F;
        __syncthreads();
        float2 H = make_float2(0.f, 0.f);
        for (int q = 0; q < seg; ++q) { const float2 f = Fs[q * 32 + pl]; const float hr = A18.x * H.x - A18.y * H.y + f.x, hi = A18.x * H.y + A18.y * H.x + f.y; H.x = hr; H.y = hi; }
#pragma unroll
        for (int i = 0; i < SEGLEN; ++i) {
            *(unsigned*)(Hp + (size_t)chunk_col(d, b, seg * SEGLEN + i) * 256) = pack2(H.x, H.y);
            const float hr = A.x * H.x - A.y * H.y + s[i].x, hi = A.x * H.y + A.y * H.x + s[i].y; H.x = hr; H.y = hi;
        }
    }
}

struct EpiS3 {
    bf16_t* Y; int m0, n0, g;
    __device__ __forceinline__ void operator()(const f32x16 (&acc)[2][2], int r0, int c0) const {
        ACC_FOREACH(acc, r0, c0, {
            const int col = n0 + cl, tok = (m0 + rl) * TCH + (col >> 4);
            uint2 o; o.x = pack2(gelu_tanh(v0), gelu_tanh(v1)); o.y = pack2(gelu_tanh(v2), gelu_tanh(v3));
            *(uint2*)(Y + (size_t)tok * DS5 + g * 16 + (col & 15)) = o;
        })
    }
};
__device__ __forceinline__ void phase_s3(const Params& p, unsigned char* lds, int l) {
    const WS w{p.ws};
    const int nmt = l == 0 ? 9 : 8, ntile = NG * nmt * 2;
    for (int t = blockIdx.x; t < ntile; t += gridDim.x) {
        const int g = t / (nmt * 2), r = t % (nmt * 2), mt = r >> 1, nt = r & 1;
        Src4 A, B;
        src_split(A, w.ug() + (size_t)g * NROW * 16, 256, w.hprev() + (size_t)g * NCOL * 256, 256, mt * 128, 256);
        src_plain(B, w.w2(l, g), nt * 128, 512);
        EpiS3 e{w.Y(), mt * 128, nt * 128, g};
        gemm128(lds, A, B, 512, e);
    }
}

struct EpiGlu {
    const bf16_t* Y; bf16_t* hb; const float* bg; int m0, n0;
    __device__ __forceinline__ void operator()(const f32x16 (&acc)[2][2], int r0, int c0) const {
        ACC_FOREACH(acc, r0, c0, {
            const int row = m0 + rl, col = n0 + cl;
            const uint2 t = *(const uint2*)(Y + (size_t)row * DS5 + col);
            const float4 b = *(const float4*)(bg + col);
            uint2 o;
            o.x = pack2(bflo(t.x) * sigmoidf_(v0 + b.x), bfhi(t.x) * sigmoidf_(v1 + b.y));
            o.y = pack2(bflo(t.y) * sigmoidf_(v2 + b.z), bfhi(t.y) * sigmoidf_(v3 + b.w));
            *(uint2*)(hb + (size_t)row * D + col) = o;
        })
    }
};
__device__ __forceinline__ void phase_glu(const Params& p, unsigned char* lds, int l) {
    const WS w{p.ws};
    const int nmt = l == 0 ? 144 : 128, ntile = nmt * 4;
    for (int t = blockIdx.x; t < ntile; t += gridDim.x) {
        const int mt = t >> 2, nt = t & 3;
        Src4 A, B;
        src_plain(A, w.Y(), mt * 128, DS5);
        src_plain(B, w.wt_glu(l), nt * 128, 512);
        EpiGlu e{w.Y(), w.hb(), p.in[16] + l * DS5, mt * 128, nt * 128};
        gemm128(lds, A, B, 512, e);
    }
}

struct EpiOut {
    const Params* p; const float* mod; int l, m0, n0;
    __device__ __forceinline__ void operator()(const f32x16 (&acc)[2][2], int r0, int c0) const {
        ACC_FOREACH(acc, r0, c0, {
            const int row = m0 + rl, col = n0 + cl, m = modrow(row);
            const float4 g1 = *(const float4*)(mod + (size_t)m * 6144 + 2048 + col);
            float* R = Rrow(*p, row) + col;
            const float* res = l == 0 ? (row < NLAT ? p->in[0] + (size_t)row * D + col : p->in[2] + (size_t)(row - NLAT) * D + col) : R;
            const float4 x = *(const float4*)res;
            *(float4*)R = make_float4(DN_ALPHA * x.x + g1.x * v0, DN_ALPHA * x.y + g1.y * v1, DN_ALPHA * x.z + g1.z * v2, DN_ALPHA * x.w + g1.w * v3);
        })
    }
};
__device__ __forceinline__ void phase_outproj(const Params& p, unsigned char* lds, int l) {
    const WS w{p.ws};
    const int nmt = l == 0 ? 144 : 128, ntile = nmt * 8;
    for (int t = blockIdx.x; t < ntile; t += gridDim.x) {
        const int mt = t >> 3, nt = t & 7;
        Src4 A, B;
        src_plain(A, w.hb(), mt * 128, D);
        src_plain(B, w.wt_o(l), nt * 128, D);
        EpiOut e{&p, w.mod(l), l, mt * 128, nt * 128};
        gemm128(lds, A, B, D, e);
    }
}

__device__ __forceinline__ void phase_ln1(const Params& p, unsigned char* lds, int l) {
    const WS w{p.ws};
    const int tid = threadIdx.x, lane = tid & 63, wid = tid >> 6;
    float* wl = (float*)lds;
    __syncthreads();
    for (int i = tid; i < 1024 * 20; i += 256) {
        const int k = i / 20, o = i % 20;
        const float v = o < 4 ? p.in[25][((size_t)l * D + k) * 4 + o] : p.in[27][((size_t)l * D + k) * 16 + (o - 4)];
        const int s = ((k >> 8) * 4 + (k & 3)) * 64 + ((k >> 2) & 63);
        wl[((o >> 2) * 1024 + s) * 4 + (o & 3)] = v;
    }
    __syncthreads();
    const int nrows = l == 0 ? NROW : NLAT;
    const float* md = w.mod(l);
    const float* lng = p.in[23] + l * D; const float* lnb = p.in[24] + l * D;
    for (int row = blockIdx.x * 4 + wid; row < nrows; row += gridDim.x * 4) {
        float* R = Rrow(p, row);
        const int m = modrow(row);
        float h[16];
        float4 v[4];
#pragma unroll
        for (int i = 0; i < 4; ++i) v[i] = *(const float4*)(R + i * 256 + lane * 4);
        float s = 0.f;
#pragma unroll
        for (int i = 0; i < 4; ++i) s += (v[i].x + v[i].y) + (v[i].z + v[i].w);
        const float mean = wave_sum(s) * (1.0f / 1024.0f);
        float q = 0.f;
#pragma unroll
        for (int i = 0; i < 4; ++i) { const float a = v[i].x - mean, b = v[i].y - mean, c = v[i].z - mean, d = v[i].w - mean; q += (a * a + b * b) + (c * c + d * d); }
        const float rs = rsqrtf(wave_sum(q) * (1.0f / 1024.0f) + LN_EPS);
#pragma unroll
        for (int i = 0; i < 4; ++i) {
            const int col = i * 256 + lane * 4;
            const float4 g = *(const float4*)(lng + col), b = *(const float4*)(lnb + col);
            const float4 sh = *(const float4*)(md + (size_t)m * 6144 + 3072 + col), sc = *(const float4*)(md + (size_t)m * 6144 + 4096 + col);
            float4 x;
            x.x = (v[i].x - mean) * rs * g.x + b.x; x.y = (v[i].y - mean) * rs * g.y + b.y; x.z = (v[i].z - mean) * rs * g.z + b.z; x.w = (v[i].w - mean) * rs * g.w + b.w;
            *(float4*)(R + col) = x;
            h[i * 4 + 0] = x.x * (1.f + sc.x) + sh.x; h[i * 4 + 1] = x.y * (1.f + sc.y) + sh.y; h[i * 4 + 2] = x.z * (1.f + sc.z) + sh.z; h[i * 4 + 3] = x.w * (1.f + sc.w) + sh.w;
            uint2 o; o.x = pack2(h[i * 4 + 0], h[i * 4 + 1]); o.y = pack2(h[i * 4 + 2], h[i * 4 + 3]);
            *(uint2*)(w.hb() + (size_t)row * D + col) = o;
        }
        float mylg = 0.f;
#pragma unroll 1
        for (int o4 = 0; o4 < 5; ++o4) {
            float a0 = 0.f, a1 = 0.f, a2 = 0.f, a3 = 0.f;
#pragma unroll
            for (int e = 0; e < 16; ++e) {
                const float4 wv = *(const float4*)(wl + ((o4 * 1024) + e * 64 + lane) * 4);
                a0 += h[e] * wv.x; a1 += h[e] * wv.y; a2 += h[e] * wv.z; a3 += h[e] * wv.w;
            }
            a0 = wave_sum(a0); a1 = wave_sum(a1); a2 = wave_sum(a2); a3 = wave_sum(a3);
            if (lane == o4 * 4 + 0) mylg = a0;
            if (lane == o4 * 4 + 1) mylg = a1;
            if (lane == o4 * 4 + 2) mylg = a2;
            if (lane == o4 * 4 + 3) mylg = a3;
        }
        float lg[20];
#pragma unroll
        for (int i = 0; i < 20; ++i) lg[i] = __shfl(mylg, i);
        if (lane == 0) {
            float gl[4];
#pragma unroll
            for (int i = 0; i < 4; ++i) gl[i] = lg[i] + p.in[26][l * 4 + i];
            int gi = 0; float gm = gl[0];
#pragma unroll
            for (int i = 1; i < 4; ++i) if (gl[i] > gm) { gm = gl[i]; gi = i; }
            float den = 0.f;
#pragma unroll
            for (int i = 0; i < 4; ++i) den += __expf(gl[i] - gm);
            const float gw = 1.0f / den;
            float el[4];
#pragma unroll
            for (int i = 0; i < 4; ++i) {
                float t = lg[4 + i];
                if (gi == 1) t = lg[8 + i]; else if (gi == 2) t = lg[12 + i]; else if (gi == 3) t = lg[16 + i];
                el[i] = t + p.in[28][l * 16 + gi * 4 + i];
            }
            int i1 = 0; float m1 = el[0];
#pragma unroll
            for (int i = 1; i < 4; ++i) if (el[i] > m1) { m1 = el[i]; i1 = i; }
            int i2 = -1; float m2 = -3.0e38f;
#pragma unroll
            for (int i = 0; i < 4; ++i) if (i != i1 && el[i] > m2) { m2 = el[i]; i2 = i; }
            const float e2 = __expf(m2 - m1);
            const float w1 = gw / (1.0f + e2), w2 = gw * e2 / (1.0f + e2);
            const int lo = i1 < i2 ? i1 : i2, hi = i1 < i2 ? i2 : i1;
            const float wlo = i1 < i2 ? w1 : w2, whi = i1 < i2 ? w2 : w1;
            const int pair = lo == 0 ? (hi - 1) : (lo == 1 ? (hi + 1) : 5);
            const int cls = gi * 6 + pair;
            const int pos = atomicAdd(w.cnt(l) + cls, 1);
            w.list()[(size_t)cls * LISTCAP + pos] = row;
            w.lw()[(size_t)cls * LISTCAP + pos] = make_float2(wlo, whi);
        }
    }
}

__device__ __forceinline__ void cls_experts(int cls, int& elo, int& ehi) {
    const int g = cls / 6, pr = cls % 6;
    const int lo = pr < 3 ? 0 : (pr < 5 ? 1 : 2);
    const int hi = pr < 3 ? pr + 1 : (pr < 5 ? pr - 1 : 3);
    elo = g * 4 + lo; ehi = g * 4 + hi;
}

struct EpiGU {
    bf16_t* act; const float2* lw; int cnt, pos0, orow0, half, fcol0;
    __device__ __forceinline__ void operator()(const f32x16 (&acc)[2][2], int r0, int c0) const {
        const int hh4 = c0 & 4, wn64 = c0 & 64;
#pragma unroll
        for (int mt = 0; mt < 2; ++mt) {
            const int rl = r0 + mt * 32, pos = pos0 + rl;
            float wt = 0.f;
            if (pos < cnt) { const float2 ww = lw[pos]; wt = half ? ww.y : ww.x; }
#pragma unroll
            for (int nt = 0; nt < 2; ++nt)
#pragma unroll
                for (int qp = 0; qp < 2; ++qp) {
                    const int f = fcol0 + ((wn64 + nt * 32) >> 1) + qp * 8 + hh4;
                    const int qg = qp * 2, qu = qp * 2 + 1;
                    const float a0 = siluf_(acc[mt][nt][qg * 4 + 0]) * acc[mt][nt][qu * 4 + 0] * wt;
                    const float a1 = siluf_(acc[mt][nt][qg * 4 + 1]) * acc[mt][nt][qu * 4 + 1] * wt;
                    const float a2 = siluf_(acc[mt][nt][qg * 4 + 2]) * acc[mt][nt][qu * 4 + 2] * wt;
                    const float a3 = siluf_(acc[mt][nt][qg * 4 + 3]) * acc[mt][nt][qu * 4 + 3] * wt;
                    uint2 o; o.x = pack2(a0, a1); o.y = pack2(a2, a3);
                    *(uint2*)(act + (size_t)(orow0 + rl) * 512 + half * 256 + f) = o;
                }
        }
    }
};
__device__ __forceinline__ void phase_moe_gu(const Params& p, unsigned char* lds, int l) {
    const WS w{p.ws};
    int ntl[NCLS]; int tot = 0;
#pragma unroll
    for (int c = 0; c < NCLS; ++c) { ntl[c] = (w.cnt(l)[c] + 127) >> 7; tot += ntl[c]; }
    const int ntile = tot * 8;
    const int lr = threadIdx.x >> 3, lc = threadIdx.x & 7;
    for (int t = blockIdx.x; t < ntile; t += gridDim.x) {
        const int mg = t >> 3, nt = t & 7;
        int cls = 0, mt = 0, run = 0;
#pragma unroll
        for (int c = 0; c < NCLS; ++c) { if (mg >= run && mg < run + ntl[c]) { cls = c; mt = mg - run; } run += ntl[c]; }
        const int cnt = w.cnt(l)[cls];
        int elo, ehi; cls_experts(cls, elo, ehi);
        const int half = nt >> 2, e = half ? ehi : elo;
        const int* lst = w.list() + (size_t)cls * LISTCAP;
        Src4 A, B;
#pragma unroll
        for (int j = 0; j < 4; ++j) {
            int pos = mt * 128 + lr + 32 * j; if (pos >= cnt) pos = 0;
            const int tok = lst[pos];
            A.p0[j] = w.hb() + (size_t)tok * D + lc * 8; A.p1[j] = A.p0[j];
        }
        A.split = 1 << 30;
        src_plain(B, w.wt_gu(l, e), (nt & 3) * 128, D);
        EpiGU ep{w.act(), w.lw() + (size_t)cls * LISTCAP, cnt, mt * 128, mg * 128, half, (nt & 3) * 64};
        gemm128(lds, A, B, D, ep);
    }
}

struct EpiDown {
    const Params* p; const float* mod; const int* lst; int cnt, pos0, n0;
    __device__ __forceinline__ void operator()(const f32x16 (&acc)[2][2], int r0, int c0) const {
#pragma unroll
        for (int mt = 0; mt < 2; ++mt) {
            const int pos = pos0 + r0 + mt * 32;
            if (pos < cnt) {
                const int row = lst[pos], m = modrow(row);
                float* R = Rrow(*p, row);
#pragma unroll
                for (int nt = 0; nt < 2; ++nt)
#pragma unroll
                    for (int q = 0; q < 4; ++q) {
                        const int col = n0 + c0 + nt * 32 + q * 8;
                        const float4 g2 = *(const float4*)(mod + (size_t)m * 6144 + 5120 + col);
                        const float4 x = *(const float4*)(R + col);
                        *(float4*)(R + col) = make_float4(DN_ALPHA * x.x + g2.x * acc[mt][nt][q * 4 + 0], DN_ALPHA * x.y + g2.y * acc[mt][nt][q * 4 + 1],
                                                          DN_ALPHA * x.z + g2.z * acc[mt][nt][q * 4 + 2], DN_ALPHA * x.w + g2.w * acc[mt][nt][q * 4 + 3]);
                    }
            }
        }
    }
};
__device__ __forceinline__ void phase_moe_dn(const Params& p, unsigned char* lds, int l) {
    const WS w{p.ws};
    int ntl[NCLS]; int tot = 0;
#pragma unroll
    for (int c = 0; c < NCLS; ++c) { ntl[c] = (w.cnt(l)[c] + 127) >> 7; tot += ntl[c]; }
    const int ntile = tot * 8;
    for (int t = blockIdx.x; t < ntile; t += gridDim.x) {
        const int mg = t >> 3, nt = t & 7;
        int cls = 0, mt = 0, run = 0;
#pragma unroll
        for (int c = 0; c < NCLS; ++c) { if (mg >= run && mg < run + ntl[c]) { cls = c; mt = mg - run; } run += ntl[c]; }
        const int cnt = w.cnt(l)[cls];
        int elo, ehi; cls_experts(cls, elo, ehi);
        Src4 A, B;
        src_plain(A, w.act(), mg * 128, 512);
        src_split(B, w.wt_dn(l, elo), 256, w.wt_dn(l, ehi), 256, nt * 128, 256);
        EpiDown ep{&p, w.mod(l), w.list() + (size_t)cls * LISTCAP, cnt, mt * 128, nt * 128};
        gemm128(lds, A, B, 512, ep);
    }
}

__device__ __forceinline__ void phase_ln2(const Params& p, int l) {
    const WS w{p.ws};
    const int tid = threadIdx.x, lane = tid & 63, wid = tid >> 6;
    const int nrows = l == 0 ? NROW : NLAT;
    const float* lng = p.in[32] + l * D; const float* lnb = p.in[33] + l * D;
    const float* mdn = w.mod(1);
    for (int row = blockIdx.x * 4 + wid; row < nrows; row += gridDim.x * 4) {
        float* R = Rrow(p, row);
        const int m = modrow(row);
        float4 v[4];
#pragma unroll
        for (int i = 0; i < 4; ++i) v[i] = *(const float4*)(R + i * 256 + lane * 4);
        float s = 0.f;
#pragma unroll
        for (int i = 0; i < 4; ++i) s += (v[i].x + v[i].y) + (v[i].z + v[i].w);
        const float mean = wave_sum(s) * (1.0f / 1024.0f);
        float q = 0.f;
#pragma unroll
        for (int i = 0; i < 4; ++i) { const float a = v[i].x - mean, b = v[i].y - mean, c = v[i].z - mean, d = v[i].w - mean; q += (a * a + b * b) + (c * c + d * d); }
        const float rs = rsqrtf(wave_sum(q) * (1.0f / 1024.0f) + LN_EPS);
#pragma unroll
        for (int i = 0; i < 4; ++i) {
            const int col = i * 256 + lane * 4;
            const float4 g = *(const float4*)(lng + col), b = *(const float4*)(lnb + col);
            float4 x;
            x.x = (v[i].x - mean) * rs * g.x + b.x; x.y = (v[i].y - mean) * rs * g.y + b.y; x.z = (v[i].z - mean) * rs * g.z + b.z; x.w = (v[i].w - mean) * rs * g.w + b.w;
            *(float4*)(R + col) = x;
            if (l == 0) {
                const float4 sh = *(const float4*)(mdn + (size_t)m * 6144 + col), sc = *(const float4*)(mdn + (size_t)m * 6144 + 1024 + col);
                uint2 o; o.x = pack2(x.x * (1.f + sc.x) + sh.x, x.y * (1.f + sc.y) + sh.y); o.y = pack2(x.z * (1.f + sc.z) + sh.z, x.w * (1.f + sc.w) + sh.w);
                *(uint2*)(w.hb() + (size_t)row * D + col) = o;
            }
        }
    }
}

#define XB_TMO      128
#define XB_XCNT(j)  (256  + 64 * (j))
#define XB_XSUB(j)  (1280 + 64 * (j))
#define XB_XGEN(j)  (2304 + 64 * (j))
#define XB_TOP      3328
#define XB_TOPGEN   3392
#define XB_SPIN_CAP (1u << 20)
__device__ __forceinline__ unsigned xb_ld(unsigned* p)              { return __hip_atomic_load(p, __ATOMIC_RELAXED, __HIP_MEMORY_SCOPE_AGENT); }
__device__ __forceinline__ unsigned xb_add(unsigned* p, unsigned v) { return __hip_atomic_fetch_add(p, v, __ATOMIC_RELAXED, __HIP_MEMORY_SCOPE_AGENT); }
__device__ __forceinline__ unsigned xb_xcc_id() { return (unsigned)__builtin_amdgcn_s_getreg((3 << 11) | 20) & 0xFu; }
#define XB_SPIN(cond, bar) do { unsigned _sp = 0; while (cond) { __builtin_amdgcn_s_sleep(1); \
    if ((++_sp & 255u) == 0u) { if (xb_ld(&(bar)[XB_TMO])) break; if (_sp > XB_SPIN_CAP) { atomicAdd(&(bar)[XB_TMO], 1u); break; } } } } while (0)
struct XcdBarrier { unsigned* bar; unsigned x, nloc, nx; };
__device__ __forceinline__ void xcd_barrier_post(XcdBarrier& b, unsigned* bar) {
    b.bar = bar; b.x = xb_xcc_id(); b.nloc = 0u; b.nx = 0u;
    if (threadIdx.x == 0) (void)xb_add(&bar[XB_XCNT(b.x)], 1u);
}
__device__ __forceinline__ void xcd_barrier_complete(unsigned* bar, unsigned x, unsigned& nloc, unsigned& nx) {
    const unsigned G = gridDim.x;
    unsigned sum, cnt, mine, sp = 0u;
    for (;;) {
        sum = 0u; cnt = 0u; mine = 0u;
#pragma unroll
        for (unsigned j = 0; j < 16; ++j) { const unsigned c = xb_ld(&bar[XB_XCNT(j)]); sum += c; cnt += (c > 0u) ? 1u : 0u; mine = (j == x) ? c : mine; }
        if (sum == G) break;
        __builtin_amdgcn_s_sleep(1);
        if ((++sp & 255u) == 0u) { if (xb_ld(&bar[XB_TMO])) break; if (sp > XB_SPIN_CAP) { atomicAdd(&bar[XB_TMO], 1u); break; } }
    }
    nloc = mine > 0u ? mine : 1u; nx = cnt > 0u ? cnt : 1u;
}
__device__ __forceinline__ void xcd_barrier(XcdBarrier& b) {
    asm volatile("s_waitcnt vmcnt(0)" ::: "memory");
    __syncthreads();
    if (threadIdx.x == 0) {
        unsigned* bar = b.bar;
        __builtin_amdgcn_s_waitcnt(0);
        if (b.nloc == 0u) xcd_barrier_complete(bar, b.x, b.nloc, b.nx);
        const unsigned nloc = b.nloc, nx = b.nx;
        const unsigned old = xb_add(&bar[XB_XSUB(b.x)], 1u);
        const unsigned gen = old / nloc;
        if (old + 1u == (gen + 1u) * nloc) {
            __builtin_amdgcn_fence(__ATOMIC_RELEASE, "agent");
            asm volatile("s_waitcnt vmcnt(0)" ::: "memory");
            const unsigned og = xb_add(&bar[XB_TOP], 1u);
            const unsigned tg = og / nx;
            if (og + 1u == (tg + 1u) * nx) xb_add(&bar[XB_TOPGEN], 1u);
            else XB_SPIN(xb_ld(&bar[XB_TOPGEN]) == tg, bar);
            __builtin_amdgcn_fence(__ATOMIC_ACQUIRE, "agent");
            xb_add(&bar[XB_XGEN(b.x)], 1u);
            asm volatile("s_waitcnt vmcnt(0)" ::: "memory");
        } else {
            XB_SPIN(xb_ld(&bar[XB_XGEN(b.x)]) == gen, bar);
            __builtin_amdgcn_fence(__ATOMIC_ACQUIRE, "agent");
            asm volatile("s_waitcnt vmcnt(0)" ::: "memory");
        }
    }
    __syncthreads();
}

constexpr int NPHASE = 3 + 2 * 10;
__global__ void __launch_bounds__(256, 2) mega(Params p, int ph_lo, int ph_hi) {
    __shared__ __attribute__((aligned(16))) unsigned char lds[LDS_BYTES];
    XcdBarrier xb; xcd_barrier_post(xb, (unsigned*)(p.ws + OFF_BAR));
#define RUN(idx, ...) if (ph_lo <= (idx) && (idx) < ph_hi) { __VA_ARGS__; if ((idx) + 1 < ph_hi) xcd_barrier(xb); }
    RUN(0, phase_pro_a(p, lds))
    RUN(1, phase_pro_b(p))
    RUN(2, phase_pro_c(p))
#define LAYER(l) \
    RUN(3 + 10 * l + 0, phase_inproj(p, lds, l)) \
    RUN(3 + 10 * l + 1, phase_s1(p, lds, l)) \
    RUN(3 + 10 * l + 2, phase_s2(p, lds, l)) \
    RUN(3 + 10 * l + 3, phase_s3(p, lds, l)) \
    RUN(3 + 10 * l + 4, phase_glu(p, lds, l)) \
    RUN(3 + 10 * l + 5, phase_outproj(p, lds, l)) \
    RUN(3 + 10 * l + 6, phase_ln1(p, lds, l)) \
    RUN(3 + 10 * l + 7, phase_moe_gu(p, lds, l)) \
    RUN(3 + 10 * l + 8, phase_moe_dn(p, lds, l)) \
    RUN(3 + 10 * l + 9, phase_ln2(p, l))
    LAYER(0)
    LAYER(1)
#undef LAYER
#undef RUN
}

extern "C" void kernel_launch(void* const* d_in, const int* in_sizes, int n_in, void* d_out, int out_size, void* d_ws, size_t ws_size, hipStream_t stream) {
    static int grid_blocks = 0;
    if (grid_blocks == 0) {
        if (n_in != 34 || out_size != NLAT * D || ws_size < WS_END) {
            fprintf(stderr, "kernel_launch: unexpected shapes (n_in %d out %d ws %zu need %zu)\n", n_in, out_size, ws_size, (size_t)WS_END);
            grid_blocks = -1; return;
        }
        int dev = 0, cus = 0, per_cu = 0;
        hipGetDevice(&dev);
        hipDeviceGetAttribute(&cus, hipDeviceAttributeMultiprocessorCount, dev);
        hipOccupancyMaxActiveBlocksPerMultiprocessor(&per_cu, (const void*)mega, 256, 0);
        if (per_cu < 1) per_cu = 1;
        if (per_cu > 2) per_cu = 2;
        grid_blocks = cus * per_cu;
        fprintf(stderr, "kernel_launch: cus %d per_cu %d grid %d ws need %zu have %zu\n", cus, per_cu, grid_blocks, (size_t)WS_END, ws_size);
    }
    if (grid_blocks < 0) return;
    Params p{};
    for (int i = 0; i < 34; ++i) p.in[i] = (const float*)d_in[i];
    p.out = (float*)d_out; p.ws = (unsigned char*)d_ws;
    if (hipMemsetAsync((unsigned char*)d_ws + OFF_BAR, 0, SZ_BAR, stream) != hipSuccess) fprintf(stderr, "memset failed\n");
#if FUSED
    int lo = 0, hi = NPHASE;
    void* args[] = {&p, &lo, &hi};
    hipError_t e = hipLaunchCooperativeKernel((const void*)mega, dim3(grid_blocks), dim3(256), args, 0, stream);
    if (e != hipSuccess) fprintf(stderr, "cooperative launch failed: %s (grid %d)\n", hipGetErrorString(e), grid_blocks);
#else
    for (int ph = 0; ph < NPHASE; ++ph) hipLaunchKernelGGL(mega, dim3(grid_blocks), dim3(256), 0, stream, p, ph, ph + 1);
#endif
}
```

```cpp
#include <hip/hip_runtime.h>
#include <cstdio>
#include <cstdint>

#ifndef FUSED
#define FUSED 1
#endif

typedef unsigned short bf16_t;
typedef __attribute__((ext_vector_type(8))) short bf16x8;
typedef __attribute__((ext_vector_type(16))) float f32x16;

constexpr int D = 1024, NB = 8, SEQ = 2048, CTX = 256;
constexpr int NLAT = NB * SEQ, NCTX = NB * CTX, NROW = NLAT + NCTX;
constexpr int DIN = 1792, DS5 = 512, NG = 32, PS = 64;
constexpr int TCH = 16, NT = 256;
constexpr int NCOL = NROW / TCH;
constexpr int NCOL_LAT = NLAT / TCH;
constexpr int CH_LAT = SEQ / TCH, CH_CTX = CTX / TCH;
constexpr int NSTEP = CH_LAT + CH_CTX;
constexpr int NSEG = 8, SEGLEN = NSTEP / NSEG;
constexpr int NCLS = 24, LISTCAP = NROW;
constexpr int MAXMT = NROW / 128 + NCLS;
constexpr int KSPLIT_MOD = 16;
constexpr float LN_EPS = 1e-5f;
constexpr float DN_ALPHA = 1.4142135623730951f;
constexpr int NPOW = 18;

constexpr size_t AL(size_t x) { return (x + 255) & ~(size_t)255; }
constexpr size_t SZ_WT_IN = (size_t)2 * DIN * D * 2;
constexpr size_t SZ_WT_GLU = (size_t)2 * 512 * 512 * 2;
constexpr size_t SZ_WT_O = (size_t)2 * D * D * 2;
constexpr size_t SZ_WT_GU = (size_t)2 * 16 * 512 * 1024 * 2;
constexpr size_t SZ_WT_DN = (size_t)2 * 16 * 1024 * 256 * 2;
constexpr size_t SZ_MOD = (size_t)2 * 9 * 6144 * 4;
constexpr size_t SZ_LAMPOW = (size_t)2 * 2 * NG * PS * NPOW * 8;
constexpr size_t SZ_BBAR = (size_t)2 * 2 * NG * PS * 16 * 8;
constexpr size_t SZ_KFULL = (size_t)2 * NG * 31 * 256 * 4;
constexpr size_t SZ_M1 = (size_t)2 * NG * 256 * 256 * 2;
constexpr size_t SZ_W2 = (size_t)2 * NG * 256 * 512 * 2;
constexpr size_t SZ_HB = (size_t)NROW * D * 2;
constexpr size_t SZ_UG = (size_t)NG * NROW * 16 * 2;
constexpr size_t SZ_ZR = (size_t)NROW * 1280 * 2;
constexpr size_t SZ_S = (size_t)NG * NCOL * 256 * 4;
constexpr size_t SZ_RCTX = (size_t)NCTX * D * 4;
constexpr size_t SZ_CNT = 256 * 4;
constexpr size_t SZ_LIST = (size_t)NCLS * LISTCAP * 4;
constexpr size_t SZ_LW = (size_t)NCLS * LISTCAP * 8;

constexpr size_t OFF_WT_IN = 0;
constexpr size_t OFF_WT_GLU = OFF_WT_IN + AL(SZ_WT_IN);
constexpr size_t OFF_WT_O = OFF_WT_GLU + AL(SZ_WT_GLU);
constexpr size_t OFF_WT_GU = OFF_WT_O + AL(SZ_WT_O);
constexpr size_t OFF_WT_DN = OFF_WT_GU + AL(SZ_WT_GU);
constexpr size_t OFF_MOD = OFF_WT_DN + AL(SZ_WT_DN);
constexpr size_t OFF_LAMPOW = OFF_MOD + AL(SZ_MOD);
constexpr size_t OFF_BBAR = OFF_LAMPOW + AL(SZ_LAMPOW);
constexpr size_t OFF_KFULL = OFF_BBAR + AL(SZ_BBAR);
constexpr size_t OFF_M1 = OFF_KFULL + AL(SZ_KFULL);
constexpr size_t OFF_W2 = OFF_M1 + AL(SZ_M1);
constexpr size_t OFF_HB = OFF_W2 + AL(SZ_W2);
constexpr size_t OFF_UG = OFF_HB + AL(SZ_HB);
constexpr size_t OFF_ZR = OFF_UG + AL(SZ_UG);
constexpr size_t OFF_S = OFF_ZR + AL(SZ_ZR);
constexpr size_t OFF_RCTX = OFF_S + AL(SZ_S);
constexpr size_t OFF_CNT = OFF_RCTX + AL(SZ_RCTX);
constexpr size_t OFF_LIST = OFF_CNT + AL(SZ_CNT);
constexpr size_t OFF_LW = OFF_LIST + AL(SZ_LIST);
constexpr size_t OFF_BAR = OFF_LW + AL(SZ_LW);
constexpr size_t SZ_BAR = 3456 * 4;
constexpr size_t WS_END = OFF_BAR + AL(SZ_BAR);
static_assert((size_t)KSPLIT_MOD * 2 * 9 * 6144 * 4 <= SZ_ZR, "modp alias");
static_assert((size_t)NG * NCOL * 256 * 2 <= SZ_ZR, "hprev alias");
static_assert((size_t)NROW * 512 * 2 <= SZ_S && (size_t)MAXMT * 128 * 512 * 2 <= SZ_S, "Y/act alias");
static_assert(WS_END <= (size_t)256 * 1024 * 1024, "workspace over 256 MiB");

constexpr int LDS_BYTES = 81920;

struct Params {
    const float* in[34];
    float* out;
    unsigned char* ws;
};

__device__ __forceinline__ unsigned f2bf(float f) { unsigned u = __float_as_uint(f); u += 0x7fffu + ((u >> 16) & 1u); return u >> 16; }
__device__ __forceinline__ float bf2f(unsigned h) { return __uint_as_float(h << 16); }
__device__ __forceinline__ unsigned pack2(float a, float b) { return f2bf(a) | (f2bf(b) << 16); }
__device__ __forceinline__ float bflo(unsigned w) { return __uint_as_float(w << 16); }
__device__ __forceinline__ float bfhi(unsigned w) { return __uint_as_float(w & 0xffff0000u); }
__device__ __forceinline__ float wave_sum(float v) {
#pragma unroll
    for (int o = 32; o >= 1; o >>= 1) v += __shfl_xor(v, o);
    return v;
}
__device__ __forceinline__ float sigmoidf_(float x) { return 1.0f / (1.0f + __expf(-x)); }
__device__ __forceinline__ float siluf_(float x) { return x / (1.0f + __expf(-x)); }
__device__ __forceinline__ float gelu_tanh(float x) {
    const float z = 0.7978845608028654f * (x + 0.044715f * x * x * x);
    const float e = __expf(2.0f * z);
    const float t = 1.0f - 2.0f / (1.0f + e);
    return 0.5f * x * (1.0f + t);
}
__device__ __forceinline__ int modrow(int row) { return row < NLAT ? (row >> 11) : 8; }

struct Src4 { const bf16_t* p0[4]; const bf16_t* p1[4]; int split; };

#define LDS_AS __attribute__((address_space(3)))
template <class EPI>
__device__ __forceinline__ void gemm128(unsigned char* lds, const Src4& A, const Src4& B, const int K, const EPI& epi) {
    const int tid = threadIdx.x, lane = tid & 63, wid = __builtin_amdgcn_readfirstlane(tid >> 6), wm = wid >> 1, wn = wid & 1;
    const int l31 = lane & 31, hh = lane >> 5, sw = (l31 >> 1) & 7;
    const int xbase = (wm * 64 + l31) * 128, wbase = 16384 + (wn * 64 + l31) * 128;
    LDS_AS unsigned char* ldsw = (LDS_AS unsigned char*)lds + wid * 1024;
    f32x16 acc[2][2];
#pragma unroll
    for (int i = 0; i < 2; ++i)
#pragma unroll
        for (int j = 0; j < 2; ++j)
#pragma unroll
            for (int e = 0; e < 16; ++e) acc[i][j][e] = 0.f;
    const int nk = K >> 6;
#define G_STAGE(kt_, bufo_) do { const int k_ = (kt_) * 64; \
        _Pragma("unroll") for (int j = 0; j < 4; ++j) __builtin_amdgcn_global_load_lds((const unsigned*)(k_ < A.split ? A.p0[j] + k_ : A.p1[j] + (k_ - A.split)), (LDS_AS unsigned*)(ldsw + (bufo_) + j * 4096), 16, 0, 0); \
        _Pragma("unroll") for (int j = 0; j < 4; ++j) __builtin_amdgcn_global_load_lds((const unsigned*)(k_ < B.split ? B.p0[j] + k_ : B.p1[j] + (k_ - B.split)), (LDS_AS unsigned*)(ldsw + (bufo_) + 16384 + j * 4096), 16, 0, 0); } while (0)
    G_STAGE(0, 0);
    asm volatile("s_waitcnt vmcnt(0)" ::: "memory");
    __syncthreads();
    for (int kt = 0; kt < nk; ++kt) {
        const int buf = (kt & 1) * 32768;
        if (kt + 1 < nk) G_STAGE(kt + 1, ((kt + 1) & 1) * 32768);
#pragma unroll
        for (int ks = 0; ks < 4; ++ks) {
            const int co = ((ks * 2 + hh) ^ sw) << 4;
            const bf16x8 x0 = *(const bf16x8*)(lds + buf + xbase + co);
            const bf16x8 x1 = *(const bf16x8*)(lds + buf + xbase + 4096 + co);
            const bf16x8 w0 = *(const bf16x8*)(lds + buf + wbase + co);
            const bf16x8 w1 = *(const bf16x8*)(lds + buf + wbase + 4096 + co);
            acc[0][0] = __builtin_amdgcn_mfma_f32_32x32x16_bf16(w0, x0, acc[0][0], 0, 0, 0);
            acc[0][1] = __builtin_amdgcn_mfma_f32_32x32x16_bf16(w1, x0, acc[0][1], 0, 0, 0);
            acc[1][0] = __builtin_amdgcn_mfma_f32_32x32x16_bf16(w0, x1, acc[1][0], 0, 0, 0);
            acc[1][1] = __builtin_amdgcn_mfma_f32_32x32x16_bf16(w1, x1, acc[1][1], 0, 0, 0);
        }
        asm volatile("s_waitcnt vmcnt(0)" ::: "memory");
        __syncthreads();
    }
#undef G_STAGE
    epi(acc, wm * 64 + l31, wn * 64 + hh * 4);
}

__device__ __forceinline__ void src_plain(Src4& s, const bf16_t* base, int row0, int ld) {
    const int lr = threadIdx.x >> 3, lc = (threadIdx.x & 7) ^ ((lr >> 1) & 7);
#pragma unroll
    for (int j = 0; j < 4; ++j) { s.p0[j] = base + (size_t)(row0 + lr + 32 * j) * ld + lc * 8; s.p1[j] = s.p0[j]; }
    s.split = 1 << 30;
}
__device__ __forceinline__ void src_split(Src4& s, const bf16_t* base0, int ld0, const bf16_t* base1, int ld1, int row0, int split) {
    const int lr = threadIdx.x >> 3, lc = (threadIdx.x & 7) ^ ((lr >> 1) & 7);
#pragma unroll
    for (int j = 0; j < 4; ++j) { s.p0[j] = base0 + (size_t)(row0 + lr + 32 * j) * ld0 + lc * 8; s.p1[j] = base1 + (size_t)(row0 + lr + 32 * j) * ld1 + lc * 8; }
    s.split = split;
}

#define ACC_FOREACH(acc, r0, c0, ...) \
    _Pragma("unroll") for (int mt_ = 0; mt_ < 2; ++mt_) \
    _Pragma("unroll") for (int nt_ = 0; nt_ < 2; ++nt_) \
    _Pragma("unroll") for (int q_ = 0; q_ < 4; ++q_) { \
        const int rl = (r0) + mt_ * 32, cl = (c0) + nt_ * 32 + q_ * 8; \
        const float v0 = acc[mt_][nt_][q_ * 4 + 0], v1 = acc[mt_][nt_][q_ * 4 + 1], v2 = acc[mt_][nt_][q_ * 4 + 2], v3 = acc[mt_][nt_][q_ * 4 + 3]; \
        __VA_ARGS__ }

struct WS {
    unsigned char* b;
    __device__ bf16_t* wt_in(int l) const { return (bf16_t*)(b + OFF_WT_IN) + (size_t)l * DIN * D; }
    __device__ bf16_t* wt_glu(int l) const { return (bf16_t*)(b + OFF_WT_GLU) + (size_t)l * 512 * 512; }
    __device__ bf16_t* wt_o(int l) const { return (bf16_t*)(b + OFF_WT_O) + (size_t)l * D * D; }
    __device__ bf16_t* wt_gu(int l, int e) const { return (bf16_t*)(b + OFF_WT_GU) + (size_t)(l * 16 + e) * 512 * 1024; }
    __device__ bf16_t* wt_dn(int l, int e) const { return (bf16_t*)(b + OFF_WT_DN) + (size_t)(l * 16 + e) * 1024 * 256; }
    __device__ float* mod(int l) const { return (float*)(b + OFF_MOD) + (size_t)l * 9 * 6144; }
    __device__ float* modp() const { return (float*)(b + OFF_ZR); }
    __device__ float2* lampow(int l, int d, int g) const { return (float2*)(b + OFF_LAMPOW) + (size_t)((l * 2 + d) * NG + g) * PS * NPOW; }
    __device__ float2* bbar(int l, int d, int g) const { return (float2*)(b + OFF_BBAR) + (size_t)((l * 2 + d) * NG + g) * PS * 16; }
    __device__ float* kfull(int l, int g) const { return (float*)(b + OFF_KFULL) + (size_t)(l * NG + g) * 31 * 256; }
    __device__ bf16_t* m1(int l, int g) const { return (bf16_t*)(b + OFF_M1) + (size_t)(l * NG + g) * 256 * 256; }
    __device__ bf16_t* w2(int l, int g) const { return (bf16_t*)(b + OFF_W2) + (size_t)(l * NG + g) * 256 * 512; }
    __device__ bf16_t* hb() const { return (bf16_t*)(b + OFF_HB); }
    __device__ bf16_t* ug() const { return (bf16_t*)(b + OFF_UG); }
    __device__ bf16_t* zr() const { return (bf16_t*)(b + OFF_ZR); }
    __device__ bf16_t* hprev() const { return (bf16_t*)(b + OFF_ZR); }
    __device__ float* S() const { return (float*)(b + OFF_S); }
    __device__ bf16_t* Y() const { return (bf16_t*)(b + OFF_S); }
    __device__ bf16_t* act() const { return (bf16_t*)(b + OFF_S); }
    __device__ float* rctx() const { return (float*)(b + OFF_RCTX); }
    __device__ int* cnt(int l) const { return (int*)(b + OFF_CNT) + l * 32; }
    __device__ int* list() const { return (int*)(b + OFF_LIST); }
    __device__ float2* lw() const { return (float2*)(b + OFF_LW); }
};
__device__ __forceinline__ float* Rrow(const Params& p, int row) {
    return row < NLAT ? p.out + (size_t)row * D : (float*)(p.ws + OFF_RCTX) + (size_t)(row - NLAT) * D;
}

__device__ __forceinline__ void transpose_tile(unsigned char* lds, const float* src, int ldsrc, int k0, int n0, bf16_t* dst, int lddst, int rowmode) {
    float* tile = (float*)lds;
    const int tid = threadIdx.x;
    __syncthreads();
#pragma unroll
    for (int pass = 0; pass < 4; ++pass) {
        const int k = pass * 16 + (tid >> 4), n4 = (tid & 15) * 4;
        const float4 v = *(const float4*)(src + (size_t)(k0 + k) * ldsrc + n0 + n4);
        tile[k * 65 + n4 + 0] = v.x; tile[k * 65 + n4 + 1] = v.y; tile[k * 65 + n4 + 2] = v.z; tile[k * 65 + n4 + 3] = v.w;
    }
    __syncthreads();
#pragma unroll
    for (int t2 = 0; t2 < 2; ++t2) {
        const int task = tid + t2 * 256, n = task & 63, kc = task >> 6;
        float f[8];
#pragma unroll
        for (int i = 0; i < 8; ++i) f[i] = tile[(kc * 8 + i) * 65 + n];
        const int ng = n0 + n;
        int drow = ng;
        if (rowmode == 1) drow = ((ng >> 3) << 4) + (ng & 7);
        else if (rowmode == 2) drow = ((ng >> 3) << 4) + 8 + (ng & 7);
        uint4 o; o.x = pack2(f[0], f[1]); o.y = pack2(f[2], f[3]); o.z = pack2(f[4], f[5]); o.w = pack2(f[6], f[7]);
        *(uint4*)(dst + (size_t)drow * lddst + k0 + kc * 8) = o;
    }
}

__device__ __forceinline__ void phase_pro_a(const Params& p, unsigned char* lds) {
    const WS w{p.ws};
    const int tid = threadIdx.x;
    if (blockIdx.x == 0 && tid < 64) ((int*)(p.ws + OFF_CNT))[tid] = 0;
    constexpr int N_MOD = 2 * 6 * KSPLIT_MOD, N_TAB = 32, N_WT = 2 * 3840;
    for (int it = blockIdx.x; it < N_MOD + N_TAB + N_WT; it += gridDim.x) {
        if (it < N_MOD) {
            const int l = it / (6 * KSPLIT_MOD), rem = it % (6 * KSPLIT_MOD), cb = rem / KSPLIT_MOD, ks = rem % KSPLIT_MOD;
            float* sc = (float*)lds;
            __syncthreads();
            for (int i = tid; i < 9 * 64; i += 256) {
                const int r = i >> 6, kk = i & 63, k = ks * 64 + kk;
                const float cv = r < 8 ? p.in[1][r * D + k] : p.in[3][k];
                sc[i] = siluf_(cv);
            }
            __syncthreads();
            float acc[9][4];
#pragma unroll
            for (int r = 0; r < 9; ++r) { acc[r][0] = acc[r][1] = acc[r][2] = acc[r][3] = 0.f; }
            const float* wm = p.in[4] + ((size_t)l * D + ks * 64) * 6144 + cb * 1024 + tid * 4;
#pragma unroll 8
            for (int kk = 0; kk < 64; ++kk) {
                const float4 v = *(const float4*)(wm + (size_t)kk * 6144);
#pragma unroll
                for (int r = 0; r < 9; ++r) { const float s = sc[r * 64 + kk]; acc[r][0] += s * v.x; acc[r][1] += s * v.y; acc[r][2] += s * v.z; acc[r][3] += s * v.w; }
            }
            float* mp = w.modp() + ((size_t)(ks * 2 + l) * 9) * 6144 + cb * 1024 + tid * 4;
#pragma unroll
            for (int r = 0; r < 9; ++r) *(float4*)(mp + (size_t)r * 6144) = make_float4(acc[r][0], acc[r][1], acc[r][2], acc[r][3]);
        } else if (it < N_MOD + N_TAB) {
            const int id = (it - N_MOD) * 256 + tid;
            const int pp = id & 63, g = (id >> 6) & 31, d = (id >> 11) & 1, l = id >> 12;
            const int i3 = (l * 2 + d) * NG + g;
            const double dt = exp((double)p.in[9][i3]);
            const double are = (double)p.in[7][i3 * PS + pp], aim = (double)p.in[8][i3 * PS + pp];
            float2* lp = w.lampow(l, d, g) + pp * NPOW;
            double lbr = 0, lbi = 0;
            for (int k = 0; k < NPOW; ++k) {
                const double kk = (k == 17) ? (double)(TCH * SEGLEN) : (double)k;
                const double mag = exp(kk * are * dt);
                double s, c; sincos(kk * aim * dt, &s, &c);
                lp[k] = make_float2((float)(mag * c), (float)(mag * s));
                if (k == 1) { lbr = mag * c; lbi = mag * s; }
            }
            const double nr = lbr - 1.0, ni = lbi, den = are * are + aim * aim;
            const double cr = (nr * are + ni * aim) / den, ci = (ni * are - nr * aim) / den;
            float2* bb = w.bbar(l, d, g) + pp * 16;
            for (int n = 0; n < 16; ++n) {
                const double br = (double)p.in[10][(size_t)(i3 * PS + pp) * 16 + n], bi = (double)p.in[11][(size_t)(i3 * PS + pp) * 16 + n];
                bb[n] = make_float2((float)(cr * br - ci * bi), (float)(cr * bi + ci * br));
            }
        } else {
            int t = it - N_MOD - N_TAB;
            const int l = t / 3840; t %= 3840;
            if (t < 448) { const int kt = t / 28, nt = t % 28; transpose_tile(lds, p.in[6] + (size_t)l * D * DIN, DIN, kt * 64, nt * 64, w.wt_in(l), D, 0); }
            else if (t < 512) { t -= 448; const int kt = t / 8, nt = t % 8; transpose_tile(lds, p.in[15] + (size_t)l * 512 * 512, 512, kt * 64, nt * 64, w.wt_glu(l), 512, 0); }
            else if (t < 768) { t -= 512; const int kt = t / 16, nt = t % 16; transpose_tile(lds, p.in[22] + (size_t)l * D * D, D, kt * 64, nt * 64, w.wt_o(l), D, 0); }
            else if (t < 1792) { t -= 768; const int e = t / 64, r = t % 64, kt = r / 4, nt = r % 4; transpose_tile(lds, p.in[29] + (size_t)(l * 16 + e) * D * 256, 256, kt * 64, nt * 64, w.wt_gu(l, e), D, 1); }
            else if (t < 2816) { t -= 1792; const int e = t / 64, r = t % 64, kt = r / 4, nt = r % 4; transpose_tile(lds, p.in[30] + (size_t)(l * 16 + e) * D * 256, 256, kt * 64, nt * 64, w.wt_gu(l, e), D, 2); }
            else { t -= 2816; const int e = t / 64, r = t % 64, kt = r / 16, nt = r % 16; transpose_tile(lds, p.in[31] + (size_t)(l * 16 + e) * 256 * D, D, kt * 64, nt * 64, w.wt_dn(l, e), 256, 0); }
        }
    }
}

__device__ __forceinline__ void phase_pro_b(const Params& p) {
    const WS w{p.ws};
    const int gt = blockIdx.x * 256 + threadIdx.x, gs = gridDim.x * 256;
    for (int i = gt; i < 2 * 9 * 6144; i += gs) {
        const int l = i / (9 * 6144), n = i % 6144;
        float s = p.in[5][l * 6144 + n];
        const float* mp = w.modp() + i;
#pragma unroll
        for (int ks = 0; ks < KSPLIT_MOD; ++ks) s += mp[(size_t)ks * 2 * 9 * 6144];
        ((float*)(p.ws + OFF_MOD))[i] = s;
    }
    for (int i = gt; i < 2 * NG * 31 * 256; i += gs) {
        const int ni = i & 15, no = (i >> 4) & 15, ti = (i >> 8) % 31, lg = i / (31 * 256), g = lg & 31, l = lg >> 5;
        const int tau = ti - 15;
        float s = 0.f;
#pragma unroll
        for (int d = 0; d < 2; ++d) {
            if ((d == 0 && tau < 0) || (d == 1 && tau > 0)) continue;
            const int at = tau < 0 ? -tau : tau;
            const float2* lp = w.lampow(l, d, g);
            const float2* bb = w.bbar(l, d, g);
            const float* cre = p.in[12] + ((size_t)((l * 2 + d) * NG + g) * 16 + no) * PS;
            const float* cim = p.in[13] + ((size_t)((l * 2 + d) * NG + g) * 16 + no) * PS;
            for (int pp = 0; pp < PS; ++pp) {
                const float2 L = lp[pp * NPOW + at], Bv = bb[pp * 16 + ni];
                const float er = L.x * Bv.x - L.y * Bv.y, ei = L.x * Bv.y + L.y * Bv.x;
                s += cre[pp] * er - cim[pp] * ei;
            }
        }
        if (tau == 0 && no == ni) s += p.in[14][l * DS5 + g * 16 + no];
        ((float*)(p.ws + OFF_KFULL))[i] = s;
    }
    for (int i = gt; i < 2 * NG * 256 * 32; i += gs) {
        const int c8 = i & 31, row = (i >> 5) & 255, lg = i >> 13, g = lg & 31, l = lg >> 5;
        const int d = row >> 7, pp = (row & 127) >> 1, c = row & 1, j = c8 >> 1, n0 = (c8 & 1) * 8;
        const int e = d == 0 ? (TCH - 1 - j) : j;
        const float2 L = w.lampow(l, d, g)[pp * NPOW + e];
        const float2* bb = w.bbar(l, d, g) + pp * 16 + n0;
        float f[8];
#pragma unroll
        for (int n = 0; n < 8; ++n) { const float2 Bv = bb[n]; f[n] = c == 0 ? (L.x * Bv.x - L.y * Bv.y) : (L.x * Bv.y + L.y * Bv.x); }
        uint4 o; o.x = pack2(f[0], f[1]); o.y = pack2(f[2], f[3]); o.z = pack2(f[4], f[5]); o.w = pack2(f[6], f[7]);
        *(uint4*)(w.m1(l, g) + (size_t)row * 256 + c8 * 8) = o;
    }
}

__device__ __forceinline__ void phase_pro_c(const Params& p) {
    const WS w{p.ws};
    const int gt = blockIdx.x * 256 + threadIdx.x, gs = gridDim.x * 256;
    for (int i = gt; i < 2 * NG * 256 * 64; i += gs) {
        const int c8 = i & 63, r = (i >> 6) & 255, lg = i >> 14, g = lg & 31, l = lg >> 5;
        const int jo = r >> 4, no = r & 15;
        float f[8];
        if (c8 < 32) {
            const int ji = c8 >> 1, n0 = (c8 & 1) * 8;
            const float* kf = w.kfull(l, g) + ((size_t)(jo - ji + 15) * 16 + no) * 16 + n0;
#pragma unroll
            for (int n = 0; n < 8; ++n) f[n] = kf[n];
        } else {
            const int kk = (c8 - 32) * 8, d = kk >> 7, p0 = (kk & 127) >> 1;
            const int e = d == 0 ? (jo + 1) : (TCH - jo);
            const float* cre = p.in[12] + ((size_t)((l * 2 + d) * NG + g) * 16 + no) * PS;
            const float* cim = p.in[13] + ((size_t)((l * 2 + d) * NG + g) * 16 + no) * PS;
            const float2* lp = w.lampow(l, d, g);
#pragma unroll
            for (int q = 0; q < 4; ++q) {
                const int pp = p0 + q;
                const float2 L = lp[pp * NPOW + e];
                const float cr = cre[pp], ci = cim[pp];
                f[2 * q] = cr * L.x - ci * L.y;
                f[2 * q + 1] = -(cr * L.y + ci * L.x);
            }
        }
        uint4 o; o.x = pack2(f[0], f[1]); o.y = pack2(f[2], f[3]); o.z = pack2(f[4], f[5]); o.w = pack2(f[6], f[7]);
        *(uint4*)(w.w2(l, g) + (size_t)r * 512 + c8 * 8) = o;
    }
    const float* md = w.mod(0);
    for (int i = gt; i < NROW * 128; i += gs) {
        const int row = i >> 7, c8 = (i & 127) * 8, m = modrow(row);
        const float* xs = row < NLAT ? p.in[0] + (size_t)row * D : p.in[2] + (size_t)(row - NLAT) * D;
        const float4 a = *(const float4*)(xs + c8), b = *(const float4*)(xs + c8 + 4);
        const float* sh = md + (size_t)m * 6144 + c8; const float* sc = sh + 1024;
        const float4 s0 = *(const float4*)sh, s1 = *(const float4*)(sh + 4), c0 = *(const float4*)sc, c1 = *(const float4*)(sc + 4);
        uint4 o;
        o.x = pack2(a.x * (1.f + c0.x) + s0.x, a.y * (1.f + c0.y) + s0.y);
        o.y = pack2(a.z * (1.f + c0.z) + s0.z, a.w * (1.f + c0.w) + s0.w);
        o.z = pack2(b.x * (1.f + c1.x) + s1.x, b.y * (1.f + c1.y) + s1.y);
        o.w = pack2(b.z * (1.f + c1.z) + s1.z, b.w * (1.f + c1.w) + s1.w);
        *(uint4*)(w.hb() + (size_t)row * D + c8) = o;
    }
}

struct EpiInproj {
    bf16_t* ug; bf16_t* zr; int m0, n0;
    __device__ __forceinline__ void operator()(const f32x16 (&acc)[2][2], int r0, int c0) const {
        ACC_FOREACH(acc, r0, c0, {
            const int row = m0 + rl, col = n0 + cl;
            uint2 o; o.x = pack2(v0, v1); o.y = pack2(v2, v3);
            if (col < DS5) *(uint2*)(ug + ((size_t)(col >> 4) * NROW + row) * 16 + (col & 15)) = o;
            else *(uint2*)(zr + (size_t)row * 1280 + (col - DS5)) = o;
        })
    }
};
__device__ __forceinline__ void phase_inproj(const Params& p, unsigned char* lds, int l) {
    const WS w{p.ws};
    const int nfull = (l == 0 ? 144 : 128) * 14, ntile = nfull + (l == 0 ? 0 : 16 * 4);
    for (int t = blockIdx.x; t < ntile; t += gridDim.x) {
        int mt, nt;
        if (t < nfull) { mt = t / 14; nt = t % 14; } else { mt = 128 + (t - nfull) / 4; nt = (t - nfull) % 4; }
        Src4 A, B;
        src_plain(A, w.hb(), mt * 128, D);
        src_plain(B, w.wt_in(l), nt * 128, D);
        EpiInproj e{w.ug(), w.zr(), mt * 128, nt * 128};
        gemm128(lds, A, B, D, e);
    }
}

struct EpiS1 {
    float* S; int m0, n0;
    __device__ __forceinline__ void operator()(const f32x16 (&acc)[2][2], int r0, int c0) const {
        ACC_FOREACH(acc, r0, c0, {
            *(float4*)(S + (size_t)(m0 + rl) * 256 + n0 + cl) = make_float4(v0, v1, v2, v3);
        })
    }
};

__device__ __forceinline__ void conv_sc(const Params& p, int l, int nrows) {
    const WS w{p.ws};
    const float* wsc = p.in[17] + (size_t)l * 3 * 256;
    const int gt = blockIdx.x * 256 + threadIdx.x, gs = gridDim.x * 256;
    for (int i = gt; i < nrows * 32; i += gs) {
        const int row = i >> 5, c8 = (i & 31) * 8;
        int pos, len;
        if (row < NLAT) { pos = row & 63; len = 64; } else { pos = (row - NLAT) & 255; len = 256; }
        const bf16_t* zr = w.zr() + (size_t)row * 1280;
        float accv[8];
#pragma unroll
        for (int e = 0; e < 8; ++e) accv[e] = 0.f;
#pragma unroll
        for (int j = -1; j <= 1; ++j) {
            if (pos + j < 0 || pos + j >= len) continue;
            const uint4 cg = *(const uint4*)(zr + (ptrdiff_t)j * 1280 + 256 + c8);
            const uint4 vv = *(const uint4*)(zr + (ptrdiff_t)j * 1280 + 512 + c8);
            const float4 wa = *(const float4*)(wsc + (j + 1) * 256 + c8), wb = *(const float4*)(wsc + (j + 1) * 256 + c8 + 4);
            accv[0] += wa.x * bflo(cg.x) * bflo(vv.x); accv[1] += wa.y * bfhi(cg.x) * bfhi(vv.x);
            accv[2] += wa.z * bflo(cg.y) * bflo(vv.y); accv[3] += wa.w * bfhi(cg.y) * bfhi(vv.y);
            accv[4] += wb.x * bflo(cg.z) * bflo(vv.z); accv[5] += wb.y * bfhi(cg.z) * bfhi(vv.z);
            accv[6] += wb.z * bflo(cg.w) * bflo(vv.w); accv[7] += wb.w * bfhi(cg.w) * bfhi(vv.w);
        }
        const uint4 bg = *(const uint4*)(zr + c8);
        uint4 o;
        o.x = pack2(accv[0] * bflo(bg.x), accv[1] * bfhi(bg.x));
        o.y = pack2(accv[2] * bflo(bg.y), accv[3] * bfhi(bg.y));
        o.z = pack2(accv[4] * bflo(bg.z), accv[5] * bfhi(bg.z));
        o.w = pack2(accv[6] * bflo(bg.w), accv[7] * bfhi(bg.w));
        *(uint4*)(w.hb() + (size_t)row * D + 512 + c8) = o;
    }
}

__device__ __forceinline__ void conv_cf(const Params& p, unsigned char* lds, int l, bool with_ctx) {
    const WS w{p.ws};
    float* P = (float*)lds;
    const int tid = threadIdx.x, lane = tid & 63, wid = tid >> 6;
    const float* wdw = p.in[18] + (size_t)l * 31 * 256;
    const float4 bdw = *(const float4*)(p.in[19] + l * 256 + lane * 4);
    const float4 lg = *(const float4*)(p.in[20] + l * 256 + lane * 4);
    const float4 lb = *(const float4*)(p.in[21] + l * 256 + lane * 4);
    const int nitem = 256 + (with_ctx ? 64 : 0);
    for (int it = blockIdx.x; it < nitem; it += gridDim.x) {
        const bool lat = it < 256;
        int b, base, nslot, sstride, s0 = 0;
        if (lat) { b = it >> 5; base = b * SEQ + (it & 31) * 2; nslot = 64; sstride = 2; }
        else { const int j = it - 256; b = j >> 3; s0 = (j & 7) * 32; base = NLAT + b * CTX; nslot = 62; sstride = 1; }
        __syncthreads();
        for (int task = tid; task < 64 * 32; task += 256) {
            const int slot = task >> 5, c8 = (task & 31) * 8;
            int row; bool valid = true;
            if (lat) row = base + (slot >> 1) * 64 + (slot & 1);
            else { const int s = s0 - 15 + slot; valid = (slot < nslot) && s >= 0 && s < CTX; row = base + s; }
            float f[8];
            if (valid) {
                const bf16_t* zr = w.zr() + (size_t)row * 1280;
                const uint4 ga = *(const uint4*)(zr + 768 + c8), gb = *(const uint4*)(zr + 1024 + c8);
                f[0] = bflo(ga.x) * sigmoidf_(bflo(gb.x)); f[1] = bfhi(ga.x) * sigmoidf_(bfhi(gb.x));
                f[2] = bflo(ga.y) * sigmoidf_(bflo(gb.y)); f[3] = bfhi(ga.y) * sigmoidf_(bfhi(gb.y));
                f[4] = bflo(ga.z) * sigmoidf_(bflo(gb.z)); f[5] = bfhi(ga.z) * sigmoidf_(bfhi(gb.z));
                f[6] = bflo(ga.w) * sigmoidf_(bflo(gb.w)); f[7] = bfhi(ga.w) * sigmoidf_(bfhi(gb.w));
            } else {
#pragma unroll
                for (int e = 0; e < 8; ++e) f[e] = 0.f;
            }
            *(float4*)(P + slot * 256 + c8) = make_float4(f[0], f[1], f[2], f[3]);
            *(float4*)(P + slot * 256 + c8 + 4) = make_float4(f[4], f[5], f[6], f[7]);
        }
        __syncthreads();
        const int nout = lat ? 64 : 32;
        for (int o = wid; o < nout; o += 4) {
            float4 a = bdw;
            int row;
            if (lat) {
                const int r = o >> 1, i = o & 1;
                row = base + r * 64 + i;
                for (int k = 0; k < 31; ++k) {
                    const int rr = r + k - 15;
                    if (rr < 0 || rr >= 32) continue;
                    const float4 wv = *(const float4*)(wdw + k * 256 + lane * 4);
                    const float4 pv = *(const float4*)(P + (rr * 2 + i) * 256 + lane * 4);
                    a.x += wv.x * pv.x; a.y += wv.y * pv.y; a.z += wv.z * pv.z; a.w += wv.w * pv.w;
                }
            } else {
                row = base + s0 + o;
                for (int k = 0; k < 31; ++k) {
                    const float4 wv = *(const float4*)(wdw + k * 256 + lane * 4);
                    const float4 pv = *(const float4*)(P + (o + k) * 256 + lane * 4);
                    a.x += wv.x * pv.x; a.y += wv.y * pv.y; a.z += wv.z * pv.z; a.w += wv.w * pv.w;
                }
            }
            const float mean = wave_sum(a.x + a.y + a.z + a.w) * (1.0f / 256.0f);
            const float dx = a.x - mean, dy = a.y - mean, dz = a.z - mean, dw = a.w - mean;
            const float var = wave_sum(dx * dx + dy * dy + dz * dz + dw * dw) * (1.0f / 256.0f);
            const float rs = rsqrtf(var + LN_EPS);
            const float y0 = siluf_(dx * rs * lg.x + lb.x), y1 = siluf_(dy * rs * lg.y + lb.y), y2 = siluf_(dz * rs * lg.z + lb.z), y3 = siluf_(dw * rs * lg.w + lb.w);
            uint2 ov; ov.x = pack2(y0, y1); ov.y = pack2(y2, y3);
            *(uint2*)(w.hb() + (size_t)row * D + 768 + lane * 4) = ov;
        }
    }
}

__device__ __forceinline__ void phase_s1(const Params& p, unsigned char* lds, int l) {
    const WS w{p.ws};
    const int ntile = NG * 9 * 2;
    for (int t = blockIdx.x; t < ntile; t += gridDim.x) {
        const int g = t / 18, r = t % 18, mt = r >> 1, nt = r & 1;
        Src4 A, B;
        src_plain(A, w.ug() + (size_t)g * NROW * 16, mt * 128, 256);
        src_plain(B, w.m1(l, g), nt * 128, 256);
        EpiS1 e{w.S() + (size_t)g * NCOL * 256, mt * 128, nt * 128};
        gemm128(lds, A, B, 256, e);
    }
    conv_sc(p, l, l == 0 ? NROW : NLAT);
    conv_cf(p, lds, l, l == 0);
}

__device__ __forceinline__ int chunk_col(int d, int b, int step) {
    if (step < CH_CTX) { const int c = d == 0 ? step : (CH_CTX - 1 - step); return NCOL_LAT + b * CH_CTX + c; }
    const int s = step - CH_CTX; const int c = d == 0 ? s : (CH_LAT - 1 - s); return b * CH_LAT + c;
}
__device__ __forceinline__ void phase_s2(const Params& p, unsigned char* lds, int l) {
    const WS w{p.ws};
    float2* Fs = (float2*)lds;
    const int tid = threadIdx.x, seg = tid >> 5, pl = tid & 31;
    for (int it = blockIdx.x; it < NG * 2 * NB * 2; it += gridDim.x) {
        const int ph = it & 1, b = (it >> 1) & 7, d = (it >> 4) & 1, g = it >> 5;
        const int pp = ph * 32 + pl;
        const float2 A = w.lampow(l, d, g)[pp * NPOW + 16], A18 = w.lampow(l, d, g)[pp * NPOW + 17];
        const float* S = w.S() + (size_t)g * NCOL * 256 + d * 128 + 2 * pp;
        bf16_t* Hp = w.hprev() + (size_t)g * NCOL * 256 + d * 128 + 2 * pp;
        float2 s[SEGLEN];
#pragma unroll
        for (int i = 0; i < SEGLEN; ++i) s[i] = *(const float2*)(S + (size_t)chunk_col(d, b, seg * SEGLEN + i) * 256);
        float2 F = make_float2(0.f, 0.f);
#pragma unroll
        for (int i = 0; i < SEGLEN; ++i) { const float fr = A.x * F.x - A.y * F.y + s[i].x, fi = A.x * F.y + A.y * F.x + s[i].y; F.x = fr; F.y = fi; }
        __syncthreads();
        Fs[seg * 32 + pl] = F;
        __syncthreads();
        float2 H = make_float2(0.f, 0.f);
        for (int q = 0; q < seg; ++q) { const float2 f = Fs[q * 32 + pl]; const float hr = A18.x * H.x - A18.y * H.y + f.x, hi = A18.x * H.y + A18.y * H.x + f.y; H.x = hr; H.y = hi; }
#pragma unroll
        for (int i = 0; i < SEGLEN; ++i) {
            *(unsigned*)(Hp + (size_t)chunk_col(d, b, seg * SEGLEN + i) * 256) = pack2(H.x, H.y);
            const float hr = A.x * H.x - A.y * H.y + s[i].x, hi = A.x * H.y + A.y * H.x + s[i].y; H.x = hr; H.y = hi;
        }
    }
}

struct EpiS3 {
    bf16_t* Y; int m0, n0, g;
    __device__ __forceinline__ void operator()(const f32x16 (&acc)[2][2], int r0, int c0) const {
        ACC_FOREACH(acc, r0, c0, {
            const int col = n0 + cl, tok = (m0 + rl) * TCH + (col >> 4);
            uint2 o; o.x = pack2(gelu_tanh(v0), gelu_tanh(v1)); o.y = pack2(gelu_tanh(v2), gelu_tanh(v3));
            *(uint2*)(Y + (size_t)tok * DS5 + g * 16 + (col & 15)) = o;
        })
    }
};
__device__ __forceinline__ void phase_s3(const Params& p, unsigned char* lds, int l) {
    const WS w{p.ws};
    const int nmt = l == 0 ? 9 : 8, ntile = NG * nmt * 2;
    for (int t = blockIdx.x; t < ntile; t += gridDim.x) {
        const int g = t / (nmt * 2), r = t % (nmt * 2), mt = r >> 1, nt = r & 1;
        Src4 A, B;
        src_split(A, w.ug() + (size_t)g * NROW * 16, 256, w.hprev() + (size_t)g * NCOL * 256, 256, mt * 128, 256);
        src_plain(B, w.w2(l, g), nt * 128, 512);
        EpiS3 e{w.Y(), mt * 128, nt * 128, g};
        gemm128(lds, A, B, 512, e);
    }
}

struct EpiGlu {
    const bf16_t* Y; bf16_t* hb; const float* bg; int m0, n0;
    __device__ __forceinline__ void operator()(const f32x16 (&acc)[2][2], int r0, int c0) const {
        ACC_FOREACH(acc, r0, c0, {
            const int row = m0 + rl, col = n0 + cl;
            const uint2 t = *(const uint2*)(Y + (size_t)row * DS5 + col);
            const float4 b = *(const float4*)(bg + col);
            uint2 o;
            o.x = pack2(bflo(t.x) * sigmoidf_(v0 + b.x), bfhi(t.x) * sigmoidf_(v1 + b.y));
            o.y = pack2(bflo(t.y) * sigmoidf_(v2 + b.z), bfhi(t.y) * sigmoidf_(v3 + b.w));
            *(uint2*)(hb + (size_t)row * D + col) = o;
        })
    }
};
__device__ __forceinline__ void phase_glu(const Params& p, unsigned char* lds, int l) {
    const WS w{p.ws};
    const int nmt = l == 0 ? 144 : 128, ntile = nmt * 4;
    for (int t = blockIdx.x; t < ntile; t += gridDim.x) {
        const int mt = t >> 2, nt = t & 3;
        Src4 A, B;
        src_plain(A, w.Y(), mt * 128, DS5);
        src_plain(B, w.wt_glu(l), nt * 128, 512);
        EpiGlu e{w.Y(), w.hb(), p.in[16] + l * DS5, mt * 128, nt * 128};
        gemm128(lds, A, B, 512, e);
    }
}

struct EpiOut {
    const Params* p; const float* mod; int l, m0, n0;
    __device__ __forceinline__ void operator()(const f32x16 (&acc)[2][2], int r0, int c0) const {
        ACC_FOREACH(acc, r0, c0, {
            const int row = m0 + rl, col = n0 + cl, m = modrow(row);
            const float4 g1 = *(const float4*)(mod + (size_t)m * 6144 + 2048 + col);
            float* R = Rrow(*p, row) + col;
            const float* res = l == 0 ? (row < NLAT ? p->in[0] + (size_t)row * D + col : p->in[2] + (size_t)(row - NLAT) * D + col) : R;
            const float4 x = *(const float4*)res;
            *(float4*)R = make_float4(DN_ALPHA * x.x + g1.x * v0, DN_ALPHA * x.y + g1.y * v1, DN_ALPHA * x.z + g1.z * v2, DN_ALPHA * x.w + g1.w * v3);
        })
    }
};
__device__ __forceinline__ void phase_outproj(const Params& p, unsigned char* lds, int l) {
    const WS w{p.ws};
    const int nmt = l == 0 ? 144 : 128, ntile = nmt * 8;
    for (int t = blockIdx.x; t < ntile; t += gridDim.x) {
        const int mt = t >> 3, nt = t & 7;
        Src4 A, B;
        src_plain(A, w.hb(), mt * 128, D);
        src_plain(B, w.wt_o(l), nt * 128, D);
        EpiOut e{&p, w.mod(l), l, mt * 128, nt * 128};
        gemm128(lds, A, B, D, e);
    }
}

__device__ __forceinline__ void phase_ln1(const Params& p, unsigned char* lds, int l) {
    const WS w{p.ws};
    const int tid = threadIdx.x, lane = tid & 63, wid = tid >> 6;
    float* wl = (float*)lds;
    __syncthreads();
    for (int i = tid; i < 1024 * 20; i += 256) {
        const int k = i / 20, o = i % 20;
        const float v = o < 4 ? p.in[25][((size_t)l * D + k) * 4 + o] : p.in[27][((size_t)l * D + k) * 16 + (o - 4)];
        const int s = ((k >> 8) * 4 + (k & 3)) * 64 + ((k >> 2) & 63);
        wl[((o >> 2) * 1024 + s) * 4 + (o & 3)] = v;
    }
    __syncthreads();
    const int nrows = l == 0 ? NROW : NLAT;
    const float* md = w.mod(l);
    const float* lng = p.in[23] + l * D; const float* lnb = p.in[24] + l * D;
    for (int row = blockIdx.x * 4 + wid; row < nrows; row += gridDim.x * 4) {
        float* R = Rrow(p, row);
        const int m = modrow(row);
        float h[16];
        float4 v[4];
#pragma unroll
        for (int i = 0; i < 4; ++i) v[i] = *(const float4*)(R + i * 256 + lane * 4);
        float s = 0.f;
#pragma unroll
        for (int i = 0; i < 4; ++i) s += (v[i].x + v[i].y) + (v[i].z + v[i].w);
        const float mean = wave_sum(s) * (1.0f / 1024.0f);
        float q = 0.f;
#pragma unroll
        for (int i = 0; i < 4; ++i) { const float a = v[i].x - mean, b = v[i].y - mean, c = v[i].z - mean, d = v[i].w - mean; q += (a * a + b * b) + (c * c + d * d); }
        const float rs = rsqrtf(wave_sum(q) * (1.0f / 1024.0f) + LN_EPS);
#pragma unroll
        for (int i = 0; i < 4; ++i) {
            const int col = i * 256 + lane * 4;
            const float4 g = *(const float4*)(lng + col), b = *(const float4*)(lnb + col);
            const float4 sh = *(const float4*)(md + (size_t)m * 6144 + 3072 + col), sc = *(const float4*)(md + (size_t)m * 6144 + 4096 + col);
            float4 x;
            x.x = (v[i].x - mean) * rs * g.x + b.x; x.y = (v[i].y - mean) * rs * g.y + b.y; x.z = (v[i].z - mean) * rs * g.z + b.z; x.w = (v[i].w - mean) * rs * g.w + b.w;
            *(float4*)(R + col) = x;
            h[i * 4 + 0] = x.x * (1.f + sc.x) + sh.x; h[i * 4 + 1] = x.y * (1.f + sc.y) + sh.y; h[i * 4 + 2] = x.z * (1.f + sc.z) + sh.z; h[i * 4 + 3] = x.w * (1.f + sc.w) + sh.w;
            uint2 o; o.x = pack2(h[i * 4 + 0], h[i * 4 + 1]); o.y = pack2(h[i * 4 + 2], h[i * 4 + 3]);
            *(uint2*)(w.hb() + (size_t)row * D + col) = o;
        }
        float mylg = 0.f;
#pragma unroll 1
        for (int o4 = 0; o4 < 5; ++o4) {
            float a0 = 0.f, a1 = 0.f, a2 = 0.f, a3 = 0.f;
#pragma unroll
            for (int e = 0; e < 16; ++e) {
                const float4 wv = *(const float4*)(wl + ((o4 * 1024) + e * 64 + lane) * 4);
                a0 += h[e] * wv.x; a1 += h[e] * wv.y; a2 += h[e] * wv.z; a3 += h[e] * wv.w;
            }
            a0 = wave_sum(a0); a1 = wave_sum(a1); a2 = wave_sum(a2); a3 = wave_sum(a3);
            if (lane == o4 * 4 + 0) mylg = a0;
            if (lane == o4 * 4 + 1) mylg = a1;
            if (lane == o4 * 4 + 2) mylg = a2;
            if (lane == o4 * 4 + 3) mylg = a3;
        }
        float lg[20];
#pragma unroll
        for (int i = 0; i < 20; ++i) lg[i] = __shfl(mylg, i);
        if (lane == 0) {
            float gl[4];
#pragma unroll
            for (int i = 0; i < 4; ++i) gl[i] = lg[i] + p.in[26][l * 4 + i];
            int gi = 0; float gm = gl[0];
#pragma unroll
            for (int i = 1; i < 4; ++i) if (gl[i] > gm) { gm = gl[i]; gi = i; }
            float den = 0.f;
#pragma unroll
            for (int i = 0; i < 4; ++i) den += __expf(gl[i] - gm);
            const float gw = 1.0f / den;
            float el[4];
#pragma unroll
            for (int i = 0; i < 4; ++i) {
                float t = lg[4 + i];
                if (gi == 1) t = lg[8 + i]; else if (gi == 2) t = lg[12 + i]; else if (gi == 3) t = lg[16 + i];
                el[i] = t + p.in[28][l * 16 + gi * 4 + i];
            }
            int i1 = 0; float m1 = el[0];
#pragma unroll
            for (int i = 1; i < 4; ++i) if (el[i] > m1) { m1 = el[i]; i1 = i; }
            int i2 = -1; float m2 = -3.0e38f;
#pragma unroll
            for (int i = 0; i < 4; ++i) if (i != i1 && el[i] > m2) { m2 = el[i]; i2 = i; }
            const float e2 = __expf(m2 - m1);
            const float w1 = gw / (1.0f + e2), w2 = gw * e2 / (1.0f + e2);
            const int lo = i1 < i2 ? i1 : i2, hi = i1 < i2 ? i2 : i1;
            const float wlo = i1 < i2 ? w1 : w2, whi = i1 < i2 ? w2 : w1;
            const int pair = lo == 0 ? (hi - 1) : (lo == 1 ? (hi + 1) : 5);
            const int cls = gi * 6 + pair;
            const int pos = atomicAdd(w.cnt(l) + cls, 1);
            w.list()[(size_t)cls * LISTCAP + pos] = row;
            w.lw()[(size_t)cls * LISTCAP + pos] = make_float2(wlo, whi);
        }
    }
}

__device__ __forceinline__ void cls_experts(int cls, int& elo, int& ehi) {
    const int g = cls / 6, pr = cls % 6;
    const int lo = pr < 3 ? 0 : (pr < 5 ? 1 : 2);
    const int hi = pr < 3 ? pr + 1 : (pr < 5 ? pr - 1 : 3);
    elo = g * 4 + lo; ehi = g * 4 + hi;
}

struct EpiGU {
    bf16_t* act; const float2* lw; int cnt, pos0, orow0, half, fcol0;
    __device__ __forceinline__ void operator()(const f32x16 (&acc)[2][2], int r0, int c0) const {
        const int hh4 = c0 & 4, wn64 = c0 & 64;
#pragma unroll
        for (int mt = 0; mt < 2; ++mt) {
            const int rl = r0 + mt * 32, pos = pos0 + rl;
            float wt = 0.f;
            if (pos < cnt) { const float2 ww = lw[pos]; wt = half ? ww.y : ww.x; }
#pragma unroll
            for (int nt = 0; nt < 2; ++nt)
#pragma unroll
                for (int qp = 0; qp < 2; ++qp) {
                    const int f = fcol0 + ((wn64 + nt * 32) >> 1) + qp * 8 + hh4;
                    const int qg = qp * 2, qu = qp * 2 + 1;
                    const float a0 = siluf_(acc[mt][nt][qg * 4 + 0]) * acc[mt][nt][qu * 4 + 0] * wt;
                    const float a1 = siluf_(acc[mt][nt][qg * 4 + 1]) * acc[mt][nt][qu * 4 + 1] * wt;
                    const float a2 = siluf_(acc[mt][nt][qg * 4 + 2]) * acc[mt][nt][qu * 4 + 2] * wt;
                    const float a3 = siluf_(acc[mt][nt][qg * 4 + 3]) * acc[mt][nt][qu * 4 + 3] * wt;
                    uint2 o; o.x = pack2(a0, a1); o.y = pack2(a2, a3);
                    *(uint2*)(act + (size_t)(orow0 + rl) * 512 + half * 256 + f) = o;
                }
        }
    }
};
__device__ __forceinline__ void phase_moe_gu(const Params& p, unsigned char* lds, int l) {
    const WS w{p.ws};
    int ntl[NCLS]; int tot = 0;
#pragma unroll
    for (int c = 0; c < NCLS; ++c) { ntl[c] = (w.cnt(l)[c] + 127) >> 7; tot += ntl[c]; }
    const int ntile = tot * 8;
    const int lr = threadIdx.x >> 3, lc = (threadIdx.x & 7) ^ ((lr >> 1) & 7);
    for (int t = blockIdx.x; t < ntile; t += gridDim.x) {
        const int mg = t >> 3, nt = t & 7;
        int cls = 0, mt = 0, run = 0;
#pragma unroll
        for (int c = 0; c < NCLS; ++c) { if (mg >= run && mg < run + ntl[c]) { cls = c; mt = mg - run; } run += ntl[c]; }
        const int cnt = w.cnt(l)[cls];
        int elo, ehi; cls_experts(cls, elo, ehi);
        const int half = nt >> 2, e = half ? ehi : elo;
        const int* lst = w.list() + (size_t)cls * LISTCAP;
        Src4 A, B;
#pragma unroll
        for (int j = 0; j < 4; ++j) {
            int pos = mt * 128 + lr + 32 * j; if (pos >= cnt) pos = 0;
            const int tok = lst[pos];
            A.p0[j] = w.hb() + (size_t)tok * D + lc * 8; A.p1[j] = A.p0[j];
        }
        A.split = 1 << 30;
        src_plain(B, w.wt_gu(l, e), (nt & 3) * 128, D);
        EpiGU ep{w.act(), w.lw() + (size_t)cls * LISTCAP, cnt, mt * 128, mg * 128, half, (nt & 3) * 64};
        gemm128(lds, A, B, D, ep);
    }
}

struct EpiDown {
    const Params* p; const float* mod; const int* lst; int cnt, pos0, n0;
    __device__ __forceinline__ void operator()(const f32x16 (&acc)[2][2], int r0, int c0) const {
#pragma unroll
        for (int mt = 0; mt < 2; ++mt) {
            const int pos = pos0 + r0 + mt * 32;
            if (pos < cnt) {
                const int row = lst[pos], m = modrow(row);
                float* R = Rrow(*p, row);
#pragma unroll
                for (int nt = 0; nt < 2; ++nt)
#pragma unroll
                    for (int q = 0; q < 4; ++q) {
                        const int col = n0 + c0 + nt * 32 + q * 8;
                        const float4 g2 = *(const float4*)(mod + (size_t)m * 6144 + 5120 + col);
                        const float4 x = *(const float4*)(R + col);
                        *(float4*)(R + col) = make_float4(DN_ALPHA * x.x + g2.x * acc[mt][nt][q * 4 + 0], DN_ALPHA * x.y + g2.y * acc[mt][nt][q * 4 + 1],
                                                          DN_ALPHA * x.z + g2.z * acc[mt][nt][q * 4 + 2], DN_ALPHA * x.w + g2.w * acc[mt][nt][q * 4 + 3]);
                    }
            }
        }
    }
};
__device__ __forceinline__ void phase_moe_dn(const Params& p, unsigned char* lds, int l) {
    const WS w{p.ws};
    int ntl[NCLS]; int tot = 0;
#pragma unroll
    for (int c = 0; c < NCLS; ++c) { ntl[c] = (w.cnt(l)[c] + 127) >> 7; tot += ntl[c]; }
    const int ntile = tot * 8;
    for (int t = blockIdx.x; t < ntile; t += gridDim.x) {
        const int mg = t >> 3, nt = t & 7;
        int cls = 0, mt = 0, run = 0;
#pragma unroll
        for (int c = 0; c < NCLS; ++c) { if (mg >= run && mg < run + ntl[c]) { cls = c; mt = mg - run; } run += ntl[c]; }
        const int cnt = w.cnt(l)[cls];
        int elo, ehi; cls_experts(cls, elo, ehi);
        Src4 A, B;
        src_plain(A, w.act(), mg * 128, 512);
        src_split(B, w.wt_dn(l, elo), 256, w.wt_dn(l, ehi), 256, nt * 128, 256);
        EpiDown ep{&p, w.mod(l), w.list() + (size_t)cls * LISTCAP, cnt, mt * 128, nt * 128};
        gemm128(lds, A, B, 512, ep);
    }
}

__device__ __forceinline__ void phase_ln2(const Params& p, int l) {
    const WS w{p.ws};
    const int tid = threadIdx.x, lane = tid & 63, wid = tid >> 6;
    const int nrows = l == 0 ? NROW : NLAT;
    const float* lng = p.in[32] + l * D; const float* lnb = p.in[33] + l * D;
    const float* mdn = w.mod(1);
    for (int row = blockIdx.x * 4 + wid; row < nrows; row += gridDim.x * 4) {
        float* R = Rrow(p, row);
        const int m = modrow(row);
        float4 v[4];
#pragma unroll
        for (int i = 0; i < 4; ++i) v[i] = *(const float4*)(R + i * 256 + lane * 4);
        float s = 0.f;
#pragma unroll
        for (int i = 0; i < 4; ++i) s += (v[i].x + v[i].y) + (v[i].z + v[i].w);
        const float mean = wave_sum(s) * (1.0f / 1024.0f);
        float q = 0.f;
#pragma unroll
        for (int i = 0; i < 4; ++i) { const float a = v[i].x - mean, b = v[i].y - mean, c = v[i].z - mean, d = v[i].w - mean; q += (a * a + b * b) + (c * c + d * d); }
        const float rs = rsqrtf(wave_sum(q) * (1.0f / 1024.0f) + LN_EPS);
#pragma unroll
        for (int i = 0; i < 4; ++i) {
            const int col = i * 256 + lane * 4;
            const float4 g = *(const float4*)(lng + col), b = *(const float4*)(lnb + col);
            float4 x;
            x.x = (v[i].x - mean) * rs * g.x + b.x; x.y = (v[i].y - mean) * rs * g.y + b.y; x.z = (v[i].z - mean) * rs * g.z + b.z; x.w = (v[i].w - mean) * rs * g.w + b.w;
            *(float4*)(R + col) = x;
            if (l == 0) {
                const float4 sh = *(const float4*)(mdn + (size_t)m * 6144 + col), sc = *(const float4*)(mdn + (size_t)m * 6144 + 1024 + col);
                uint2 o; o.x = pack2(x.x * (1.f + sc.x) + sh.x, x.y * (1.f + sc.y) + sh.y); o.y = pack2(x.z * (1.f + sc.z) + sh.z, x.w * (1.f + sc.w) + sh.w);
                *(uint2*)(w.hb() + (size_t)row * D + col) = o;
            }
        }
    }
}

#define XB_TMO      128
#define XB_XCNT(j)  (256  + 64 * (j))
#define XB_XSUB(j)  (1280 + 64 * (j))
#define XB_XGEN(j)  (2304 + 64 * (j))
#define XB_TOP      3328
#define XB_TOPGEN   3392
#define XB_SPIN_CAP (1u << 20)
__device__ __forceinline__ unsigned xb_ld(unsigned* p)              { return __hip_atomic_load(p, __ATOMIC_RELAXED, __HIP_MEMORY_SCOPE_AGENT); }
__device__ __forceinline__ unsigned xb_add(unsigned* p, unsigned v) { return __hip_atomic_fetch_add(p, v, __ATOMIC_RELAXED, __HIP_MEMORY_SCOPE_AGENT); }
__device__ __forceinline__ unsigned xb_xcc_id() { return (unsigned)__builtin_amdgcn_s_getreg((3 << 11) | 20) & 0xFu; }
#define XB_SPIN(cond, bar) do { unsigned _sp = 0; while (cond) { __builtin_amdgcn_s_sleep(1); \
    if ((++_sp & 255u) == 0u) { if (xb_ld(&(bar)[XB_TMO])) break; if (_sp > XB_SPIN_CAP) { atomicAdd(&(bar)[XB_TMO], 1u); break; } } } } while (0)
struct XcdBarrier { unsigned* bar; unsigned x, nloc, nx; };
__device__ __forceinline__ void xcd_barrier_post(XcdBarrier& b, unsigned* bar) {
    b.bar = bar; b.x = xb_xcc_id(); b.nloc = 0u; b.nx = 0u;
    if (threadIdx.x == 0) (void)xb_add(&bar[XB_XCNT(b.x)], 1u);
}
__device__ __forceinline__ void xcd_barrier_complete(unsigned* bar, unsigned x, unsigned& nloc, unsigned& nx) {
    const unsigned G = gridDim.x;
    unsigned sum, cnt, mine, sp = 0u;
    for (;;) {
        sum = 0u; cnt = 0u; mine = 0u;
#pragma unroll
        for (unsigned j = 0; j < 16; ++j) { const unsigned c = xb_ld(&bar[XB_XCNT(j)]); sum += c; cnt += (c > 0u) ? 1u : 0u; mine = (j == x) ? c : mine; }
        if (sum == G) break;
        __builtin_amdgcn_s_sleep(1);
        if ((++sp & 255u) == 0u) { if (xb_ld(&bar[XB_TMO])) break; if (sp > XB_SPIN_CAP) { atomicAdd(&bar[XB_TMO], 1u); break; } }
    }
    nloc = mine > 0u ? mine : 1u; nx = cnt > 0u ? cnt : 1u;
}
__device__ __forceinline__ void xcd_barrier(XcdBarrier& b) {
    asm volatile("s_waitcnt vmcnt(0)" ::: "memory");
    __syncthreads();
    if (threadIdx.x == 0) {
        unsigned* bar = b.bar;
        __builtin_amdgcn_s_waitcnt(0);
        if (b.nloc == 0u) xcd_barrier_complete(bar, b.x, b.nloc, b.nx);
        const unsigned nloc = b.nloc, nx = b.nx;
        const unsigned old = xb_add(&bar[XB_XSUB(b.x)], 1u);
        const unsigned gen = old / nloc;
        if (old + 1u == (gen + 1u) * nloc) {
            __builtin_amdgcn_fence(__ATOMIC_RELEASE, "agent");
            asm volatile("s_waitcnt vmcnt(0)" ::: "memory");
            const unsigned og = xb_add(&bar[XB_TOP], 1u);
            const unsigned tg = og / nx;
            if (og + 1u == (tg + 1u) * nx) xb_add(&bar[XB_TOPGEN], 1u);
            else XB_SPIN(xb_ld(&bar[XB_TOPGEN]) == tg, bar);
            __builtin_amdgcn_fence(__ATOMIC_ACQUIRE, "agent");
            xb_add(&bar[XB_XGEN(b.x)], 1u);
            asm volatile("s_waitcnt vmcnt(0)" ::: "memory");
        } else {
            XB_SPIN(xb_ld(&bar[XB_XGEN(b.x)]) == gen, bar);
            __builtin_amdgcn_fence(__ATOMIC_ACQUIRE, "agent");
            asm volatile("s_waitcnt vmcnt(0)" ::: "memory");
        }
    }
    __syncthreads();
}

constexpr int NPHASE = 3 + 2 * 10;
__global__ void __launch_bounds__(256, 2) mega(Params p, int ph_lo, int ph_hi) {
    __shared__ __attribute__((aligned(16))) unsigned char lds[LDS_BYTES];
    XcdBarrier xb; xcd_barrier_post(xb, (unsigned*)(p.ws + OFF_BAR));
#define RUN(idx, ...) if (ph_lo <= (idx) && (idx) < ph_hi) { __VA_ARGS__; if ((idx) + 1 < ph_hi) xcd_barrier(xb); }
    RUN(0, phase_pro_a(p, lds))
    RUN(1, phase_pro_b(p))
    RUN(2, phase_pro_c(p))
#define LAYER(l) \
    RUN(3 + 10 * l + 0, phase_inproj(p, lds, l)) \
    RUN(3 + 10 * l + 1, phase_s1(p, lds, l)) \
    RUN(3 + 10 * l + 2, phase_s2(p, lds, l)) \
    RUN(3 + 10 * l + 3, phase_s3(p, lds, l)) \
    RUN(3 + 10 * l + 4, phase_glu(p, lds, l)) \
    RUN(3 + 10 * l + 5, phase_outproj(p, lds, l)) \
    RUN(3 + 10 * l + 6, phase_ln1(p, lds, l)) \
    RUN(3 + 10 * l + 7, phase_moe_gu(p, lds, l)) \
    RUN(3 + 10 * l + 8, phase_moe_dn(p, lds, l)) \
    RUN(3 + 10 * l + 9, phase_ln2(p, l))
    LAYER(0)
    LAYER(1)
#undef LAYER
#undef RUN
}

extern "C" void kernel_launch(void* const* d_in, const int* in_sizes, int n_in, void* d_out, int out_size, void* d_ws, size_t ws_size, hipStream_t stream) {
    static int grid_blocks = 0;
    if (grid_blocks == 0) {
        if (n_in != 34 || out_size != NLAT * D || ws_size < WS_END) {
            fprintf(stderr, "kernel_launch: unexpected shapes (n_in %d out %d ws %zu need %zu)\n", n_in, out_size, ws_size, (size_t)WS_END);
            grid_blocks = -1; return;
        }
        int dev = 0, cus = 0, per_cu = 0;
        hipGetDevice(&dev);
        hipDeviceGetAttribute(&cus, hipDeviceAttributeMultiprocessorCount, dev);
        hipOccupancyMaxActiveBlocksPerMultiprocessor(&per_cu, (const void*)mega, 256, 0);
        if (per_cu < 1) per_cu = 1;
        if (per_cu > 2) per_cu = 2;
        grid_blocks = cus * per_cu;
        fprintf(stderr, "kernel_launch: cus %d per_cu %d grid %d ws need %zu have %zu\n", cus, per_cu, grid_blocks, (size_t)WS_END, ws_size);
    }
    if (grid_blocks < 0) return;
    Params p{};
    for (int i = 0; i < 34; ++i) p.in[i] = (const float*)d_in[i];
    p.out = (float*)d_out; p.ws = (unsigned char*)d_ws;
    if (hipMemsetAsync((unsigned char*)d_ws + OFF_BAR, 0, SZ_BAR, stream) != hipSuccess) fprintf(stderr, "memset failed\n");
#if FUSED
    int lo = 0, hi = NPHASE;
    void* args[] = {&p, &lo, &hi};
    hipError_t e = hipLaunchCooperativeKernel((const void*)mega, dim3(grid_blocks), dim3(256), args, 0, stream);
    if (e != hipSuccess) fprintf(stderr, "cooperative launch failed: %s (grid %d)\n", hipGetErrorString(e), grid_blocks);
#else
    for (int ph = 0; ph < NPHASE; ++ph) hipLaunchKernelGGL(mega, dim3(grid_blocks), dim3(256), 0, stream, p, ph, ph + 1);
#endif
}
```

```cpp
#include <hip/hip_runtime.h>
#include <cstdio>
#include <cstdint>

#ifndef FUSED
#define FUSED 1
#endif
#define REP_INPROJ 1
#define REP_S1 1
#define REP_S3 1
#define REP_GLU 1
#define REP_OUT0 1
#define REP_GU 1
#define REP_CONV 1
#define REP_S2 1
#define REP_PRO 1
#define REP_BAR 1
#define REP_PROBC 1
#define DRY_LN1 0
#define DRY_LN2 0
#define KEEP(x) asm volatile("" :: "v"(x))

typedef unsigned short bf16_t;
typedef __attribute__((ext_vector_type(8))) short bf16x8;
typedef __attribute__((ext_vector_type(16))) float f32x16;

constexpr int D = 1024, NB = 8, SEQ = 2048, CTX = 256;
constexpr int NLAT = NB * SEQ, NCTX = NB * CTX, NROW = NLAT + NCTX;
constexpr int DIN = 1792, DS5 = 512, NG = 32, PS = 64;
constexpr int TCH = 16, NT = 256;
constexpr int NCOL = NROW / TCH;
constexpr int NCOL_LAT = NLAT / TCH;
constexpr int CH_LAT = SEQ / TCH, CH_CTX = CTX / TCH;
constexpr int NSTEP = CH_LAT + CH_CTX;
constexpr int NSEG = 8, SEGLEN = NSTEP / NSEG;
constexpr int NCLS = 24, LISTCAP = NROW;
constexpr int MAXMT = NROW / 128 + NCLS;
constexpr int KSPLIT_MOD = 16;
constexpr float LN_EPS = 1e-5f;
constexpr float DN_ALPHA = 1.4142135623730951f;
constexpr int NPOW = 18;

constexpr size_t AL(size_t x) { return (x + 255) & ~(size_t)255; }
constexpr size_t SZ_WT_IN = (size_t)2 * DIN * D * 2;
constexpr size_t SZ_WT_GLU = (size_t)2 * 512 * 512 * 2;
constexpr size_t SZ_WT_O = (size_t)2 * D * D * 2;
constexpr size_t SZ_WT_GU = (size_t)2 * 16 * 512 * 1024 * 2;
constexpr size_t SZ_WT_DN = (size_t)2 * 16 * 1024 * 256 * 2;
constexpr size_t SZ_MOD = (size_t)2 * 9 * 6144 * 4;
constexpr size_t SZ_LAMPOW = (size_t)2 * 2 * NG * PS * NPOW * 8;
constexpr size_t SZ_BBAR = (size_t)2 * 2 * NG * PS * 16 * 8;
constexpr size_t SZ_KFULL = (size_t)2 * NG * 32 * 256 * 4;
constexpr size_t SZ_M1 = (size_t)2 * NG * 256 * 256 * 2;
constexpr size_t SZ_W2 = (size_t)2 * NG * 256 * 512 * 2;
constexpr size_t SZ_HB = (size_t)NROW * D * 2;
constexpr size_t SZ_UG = (size_t)NG * NROW * 16 * 2;
constexpr size_t SZ_ZR = (size_t)NROW * 1280 * 2;
constexpr size_t SZ_S = (size_t)NG * NCOL * 256 * 4;
constexpr size_t SZ_RCTX = (size_t)NCTX * D * 4;
constexpr size_t SZ_CNT = 256 * 4;
constexpr size_t SZ_LIST = (size_t)NCLS * LISTCAP * 4;
constexpr size_t SZ_LW = (size_t)NCLS * LISTCAP * 8;

constexpr size_t OFF_WT_IN = 0;
constexpr size_t OFF_WT_GLU = OFF_WT_IN + AL(SZ_WT_IN);
constexpr size_t OFF_WT_O = OFF_WT_GLU + AL(SZ_WT_GLU);
constexpr size_t OFF_WT_GU = OFF_WT_O + AL(SZ_WT_O);
constexpr size_t OFF_WT_DN = OFF_WT_GU + AL(SZ_WT_GU);
constexpr size_t OFF_MOD = OFF_WT_DN + AL(SZ_WT_DN);
constexpr size_t OFF_LAMPOW = OFF_MOD + AL(SZ_MOD);
constexpr size_t OFF_BBAR = OFF_LAMPOW + AL(SZ_LAMPOW);
constexpr size_t OFF_KFULL = OFF_BBAR + AL(SZ_BBAR);
constexpr size_t OFF_M1 = OFF_KFULL + AL(SZ_KFULL);
constexpr size_t OFF_W2 = OFF_M1 + AL(SZ_M1);
constexpr size_t OFF_HB = OFF_W2 + AL(SZ_W2);
constexpr size_t OFF_UG = OFF_HB + AL(SZ_HB);
constexpr size_t OFF_ZR = OFF_UG + AL(SZ_UG);
constexpr size_t OFF_S = OFF_ZR + AL(SZ_ZR);
constexpr size_t OFF_RCTX = OFF_S + AL(SZ_S);
constexpr size_t OFF_CNT = OFF_RCTX + AL(SZ_RCTX);
constexpr size_t OFF_LIST = OFF_CNT + AL(SZ_CNT);
constexpr size_t OFF_LW = OFF_LIST + AL(SZ_LIST);
constexpr size_t OFF_BAR = OFF_LW + AL(SZ_LW);
constexpr size_t SZ_BAR = 3456 * 4;
constexpr size_t WS_END = OFF_BAR + AL(SZ_BAR);
static_assert((size_t)KSPLIT_MOD * 2 * 9 * 6144 * 4 <= SZ_ZR, "modp alias");
static_assert((size_t)NG * NCOL * 256 * 2 <= SZ_ZR, "hprev alias");
static_assert((size_t)NROW * 512 * 2 <= SZ_S && (size_t)MAXMT * 128 * 512 * 2 <= SZ_S, "Y/act alias");
static_assert(WS_END <= (size_t)256 * 1024 * 1024, "workspace over 256 MiB");

constexpr int LDS_BYTES = 81920;

struct Params {
    const float* in[34];
    float* out;
    unsigned char* ws;
};

__device__ __forceinline__ unsigned f2bf(float f) { unsigned u = __float_as_uint(f); u += 0x7fffu + ((u >> 16) & 1u); return u >> 16; }
__device__ __forceinline__ float bf2f(unsigned h) { return __uint_as_float(h << 16); }
__device__ __forceinline__ unsigned pack2(float a, float b) { return f2bf(a) | (f2bf(b) << 16); }
__device__ __forceinline__ float bflo(unsigned w) { return __uint_as_float(w << 16); }
__device__ __forceinline__ float bfhi(unsigned w) { return __uint_as_float(w & 0xffff0000u); }
__device__ __forceinline__ float wave_sum(float v) {
#pragma unroll
    for (int o = 32; o >= 1; o >>= 1) v += __shfl_xor(v, o);
    return v;
}
__device__ __forceinline__ float sigmoidf_(float x) { return 1.0f / (1.0f + __expf(-x)); }
__device__ __forceinline__ float siluf_(float x) { return x / (1.0f + __expf(-x)); }
__device__ __forceinline__ float gelu_tanh(float x) {
    const float z = 0.7978845608028654f * (x + 0.044715f * x * x * x);
    const float e = __expf(2.0f * z);
    const float t = 1.0f - 2.0f / (1.0f + e);
    return 0.5f * x * (1.0f + t);
}
__device__ __forceinline__ int modrow(int row) { return row < NLAT ? (row >> 11) : 8; }

struct Src4 { const bf16_t* p0[4]; const bf16_t* p1[4]; int split; };

#define LDS_AS __attribute__((address_space(3)))
template <class EPI>
__device__ __forceinline__ void gemm128(unsigned char* lds, const Src4& A, const Src4& B, const int K, const EPI& epi) {
    const int tid = threadIdx.x, lane = tid & 63, wid = __builtin_amdgcn_readfirstlane(tid >> 6), wm = wid >> 1, wn = wid & 1;
    const int l31 = lane & 31, hh = lane >> 5, sw = (l31 >> 1) & 7;
    const int xbase = (wm * 64 + l31) * 128, wbase = 16384 + (wn * 64 + l31) * 128;
    LDS_AS unsigned char* ldsw = (LDS_AS unsigned char*)lds + wid * 1024;
    f32x16 acc[2][2];
#pragma unroll
    for (int i = 0; i < 2; ++i)
#pragma unroll
        for (int j = 0; j < 2; ++j)
#pragma unroll
            for (int e = 0; e < 16; ++e) acc[i][j][e] = 0.f;
    const int nk = K >> 6;
#define G_STAGE(kt_, bufo_) do { const int k_ = (kt_) * 64; \
        _Pragma("unroll") for (int j = 0; j < 4; ++j) __builtin_amdgcn_global_load_lds((const unsigned*)(k_ < A.split ? A.p0[j] + k_ : A.p1[j] + (k_ - A.split)), (LDS_AS unsigned*)(ldsw + (bufo_) + j * 4096), 16, 0, 0); \
        _Pragma("unroll") for (int j = 0; j < 4; ++j) __builtin_amdgcn_global_load_lds((const unsigned*)(k_ < B.split ? B.p0[j] + k_ : B.p1[j] + (k_ - B.split)), (LDS_AS unsigned*)(ldsw + (bufo_) + 16384 + j * 4096), 16, 0, 0); } while (0)
    G_STAGE(0, 0);
    asm volatile("s_waitcnt vmcnt(0)" ::: "memory");
    __syncthreads();
    for (int kt = 0; kt < nk; ++kt) {
        const int buf = (kt & 1) * 32768;
        if (kt + 1 < nk) G_STAGE(kt + 1, ((kt + 1) & 1) * 32768);
#pragma unroll
        for (int ks = 0; ks < 4; ++ks) {
            const int co = ((ks * 2 + hh) ^ sw) << 4;
            const bf16x8 x0 = *(const bf16x8*)(lds + buf + xbase + co);
            const bf16x8 x1 = *(const bf16x8*)(lds + buf + xbase + 4096 + co);
            const bf16x8 w0 = *(const bf16x8*)(lds + buf + wbase + co);
            const bf16x8 w1 = *(const bf16x8*)(lds + buf + wbase + 4096 + co);
            acc[0][0] = __builtin_amdgcn_mfma_f32_32x32x16_bf16(w0, x0, acc[0][0], 0, 0, 0);
            acc[0][1] = __builtin_amdgcn_mfma_f32_32x32x16_bf16(w1, x0, acc[0][1], 0, 0, 0);
            acc[1][0] = __builtin_amdgcn_mfma_f32_32x32x16_bf16(w0, x1, acc[1][0], 0, 0, 0);
            acc[1][1] = __builtin_amdgcn_mfma_f32_32x32x16_bf16(w1, x1, acc[1][1], 0, 0, 0);
        }
        asm volatile("s_waitcnt vmcnt(0)" ::: "memory");
        __syncthreads();
    }
#undef G_STAGE
    epi(acc, wm * 64 + l31, wn * 64 + hh * 4);
}

__device__ __forceinline__ void src_plain(Src4& s, const bf16_t* base, int row0, int ld) {
    const int lr = threadIdx.x >> 3, lc = (threadIdx.x & 7) ^ ((lr >> 1) & 7);
#pragma unroll
    for (int j = 0; j < 4; ++j) { s.p0[j] = base + (size_t)(row0 + lr + 32 * j) * ld + lc * 8; s.p1[j] = s.p0[j]; }
    s.split = 1 << 30;
}
__device__ __forceinline__ void src_split(Src4& s, const bf16_t* base0, int ld0, const bf16_t* base1, int ld1, int row0, int split) {
    const int lr = threadIdx.x >> 3, lc = (threadIdx.x & 7) ^ ((lr >> 1) & 7);
#pragma unroll
    for (int j = 0; j < 4; ++j) { s.p0[j] = base0 + (size_t)(row0 + lr + 32 * j) * ld0 + lc * 8; s.p1[j] = base1 + (size_t)(row0 + lr + 32 * j) * ld1 + lc * 8; }
    s.split = split;
}

#define ACC_FOREACH(acc, r0, c0, ...) \
    _Pragma("unroll") for (int mt_ = 0; mt_ < 2; ++mt_) \
    _Pragma("unroll") for (int nt_ = 0; nt_ < 2; ++nt_) \
    _Pragma("unroll") for (int q_ = 0; q_ < 4; ++q_) { \
        const int rl = (r0) + mt_ * 32, cl = (c0) + nt_ * 32 + q_ * 8; \
        const float v0 = acc[mt_][nt_][q_ * 4 + 0], v1 = acc[mt_][nt_][q_ * 4 + 1], v2 = acc[mt_][nt_][q_ * 4 + 2], v3 = acc[mt_][nt_][q_ * 4 + 3]; \
        __VA_ARGS__ }

struct WS {
    unsigned char* b;
    __device__ bf16_t* wt_in(int l) const { return (bf16_t*)(b + OFF_WT_IN) + (size_t)l * DIN * D; }
    __device__ bf16_t* wt_glu(int l) const { return (bf16_t*)(b + OFF_WT_GLU) + (size_t)l * 512 * 512; }
    __device__ bf16_t* wt_o(int l) const { return (bf16_t*)(b + OFF_WT_O) + (size_t)l * D * D; }
    __device__ bf16_t* wt_gu(int l, int e) const { return (bf16_t*)(b + OFF_WT_GU) + (size_t)(l * 16 + e) * 512 * 1024; }
    __device__ bf16_t* wt_dn(int l, int e) const { return (bf16_t*)(b + OFF_WT_DN) + (size_t)(l * 16 + e) * 1024 * 256; }
    __device__ float* mod(int l) const { return (float*)(b + OFF_MOD) + (size_t)l * 9 * 6144; }
    __device__ float* modp() const { return (float*)(b + OFF_ZR); }
    __device__ float2* lampow(int l, int d, int g) const { return (float2*)(b + OFF_LAMPOW) + (size_t)((l * 2 + d) * NG + g) * PS * NPOW; }
    __device__ float2* bbar(int l, int d, int g) const { return (float2*)(b + OFF_BBAR) + (size_t)((l * 2 + d) * NG + g) * PS * 16; }
    __device__ float* kfull(int l, int g) const { return (float*)(b + OFF_KFULL) + (size_t)(l * NG + g) * 32 * 256; }
    __device__ bf16_t* m1(int l, int g) const { return (bf16_t*)(b + OFF_M1) + (size_t)(l * NG + g) * 256 * 256; }
    __device__ bf16_t* w2(int l, int g) const { return (bf16_t*)(b + OFF_W2) + (size_t)(l * NG + g) * 256 * 512; }
    __device__ bf16_t* hb() const { return (bf16_t*)(b + OFF_HB); }
    __device__ bf16_t* ug() const { return (bf16_t*)(b + OFF_UG); }
    __device__ bf16_t* zr() const { return (bf16_t*)(b + OFF_ZR); }
    __device__ bf16_t* hprev() const { return (bf16_t*)(b + OFF_ZR); }
    __device__ float* S() const { return (float*)(b + OFF_S); }
    __device__ bf16_t* Y() const { return (bf16_t*)(b + OFF_S); }
    __device__ bf16_t* act() const { return (bf16_t*)(b + OFF_S); }
    __device__ float* rctx() const { return (float*)(b + OFF_RCTX); }
    __device__ int* cnt(int l) const { return (int*)(b + OFF_CNT) + l * 32; }
    __device__ int* list() const { return (int*)(b + OFF_LIST); }
    __device__ float2* lw() const { return (float2*)(b + OFF_LW); }
};
__device__ __forceinline__ float* Rrow(const Params& p, int row) {
    return row < NLAT ? p.out + (size_t)row * D : (float*)(p.ws + OFF_RCTX) + (size_t)(row - NLAT) * D;
}

__device__ __forceinline__ void transpose_tile(unsigned char* lds, const float* src, int ldsrc, int k0, int n0, bf16_t* dst, int lddst, int rowmode) {
    float* tile = (float*)lds;
    const int tid = threadIdx.x;
    __syncthreads();
#pragma unroll
    for (int pass = 0; pass < 4; ++pass) {
        const int k = pass * 16 + (tid >> 4), n4 = (tid & 15) * 4;
        const float4 v = *(const float4*)(src + (size_t)(k0 + k) * ldsrc + n0 + n4);
        tile[k * 65 + n4 + 0] = v.x; tile[k * 65 + n4 + 1] = v.y; tile[k * 65 + n4 + 2] = v.z; tile[k * 65 + n4 + 3] = v.w;
    }
    __syncthreads();
#pragma unroll
    for (int t2 = 0; t2 < 2; ++t2) {
        const int task = tid + t2 * 256, n = task & 63, kc = task >> 6;
        float f[8];
#pragma unroll
        for (int i = 0; i < 8; ++i) f[i] = tile[(kc * 8 + i) * 65 + n];
        const int ng = n0 + n;
        int drow = ng;
        if (rowmode == 1) drow = ((ng >> 3) << 4) + (ng & 7);
        else if (rowmode == 2) drow = ((ng >> 3) << 4) + 8 + (ng & 7);
        uint4 o; o.x = pack2(f[0], f[1]); o.y = pack2(f[2], f[3]); o.z = pack2(f[4], f[5]); o.w = pack2(f[6], f[7]);
        *(uint4*)(dst + (size_t)drow * lddst + k0 + kc * 8) = o;
    }
}

__device__ __forceinline__ void phase_pro_a(const Params& p, unsigned char* lds) {
    const WS w{p.ws};
    const int tid = threadIdx.x;
    if (blockIdx.x == 0 && tid < 64) ((int*)(p.ws + OFF_CNT))[tid] = 0;
    constexpr int N_MOD = 2 * 6 * KSPLIT_MOD, N_TAB = 32, N_WT = 2 * 3840;
    for (int rep = 0; rep < REP_PRO; ++rep)
    for (int it = blockIdx.x; it < N_MOD + N_TAB + N_WT; it += gridDim.x) {
        if (it < N_MOD) {
            const int l = it / (6 * KSPLIT_MOD), rem = it % (6 * KSPLIT_MOD), cb = rem / KSPLIT_MOD, ks = rem % KSPLIT_MOD;
            float* sc = (float*)lds;
            __syncthreads();
            for (int i = tid; i < 9 * 64; i += 256) {
                const int r = i >> 6, kk = i & 63, k = ks * 64 + kk;
                const float cv = r < 8 ? p.in[1][r * D + k] : p.in[3][k];
                sc[i] = siluf_(cv);
            }
            __syncthreads();
            float acc[9][4];
#pragma unroll
            for (int r = 0; r < 9; ++r) { acc[r][0] = acc[r][1] = acc[r][2] = acc[r][3] = 0.f; }
            const float* wm = p.in[4] + ((size_t)l * D + ks * 64) * 6144 + cb * 1024 + tid * 4;
#pragma unroll 8
            for (int kk = 0; kk < 64; ++kk) {
                const float4 v = *(const float4*)(wm + (size_t)kk * 6144);
#pragma unroll
                for (int r = 0; r < 9; ++r) { const float s = sc[r * 64 + kk]; acc[r][0] += s * v.x; acc[r][1] += s * v.y; acc[r][2] += s * v.z; acc[r][3] += s * v.w; }
            }
            float* mp = w.modp() + ((size_t)(ks * 2 + l) * 9) * 6144 + cb * 1024 + tid * 4;
#pragma unroll
            for (int r = 0; r < 9; ++r) *(float4*)(mp + (size_t)r * 6144) = make_float4(acc[r][0], acc[r][1], acc[r][2], acc[r][3]);
        } else if (it < N_MOD + N_TAB) {
            const int id = (it - N_MOD) * 256 + tid;
            const int pp = id & 63, g = (id >> 6) & 31, d = (id >> 11) & 1, l = id >> 12;
            const int i3 = (l * 2 + d) * NG + g;
            const double dt = exp((double)p.in[9][i3]);
            const double are = (double)p.in[7][i3 * PS + pp], aim = (double)p.in[8][i3 * PS + pp];
            float2* lp = w.lampow(l, d, g) + pp * NPOW;
            double lbr = 0, lbi = 0;
            for (int k = 0; k < NPOW; ++k) {
                const double kk = (k == 17) ? (double)(TCH * SEGLEN) : (double)k;
                const double mag = exp(kk * are * dt);
                double s, c; sincos(kk * aim * dt, &s, &c);
                lp[k] = make_float2((float)(mag * c), (float)(mag * s));
                if (k == 1) { lbr = mag * c; lbi = mag * s; }
            }
            const double nr = lbr - 1.0, ni = lbi, den = are * are + aim * aim;
            const double cr = (nr * are + ni * aim) / den, ci = (ni * are - nr * aim) / den;
            float2* bb = w.bbar(l, d, g) + pp * 16;
            for (int n = 0; n < 16; ++n) {
                const double br = (double)p.in[10][(size_t)(i3 * PS + pp) * 16 + n], bi = (double)p.in[11][(size_t)(i3 * PS + pp) * 16 + n];
                bb[n] = make_float2((float)(cr * br - ci * bi), (float)(cr * bi + ci * br));
            }
        } else {
            int t = it - N_MOD - N_TAB;
            const int l = t / 3840; t %= 3840;
            if (t < 448) { const int kt = t / 28, nt = t % 28; transpose_tile(lds, p.in[6] + (size_t)l * D * DIN, DIN, kt * 64, nt * 64, w.wt_in(l), D, 0); }
            else if (t < 512) { t -= 448; const int kt = t / 8, nt = t % 8; transpose_tile(lds, p.in[15] + (size_t)l * 512 * 512, 512, kt * 64, nt * 64, w.wt_glu(l), 512, 0); }
            else if (t < 768) { t -= 512; const int kt = t / 16, nt = t % 16; transpose_tile(lds, p.in[22] + (size_t)l * D * D, D, kt * 64, nt * 64, w.wt_o(l), D, 0); }
            else if (t < 1792) { t -= 768; const int e = t / 64, r = t % 64, kt = r / 4, nt = r % 4; transpose_tile(lds, p.in[29] + (size_t)(l * 16 + e) * D * 256, 256, kt * 64, nt * 64, w.wt_gu(l, e), D, 1); }
            else if (t < 2816) { t -= 1792; const int e = t / 64, r = t % 64, kt = r / 4, nt = r % 4; transpose_tile(lds, p.in[30] + (size_t)(l * 16 + e) * D * 256, 256, kt * 64, nt * 64, w.wt_gu(l, e), D, 2); }
            else { t -= 2816; const int e = t / 64, r = t % 64, kt = r / 16, nt = r % 16; transpose_tile(lds, p.in[31] + (size_t)(l * 16 + e) * 256 * D, D, kt * 64, nt * 64, w.wt_dn(l, e), 256, 0); }
        }
    }
}

__device__ __forceinline__ void phase_pro_b(const Params& p, unsigned char* lds) {
    const WS w{p.ws};
    const int tid = threadIdx.x;
    const int gt = blockIdx.x * 256 + tid, gs = gridDim.x * 256;
    for (int it = blockIdx.x; it < 2 * NG * 2; it += gridDim.x) {
        const int d = it & 1, g = (it >> 1) & 31, l = it >> 6;
        float2* Lp = (float2*)lds;
        float2* Bb = Lp + 64 * 16;
        float2* Cc = Bb + 64 * 16;
        __syncthreads();
        const float2* lp = w.lampow(l, d, g); const float2* bb = w.bbar(l, d, g);
        const float* cre = p.in[12] + (size_t)((l * 2 + d) * NG + g) * 16 * PS; const float* cim = p.in[13] + (size_t)((l * 2 + d) * NG + g) * 16 * PS;
        for (int i = tid; i < 1024; i += 256) {
            Lp[i] = lp[(i >> 4) * NPOW + (i & 15)];
            Bb[i] = bb[i];
            Cc[i] = make_float2(cre[i], cim[i]);
        }
        __syncthreads();
        const int no = tid >> 4, ni = tid & 15;
        float acc[16];
#pragma unroll
        for (int t = 0; t < 16; ++t) acc[t] = 0.f;
        for (int pp = 0; pp < PS; ++pp) {
            const float2 c = Cc[no * 64 + pp], b = Bb[pp * 16 + ni];
            const float cr = c.x * b.x - c.y * b.y, ci = c.x * b.y + c.y * b.x;
#pragma unroll
            for (int t = 0; t < 16; ++t) { const float2 L = Lp[pp * 16 + t]; acc[t] += cr * L.x - ci * L.y; }
        }
        if (d == 0) acc[0] += (no == ni) ? p.in[14][l * DS5 + g * 16 + no] : 0.f;
        float* kf = w.kfull(l, g);
#pragma unroll
        for (int t = 0; t < 16; ++t) {
            const int ti = d == 0 ? 15 + t : (t == 0 ? 31 : 15 - t);
            kf[(ti * 16 + no) * 16 + ni] = acc[t];
        }
    }
    for (int i = gt; i < 2 * 9 * 6144; i += gs) {
        const int l = i / (9 * 6144), n = i % 6144;
        float s = p.in[5][l * 6144 + n];
        const float* mp = w.modp() + i;
#pragma unroll
        for (int ks = 0; ks < KSPLIT_MOD; ++ks) s += mp[(size_t)ks * 2 * 9 * 6144];
        ((float*)(p.ws + OFF_MOD))[i] = s;
    }
    for (int i = gt; i < 2 * NG * 256 * 32; i += gs) {
        const int c8 = i & 31, row = (i >> 5) & 255, lg = i >> 13, g = lg & 31, l = lg >> 5;
        const int d = row >> 7, pp = (row & 127) >> 1, c = row & 1, j = c8 >> 1, n0 = (c8 & 1) * 8;
        const int e = d == 0 ? (TCH - 1 - j) : j;
        const float2 L = w.lampow(l, d, g)[pp * NPOW + e];
        const float2* bb = w.bbar(l, d, g) + pp * 16 + n0;
        float f[8];
#pragma unroll
        for (int n = 0; n < 8; ++n) { const float2 Bv = bb[n]; f[n] = c == 0 ? (L.x * Bv.x - L.y * Bv.y) : (L.x * Bv.y + L.y * Bv.x); }
        uint4 o; o.x = pack2(f[0], f[1]); o.y = pack2(f[2], f[3]); o.z = pack2(f[4], f[5]); o.w = pack2(f[6], f[7]);
        *(uint4*)(w.m1(l, g) + (size_t)row * 256 + c8 * 8) = o;
    }
    for (int i = gt; i < 2 * NG * 256 * 32; i += gs) {
        const int c8 = i & 31, r = (i >> 5) & 255, lg = i >> 13, g = lg & 31, l = lg >> 5;
        const int jo = r >> 4, no = r & 15;
        const int kk = c8 * 8, d = kk >> 7, p0 = (kk & 127) >> 1;
        const int e = d == 0 ? (jo + 1) : (TCH - jo);
        const float* cre = p.in[12] + ((size_t)((l * 2 + d) * NG + g) * 16 + no) * PS;
        const float* cim = p.in[13] + ((size_t)((l * 2 + d) * NG + g) * 16 + no) * PS;
        const float2* lp = w.lampow(l, d, g);
        float f[8];
#pragma unroll
        for (int q = 0; q < 4; ++q) {
            const int pp = p0 + q;
            const float2 L = lp[pp * NPOW + e];
            const float cr = cre[pp], ci = cim[pp];
            f[2 * q] = cr * L.x - ci * L.y;
            f[2 * q + 1] = -(cr * L.y + ci * L.x);
        }
        uint4 o; o.x = pack2(f[0], f[1]); o.y = pack2(f[2], f[3]); o.z = pack2(f[4], f[5]); o.w = pack2(f[6], f[7]);
        *(uint4*)(w.w2(l, g) + (size_t)r * 512 + 256 + c8 * 8) = o;
    }
    {
        float* shsc = (float*)lds;
        for (int it = blockIdx.x; it < NROW / 32; it += gridDim.x) {
            const int row0 = it * 32, m = modrow(row0);
            __syncthreads();
            for (int i = tid; i < 2048; i += 256) {
                float sacc = p.in[5][i];
                const float* mp = w.modp() + (size_t)m * 6144 + i;
#pragma unroll
                for (int ks = 0; ks < KSPLIT_MOD; ++ks) sacc += mp[(size_t)ks * 2 * 9 * 6144];
                shsc[i] = sacc;
            }
            __syncthreads();
            for (int i = tid; i < 32 * 128; i += 256) {
                const int row = row0 + (i >> 7), c8 = (i & 127) * 8;
                const float* xs = row < NLAT ? p.in[0] + (size_t)row * D : p.in[2] + (size_t)(row - NLAT) * D;
                const float4 a = *(const float4*)(xs + c8), b = *(const float4*)(xs + c8 + 4);
                const float4 s0 = *(const float4*)(shsc + c8), s1 = *(const float4*)(shsc + c8 + 4), c0 = *(const float4*)(shsc + 1024 + c8), c1 = *(const float4*)(shsc + 1024 + c8 + 4);
                uint4 o;
                o.x = pack2(a.x * (1.f + c0.x) + s0.x, a.y * (1.f + c0.y) + s0.y);
                o.y = pack2(a.z * (1.f + c0.z) + s0.z, a.w * (1.f + c0.w) + s0.w);
                o.z = pack2(b.x * (1.f + c1.x) + s1.x, b.y * (1.f + c1.y) + s1.y);
                o.w = pack2(b.z * (1.f + c1.z) + s1.z, b.w * (1.f + c1.w) + s1.w);
                *(uint4*)(w.hb() + (size_t)row * D + c8) = o;
            }
        }
    }
}

__device__ __forceinline__ void w2_toeplitz_fill(const Params& p) {
    const WS w{p.ws};
    const int gt = blockIdx.x * 256 + threadIdx.x, gs = gridDim.x * 256;
    for (int i = gt; i < 2 * NG * 256 * 32; i += gs) {
        const int c8 = i & 31, r = (i >> 5) & 255, lg = i >> 13, g = lg & 31, l = lg >> 5;
        const int jo = r >> 4, no = r & 15, ji = c8 >> 1, n0 = (c8 & 1) * 8;
        const float* kf = w.kfull(l, g) + ((size_t)(jo - ji + 15) * 16 + no) * 16 + n0;
        float f[8];
#pragma unroll
        for (int n = 0; n < 8; ++n) f[n] = kf[n];
        if (jo == ji) {
            const float* k2 = w.kfull(l, g) + ((size_t)31 * 16 + no) * 16 + n0;
#pragma unroll
            for (int n = 0; n < 8; ++n) f[n] += k2[n];
        }
        uint4 o; o.x = pack2(f[0], f[1]); o.y = pack2(f[2], f[3]); o.z = pack2(f[4], f[5]); o.w = pack2(f[6], f[7]);
        *(uint4*)(w.w2(l, g) + (size_t)r * 512 + c8 * 8) = o;
    }
}

struct EpiInproj {
    bf16_t* ug; bf16_t* zr; int m0, n0;
    __device__ __forceinline__ void operator()(const f32x16 (&acc)[2][2], int r0, int c0) const {
        ACC_FOREACH(acc, r0, c0, {
            const int row = m0 + rl, col = n0 + cl;
            uint2 o; o.x = pack2(v0, v1); o.y = pack2(v2, v3);
            if (col < DS5) *(uint2*)(ug + ((size_t)(col >> 4) * NROW + row) * 16 + (col & 15)) = o;
            else *(uint2*)(zr + (size_t)row * 1280 + (col - DS5)) = o;
        })
    }
};
__device__ __forceinline__ void phase_inproj(const Params& p, unsigned char* lds, int l) {
    const WS w{p.ws};
    const int nfull = (l == 0 ? 144 : 128) * 14, ntile = nfull + (l == 0 ? 0 : 16 * 4);
    for (int rep = 0; rep < REP_INPROJ; ++rep)
    for (int t = blockIdx.x; t < ntile; t += gridDim.x) {
        int mt, nt;
        if (t < nfull) { mt = t / 14; nt = t % 14; } else { mt = 128 + (t - nfull) / 4; nt = (t - nfull) % 4; }
        Src4 A, B;
        src_plain(A, w.hb(), mt * 128, D);
        src_plain(B, w.wt_in(l), nt * 128, D);
        EpiInproj e{w.ug(), w.zr(), mt * 128, nt * 128};
        gemm128(lds, A, B, D, e);
    }
}

struct EpiS1 {
    float* S; int m0, n0;
    __device__ __forceinline__ void operator()(const f32x16 (&acc)[2][2], int r0, int c0) const {
        ACC_FOREACH(acc, r0, c0, {
            *(float4*)(S + (size_t)(m0 + rl) * 256 + n0 + cl) = make_float4(v0, v1, v2, v3);
        })
    }
};

__device__ __forceinline__ void conv_sc(const Params& p, int l, int nrows) {
    const WS w{p.ws};
    const float* wsc = p.in[17] + (size_t)l * 3 * 256;
    const int gt = blockIdx.x * 256 + threadIdx.x, gs = gridDim.x * 256;
    for (int i = gt; i < nrows * 32; i += gs) {
        const int row = i >> 5, c8 = (i & 31) * 8;
        int pos, len;
        if (row < NLAT) { pos = row & 63; len = 64; } else { pos = (row - NLAT) & 255; len = 256; }
        const bf16_t* zr = w.zr() + (size_t)row * 1280;
        float accv[8];
#pragma unroll
        for (int e = 0; e < 8; ++e) accv[e] = 0.f;
#pragma unroll
        for (int j = -1; j <= 1; ++j) {
            if (pos + j < 0 || pos + j >= len) continue;
            const uint4 cg = *(const uint4*)(zr + (ptrdiff_t)j * 1280 + 256 + c8);
            const uint4 vv = *(const uint4*)(zr + (ptrdiff_t)j * 1280 + 512 + c8);
            const float4 wa = *(const float4*)(wsc + (j + 1) * 256 + c8), wb = *(const float4*)(wsc + (j + 1) * 256 + c8 + 4);
            accv[0] += wa.x * bflo(cg.x) * bflo(vv.x); accv[1] += wa.y * bfhi(cg.x) * bfhi(vv.x);
            accv[2] += wa.z * bflo(cg.y) * bflo(vv.y); accv[3] += wa.w * bfhi(cg.y) * bfhi(vv.y);
            accv[4] += wb.x * bflo(cg.z) * bflo(vv.z); accv[5] += wb.y * bfhi(cg.z) * bfhi(vv.z);
            accv[6] += wb.z * bflo(cg.w) * bflo(vv.w); accv[7] += wb.w * bfhi(cg.w) * bfhi(vv.w);
        }
        const uint4 bg = *(const uint4*)(zr + c8);
        uint4 o;
        o.x = pack2(accv[0] * bflo(bg.x), accv[1] * bfhi(bg.x));
        o.y = pack2(accv[2] * bflo(bg.y), accv[3] * bfhi(bg.y));
        o.z = pack2(accv[4] * bflo(bg.z), accv[5] * bfhi(bg.z));
        o.w = pack2(accv[6] * bflo(bg.w), accv[7] * bfhi(bg.w));
        *(uint4*)(w.hb() + (size_t)row * D + 512 + c8) = o;
    }
}

__device__ __forceinline__ void conv_cf(const Params& p, unsigned char* lds, int l, bool with_ctx) {
    const WS w{p.ws};
    float* P = (float*)lds;
    const int tid = threadIdx.x, lane = tid & 63, wid = tid >> 6;
    const float* wdw = p.in[18] + (size_t)l * 31 * 256 + lane * 4;
    const float4 bdw = *(const float4*)(p.in[19] + l * 256 + lane * 4);
    const float4 lg = *(const float4*)(p.in[20] + l * 256 + lane * 4);
    const float4 lb = *(const float4*)(p.in[21] + l * 256 + lane * 4);
    const int nitem = 512 + (with_ctx ? 64 : 0);
    for (int it = blockIdx.x; it < nitem; it += gridDim.x) {
        const bool lat = it < 512;
        int base, nslot, s0 = 0;
        if (lat) { base = (it >> 6) * SEQ + (it & 63); nslot = 32; }
        else { const int j = it - 512; s0 = (j & 7) * 32; base = NLAT + (j >> 3) * CTX; nslot = 62; }
        __syncthreads();
        for (int task = tid; task < nslot * 32; task += 256) {
            const int slot = task >> 5, c8 = (task & 31) * 8;
            int row; bool valid = true;
            if (lat) row = base + slot * 64;
            else { const int sq = s0 - 15 + slot; valid = sq >= 0 && sq < CTX; row = base + sq; }
            float f[8];
            if (valid) {
                const bf16_t* zr = w.zr() + (size_t)row * 1280;
                const uint4 ga = *(const uint4*)(zr + 768 + c8), gb = *(const uint4*)(zr + 1024 + c8);
                f[0] = bflo(ga.x) * sigmoidf_(bflo(gb.x)); f[1] = bfhi(ga.x) * sigmoidf_(bfhi(gb.x));
                f[2] = bflo(ga.y) * sigmoidf_(bflo(gb.y)); f[3] = bfhi(ga.y) * sigmoidf_(bfhi(gb.y));
                f[4] = bflo(ga.z) * sigmoidf_(bflo(gb.z)); f[5] = bfhi(ga.z) * sigmoidf_(bfhi(gb.z));
                f[6] = bflo(ga.w) * sigmoidf_(bflo(gb.w)); f[7] = bfhi(ga.w) * sigmoidf_(bfhi(gb.w));
            } else {
#pragma unroll
                for (int e = 0; e < 8; ++e) f[e] = 0.f;
            }
            *(float4*)(P + slot * 256 + c8) = make_float4(f[0], f[1], f[2], f[3]);
            *(float4*)(P + slot * 256 + c8 + 4) = make_float4(f[4], f[5], f[6], f[7]);
        }
        __syncthreads();
        const int o0 = wid * 8;
        float4 a[8];
#pragma unroll
        for (int o = 0; o < 8; ++o) a[o] = bdw;
        if (lat) {
#pragma unroll 1
            for (int k = 0; k < 31; ++k) {
                const float4 wv = *(const float4*)(wdw + k * 256);
#pragma unroll
                for (int o = 0; o < 8; ++o) {
                    const int rr = o0 + o + k - 15;
                    if (rr >= 0 && rr < 32) {
                        const float4 pv = *(const float4*)(P + rr * 256 + lane * 4);
                        a[o].x += wv.x * pv.x; a[o].y += wv.y * pv.y; a[o].z += wv.z * pv.z; a[o].w += wv.w * pv.w;
                    }
                }
            }
        } else {
#pragma unroll 1
            for (int k = 0; k < 31; ++k) {
                const float4 wv = *(const float4*)(wdw + k * 256);
#pragma unroll
                for (int o = 0; o < 8; ++o) {
                    const float4 pv = *(const float4*)(P + (o0 + o + k) * 256 + lane * 4);
                    a[o].x += wv.x * pv.x; a[o].y += wv.y * pv.y; a[o].z += wv.z * pv.z; a[o].w += wv.w * pv.w;
                }
            }
        }
#pragma unroll
        for (int o = 0; o < 8; ++o) {
            const int row = lat ? base + (o0 + o) * 64 : base + s0 + o0 + o;
            const float mean = wave_sum(a[o].x + a[o].y + a[o].z + a[o].w) * (1.0f / 256.0f);
            const float dx = a[o].x - mean, dy = a[o].y - mean, dz = a[o].z - mean, dw = a[o].w - mean;
            const float var = wave_sum(dx * dx + dy * dy + dz * dz + dw * dw) * (1.0f / 256.0f);
            const float rs = rsqrtf(var + LN_EPS);
            const float y0 = siluf_(dx * rs * lg.x + lb.x), y1 = siluf_(dy * rs * lg.y + lb.y), y2 = siluf_(dz * rs * lg.z + lb.z), y3 = siluf_(dw * rs * lg.w + lb.w);
            uint2 ov; ov.x = pack2(y0, y1); ov.y = pack2(y2, y3);
            *(uint2*)(w.hb() + (size_t)row * D + 768 + lane * 4) = ov;
        }
    }
}

__device__ __forceinline__ void phase_s1(const Params& p, unsigned char* lds, int l) {
    const WS w{p.ws};
    const int ntile = NG * 9 * 2;
    for (int rep = 0; rep < REP_S1; ++rep)
    for (int t = blockIdx.x; t < ntile; t += gridDim.x) {
        const int g = t / 18, r = t % 18, mt = r >> 1, nt = r & 1;
        Src4 A, B;
        src_plain(A, w.ug() + (size_t)g * NROW * 16, mt * 128, 256);
        src_plain(B, w.m1(l, g), nt * 128, 256);
        EpiS1 e{w.S() + (size_t)g * NCOL * 256, mt * 128, nt * 128};
        gemm128(lds, A, B, 256, e);
    }
    for (int rep = 0; rep < REP_CONV; ++rep) {
    conv_sc(p, l, l == 0 ? NROW : NLAT);
    conv_cf(p, lds, l, l == 0);
    }
}

__device__ __forceinline__ int chunk_col(int d, int b, int step) {
    if (step < CH_CTX) { const int c = d == 0 ? step : (CH_CTX - 1 - step); return NCOL_LAT + b * CH_CTX + c; }
    const int s = step - CH_CTX; const int c = d == 0 ? s : (CH_LAT - 1 - s); return b * CH_LAT + c;
}
__device__ __forceinline__ void phase_s2(const Params& p, unsigned char* lds, int l) {
    const WS w{p.ws};
    float2* Fs = (float2*)lds;
    const int tid = threadIdx.x, seg = tid >> 5, pl = tid & 31;
    for (int rep = 0; rep < REP_S2; ++rep)
    for (int it = blockIdx.x; it < NG * 2 * NB * 2; it += gridDim.x) {
        const int ph = it & 1, b = (it >> 1) & 7, d = (it >> 4) & 1, g = it >> 5;
        const int pp = ph * 32 + pl;
        const float2 A = w.lampow(l, d, g)[pp * NPOW + 16], A18 = w.lampow(l, d, g)[pp * NPOW + 17];
        const float* S = w.S() + (size_t)g * NCOL * 256 + d * 128 + 2 * pp;
        bf16_t* Hp = w.hprev() + (size_t)g * NCOL * 256 + d * 128 + 2 * pp;
        float2 s[SEGLEN];
#pragma unroll
        for (int i = 0; i < SEGLEN; ++i) s[i] = *(const float2*)(S + (size_t)chunk_col(d, b, seg * SEGLEN + i) * 256);
        float2 F = make_float2(0.f, 0.f);
#pragma unroll
        for (int i = 0; i < SEGLEN; ++i) { const float fr = A.x * F.x - A.y * F.y + s[i].x, fi = A.x * F.y + A.y * F.x + s[i].y; F.x = fr; F.y = fi; }
        __syncthreads();
        Fs[seg * 32 + pl] = F;
        __syncthreads();
        float2 H = make_float2(0.f, 0.f);
        for (int q = 0; q < seg; ++q) { const float2 f = Fs[q * 32 + pl]; const float hr = A18.x * H.x - A18.y * H.y + f.x, hi = A18.x * H.y + A18.y * H.x + f.y; H.x = hr; H.y = hi; }
#pragma unroll
        for (int i = 0; i < SEGLEN; ++i) {
            *(unsigned*)(Hp + (size_t)chunk_col(d, b, seg * SEGLEN + i) * 256) = pack2(H.x, H.y);
            const float hr = A.x * H.x - A.y * H.y + s[i].x, hi = A.x * H.y + A.y * H.x + s[i].y; H.x = hr; H.y = hi;
        }
    }
}

struct EpiS3 {
    bf16_t* Y; int m0, n0, g;
    __device__ __forceinline__ void operator()(const f32x16 (&acc)[2][2], int r0, int c0) const {
        ACC_FOREACH(acc, r0, c0, {
            const int col = n0 + cl, tok = (m0 + rl) * TCH + (col >> 4);
            uint2 o; o.x = pack2(gelu_tanh(v0), gelu_tanh(v1)); o.y = pack2(gelu_tanh(v2), gelu_tanh(v3));
            *(uint2*)(Y + (size_t)tok * DS5 + g * 16 + (col & 15)) = o;
        })
    }
};
__device__ __forceinline__ void phase_s3(const Params& p, unsigned char* lds, int l) {
    const WS w{p.ws};
    const int nmt = l == 0 ? 9 : 8, ntile = NG * nmt * 2;
    for (int rep = 0; rep < REP_S3; ++rep)
    for (int t = blockIdx.x; t < ntile; t += gridDim.x) {
        const int g = t / (nmt * 2), r = t % (nmt * 2), mt = r >> 1, nt = r & 1;
        Src4 A, B;
        src_split(A, w.ug() + (size_t)g * NROW * 16, 256, w.hprev() + (size_t)g * NCOL * 256, 256, mt * 128, 256);
        src_plain(B, w.w2(l, g), nt * 128, 512);
        EpiS3 e{w.Y(), mt * 128, nt * 128, g};
        gemm128(lds, A, B, 512, e);
    }
}

struct EpiGlu {
    const bf16_t* Y; bf16_t* hb; const float* bg; int m0, n0;
    __device__ __forceinline__ void operator()(const f32x16 (&acc)[2][2], int r0, int c0) const {
        ACC_FOREACH(acc, r0, c0, {
            const int row = m0 + rl, col = n0 + cl;
            const uint2 t = *(const uint2*)(Y + (size_t)row * DS5 + col);
            const float4 b = *(const float4*)(bg + col);
            uint2 o;
            o.x = pack2(bflo(t.x) * sigmoidf_(v0 + b.x), bfhi(t.x) * sigmoidf_(v1 + b.y));
            o.y = pack2(bflo(t.y) * sigmoidf_(v2 + b.z), bfhi(t.y) * sigmoidf_(v3 + b.w));
            *(uint2*)(hb + (size_t)row * D + col) = o;
        })
    }
};
__device__ __forceinline__ void phase_glu(const Params& p, unsigned char* lds, int l) {
    const WS w{p.ws};
    const int nmt = l == 0 ? 144 : 128, ntile = nmt * 4;
    for (int rep = 0; rep < REP_GLU; ++rep)
    for (int t = blockIdx.x; t < ntile; t += gridDim.x) {
        const int mt = t >> 2, nt = t & 3;
        Src4 A, B;
        src_plain(A, w.Y(), mt * 128, DS5);
        src_plain(B, w.wt_glu(l), nt * 128, 512);
        EpiGlu e{w.Y(), w.hb(), p.in[16] + l * DS5, mt * 128, nt * 128};
        gemm128(lds, A, B, 512, e);
    }
}

struct EpiOut {
    const Params* p; const float* mod; int l, m0, n0;
    __device__ __forceinline__ void operator()(const f32x16 (&acc)[2][2], int r0, int c0) const {
        ACC_FOREACH(acc, r0, c0, {
            const int row = m0 + rl, col = n0 + cl, m = modrow(row);
            const float4 g1 = *(const float4*)(mod + (size_t)m * 6144 + 2048 + col);
            float* R = Rrow(*p, row) + col;
            const float* res = l == 0 ? (row < NLAT ? p->in[0] + (size_t)row * D + col : p->in[2] + (size_t)(row - NLAT) * D + col) : R;
            const float4 x = *(const float4*)res;
            *(float4*)R = make_float4(DN_ALPHA * x.x + g1.x * v0, DN_ALPHA * x.y + g1.y * v1, DN_ALPHA * x.z + g1.z * v2, DN_ALPHA * x.w + g1.w * v3);
        })
    }
};
__device__ __forceinline__ void phase_outproj(const Params& p, unsigned char* lds, int l) {
    const WS w{p.ws};
    const int nmt = l == 0 ? 144 : 128, ntile = nmt * 8;
    for (int rep = 0; rep < (l == 0 ? REP_OUT0 : 1); ++rep)
    for (int t = blockIdx.x; t < ntile; t += gridDim.x) {
        const int mt = t >> 3, nt = t & 7;
        Src4 A, B;
        src_plain(A, w.hb(), mt * 128, D);
        src_plain(B, w.wt_o(l), nt * 128, D);
        EpiOut e{&p, w.mod(l), l, mt * 128, nt * 128};
        gemm128(lds, A, B, D, e);
    }
}

template <bool DRY>
__device__ __forceinline__ void phase_ln1(const Params& p, unsigned char* lds, int l) {
    const WS w{p.ws};
    const int tid = threadIdx.x, lane = tid & 63, wid = tid >> 6;
    float* wl = (float*)lds;
    __syncthreads();
#pragma unroll
    for (int kk = 0; kk < 4; ++kk) {
        const int k = tid + 256 * kk;
        const int s = ((k >> 8) * 4 + (k & 3)) * 64 + ((k >> 2) & 63);
        const float4 g = *(const float4*)(p.in[25] + ((size_t)l * D + k) * 4);
        const float4* ex = (const float4*)(p.in[27] + ((size_t)l * D + k) * 16);
        const float4 e0 = ex[0], e1 = ex[1], e2 = ex[2], e3 = ex[3];
        *(float4*)(wl + (0 * 1024 + s) * 4) = g;
        *(float4*)(wl + (1 * 1024 + s) * 4) = e0;
        *(float4*)(wl + (2 * 1024 + s) * 4) = e1;
        *(float4*)(wl + (3 * 1024 + s) * 4) = e2;
        *(float4*)(wl + (4 * 1024 + s) * 4) = e3;
    }
    __syncthreads();
    const int nrows = l == 0 ? NROW : NLAT;
    const float* md = w.mod(l);
    const float* lng = p.in[23] + l * D; const float* lnb = p.in[24] + l * D;
    const float brg0 = p.in[26][l * 4 + 0], brg1 = p.in[26][l * 4 + 1], brg2 = p.in[26][l * 4 + 2], brg3 = p.in[26][l * 4 + 3];
    int k_cls = 0, k_row = 0, nkeep = 0; float k_wlo = 0.f, k_whi = 0.f;
    const int rstep = gridDim.x * 4;
    int row = blockIdx.x * 4 + wid;
    float4 vn[4];
    if (row < nrows) {
        const float* R0 = Rrow(p, row);
#pragma unroll
        for (int i = 0; i < 4; ++i) vn[i] = *(const float4*)(R0 + i * 256 + lane * 4);
    }
    for (; row < nrows; row += rstep) {
        float* R = Rrow(p, row);
        const int m = modrow(row);
        float h[16];
        float4 v[4];
#pragma unroll
        for (int i = 0; i < 4; ++i) v[i] = vn[i];
        if (row + rstep < nrows) {
            const float* Rn = Rrow(p, row + rstep);
#pragma unroll
            for (int i = 0; i < 4; ++i) vn[i] = *(const float4*)(Rn + i * 256 + lane * 4);
        }
        float s = 0.f;
#pragma unroll
        for (int i = 0; i < 4; ++i) s += (v[i].x + v[i].y) + (v[i].z + v[i].w);
        const float mean = wave_sum(s) * (1.0f / 1024.0f);
        float q = 0.f;
#pragma unroll
        for (int i = 0; i < 4; ++i) { const float a = v[i].x - mean, b = v[i].y - mean, c = v[i].z - mean, d = v[i].w - mean; q += (a * a + b * b) + (c * c + d * d); }
        const float rs = rsqrtf(wave_sum(q) * (1.0f / 1024.0f) + LN_EPS);
#pragma unroll
        for (int i = 0; i < 4; ++i) {
            const int col = i * 256 + lane * 4;
            const float4 g = *(const float4*)(lng + col), b = *(const float4*)(lnb + col);
            const float4 sh = *(const float4*)(md + (size_t)m * 6144 + 3072 + col), sc = *(const float4*)(md + (size_t)m * 6144 + 4096 + col);
            float4 x;
            x.x = (v[i].x - mean) * rs * g.x + b.x; x.y = (v[i].y - mean) * rs * g.y + b.y; x.z = (v[i].z - mean) * rs * g.z + b.z; x.w = (v[i].w - mean) * rs * g.w + b.w;
            if (!DRY) *(float4*)(R + col) = x; else { KEEP(x.x); KEEP(x.y); KEEP(x.z); KEEP(x.w); }
            h[i * 4 + 0] = x.x * (1.f + sc.x) + sh.x; h[i * 4 + 1] = x.y * (1.f + sc.y) + sh.y; h[i * 4 + 2] = x.z * (1.f + sc.z) + sh.z; h[i * 4 + 3] = x.w * (1.f + sc.w) + sh.w;
            uint2 o; o.x = pack2(h[i * 4 + 0], h[i * 4 + 1]); o.y = pack2(h[i * 4 + 2], h[i * 4 + 3]);
            if (!DRY) *(uint2*)(w.hb() + (size_t)row * D + col) = o; else { KEEP(o.x); KEEP(o.y); }
        }
        float mylg = 0.f;
#pragma unroll 1
        for (int o4 = 0; o4 < 5; ++o4) {
            float a0 = 0.f, a1 = 0.f, a2 = 0.f, a3 = 0.f;
#pragma unroll
            for (int e = 0; e < 16; ++e) {
                const float4 wv = *(const float4*)(wl + ((o4 * 1024) + e * 64 + lane) * 4);
                a0 += h[e] * wv.x; a1 += h[e] * wv.y; a2 += h[e] * wv.z; a3 += h[e] * wv.w;
            }
            const bool up5 = (lane & 32) != 0, up4 = (lane & 16) != 0;
            const float s0 = up5 ? a0 : a2, s1 = up5 ? a1 : a3;
            const float r0 = __shfl_xor(s0, 32), r1 = __shfl_xor(s1, 32);
            const float b0 = (up5 ? a2 : a0) + r0, b1 = (up5 ? a3 : a1) + r1;
            const float t0 = up4 ? b0 : b1;
            const float r2 = __shfl_xor(t0, 16);
            float c = (up4 ? b1 : b0) + r2;
            c += __shfl_xor(c, 8); c += __shfl_xor(c, 4); c += __shfl_xor(c, 2); c += __shfl_xor(c, 1);
            if ((lane & 15) == o4) mylg = c;
        }
        float lg[20];
#pragma unroll
        for (int i = 0; i < 20; ++i) lg[i] = __shfl(mylg, 16 * (i & 3) + (i >> 2));
        {
            float gl[4];
            gl[0] = lg[0] + brg0; gl[1] = lg[1] + brg1; gl[2] = lg[2] + brg2; gl[3] = lg[3] + brg3;
            int gi = 0; float gm = gl[0];
#pragma unroll
            for (int i = 1; i < 4; ++i) if (gl[i] > gm) { gm = gl[i]; gi = i; }
            float den = 0.f;
#pragma unroll
            for (int i = 0; i < 4; ++i) den += __expf(gl[i] - gm);
            const float gw = 1.0f / den;
            float el[4];
#pragma unroll
            for (int i = 0; i < 4; ++i) {
                float t = lg[4 + i];
                if (gi == 1) t = lg[8 + i]; else if (gi == 2) t = lg[12 + i]; else if (gi == 3) t = lg[16 + i];
                el[i] = t + p.in[28][l * 16 + gi * 4 + i];
            }
            int i1 = 0; float m1 = el[0];
#pragma unroll
            for (int i = 1; i < 4; ++i) if (el[i] > m1) { m1 = el[i]; i1 = i; }
            int i2 = -1; float m2 = -3.0e38f;
#pragma unroll
            for (int i = 0; i < 4; ++i) if (i != i1 && el[i] > m2) { m2 = el[i]; i2 = i; }
            const float e2 = __expf(m2 - m1);
            const float w1 = gw / (1.0f + e2), w2 = gw * e2 / (1.0f + e2);
            const int lo = i1 < i2 ? i1 : i2, hi = i1 < i2 ? i2 : i1;
            const float wlo = i1 < i2 ? w1 : w2, whi = i1 < i2 ? w2 : w1;
            const int pair = lo == 0 ? (hi - 1) : (lo == 1 ? (hi + 1) : 5);
            const int cls = gi * 6 + pair;
            if (lane == nkeep) { k_cls = cls; k_row = row; k_wlo = wlo; k_whi = whi; }
            ++nkeep;
        }
        if (nkeep == 64) {
            if (!DRY) { const int pos = atomicAdd(w.cnt(l) + k_cls, 1); w.list()[(size_t)k_cls * LISTCAP + pos] = k_row; w.lw()[(size_t)k_cls * LISTCAP + pos] = make_float2(k_wlo, k_whi); }
            nkeep = 0;
        }
    }
    if (lane < nkeep) {
        if (!DRY) {
            const int pos = atomicAdd(w.cnt(l) + k_cls, 1);
            w.list()[(size_t)k_cls * LISTCAP + pos] = k_row;
            w.lw()[(size_t)k_cls * LISTCAP + pos] = make_float2(k_wlo, k_whi);
        } else { KEEP(k_cls); KEEP(k_wlo); KEEP(k_whi); }
    }
}

__device__ __forceinline__ void cls_experts(int cls, int& elo, int& ehi) {
    const int g = cls / 6, pr = cls % 6;
    const int lo = pr < 3 ? 0 : (pr < 5 ? 1 : 2);
    const int hi = pr < 3 ? pr + 1 : (pr < 5 ? pr - 1 : 3);
    elo = g * 4 + lo; ehi = g * 4 + hi;
}

struct EpiGU {
    bf16_t* act; const float2* lw; int cnt, pos0, orow0, half, fcol0;
    __device__ __forceinline__ void operator()(const f32x16 (&acc)[2][2], int r0, int c0) const {
        const int hh4 = c0 & 4, wn64 = c0 & 64;
#pragma unroll
        for (int mt = 0; mt < 2; ++mt) {
            const int rl = r0 + mt * 32, pos = pos0 + rl;
            float wt = 0.f;
            if (pos < cnt) { const float2 ww = lw[pos]; wt = half ? ww.y : ww.x; }
#pragma unroll
            for (int nt = 0; nt < 2; ++nt)
#pragma unroll
                for (int qp = 0; qp < 2; ++qp) {
                    const int f = fcol0 + ((wn64 + nt * 32) >> 1) + qp * 8 + hh4;
                    const int qg = qp * 2, qu = qp * 2 + 1;
                    const float a0 = siluf_(acc[mt][nt][qg * 4 + 0]) * acc[mt][nt][qu * 4 + 0] * wt;
                    const float a1 = siluf_(acc[mt][nt][qg * 4 + 1]) * acc[mt][nt][qu * 4 + 1] * wt;
                    const float a2 = siluf_(acc[mt][nt][qg * 4 + 2]) * acc[mt][nt][qu * 4 + 2] * wt;
                    const float a3 = siluf_(acc[mt][nt][qg * 4 + 3]) * acc[mt][nt][qu * 4 + 3] * wt;
                    uint2 o; o.x = pack2(a0, a1); o.y = pack2(a2, a3);
                    *(uint2*)(act + (size_t)(orow0 + rl) * 512 + half * 256 + f) = o;
                }
        }
    }
};
__device__ __forceinline__ void phase_moe_gu(const Params& p, unsigned char* lds, int l) {
    const WS w{p.ws};
    int ntl[NCLS]; int tot = 0;
#pragma unroll
    for (int c = 0; c < NCLS; ++c) { ntl[c] = (w.cnt(l)[c] + 127) >> 7; tot += ntl[c]; }
    const int ntile = tot * 8;
    const int lr = threadIdx.x >> 3, lc = (threadIdx.x & 7) ^ ((lr >> 1) & 7);
    for (int rep = 0; rep < REP_GU; ++rep)
    for (int t = blockIdx.x; t < ntile; t += gridDim.x) {
        const int mg = t >> 3, nt = t & 7;
        int cls = 0, mt = 0, run = 0;
#pragma unroll
        for (int c = 0; c < NCLS; ++c) { if (mg >= run && mg < run + ntl[c]) { cls = c; mt = mg - run; } run += ntl[c]; }
        const int cnt = w.cnt(l)[cls];
        int elo, ehi; cls_experts(cls, elo, ehi);
        const int half = nt >> 2, e = half ? ehi : elo;
        const int* lst = w.list() + (size_t)cls * LISTCAP;
        Src4 A, B;
#pragma unroll
        for (int j = 0; j < 4; ++j) {
            int pos = mt * 128 + lr + 32 * j; if (pos >= cnt) pos = 0;
            const int tok = lst[pos];
            A.p0[j] = w.hb() + (size_t)tok * D + lc * 8; A.p1[j] = A.p0[j];
        }
        A.split = 1 << 30;
        src_plain(B, w.wt_gu(l, e), (nt & 3) * 128, D);
        EpiGU ep{w.act(), w.lw() + (size_t)cls * LISTCAP, cnt, mt * 128, mg * 128, half, (nt & 3) * 64};
        gemm128(lds, A, B, D, ep);
    }
}

struct EpiDown {
    const Params* p; const float* mod; const int* lst; int cnt, pos0, n0;
    __device__ __forceinline__ void operator()(const f32x16 (&acc)[2][2], int r0, int c0) const {
#pragma unroll
        for (int mt = 0; mt < 2; ++mt) {
            const int pos = pos0 + r0 + mt * 32;
            if (pos < cnt) {
                const int row = lst[pos], m = modrow(row);
                float* R = Rrow(*p, row);
#pragma unroll
                for (int nt = 0; nt < 2; ++nt)
#pragma unroll
                    for (int q = 0; q < 4; ++q) {
                        const int col = n0 + c0 + nt * 32 + q * 8;
                        const float4 g2 = *(const float4*)(mod + (size_t)m * 6144 + 5120 + col);
                        const float4 x = *(const float4*)(R + col);
                        *(float4*)(R + col) = make_float4(DN_ALPHA * x.x + g2.x * acc[mt][nt][q * 4 + 0], DN_ALPHA * x.y + g2.y * acc[mt][nt][q * 4 + 1],
                                                          DN_ALPHA * x.z + g2.z * acc[mt][nt][q * 4 + 2], DN_ALPHA * x.w + g2.w * acc[mt][nt][q * 4 + 3]);
                    }
            }
        }
    }
};
__device__ __forceinline__ void phase_moe_dn(const Params& p, unsigned char* lds, int l) {
    const WS w{p.ws};
    int ntl[NCLS]; int tot = 0;
#pragma unroll
    for (int c = 0; c < NCLS; ++c) { ntl[c] = (w.cnt(l)[c] + 127) >> 7; tot += ntl[c]; }
    const int ntile = tot * 8;
    for (int t = blockIdx.x; t < ntile; t += gridDim.x) {
        const int mg = t >> 3, nt = t & 7;
        int cls = 0, mt = 0, run = 0;
#pragma unroll
        for (int c = 0; c < NCLS; ++c) { if (mg >= run && mg < run + ntl[c]) { cls = c; mt = mg - run; } run += ntl[c]; }
        const int cnt = w.cnt(l)[cls];
        int elo, ehi; cls_experts(cls, elo, ehi);
        Src4 A, B;
        src_plain(A, w.act(), mg * 128, 512);
        src_split(B, w.wt_dn(l, elo), 256, w.wt_dn(l, ehi), 256, nt * 128, 256);
        EpiDown ep{&p, w.mod(l), w.list() + (size_t)cls * LISTCAP, cnt, mt * 128, nt * 128};
        gemm128(lds, A, B, 512, ep);
    }
}

template <bool DRY>
__device__ __forceinline__ void phase_ln2(const Params& p, int l) {
    const WS w{p.ws};
    const int tid = threadIdx.x, lane = tid & 63, wid = tid >> 6;
    const int nrows = l == 0 ? NROW : NLAT;
    const float* lng = p.in[32] + l * D; const float* lnb = p.in[33] + l * D;
    const float* mdn = w.mod(1);
    for (int row = blockIdx.x * 4 + wid; row < nrows; row += gridDim.x * 4) {
        float* R = Rrow(p, row);
        const int m = modrow(row);
        float4 v[4];
#pragma unroll
        for (int i = 0; i < 4; ++i) v[i] = *(const float4*)(R + i * 256 + lane * 4);
        float s = 0.f;
#pragma unroll
        for (int i = 0; i < 4; ++i) s += (v[i].x + v[i].y) + (v[i].z + v[i].w);
        const float mean = wave_sum(s) * (1.0f / 1024.0f);
        float q = 0.f;
#pragma unroll
        for (int i = 0; i < 4; ++i) { const float a = v[i].x - mean, b = v[i].y - mean, c = v[i].z - mean, d = v[i].w - mean; q += (a * a + b * b) + (c * c + d * d); }
        const float rs = rsqrtf(wave_sum(q) * (1.0f / 1024.0f) + LN_EPS);
#pragma unroll
        for (int i = 0; i < 4; ++i) {
            const int col = i * 256 + lane * 4;
            const float4 g = *(const float4*)(lng + col), b = *(const float4*)(lnb + col);
            float4 x;
            x.x = (v[i].x - mean) * rs * g.x + b.x; x.y = (v[i].y - mean) * rs * g.y + b.y; x.z = (v[i].z - mean) * rs * g.z + b.z; x.w = (v[i].w - mean) * rs * g.w + b.w;
            if (!DRY) *(float4*)(R + col) = x; else { KEEP(x.x); KEEP(x.y); KEEP(x.z); KEEP(x.w); }
            if (l == 0) {
                const float4 sh = *(const float4*)(mdn + (size_t)m * 6144 + col), sc = *(const float4*)(mdn + (size_t)m * 6144 + 1024 + col);
                uint2 o; o.x = pack2(x.x * (1.f + sc.x) + sh.x, x.y * (1.f + sc.y) + sh.y); o.y = pack2(x.z * (1.f + sc.z) + sh.z, x.w * (1.f + sc.w) + sh.w);
                if (!DRY) *(uint2*)(w.hb() + (size_t)row * D + col) = o; else { KEEP(o.x); KEEP(o.y); }
            }
        }
    }
}

#define XB_TMO      128
#define XB_XCNT(j)  (256  + 64 * (j))
#define XB_XSUB(j)  (1280 + 64 * (j))
#define XB_XGEN(j)  (2304 + 64 * (j))
#define XB_TOP      3328
#define XB_TOPGEN   3392
#define XB_SPIN_CAP (1u << 20)
__device__ __forceinline__ unsigned xb_ld(unsigned* p)              { return __hip_atomic_load(p, __ATOMIC_RELAXED, __HIP_MEMORY_SCOPE_AGENT); }
__device__ __forceinline__ unsigned xb_add(unsigned* p, unsigned v) { return __hip_atomic_fetch_add(p, v, __ATOMIC_RELAXED, __HIP_MEMORY_SCOPE_AGENT); }
__device__ __forceinline__ unsigned xb_xcc_id() { return (unsigned)__builtin_amdgcn_s_getreg((3 << 11) | 20) & 0xFu; }
#define XB_SPIN(cond, bar) do { unsigned _sp = 0; while (cond) { __builtin_amdgcn_s_sleep(1); \
    if ((++_sp & 255u) == 0u) { if (xb_ld(&(bar)[XB_TMO])) break; if (_sp > XB_SPIN_CAP) { atomicAdd(&(bar)[XB_TMO], 1u); break; } } } } while (0)
struct XcdBarrier { unsigned* bar; unsigned x, nloc, nx; };
__device__ __forceinline__ void xcd_barrier_post(XcdBarrier& b, unsigned* bar) {
    b.bar = bar; b.x = xb_xcc_id(); b.nloc = 0u; b.nx = 0u;
    if (threadIdx.x == 0) (void)xb_add(&bar[XB_XCNT(b.x)], 1u);
}
__device__ __forceinline__ void xcd_barrier_complete(unsigned* bar, unsigned x, unsigned& nloc, unsigned& nx) {
    const unsigned G = gridDim.x;
    unsigned sum, cnt, mine, sp = 0u;
    for (;;) {
        sum = 0u; cnt = 0u; mine = 0u;
#pragma unroll
        for (unsigned j = 0; j < 16; ++j) { const unsigned c = xb_ld(&bar[XB_XCNT(j)]); sum += c; cnt += (c > 0u) ? 1u : 0u; mine = (j == x) ? c : mine; }
        if (sum == G) break;
        __builtin_amdgcn_s_sleep(1);
        if ((++sp & 255u) == 0u) { if (xb_ld(&bar[XB_TMO])) break; if (sp > XB_SPIN_CAP) { atomicAdd(&bar[XB_TMO], 1u); break; } }
    }
    nloc = mine > 0u ? mine : 1u; nx = cnt > 0u ? cnt : 1u;
}
__device__ __forceinline__ void xcd_barrier(XcdBarrier& b) {
    asm volatile("s_waitcnt vmcnt(0)" ::: "memory");
    __syncthreads();
    if (threadIdx.x == 0) {
        unsigned* bar = b.bar;
        __builtin_amdgcn_s_waitcnt(0);
        if (b.nloc == 0u) xcd_barrier_complete(bar, b.x, b.nloc, b.nx);
        const unsigned nloc = b.nloc, nx = b.nx;
        const unsigned old = xb_add(&bar[XB_XSUB(b.x)], 1u);
        const unsigned gen = old / nloc;
        if (old + 1u == (gen + 1u) * nloc) {
            __builtin_amdgcn_fence(__ATOMIC_RELEASE, "agent");
            asm volatile("s_waitcnt vmcnt(0)" ::: "memory");
            const unsigned og = xb_add(&bar[XB_TOP], 1u);
            const unsigned tg = og / nx;
            if (og + 1u == (tg + 1u) * nx) xb_add(&bar[XB_TOPGEN], 1u);
            else XB_SPIN(xb_ld(&bar[XB_TOPGEN]) == tg, bar);
            __builtin_amdgcn_fence(__ATOMIC_ACQUIRE, "agent");
            xb_add(&bar[XB_XGEN(b.x)], 1u);
            asm volatile("s_waitcnt vmcnt(0)" ::: "memory");
        } else {
            XB_SPIN(xb_ld(&bar[XB_XGEN(b.x)]) == gen, bar);
            __builtin_amdgcn_fence(__ATOMIC_ACQUIRE, "agent");
            asm volatile("s_waitcnt vmcnt(0)" ::: "memory");
        }
    }
    __syncthreads();
}

constexpr int NPHASE = 2 + 2 * 10;
__global__ void __launch_bounds__(256, 2) mega(Params p, int ph_lo, int ph_hi) {
    __shared__ __attribute__((aligned(16))) unsigned char lds[LDS_BYTES];
    XcdBarrier xb; xcd_barrier_post(xb, (unsigned*)(p.ws + OFF_BAR));
#define RUN(idx, ...) if (ph_lo <= (idx) && (idx) < ph_hi) { __VA_ARGS__; if ((idx) + 1 < ph_hi) for (int rb_ = 0; rb_ < REP_BAR; ++rb_) xcd_barrier(xb); }
    RUN(0, phase_pro_a(p, lds))
    RUN(1, for (int r_ = 0; r_ < REP_PROBC; ++r_) phase_pro_b(p, lds))
#define LAYER(l) \
    RUN(2 + 10 * l + 0, phase_inproj(p, lds, l)) \
    RUN(2 + 10 * l + 1, phase_s1(p, lds, l)) \
    RUN(2 + 10 * l + 2, phase_s2(p, lds, l); if (l == 0) w2_toeplitz_fill(p)) \
    RUN(2 + 10 * l + 3, phase_s3(p, lds, l)) \
    RUN(2 + 10 * l + 4, phase_glu(p, lds, l)) \
    RUN(2 + 10 * l + 5, phase_outproj(p, lds, l)) \
    RUN(2 + 10 * l + 6, if (DRY_LN1) phase_ln1<true>(p, lds, l); phase_ln1<false>(p, lds, l)) \
    RUN(2 + 10 * l + 7, phase_moe_gu(p, lds, l)) \
    RUN(2 + 10 * l + 8, phase_moe_dn(p, lds, l)) \
    RUN(2 + 10 * l + 9, if (DRY_LN2) phase_ln2<true>(p, l); phase_ln2<false>(p, l))
    LAYER(0)
    LAYER(1)
#undef LAYER
#undef RUN
}

extern "C" void kernel_launch(void* const* d_in, const int* in_sizes, int n_in, void* d_out, int out_size, void* d_ws, size_t ws_size, hipStream_t stream) {
    static int grid_blocks = 0;
    if (grid_blocks == 0) {
        if (n_in != 34 || out_size != NLAT * D || ws_size < WS_END) {
            fprintf(stderr, "kernel_launch: unexpected shapes (n_in %d out %d ws %zu need %zu)\n", n_in, out_size, ws_size, (size_t)WS_END);
            grid_blocks = -1; return;
        }
        int dev = 0, cus = 0, per_cu = 0;
        hipGetDevice(&dev);
        hipDeviceGetAttribute(&cus, hipDeviceAttributeMultiprocessorCount, dev);
        hipOccupancyMaxActiveBlocksPerMultiprocessor(&per_cu, (const void*)mega, 256, 0);
        if (per_cu < 1) per_cu = 1;
        if (per_cu > 2) per_cu = 2;
        grid_blocks = cus * per_cu;
        fprintf(stderr, "kernel_launch: cus %d per_cu %d grid %d ws need %zu have %zu\n", cus, per_cu, grid_blocks, (size_t)WS_END, ws_size);
    }
    if (grid_blocks < 0) return;
    Params p{};
    for (int i = 0; i < 34; ++i) p.in[i] = (const float*)d_in[i];
    p.out = (float*)d_out; p.ws = (unsigned char*)d_ws;
    if (hipMemsetAsync((unsigned char*)d_ws + OFF_BAR, 0, SZ_BAR, stream) != hipSuccess) fprintf(stderr, "memset failed\n");
#if FUSED
    int lo = 0, hi = NPHASE;
    void* args[] = {&p, &lo, &hi};
    hipError_t e = hipLaunchCooperativeKernel((const void*)mega, dim3(grid_blocks), dim3(256), args, 0, stream);
    if (e != hipSuccess) fprintf(stderr, "cooperative launch failed: %s (grid %d)\n", hipGetErrorString(e), grid_blocks);
#else
    for (int ph = 0; ph < NPHASE; ++ph) hipLaunchKernelGGL(mega, dim3(grid_blocks), dim3(256), 0, stream, p, ph, ph + 1);
#endif
}
```

```cpp
#include <hip/hip_runtime.h>
#include <cstdio>
#include <cstdint>

#ifndef FUSED
#define FUSED 1
#endif
#define REP_INPROJ 1
#define REP_S1 1
#define REP_S3 1
#define REP_GLU 1
#define REP_OUT0 1
#define REP_GU 1
#define REP_CONV 1
#define REP_S2 1
#define REP_PRO 1
#define REP_BAR 1
#define REP_PROBC 1
#define REP_PB_K 1
#define REP_PB_M 1
#define REP_PB_H 1
#define DRY_LN1 0
#define DRY_LN2 0
#define KEEP(x) asm volatile("" :: "v"(x))

typedef unsigned short bf16_t;
typedef __attribute__((ext_vector_type(8))) short bf16x8;
typedef __attribute__((ext_vector_type(16))) float f32x16;

constexpr int D = 1024, NB = 8, SEQ = 2048, CTX = 256;
constexpr int NLAT = NB * SEQ, NCTX = NB * CTX, NROW = NLAT + NCTX;
constexpr int DIN = 1792, DS5 = 512, NG = 32, PS = 64;
constexpr int TCH = 16, NT = 256;
constexpr int NCOL = NROW / TCH;
constexpr int NCOL_LAT = NLAT / TCH;
constexpr int CH_LAT = SEQ / TCH, CH_CTX = CTX / TCH;
constexpr int NSTEP = CH_LAT + CH_CTX;
constexpr int NSEG = 8, SEGLEN = NSTEP / NSEG;
constexpr int NCLS = 24, LISTCAP = NROW;
constexpr int MAXMT = NROW / 128 + NCLS;
constexpr int KSPLIT_MOD = 32;
constexpr int NTHR = 512, NWV = 8;
constexpr float LN_EPS = 1e-5f;
constexpr float DN_ALPHA = 1.4142135623730951f;
constexpr int NPOW = 18;

constexpr size_t AL(size_t x) { return (x + 255) & ~(size_t)255; }
constexpr size_t SZ_WT_IN = (size_t)2 * DIN * D * 2;
constexpr size_t SZ_WT_GLU = (size_t)2 * 512 * 512 * 2;
constexpr size_t SZ_WT_O = (size_t)2 * D * D * 2;
constexpr size_t SZ_WT_GU = (size_t)2 * 16 * 512 * 1024 * 2;
constexpr size_t SZ_WT_DN = (size_t)2 * 16 * 1024 * 256 * 2;
constexpr size_t SZ_MOD = (size_t)2 * 9 * 6144 * 4;
constexpr size_t SZ_LAMPOW = (size_t)2 * 2 * NG * PS * NPOW * 8;
constexpr size_t SZ_BBAR = (size_t)2 * 2 * NG * PS * 16 * 8;
constexpr size_t SZ_KFULL = (size_t)2 * NG * 32 * 256 * 4;
constexpr size_t SZ_M1 = (size_t)2 * NG * 256 * 256 * 2;
constexpr size_t SZ_W2 = (size_t)2 * NG * 256 * 512 * 2;
constexpr size_t SZ_HB = (size_t)NROW * D * 2;
constexpr size_t SZ_UG = (size_t)NG * NROW * 16 * 2;
constexpr size_t SZ_ZR = (size_t)NROW * 1280 * 2;
constexpr size_t SZ_S = (size_t)NG * NCOL * 256 * 4;
constexpr size_t SZ_RCTX = (size_t)NCTX * D * 4;
constexpr size_t SZ_CNT = 256 * 4;
constexpr size_t SZ_LIST = (size_t)NCLS * LISTCAP * 4;
constexpr size_t SZ_LW = (size_t)NCLS * LISTCAP * 8;

constexpr size_t OFF_WT_IN = 0;
constexpr size_t OFF_WT_GLU = OFF_WT_IN + AL(SZ_WT_IN);
constexpr size_t OFF_WT_O = OFF_WT_GLU + AL(SZ_WT_GLU);
constexpr size_t OFF_WT_GU = OFF_WT_O + AL(SZ_WT_O);
constexpr size_t OFF_WT_DN = OFF_WT_GU + AL(SZ_WT_GU);
constexpr size_t OFF_MOD = OFF_WT_DN + AL(SZ_WT_DN);
constexpr size_t OFF_LAMPOW = OFF_MOD + AL(SZ_MOD);
constexpr size_t OFF_BBAR = OFF_LAMPOW + AL(SZ_LAMPOW);
constexpr size_t OFF_KFULL = OFF_BBAR + AL(SZ_BBAR);
constexpr size_t OFF_M1 = OFF_KFULL + AL(SZ_KFULL);
constexpr size_t OFF_W2 = OFF_M1 + AL(SZ_M1);
constexpr size_t OFF_HB = OFF_W2 + AL(SZ_W2);
constexpr size_t OFF_UG = OFF_HB + AL(SZ_HB);
constexpr size_t OFF_ZR = OFF_UG + AL(SZ_UG);
constexpr size_t OFF_S = OFF_ZR + AL(SZ_ZR);
constexpr size_t OFF_RCTX = OFF_S + AL(SZ_S);
constexpr size_t OFF_CNT = OFF_RCTX + AL(SZ_RCTX);
constexpr size_t OFF_LIST = OFF_CNT + AL(SZ_CNT);
constexpr size_t OFF_LW = OFF_LIST + AL(SZ_LIST);
constexpr size_t OFF_BAR = OFF_LW + AL(SZ_LW);
constexpr size_t SZ_BAR = 3456 * 4;
constexpr size_t WS_END = OFF_BAR + AL(SZ_BAR);
static_assert((size_t)KSPLIT_MOD * 2 * 9 * 6144 * 4 <= SZ_ZR, "modp alias");
static_assert((size_t)NG * NCOL * 256 * 2 <= SZ_ZR, "hprev alias");
static_assert((size_t)NROW * 512 * 2 <= SZ_S && (size_t)MAXMT * 128 * 512 * 2 <= SZ_S, "Y/act alias");
static_assert(WS_END <= (size_t)256 * 1024 * 1024, "workspace over 256 MiB");

constexpr int STAGE_BYTES = 49152, LDS_BYTES = 3 * STAGE_BYTES;

struct Params {
    const float* in[34];
    float* out;
    unsigned char* ws;
};

__device__ __forceinline__ unsigned f2bf(float f) { unsigned u = __float_as_uint(f); u += 0x7fffu + ((u >> 16) & 1u); return u >> 16; }
__device__ __forceinline__ float bf2f(unsigned h) { return __uint_as_float(h << 16); }
__device__ __forceinline__ unsigned pack2(float a, float b) { return f2bf(a) | (f2bf(b) << 16); }
__device__ __forceinline__ float bflo(unsigned w) { return __uint_as_float(w << 16); }
__device__ __forceinline__ float bfhi(unsigned w) { return __uint_as_float(w & 0xffff0000u); }
__device__ __forceinline__ float wave_sum(float v) {
#pragma unroll
    for (int o = 32; o >= 1; o >>= 1) v += __shfl_xor(v, o);
    return v;
}
__device__ __forceinline__ float sigmoidf_(float x) { return 1.0f / (1.0f + __expf(-x)); }
__device__ __forceinline__ float siluf_(float x) { return x / (1.0f + __expf(-x)); }
__device__ __forceinline__ float gelu_tanh(float x) {
    const float z = 0.7978845608028654f * (x + 0.044715f * x * x * x);
    const float e = __expf(2.0f * z);
    const float t = 1.0f - 2.0f / (1.0f + e);
    return 0.5f * x * (1.0f + t);
}
__device__ __forceinline__ int modrow(int row) { return row < NLAT ? (row >> 11) : 8; }

struct SrcA { const bf16_t* p0[4]; const bf16_t* p1[4]; int split; };
struct SrcB { const bf16_t* p0[2]; const bf16_t* p1[2]; int split; };
#define LDS_AS __attribute__((address_space(3)))

template <int MF, class EPI>
__device__ __forceinline__ void gemm_tile(unsigned char* lds, const SrcA& A, const SrcB& B, const int K, const EPI& epi) {
    const int tid = threadIdx.x, lane = tid & 63, wid = __builtin_amdgcn_readfirstlane(tid >> 6), wm = wid >> 1, wn = wid & 1;
    const int l31 = lane & 31, hh = lane >> 5, sw = (l31 >> 1) & 7;
    const int xbase = (wm * 32 * MF + l31) * 128, wbase = 32768 + (wn * 64 + l31) * 128;
    LDS_AS unsigned char* ldsw = (LDS_AS unsigned char*)lds + wid * 1024;
    f32x16 acc[MF][2];
#pragma unroll
    for (int i = 0; i < MF; ++i)
#pragma unroll
        for (int j = 0; j < 2; ++j)
#pragma unroll
            for (int e = 0; e < 16; ++e) acc[i][j][e] = 0.f;
    const int nk = K >> 6;
#define G_STAGE(kt_, bufo_) do { const int k_ = (kt_) * 64; \
        _Pragma("unroll") for (int j = 0; j < 2 * MF; ++j) __builtin_amdgcn_global_load_lds((const unsigned*)(k_ < A.split ? A.p0[j] + k_ : A.p1[j] + (k_ - A.split)), (LDS_AS unsigned*)(ldsw + (bufo_) + j * 8192), 16, 0, 0); \
        _Pragma("unroll") for (int j = 0; j < 2; ++j) __builtin_amdgcn_global_load_lds((const unsigned*)(k_ < B.split ? B.p0[j] + k_ : B.p1[j] + (k_ - B.split)), (LDS_AS unsigned*)(ldsw + (bufo_) + 32768 + j * 8192), 16, 0, 0); } while (0)
    asm volatile("s_waitcnt vmcnt(0)" ::: "memory");
    __builtin_amdgcn_s_barrier();
    asm volatile("" ::: "memory");
    G_STAGE(0, 0);
    if (nk > 1) G_STAGE(1, STAGE_BYTES);
    int cur = 0, nxt = 2 * STAGE_BYTES;
    for (int kt = 0; kt < nk; ++kt) {
        if (kt + 1 < nk) { if (MF == 2) asm volatile("s_waitcnt vmcnt(6)" ::: "memory"); else asm volatile("s_waitcnt vmcnt(4)" ::: "memory"); }
        else asm volatile("s_waitcnt vmcnt(0)" ::: "memory");
        __builtin_amdgcn_s_barrier();
        asm volatile("" ::: "memory");
        if (kt + 2 < nk) G_STAGE(kt + 2, nxt);
#pragma unroll
        for (int ks = 0; ks < 4; ++ks) {
            const int co = ((ks * 2 + hh) ^ sw) << 4;
            const bf16x8 w0 = *(const bf16x8*)(lds + cur + wbase + co);
            const bf16x8 w1 = *(const bf16x8*)(lds + cur + wbase + 4096 + co);
#pragma unroll
            for (int mt = 0; mt < MF; ++mt) {
                const bf16x8 x0 = *(const bf16x8*)(lds + cur + xbase + mt * 4096 + co);
                acc[mt][0] = __builtin_amdgcn_mfma_f32_32x32x16_bf16(w0, x0, acc[mt][0], 0, 0, 0);
                acc[mt][1] = __builtin_amdgcn_mfma_f32_32x32x16_bf16(w1, x0, acc[mt][1], 0, 0, 0);
            }
        }
        cur = (cur == 2 * STAGE_BYTES) ? 0 : cur + STAGE_BYTES;
        nxt = (nxt == 2 * STAGE_BYTES) ? 0 : nxt + STAGE_BYTES;
    }
#undef G_STAGE
    epi(acc, wm * 32 * MF + l31, wn * 64 + hh * 4);
}

template <int NJ, class S>
__device__ __forceinline__ void src_plain(S& s, const bf16_t* base, int row0, int ld) {
    const int lr = threadIdx.x >> 3, lc = (threadIdx.x & 7) ^ ((lr >> 1) & 7);
#pragma unroll
    for (int j = 0; j < NJ; ++j) { s.p0[j] = base + (size_t)(row0 + lr + 64 * j) * ld + lc * 8; s.p1[j] = s.p0[j]; }
    s.split = 1 << 30;
}
template <int NJ, class S>
__device__ __forceinline__ void src_split(S& s, const bf16_t* base0, int ld0, const bf16_t* base1, int ld1, int row0, int split) {
    const int lr = threadIdx.x >> 3, lc = (threadIdx.x & 7) ^ ((lr >> 1) & 7);
#pragma unroll
    for (int j = 0; j < NJ; ++j) { s.p0[j] = base0 + (size_t)(row0 + lr + 64 * j) * ld0 + lc * 8; s.p1[j] = base1 + (size_t)(row0 + lr + 64 * j) * ld1 + lc * 8; }
    s.split = split;
}
struct XcdIter { int nx, xcd, local, nloc; };
__device__ __forceinline__ XcdIter xcd_iter() {
    XcdIter it; it.nx = (gridDim.x & 7) == 0 ? 8 : 1; it.xcd = blockIdx.x % it.nx; it.local = blockIdx.x / it.nx; it.nloc = gridDim.x / it.nx; return it;
}

#define ACC_FOREACH(MF_, acc, r0, c0, ...) \
    _Pragma("unroll") for (int mt_ = 0; mt_ < MF_; ++mt_) \
    _Pragma("unroll") for (int nt_ = 0; nt_ < 2; ++nt_) \
    _Pragma("unroll") for (int q_ = 0; q_ < 4; ++q_) { \
        const int rl = (r0) + mt_ * 32, cl = (c0) + nt_ * 32 + q_ * 8; \
        const float v0 = acc[mt_][nt_][q_ * 4 + 0], v1 = acc[mt_][nt_][q_ * 4 + 1], v2 = acc[mt_][nt_][q_ * 4 + 2], v3 = acc[mt_][nt_][q_ * 4 + 3]; \
        __VA_ARGS__ }

struct WS {
    unsigned char* b;
    __device__ bf16_t* wt_in(int l) const { return (bf16_t*)(b + OFF_WT_IN) + (size_t)l * DIN * D; }
    __device__ bf16_t* wt_glu(int l) const { return (bf16_t*)(b + OFF_WT_GLU) + (size_t)l * 512 * 512; }
    __device__ bf16_t* wt_o(int l) const { return (bf16_t*)(b + OFF_WT_O) + (size_t)l * D * D; }
    __device__ bf16_t* wt_gu(int l, int e) const { return (bf16_t*)(b + OFF_WT_GU) + (size_t)(l * 16 + e) * 512 * 1024; }
    __device__ bf16_t* wt_dn(int l, int e) const { return (bf16_t*)(b + OFF_WT_DN) + (size_t)(l * 16 + e) * 1024 * 256; }
    __device__ float* mod(int l) const { return (float*)(b + OFF_MOD) + (size_t)l * 9 * 6144; }
    __device__ float* modp() const { return (float*)(b + OFF_ZR); }
    __device__ float2* lampow(int l, int d, int g) const { return (float2*)(b + OFF_LAMPOW) + (size_t)((l * 2 + d) * NG + g) * PS * NPOW; }
    __device__ float2* bbar(int l, int d, int g) const { return (float2*)(b + OFF_BBAR) + (size_t)((l * 2 + d) * NG + g) * PS * 16; }
    __device__ float* kfull(int l, int g) const { return (float*)(b + OFF_KFULL) + (size_t)(l * NG + g) * 32 * 256; }
    __device__ bf16_t* m1(int l, int g) const { return (bf16_t*)(b + OFF_M1) + (size_t)(l * NG + g) * 256 * 256; }
    __device__ bf16_t* w2(int l, int g) const { return (bf16_t*)(b + OFF_W2) + (size_t)(l * NG + g) * 256 * 512; }
    __device__ bf16_t* hb() const { return (bf16_t*)(b + OFF_HB); }
    __device__ bf16_t* ug() const { return (bf16_t*)(b + OFF_UG); }
    __device__ bf16_t* zr() const { return (bf16_t*)(b + OFF_ZR); }
    __device__ bf16_t* hprev() const { return (bf16_t*)(b + OFF_ZR); }
    __device__ float* S() const { return (float*)(b + OFF_S); }
    __device__ bf16_t* Y() const { return (bf16_t*)(b + OFF_S); }
    __device__ bf16_t* act() const { return (bf16_t*)(b + OFF_S); }
    __device__ float* rctx() const { return (float*)(b + OFF_RCTX); }
    __device__ int* cnt(int l) const { return (int*)(b + OFF_CNT) + l * 32; }
    __device__ int* list() const { return (int*)(b + OFF_LIST); }
    __device__ float2* lw() const { return (float2*)(b + OFF_LW); }
};
__device__ __forceinline__ float* Rrow(const Params& p, int row) {
    return row < NLAT ? p.out + (size_t)row * D : (float*)(p.ws + OFF_RCTX) + (size_t)(row - NLAT) * D;
}

__device__ __forceinline__ void transpose_tile(unsigned char* lds, const float* src, int ldsrc, int k0, int n0, bf16_t* dst, int lddst, int rowmode) {
    float* tile = (float*)lds;
    const int tid = threadIdx.x;
    __syncthreads();
#pragma unroll
    for (int pass = 0; pass < 2; ++pass) {
        const int k = pass * 32 + (tid >> 4), n4 = (tid & 15) * 4;
        const float4 v = *(const float4*)(src + (size_t)(k0 + k) * ldsrc + n0 + n4);
        tile[k * 65 + n4 + 0] = v.x; tile[k * 65 + n4 + 1] = v.y; tile[k * 65 + n4 + 2] = v.z; tile[k * 65 + n4 + 3] = v.w;
    }
    __syncthreads();
    {
        const int n = tid & 63, kc = tid >> 6;
        float f[8];
#pragma unroll
        for (int i = 0; i < 8; ++i) f[i] = tile[(kc * 8 + i) * 65 + n];
        const int ng = n0 + n;
        int drow = ng;
        if (rowmode == 1) drow = ((ng >> 3) << 4) + (ng & 7);
        else if (rowmode == 2) drow = ((ng >> 3) << 4) + 8 + (ng & 7);
        uint4 o; o.x = pack2(f[0], f[1]); o.y = pack2(f[2], f[3]); o.z = pack2(f[4], f[5]); o.w = pack2(f[6], f[7]);
        *(uint4*)(dst + (size_t)drow * lddst + k0 + kc * 8) = o;
    }
}

__device__ __forceinline__ void phase_pro_a(const Params& p, unsigned char* lds) {
    const WS w{p.ws};
    const int tid = threadIdx.x;
    if (blockIdx.x == 0 && tid < 64) ((int*)(p.ws + OFF_CNT))[tid] = 0;
    constexpr int N_MOD = 2 * 3 * KSPLIT_MOD, N_TAB = 16, N_WT = 2 * 3840;
    for (int rep = 0; rep < REP_PRO; ++rep)
    for (int it = blockIdx.x; it < N_MOD + N_TAB + N_WT; it += gridDim.x) {
        if (it < N_MOD) {
            const int l = it / (3 * KSPLIT_MOD), rem = it % (3 * KSPLIT_MOD), cb = rem / KSPLIT_MOD, ks = rem % KSPLIT_MOD;
            float* sc = (float*)lds;
            __syncthreads();
            for (int i = tid; i < 9 * 32; i += NTHR) {
                const int r = i >> 5, kk = i & 31, k = ks * 32 + kk;
                const float cv = r < 8 ? p.in[1][r * D + k] : p.in[3][k];
                sc[i] = siluf_(cv);
            }
            __syncthreads();
            float acc[9][4];
#pragma unroll
            for (int r = 0; r < 9; ++r) { acc[r][0] = acc[r][1] = acc[r][2] = acc[r][3] = 0.f; }
            const float* wm = p.in[4] + ((size_t)l * D + ks * 32) * 6144 + cb * 2048 + tid * 4;
#pragma unroll 8
            for (int kk = 0; kk < 32; ++kk) {
                const float4 v = *(const float4*)(wm + (size_t)kk * 6144);
#pragma unroll
                for (int r = 0; r < 9; ++r) { const float s = sc[r * 32 + kk]; acc[r][0] += s * v.x; acc[r][1] += s * v.y; acc[r][2] += s * v.z; acc[r][3] += s * v.w; }
            }
            float* mp = w.modp() + ((size_t)(ks * 2 + l) * 9) * 6144 + cb * 2048 + tid * 4;
#pragma unroll
            for (int r = 0; r < 9; ++r) *(float4*)(mp + (size_t)r * 6144) = make_float4(acc[r][0], acc[r][1], acc[r][2], acc[r][3]);
        } else if (it < N_MOD + N_TAB) {
            const int id = (it - N_MOD) * NTHR + tid;
            const int pp = id & 63, g = (id >> 6) & 31, d = (id >> 11) & 1, l = id >> 12;
            const int i3 = (l * 2 + d) * NG + g;
            const double dt = exp((double)p.in[9][i3]);
            const double are = (double)p.in[7][i3 * PS + pp], aim = (double)p.in[8][i3 * PS + pp];
            float2* lp = w.lampow(l, d, g) + pp * NPOW;
            double lbr = 0, lbi = 0;
            for (int k = 0; k < NPOW; ++k) {
                const double kk = (k == 17) ? (double)(TCH * SEGLEN) : (double)k;
                const double mag = exp(kk * are * dt);
                double s, c; sincos(kk * aim * dt, &s, &c);
                lp[k] = make_float2((float)(mag * c), (float)(mag * s));
                if (k == 1) { lbr = mag * c; lbi = mag * s; }
            }
            const double nr = lbr - 1.0, ni = lbi, den = are * are + aim * aim;
            const double cr = (nr * are + ni * aim) / den, ci = (ni * are - nr * aim) / den;
            float2* bb = w.bbar(l, d, g) + pp * 16;
            for (int n = 0; n < 16; ++n) {
                const double br = (double)p.in[10][(size_t)(i3 * PS + pp) * 16 + n], bi = (double)p.in[11][(size_t)(i3 * PS + pp) * 16 + n];
                bb[n] = make_float2((float)(cr * br - ci * bi), (float)(cr * bi + ci * br));
            }
        } else {
            int t = it - N_MOD - N_TAB;
            const int l = t / 3840; t %= 3840;
            if (t < 448) { const int kt = t / 28, nt = t % 28; transpose_tile(lds, p.in[6] + (size_t)l * D * DIN, DIN, kt * 64, nt * 64, w.wt_in(l), D, 0); }
            else if (t < 512) { t -= 448; const int kt = t / 8, nt = t % 8; transpose_tile(lds, p.in[15] + (size_t)l * 512 * 512, 512, kt * 64, nt * 64, w.wt_glu(l), 512, 0); }
            else if (t < 768) { t -= 512; const int kt = t / 16, nt = t % 16; transpose_tile(lds, p.in[22] + (size_t)l * D * D, D, kt * 64, nt * 64, w.wt_o(l), D, 0); }
            else if (t < 1792) { t -= 768; const int e = t / 64, r = t % 64, kt = r / 4, nt = r % 4; transpose_tile(lds, p.in[29] + (size_t)(l * 16 + e) * D * 256, 256, kt * 64, nt * 64, w.wt_gu(l, e), D, 1); }
            else if (t < 2816) { t -= 1792; const int e = t / 64, r = t % 64, kt = r / 4, nt = r % 4; transpose_tile(lds, p.in[30] + (size_t)(l * 16 + e) * D * 256, 256, kt * 64, nt * 64, w.wt_gu(l, e), D, 2); }
            else { t -= 2816; const int e = t / 64, r = t % 64, kt = r / 16, nt = r % 16; transpose_tile(lds, p.in[31] + (size_t)(l * 16 + e) * 256 * D, D, kt * 64, nt * 64, w.wt_dn(l, e), 256, 0); }
        }
    }
}

__device__ __forceinline__ void phase_pro_b(const Params& p, unsigned char* lds) {
    const WS w{p.ws};
    const int tid = threadIdx.x;
    const int gt = blockIdx.x * NTHR + tid, gs = gridDim.x * NTHR;
    for (int rep = 0; rep < REP_PB_K; ++rep)
    for (int it = blockIdx.x; it < 2 * NG * 2; it += gridDim.x) {
        const int d = it & 1, g = (it >> 1) & 31, l = it >> 6;
        float2* Lp = (float2*)lds;
        float2* Bb = Lp + 64 * 16;
        float2* Cc = Bb + 64 * 16;
        __syncthreads();
        const float2* lp = w.lampow(l, d, g); const float2* bb = w.bbar(l, d, g);
        const float* cre = p.in[12] + (size_t)((l * 2 + d) * NG + g) * 16 * PS; const float* cim = p.in[13] + (size_t)((l * 2 + d) * NG + g) * 16 * PS;
        for (int i = tid; i < 1024; i += NTHR) {
            Lp[i] = lp[(i >> 4) * NPOW + (i & 15)];
            Bb[i] = bb[i];
            Cc[i] = make_float2(cre[i], cim[i]);
        }
        __syncthreads();
        const int no = (tid >> 4) & 15, ni = tid & 15, th = tid >> 8;
        float acc[8];
#pragma unroll
        for (int t = 0; t < 8; ++t) acc[t] = 0.f;
        for (int pp = 0; pp < PS; ++pp) {
            const float2 c = Cc[no * 64 + pp], b = Bb[pp * 16 + ni];
            const float cr = c.x * b.x - c.y * b.y, ci = c.x * b.y + c.y * b.x;
#pragma unroll
            for (int t = 0; t < 8; ++t) { const float2 L = Lp[pp * 16 + th * 8 + t]; acc[t] += cr * L.x - ci * L.y; }
        }
        if (d == 0 && th == 0) acc[0] += (no == ni) ? p.in[14][l * DS5 + g * 16 + no] : 0.f;
        float* kf = w.kfull(l, g);
#pragma unroll
        for (int t = 0; t < 8; ++t) {
            const int tau = th * 8 + t;
            const int ti = d == 0 ? 15 + tau : (tau == 0 ? 31 : 15 - tau);
            kf[(ti * 16 + no) * 16 + ni] = acc[t];
        }
    }
    for (int rep = 0; rep < REP_PB_M; ++rep) {
    for (int i = gt; i < 2 * 9 * 6144; i += gs) {
        const int l = i / (9 * 6144), n = i % 6144;
        float s = p.in[5][l * 6144 + n];
        const float* mp = w.modp() + i;
#pragma unroll
        for (int ks = 0; ks < KSPLIT_MOD; ++ks) s += mp[(size_t)ks * 2 * 9 * 6144];
        ((float*)(p.ws + OFF_MOD))[i] = s;
    }
    for (int i = gt; i < 2 * NG * 256 * 32; i += gs) {
        const int c8 = i & 31, row = (i >> 5) & 255, lg = i >> 13, g = lg & 31, l = lg >> 5;
        const int d = row >> 7, pp = (row & 127) >> 1, c = row & 1, j = c8 >> 1, n0 = (c8 & 1) * 8;
        const int e = d == 0 ? (TCH - 1 - j) : j;
        const float2 L = w.lampow(l, d, g)[pp * NPOW + e];
        const float2* bb = w.bbar(l, d, g) + pp * 16 + n0;
        float f[8];
#pragma unroll
        for (int n = 0; n < 8; ++n) { const float2 Bv = bb[n]; f[n] = c == 0 ? (L.x * Bv.x - L.y * Bv.y) : (L.x * Bv.y + L.y * Bv.x); }
        uint4 o; o.x = pack2(f[0], f[1]); o.y = pack2(f[2], f[3]); o.z = pack2(f[4], f[5]); o.w = pack2(f[6], f[7]);
        *(uint4*)(w.m1(l, g) + (size_t)row * 256 + c8 * 8) = o;
    }
    for (int i = gt; i < 2 * NG * 256 * 32; i += gs) {
        const int c8 = i & 31, r = (i >> 5) & 255, lg = i >> 13, g = lg & 31, l = lg >> 5;
        const int jo = r >> 4, no = r & 15;
        const int kk = c8 * 8, d = kk >> 7, p0 = (kk & 127) >> 1;
        const int e = d == 0 ? (jo + 1) : (TCH - jo);
        const float* cre = p.in[12] + ((size_t)((l * 2 + d) * NG + g) * 16 + no) * PS;
        const float* cim = p.in[13] + ((size_t)((l * 2 + d) * NG + g) * 16 + no) * PS;
        const float2* lp = w.lampow(l, d, g);
        float f[8];
#pragma unroll
        for (int q = 0; q < 4; ++q) {
            const int pp = p0 + q;
            const float2 L = lp[pp * NPOW + e];
            const float cr = cre[pp], ci = cim[pp];
            f[2 * q] = cr * L.x - ci * L.y;
            f[2 * q + 1] = -(cr * L.y + ci * L.x);
        }
        uint4 o; o.x = pack2(f[0], f[1]); o.y = pack2(f[2], f[3]); o.z = pack2(f[4], f[5]); o.w = pack2(f[6], f[7]);
        *(uint4*)(w.w2(l, g) + (size_t)r * 512 + 256 + c8 * 8) = o;
    }
    }
    {
        float* shsc = (float*)lds;
        for (int rep = 0; rep < REP_PB_H; ++rep)
        for (int it = blockIdx.x; it < NROW / 32; it += gridDim.x) {
            const int row0 = it * 32, m = modrow(row0);
            __syncthreads();
            for (int i = tid; i < 2048; i += NTHR) {
                float sacc = p.in[5][i];
                const float* mp = w.modp() + (size_t)m * 6144 + i;
#pragma unroll
                for (int ks = 0; ks < KSPLIT_MOD; ++ks) sacc += mp[(size_t)ks * 2 * 9 * 6144];
                shsc[i] = sacc;
            }
            __syncthreads();
            for (int i0 = tid; i0 < 32 * 128; i0 += 4 * NTHR) {
                float4 a[4], b[4];
#pragma unroll
                for (int u = 0; u < 4; ++u) {
                    const int i = i0 + u * NTHR, row = row0 + (i >> 7), c8 = (i & 127) * 8;
                    const float* xs = row < NLAT ? p.in[0] + (size_t)row * D : p.in[2] + (size_t)(row - NLAT) * D;
                    a[u] = *(const float4*)(xs + c8); b[u] = *(const float4*)(xs + c8 + 4);
                }
#pragma unroll
                for (int u = 0; u < 4; ++u) {
                    const int i = i0 + u * NTHR, row = row0 + (i >> 7), c8 = (i & 127) * 8;
                    const float4 s0 = *(const float4*)(shsc + c8), s1 = *(const float4*)(shsc + c8 + 4), c0 = *(const float4*)(shsc + 1024 + c8), c1 = *(const float4*)(shsc + 1024 + c8 + 4);
                    uint4 o;
                    o.x = pack2(a[u].x * (1.f + c0.x) + s0.x, a[u].y * (1.f + c0.y) + s0.y);
                    o.y = pack2(a[u].z * (1.f + c0.z) + s0.z, a[u].w * (1.f + c0.w) + s0.w);
                    o.z = pack2(b[u].x * (1.f + c1.x) + s1.x, b[u].y * (1.f + c1.y) + s1.y);
                    o.w = pack2(b[u].z * (1.f + c1.z) + s1.z, b[u].w * (1.f + c1.w) + s1.w);
                    *(uint4*)(w.hb() + (size_t)row * D + c8) = o;
                }
            }
        }
    }
}

__device__ __forceinline__ void w2_toeplitz_fill(const Params& p) {
    const WS w{p.ws};
    const int gt = blockIdx.x * NTHR + threadIdx.x, gs = gridDim.x * NTHR;
    for (int i = gt; i < 2 * NG * 256 * 32; i += gs) {
        const int c8 = i & 31, r = (i >> 5) & 255, lg = i >> 13, g = lg & 31, l = lg >> 5;
        const int jo = r >> 4, no = r & 15, ji = c8 >> 1, n0 = (c8 & 1) * 8;
        const float* kf = w.kfull(l, g) + ((size_t)(jo - ji + 15) * 16 + no) * 16 + n0;
        float f[8];
#pragma unroll
        for (int n = 0; n < 8; ++n) f[n] = kf[n];
        if (jo == ji) {
            const float* k2 = w.kfull(l, g) + ((size_t)31 * 16 + no) * 16 + n0;
#pragma unroll
            for (int n = 0; n < 8; ++n) f[n] += k2[n];
        }
        uint4 o; o.x = pack2(f[0], f[1]); o.y = pack2(f[2], f[3]); o.z = pack2(f[4], f[5]); o.w = pack2(f[6], f[7]);
        *(uint4*)(w.w2(l, g) + (size_t)r * 512 + c8 * 8) = o;
    }
}

struct EpiInproj {
    bf16_t* ug; bf16_t* zr; int m0, n0;
    __device__ __forceinline__ void operator()(const f32x16 (&acc)[2][2], int r0, int c0) const {
        ACC_FOREACH(2, acc, r0, c0, {
            const int row = m0 + rl, col = n0 + cl;
            uint2 o; o.x = pack2(v0, v1); o.y = pack2(v2, v3);
            if (col < DS5) *(uint2*)(ug + ((size_t)(col >> 4) * NROW + row) * 16 + (col & 15)) = o;
            else *(uint2*)(zr + (size_t)row * 1280 + (col - DS5)) = o;
        })
    }
};
__device__ __forceinline__ void phase_inproj(const Params& p, unsigned char* lds, int l) {
    const WS w{p.ws};
    const XcdIter xi = xcd_iter();
    const int nlat = 64 / xi.nx, nctx = 8 / xi.nx, ctxn = l == 0 ? 14 : 4;
    const int nunit = nlat * 14 + nctx * ctxn;
    for (int rep = 0; rep < REP_INPROJ; ++rep)
    for (int u = xi.local; u < nunit; u += xi.nloc) {
        int mt, nt;
        if (u < nlat * 14) { mt = (u / 14) * xi.nx + xi.xcd; nt = u % 14; }
        else { const int v = u - nlat * 14; mt = 64 + (v / ctxn) * xi.nx + xi.xcd; nt = v % ctxn; }
        SrcA A; SrcB B;
        src_plain<4>(A, w.hb(), mt * 256, D);
        src_plain<2>(B, w.wt_in(l), nt * 128, D);
        EpiInproj e{w.ug(), w.zr(), mt * 256, nt * 128};
        gemm_tile<2>(lds, A, B, D, e);
    }
}

struct EpiS1 {
    float* S; int m0, n0;
    __device__ __forceinline__ void operator()(const f32x16 (&acc)[1][2], int r0, int c0) const {
        ACC_FOREACH(1, acc, r0, c0, {
            *(float4*)(S + (size_t)(m0 + rl) * 256 + n0 + cl) = make_float4(v0, v1, v2, v3);
        })
    }
};

__device__ __forceinline__ void conv_sc(const Params& p, int l, int nrows) {
    const WS w{p.ws};
    const float* wsc = p.in[17] + (size_t)l * 3 * 256;
    const int gt = blockIdx.x * NTHR + threadIdx.x, gs = gridDim.x * NTHR;
    for (int i = gt; i < nrows * 16; i += gs) {
        const int row = i >> 4, c16 = (i & 15) * 16;
        int pos, len;
        if (row < NLAT) { pos = row & 63; len = 64; } else { pos = (row - NLAT) & 255; len = 256; }
        const bf16_t* zr = w.zr() + (size_t)row * 1280;
        uint4 cg[3][2], vv[3][2];
#pragma unroll
        for (int j = 0; j < 3; ++j) {
            const bool ok = (pos + j - 1 >= 0) && (pos + j - 1 < len);
#pragma unroll
            for (int u = 0; u < 2; ++u) {
                if (ok) { cg[j][u] = *(const uint4*)(zr + (ptrdiff_t)(j - 1) * 1280 + 256 + c16 + u * 8); vv[j][u] = *(const uint4*)(zr + (ptrdiff_t)(j - 1) * 1280 + 512 + c16 + u * 8); }
                else { cg[j][u] = make_uint4(0, 0, 0, 0); vv[j][u] = make_uint4(0, 0, 0, 0); }
            }
        }
        uint4 bg[2];
#pragma unroll
        for (int u = 0; u < 2; ++u) bg[u] = *(const uint4*)(zr + c16 + u * 8);
#pragma unroll
        for (int u = 0; u < 2; ++u) {
            float accv[8];
#pragma unroll
            for (int e = 0; e < 8; ++e) accv[e] = 0.f;
#pragma unroll
            for (int j = 0; j < 3; ++j) {
                const float4 wa = *(const float4*)(wsc + j * 256 + c16 + u * 8), wb = *(const float4*)(wsc + j * 256 + c16 + u * 8 + 4);
                const uint4 c = cg[j][u], v = vv[j][u];
                accv[0] += wa.x * bflo(c.x) * bflo(v.x); accv[1] += wa.y * bfhi(c.x) * bfhi(v.x);
                accv[2] += wa.z * bflo(c.y) * bflo(v.y); accv[3] += wa.w * bfhi(c.y) * bfhi(v.y);
                accv[4] += wb.x * bflo(c.z) * bflo(v.z); accv[5] += wb.y * bfhi(c.z) * bfhi(v.z);
                accv[6] += wb.z * bflo(c.w) * bflo(v.w); accv[7] += wb.w * bfhi(c.w) * bfhi(v.w);
            }
            uint4 o;
            o.x = pack2(accv[0] * bflo(bg[u].x), accv[1] * bfhi(bg[u].x));
            o.y = pack2(accv[2] * bflo(bg[u].y), accv[3] * bfhi(bg[u].y));
            o.z = pack2(accv[4] * bflo(bg[u].z), accv[5] * bfhi(bg[u].z));
            o.w = pack2(accv[6] * bflo(bg[u].w), accv[7] * bfhi(bg[u].w));
            *(uint4*)(w.hb() + (size_t)row * D + 512 + c16 + u * 8) = o;
        }
    }
}

__device__ __forceinline__ void conv_cf(const Params& p, unsigned char* lds, int l, bool with_ctx) {
    const WS w{p.ws};
    float* P = (float*)lds;
    const int tid = threadIdx.x, lane = tid & 63, wid = tid >> 6;
    const float* wdw = p.in[18] + (size_t)l * 31 * 256 + lane * 4;
    const float4 bdw = *(const float4*)(p.in[19] + l * 256 + lane * 4);
    const float4 lg = *(const float4*)(p.in[20] + l * 256 + lane * 4);
    const float4 lb = *(const float4*)(p.in[21] + l * 256 + lane * 4);
    const int nitem = 512 + (with_ctx ? 64 : 0);
    for (int it = blockIdx.x; it < nitem; it += gridDim.x) {
        const bool lat = it < 512;
        int base, nslot, s0 = 0;
        if (lat) { base = (it >> 6) * SEQ + (it & 63); nslot = 32; }
        else { const int j = it - 512; s0 = (j & 7) * 32; base = NLAT + (j >> 3) * CTX; nslot = 62; }
        __syncthreads();
        for (int task = tid; task < nslot * 32; task += NTHR) {
            const int slot = task >> 5, c8 = (task & 31) * 8;
            int row; bool valid = true;
            if (lat) row = base + slot * 64;
            else { const int sq = s0 - 15 + slot; valid = sq >= 0 && sq < CTX; row = base + sq; }
            float f[8];
            if (valid) {
                const bf16_t* zr = w.zr() + (size_t)row * 1280;
                const uint4 ga = *(const uint4*)(zr + 768 + c8), gb = *(const uint4*)(zr + 1024 + c8);
                f[0] = bflo(ga.x) * sigmoidf_(bflo(gb.x)); f[1] = bfhi(ga.x) * sigmoidf_(bfhi(gb.x));
                f[2] = bflo(ga.y) * sigmoidf_(bflo(gb.y)); f[3] = bfhi(ga.y) * sigmoidf_(bfhi(gb.y));
                f[4] = bflo(ga.z) * sigmoidf_(bflo(gb.z)); f[5] = bfhi(ga.z) * sigmoidf_(bfhi(gb.z));
                f[6] = bflo(ga.w) * sigmoidf_(bflo(gb.w)); f[7] = bfhi(ga.w) * sigmoidf_(bfhi(gb.w));
            } else {
#pragma unroll
                for (int e = 0; e < 8; ++e) f[e] = 0.f;
            }
            *(float4*)(P + slot * 256 + c8) = make_float4(f[0], f[1], f[2], f[3]);
            *(float4*)(P + slot * 256 + c8 + 4) = make_float4(f[4], f[5], f[6], f[7]);
        }
        __syncthreads();
        constexpr int OPW = 32 / NWV;
        const int o0 = wid * OPW;
        float4 a[OPW];
#pragma unroll
        for (int o = 0; o < OPW; ++o) a[o] = bdw;
        if (lat) {
#pragma unroll 1
            for (int k = 0; k < 31; ++k) {
                const float4 wv = *(const float4*)(wdw + k * 256);
#pragma unroll
                for (int o = 0; o < OPW; ++o) {
                    const int rr = o0 + o + k - 15;
                    if (rr >= 0 && rr < 32) {
                        const float4 pv = *(const float4*)(P + rr * 256 + lane * 4);
                        a[o].x += wv.x * pv.x; a[o].y += wv.y * pv.y; a[o].z += wv.z * pv.z; a[o].w += wv.w * pv.w;
                    }
                }
            }
        } else {
#pragma unroll 1
            for (int k = 0; k < 31; ++k) {
                const float4 wv = *(const float4*)(wdw + k * 256);
#pragma unroll
                for (int o = 0; o < OPW; ++o) {
                    const float4 pv = *(const float4*)(P + (o0 + o + k) * 256 + lane * 4);
                    a[o].x += wv.x * pv.x; a[o].y += wv.y * pv.y; a[o].z += wv.z * pv.z; a[o].w += wv.w * pv.w;
                }
            }
        }
#pragma unroll
        for (int o = 0; o < OPW; ++o) {
            const int row = lat ? base + (o0 + o) * 64 : base + s0 + o0 + o;
            const float mean = wave_sum(a[o].x + a[o].y + a[o].z + a[o].w) * (1.0f / 256.0f);
            const float dx = a[o].x - mean, dy = a[o].y - mean, dz = a[o].z - mean, dw = a[o].w - mean;
            const float var = wave_sum(dx * dx + dy * dy + dz * dz + dw * dw) * (1.0f / 256.0f);
            const float rs = rsqrtf(var + LN_EPS);
            const float y0 = siluf_(dx * rs * lg.x + lb.x), y1 = siluf_(dy * rs * lg.y + lb.y), y2 = siluf_(dz * rs * lg.z + lb.z), y3 = siluf_(dw * rs * lg.w + lb.w);
            uint2 ov; ov.x = pack2(y0, y1); ov.y = pack2(y2, y3);
            *(uint2*)(w.hb() + (size_t)row * D + 768 + lane * 4) = ov;
        }
    }
}

__device__ __forceinline__ void phase_s1(const Params& p, unsigned char* lds, int l) {
    const WS w{p.ws};
    const XcdIter xi = xcd_iter();
    const int nunit = (NG / xi.nx) * 18;
    for (int rep = 0; rep < REP_S1; ++rep)
    for (int u = xi.local; u < nunit; u += xi.nloc) {
        const int g = (u / 18) * xi.nx + xi.xcd, r = u % 18, mt = r >> 1, nt = r & 1;
        SrcA A; SrcB B;
        src_plain<2>(A, w.ug() + (size_t)g * NROW * 16, mt * 128, 256);
        src_plain<2>(B, w.m1(l, g), nt * 128, 256);
        EpiS1 e{w.S() + (size_t)g * NCOL * 256, mt * 128, nt * 128};
        gemm_tile<1>(lds, A, B, 256, e);
    }
    for (int rep = 0; rep < REP_CONV; ++rep) {
    conv_sc(p, l, l == 0 ? NROW : NLAT);
    conv_cf(p, lds, l, l == 0);
    }
}

__device__ __forceinline__ int chunk_col(int d, int b, int step) {
    if (step < CH_CTX) { const int c = d == 0 ? step : (CH_CTX - 1 - step); return NCOL_LAT + b * CH_CTX + c; }
    const int s = step - CH_CTX; const int c = d == 0 ? s : (CH_LAT - 1 - s); return b * CH_LAT + c;
}
__device__ __forceinline__ void phase_s2(const Params& p, unsigned char* lds, int l) {
    const WS w{p.ws};
    float2* Fs = (float2*)lds;
    const int tid = threadIdx.x, seg = tid >> 6, pp = tid & 63;
    for (int rep = 0; rep < REP_S2; ++rep)
    for (int it = blockIdx.x; it < NG * 2 * NB; it += gridDim.x) {
        const int b = it & 7, d = (it >> 3) & 1, g = it >> 4;
        const float2 A = w.lampow(l, d, g)[pp * NPOW + 16], A18 = w.lampow(l, d, g)[pp * NPOW + 17];
        const float* S = w.S() + (size_t)g * NCOL * 256 + d * 128 + 2 * pp;
        bf16_t* Hp = w.hprev() + (size_t)g * NCOL * 256 + d * 128 + 2 * pp;
        float2 s[SEGLEN];
#pragma unroll
        for (int i = 0; i < SEGLEN; ++i) s[i] = *(const float2*)(S + (size_t)chunk_col(d, b, seg * SEGLEN + i) * 256);
        float2 F = make_float2(0.f, 0.f);
#pragma unroll
        for (int i = 0; i < SEGLEN; ++i) { const float fr = A.x * F.x - A.y * F.y + s[i].x, fi = A.x * F.y + A.y * F.x + s[i].y; F.x = fr; F.y = fi; }
        __syncthreads();
        Fs[seg * 64 + pp] = F;
        __syncthreads();
        float2 H = make_float2(0.f, 0.f);
        for (int q = 0; q < seg; ++q) { const float2 f = Fs[q * 64 + pp]; const float hr = A18.x * H.x - A18.y * H.y + f.x, hi = A18.x * H.y + A18.y * H.x + f.y; H.x = hr; H.y = hi; }
#pragma unroll
        for (int i = 0; i < SEGLEN; ++i) {
            *(unsigned*)(Hp + (size_t)chunk_col(d, b, seg * SEGLEN + i) * 256) = pack2(H.x, H.y);
            const float hr = A.x * H.x - A.y * H.y + s[i].x, hi = A.x * H.y + A.y * H.x + s[i].y; H.x = hr; H.y = hi;
        }
    }
}

struct EpiS3 {
    bf16_t* Y; int m0, n0, g;
    __device__ __forceinline__ void operator()(const f32x16 (&acc)[1][2], int r0, int c0) const {
        ACC_FOREACH(1, acc, r0, c0, {
            const int col = n0 + cl, tok = (m0 + rl) * TCH + (col >> 4);
            uint2 o; o.x = pack2(gelu_tanh(v0), gelu_tanh(v1)); o.y = pack2(gelu_tanh(v2), gelu_tanh(v3));
            *(uint2*)(Y + (size_t)tok * DS5 + g * 16 + (col & 15)) = o;
        })
    }
};
__device__ __forceinline__ void phase_s3(const Params& p, unsigned char* lds, int l) {
    const WS w{p.ws};
    const XcdIter xi = xcd_iter();
    const int nmt = l == 0 ? 9 : 8, nunit = (NG / xi.nx) * nmt * 2;
    for (int rep = 0; rep < REP_S3; ++rep)
    for (int u = xi.local; u < nunit; u += xi.nloc) {
        const int g = (u / (nmt * 2)) * xi.nx + xi.xcd, r = u % (nmt * 2), mt = r >> 1, nt = r & 1;
        SrcA A; SrcB B;
        src_split<2>(A, w.ug() + (size_t)g * NROW * 16, 256, w.hprev() + (size_t)g * NCOL * 256, 256, mt * 128, 256);
        src_plain<2>(B, w.w2(l, g), nt * 128, 512);
        EpiS3 e{w.Y(), mt * 128, nt * 128, g};
        gemm_tile<1>(lds, A, B, 512, e);
    }
}

struct EpiGlu {
    const bf16_t* Y; bf16_t* hb; const float* bg; int m0, n0;
    __device__ __forceinline__ void operator()(const f32x16 (&acc)[1][2], int r0, int c0) const {
        ACC_FOREACH(1, acc, r0, c0, {
            const int row = m0 + rl, col = n0 + cl;
            const uint2 t = *(const uint2*)(Y + (size_t)row * DS5 + col);
            const float4 b = *(const float4*)(bg + col);
            uint2 o;
            o.x = pack2(bflo(t.x) * sigmoidf_(v0 + b.x), bfhi(t.x) * sigmoidf_(v1 + b.y));
            o.y = pack2(bflo(t.y) * sigmoidf_(v2 + b.z), bfhi(t.y) * sigmoidf_(v3 + b.w));
            *(uint2*)(hb + (size_t)row * D + col) = o;
        })
    }
};
__device__ __forceinline__ void phase_glu(const Params& p, unsigned char* lds, int l) {
    const WS w{p.ws};
    const XcdIter xi = xcd_iter();
    const int nmt = (l == 0 ? 144 : 128) / xi.nx, nunit = nmt * 4;
    for (int rep = 0; rep < REP_GLU; ++rep)
    for (int u = xi.local; u < nunit; u += xi.nloc) {
        const int mt = (u >> 2) * xi.nx + xi.xcd, nt = u & 3;
        SrcA A; SrcB B;
        src_plain<2>(A, w.Y(), mt * 128, DS5);
        src_plain<2>(B, w.wt_glu(l), nt * 128, 512);
        EpiGlu e{w.Y(), w.hb(), p.in[16] + l * DS5, mt * 128, nt * 128};
        gemm_tile<1>(lds, A, B, 512, e);
    }
}

struct EpiOut {
    const Params* p; const float* mod; int l, m0, n0;
    __device__ __forceinline__ void operator()(const f32x16 (&acc)[2][2], int r0, int c0) const {
        ACC_FOREACH(2, acc, r0, c0, {
            const int row = m0 + rl, col = n0 + cl, m = modrow(row);
            const float4 g1 = *(const float4*)(mod + (size_t)m * 6144 + 2048 + col);
            float* R = Rrow(*p, row) + col;
            const float* res = l == 0 ? (row < NLAT ? p->in[0] + (size_t)row * D + col : p->in[2] + (size_t)(row - NLAT) * D + col) : R;
            const float4 x = *(const float4*)res;
            *(float4*)R = make_float4(DN_ALPHA * x.x + g1.x * v0, DN_ALPHA * x.y + g1.y * v1, DN_ALPHA * x.z + g1.z * v2, DN_ALPHA * x.w + g1.w * v3);
        })
    }
};
__device__ __forceinline__ void phase_outproj(const Params& p, unsigned char* lds, int l) {
    const WS w{p.ws};
    const XcdIter xi = xcd_iter();
    const int nmt = (l == 0 ? 72 : 64) / xi.nx, nunit = nmt * 8;
    for (int rep = 0; rep < (l == 0 ? REP_OUT0 : 1); ++rep)
    for (int u = xi.local; u < nunit; u += xi.nloc) {
        const int mt = (u >> 3) * xi.nx + xi.xcd, nt = u & 7;
        SrcA A; SrcB B;
        src_plain<4>(A, w.hb(), mt * 256, D);
        src_plain<2>(B, w.wt_o(l), nt * 128, D);
        EpiOut e{&p, w.mod(l), l, mt * 256, nt * 128};
        gemm_tile<2>(lds, A, B, D, e);
    }
}

template <bool DRY>
__device__ __forceinline__ void phase_ln1(const Params& p, unsigned char* lds, int l) {
    const WS w{p.ws};
    const int tid = threadIdx.x, lane = tid & 63, wid = tid >> 6;
    float* wl = (float*)lds;
    __syncthreads();
#pragma unroll
    for (int kk = 0; kk < 2; ++kk) {
        const int k = tid + NTHR * kk;
        const int s = ((k >> 8) * 4 + (k & 3)) * 64 + ((k >> 2) & 63);
        const float4 g = *(const float4*)(p.in[25] + ((size_t)l * D + k) * 4);
        const float4* ex = (const float4*)(p.in[27] + ((size_t)l * D + k) * 16);
        const float4 e0 = ex[0], e1 = ex[1], e2 = ex[2], e3 = ex[3];
        *(float4*)(wl + (0 * 1024 + s) * 4) = g;
        *(float4*)(wl + (1 * 1024 + s) * 4) = e0;
        *(float4*)(wl + (2 * 1024 + s) * 4) = e1;
        *(float4*)(wl + (3 * 1024 + s) * 4) = e2;
        *(float4*)(wl + (4 * 1024 + s) * 4) = e3;
    }
    __syncthreads();
    const int nrows = l == 0 ? NROW : NLAT;
    const float* md = w.mod(l);
    const float* lng = p.in[23] + l * D; const float* lnb = p.in[24] + l * D;
    const float brg0 = p.in[26][l * 4 + 0], brg1 = p.in[26][l * 4 + 1], brg2 = p.in[26][l * 4 + 2], brg3 = p.in[26][l * 4 + 3];
    float bre[16];
#pragma unroll
    for (int i = 0; i < 16; ++i) bre[i] = p.in[28][l * 16 + i];
    int k_cls = 0, k_row = 0, nkeep = 0; float k_wlo = 0.f, k_whi = 0.f;
    const int nwv = gridDim.x * NWV, rpw = (nrows + nwv - 1) / nwv;
    int row = (blockIdx.x * NWV + wid) * rpw;
    const int rend = min(nrows, row + rpw);
    float4 pg[4], pb[4], psh[4], psc[4];
#pragma unroll
    for (int i = 0; i < 4; ++i) { pg[i] = *(const float4*)(lng + i * 256 + lane * 4); pb[i] = *(const float4*)(lnb + i * 256 + lane * 4); psh[i] = pg[i]; psc[i] = pg[i]; }
    int mcur = -1;
    float4 vn[4];
    if (row < rend) {
        const float* R0 = Rrow(p, row);
#pragma unroll
        for (int i = 0; i < 4; ++i) vn[i] = *(const float4*)(R0 + i * 256 + lane * 4);
    }
    for (; row < rend; ++row) {
        float* R = Rrow(p, row);
        const int m = modrow(row);
        if (m != mcur) {
            mcur = m;
#pragma unroll
            for (int i = 0; i < 4; ++i) { psh[i] = *(const float4*)(md + (size_t)m * 6144 + 3072 + i * 256 + lane * 4); psc[i] = *(const float4*)(md + (size_t)m * 6144 + 4096 + i * 256 + lane * 4); }
        }
        float h[16];
        float4 v[4];
#pragma unroll
        for (int i = 0; i < 4; ++i) v[i] = vn[i];
        if (row + 1 < rend) {
            const float* Rn = Rrow(p, row + 1);
#pragma unroll
            for (int i = 0; i < 4; ++i) vn[i] = *(const float4*)(Rn + i * 256 + lane * 4);
        }
        float s = 0.f;
#pragma unroll
        for (int i = 0; i < 4; ++i) s += (v[i].x + v[i].y) + (v[i].z + v[i].w);
        const float mean = wave_sum(s) * (1.0f / 1024.0f);
        float q = 0.f;
#pragma unroll
        for (int i = 0; i < 4; ++i) { const float a = v[i].x - mean, b = v[i].y - mean, c = v[i].z - mean, d = v[i].w - mean; q += (a * a + b * b) + (c * c + d * d); }
        const float rs = rsqrtf(wave_sum(q) * (1.0f / 1024.0f) + LN_EPS);
#pragma unroll
        for (int i = 0; i < 4; ++i) {
            const int col = i * 256 + lane * 4;
            const float4 g = pg[i], b = pb[i], sh = psh[i], sc = psc[i];
            float4 x;
            x.x = (v[i].x - mean) * rs * g.x + b.x; x.y = (v[i].y - mean) * rs * g.y + b.y; x.z = (v[i].z - mean) * rs * g.z + b.z; x.w = (v[i].w - mean) * rs * g.w + b.w;
            if (!DRY) *(float4*)(R + col) = x; else { KEEP(x.x); KEEP(x.y); KEEP(x.z); KEEP(x.w); }
            h[i * 4 + 0] = x.x * (1.f + sc.x) + sh.x; h[i * 4 + 1] = x.y * (1.f + sc.y) + sh.y; h[i * 4 + 2] = x.z * (1.f + sc.z) + sh.z; h[i * 4 + 3] = x.w * (1.f + sc.w) + sh.w;
            uint2 o; o.x = pack2(h[i * 4 + 0], h[i * 4 + 1]); o.y = pack2(h[i * 4 + 2], h[i * 4 + 3]);
            if (!DRY) *(uint2*)(w.hb() + (size_t)row * D + col) = o; else { KEEP(o.x); KEEP(o.y); }
        }
        float mylg = 0.f;
#pragma unroll 1
        for (int o4 = 0; o4 < 5; ++o4) {
            float a0 = 0.f, a1 = 0.f, a2 = 0.f, a3 = 0.f;
#pragma unroll
            for (int e = 0; e < 16; ++e) {
                const float4 wv = *(const float4*)(wl + ((o4 * 1024) + e * 64 + lane) * 4);
                a0 += h[e] * wv.x; a1 += h[e] * wv.y; a2 += h[e] * wv.z; a3 += h[e] * wv.w;
            }
            const bool up5 = (lane & 32) != 0, up4 = (lane & 16) != 0;
            const float s0 = up5 ? a0 : a2, s1 = up5 ? a1 : a3;
            const float r0 = __shfl_xor(s0, 32), r1 = __shfl_xor(s1, 32);
            const float b0 = (up5 ? a2 : a0) + r0, b1 = (up5 ? a3 : a1) + r1;
            const float t0 = up4 ? b0 : b1;
            const float r2 = __shfl_xor(t0, 16);
            float c = (up4 ? b1 : b0) + r2;
            c += __shfl_xor(c, 8); c += __shfl_xor(c, 4); c += __shfl_xor(c, 2); c += __shfl_xor(c, 1);
            if ((lane & 15) == o4) mylg = c;
        }
        float lg[20];
#pragma unroll
        for (int i = 0; i < 20; ++i) lg[i] = __shfl(mylg, 16 * (i & 3) + (i >> 2));
        {
            float gl[4];
            gl[0] = lg[0] + brg0; gl[1] = lg[1] + brg1; gl[2] = lg[2] + brg2; gl[3] = lg[3] + brg3;
            int gi = 0; float gm = gl[0];
#pragma unroll
            for (int i = 1; i < 4; ++i) if (gl[i] > gm) { gm = gl[i]; gi = i; }
            float den = 0.f;
#pragma unroll
            for (int i = 0; i < 4; ++i) den += __expf(gl[i] - gm);
            const float gw = 1.0f / den;
            float el[4];
#pragma unroll
            for (int i = 0; i < 4; ++i) {
                float t = lg[4 + i] + bre[i];
                if (gi == 1) t = lg[8 + i] + bre[4 + i]; else if (gi == 2) t = lg[12 + i] + bre[8 + i]; else if (gi == 3) t = lg[16 + i] + bre[12 + i];
                el[i] = t;
            }
            int i1 = 0; float m1 = el[0];
#pragma unroll
            for (int i = 1; i < 4; ++i) if (el[i] > m1) { m1 = el[i]; i1 = i; }
            int i2 = -1; float m2 = -3.0e38f;
#pragma unroll
            for (int i = 0; i < 4; ++i) if (i != i1 && el[i] > m2) { m2 = el[i]; i2 = i; }
            const float e2 = __expf(m2 - m1);
            const float w1 = gw / (1.0f + e2), w2 = gw * e2 / (1.0f + e2);
            const int lo = i1 < i2 ? i1 : i2, hi = i1 < i2 ? i2 : i1;
            const float wlo = i1 < i2 ? w1 : w2, whi = i1 < i2 ? w2 : w1;
            const int pair = lo == 0 ? (hi - 1) : (lo == 1 ? (hi + 1) : 5);
            const int cls = gi * 6 + pair;
            if (lane == nkeep) { k_cls = cls; k_row = row; k_wlo = wlo; k_whi = whi; }
            ++nkeep;
        }
        if (nkeep == 64) {
            if (!DRY) { const int pos = atomicAdd(w.cnt(l) + k_cls, 1); w.list()[(size_t)k_cls * LISTCAP + pos] = k_row; w.lw()[(size_t)k_cls * LISTCAP + pos] = make_float2(k_wlo, k_whi); }
            nkeep = 0;
        }
    }
    if (lane < nkeep) {
        if (!DRY) {
            const int pos = atomicAdd(w.cnt(l) + k_cls, 1);
            w.list()[(size_t)k_cls * LISTCAP + pos] = k_row;
            w.lw()[(size_t)k_cls * LISTCAP + pos] = make_float2(k_wlo, k_whi);
        } else { KEEP(k_cls); KEEP(k_wlo); KEEP(k_whi); }
    }
}

__device__ __forceinline__ void cls_experts(int cls, int& elo, int& ehi) {
    const int g = cls / 6, pr = cls % 6;
    const int lo = pr < 3 ? 0 : (pr < 5 ? 1 : 2);
    const int hi = pr < 3 ? pr + 1 : (pr < 5 ? pr - 1 : 3);
    elo = g * 4 + lo; ehi = g * 4 + hi;
}

struct EpiGU {
    bf16_t* act; const float2* lw; int cnt, pos0, orow0, half, fcol0;
    __device__ __forceinline__ void operator()(const f32x16 (&acc)[1][2], int r0, int c0) const {
        const int hh4 = c0 & 4, wn64 = c0 & 64;
        const int rl = r0, pos = pos0 + rl;
        float wt = 0.f;
        if (pos < cnt) { const float2 ww = lw[pos]; wt = half ? ww.y : ww.x; }
#pragma unroll
        for (int nt = 0; nt < 2; ++nt)
#pragma unroll
            for (int qp = 0; qp < 2; ++qp) {
                const int f = fcol0 + ((wn64 + nt * 32) >> 1) + qp * 8 + hh4;
                const int qg = qp * 2, qu = qp * 2 + 1;
                const float a0 = siluf_(acc[0][nt][qg * 4 + 0]) * acc[0][nt][qu * 4 + 0] * wt;
                const float a1 = siluf_(acc[0][nt][qg * 4 + 1]) * acc[0][nt][qu * 4 + 1] * wt;
                const float a2 = siluf_(acc[0][nt][qg * 4 + 2]) * acc[0][nt][qu * 4 + 2] * wt;
                const float a3 = siluf_(acc[0][nt][qg * 4 + 3]) * acc[0][nt][qu * 4 + 3] * wt;
                uint2 o; o.x = pack2(a0, a1); o.y = pack2(a2, a3);
                *(uint2*)(act + (size_t)(orow0 + rl) * 512 + half * 256 + f) = o;
            }
    }
};
__device__ __forceinline__ void phase_moe_gu(const Params& p, unsigned char* lds, int l) {
    const WS w{p.ws};
    const XcdIter xi = xcd_iter();
    int ntl[NCLS]; int tot = 0;
#pragma unroll
    for (int c = 0; c < NCLS; ++c) { ntl[c] = (w.cnt(l)[c] + 127) >> 7; tot += ntl[c]; }
    const int nmg = (tot + xi.nx - 1) / xi.nx, nunit = nmg * 8;
    const int lr = threadIdx.x >> 3, lc = (threadIdx.x & 7) ^ ((lr >> 1) & 7);
    for (int rep = 0; rep < REP_GU; ++rep)
    for (int u = xi.local; u < nunit; u += xi.nloc) {
        const int mg = (u >> 3) * xi.nx + xi.xcd, nt = u & 7;
        if (mg >= tot) continue;
        int cls = 0, mt = 0, run = 0;
#pragma unroll
        for (int c = 0; c < NCLS; ++c) { if (mg >= run && mg < run + ntl[c]) { cls = c; mt = mg - run; } run += ntl[c]; }
        const int cnt = w.cnt(l)[cls];
        int elo, ehi; cls_experts(cls, elo, ehi);
        const int half = nt >> 2, e = half ? ehi : elo;
        const int* lst = w.list() + (size_t)cls * LISTCAP;
        SrcA A; SrcB B;
#pragma unroll
        for (int j = 0; j < 2; ++j) {
            int pos = mt * 128 + lr + 64 * j; if (pos >= cnt) pos = 0;
            const int tok = lst[pos];
            A.p0[j] = w.hb() + (size_t)tok * D + lc * 8; A.p1[j] = A.p0[j];
        }
        A.split = 1 << 30;
        src_plain<2>(B, w.wt_gu(l, e), (nt & 3) * 128, D);
        EpiGU ep{w.act(), w.lw() + (size_t)cls * LISTCAP, cnt, mt * 128, mg * 128, half, (nt & 3) * 64};
        gemm_tile<1>(lds, A, B, D, ep);
    }
}

struct EpiDown {
    const Params* p; const float* mod; const int* lst; int cnt, pos0, n0;
    __device__ __forceinline__ void operator()(const f32x16 (&acc)[1][2], int r0, int c0) const {
        const int pos = pos0 + r0;
        if (pos < cnt) {
            const int row = lst[pos], m = modrow(row);
            float* R = Rrow(*p, row);
#pragma unroll
            for (int nt = 0; nt < 2; ++nt)
#pragma unroll
                for (int q = 0; q < 4; ++q) {
                    const int col = n0 + c0 + nt * 32 + q * 8;
                    const float4 g2 = *(const float4*)(mod + (size_t)m * 6144 + 5120 + col);
                    const float4 x = *(const float4*)(R + col);
                    *(float4*)(R + col) = make_float4(DN_ALPHA * x.x + g2.x * acc[0][nt][q * 4 + 0], DN_ALPHA * x.y + g2.y * acc[0][nt][q * 4 + 1],
                                                      DN_ALPHA * x.z + g2.z * acc[0][nt][q * 4 + 2], DN_ALPHA * x.w + g2.w * acc[0][nt][q * 4 + 3]);
                }
        }
    }
};
__device__ __forceinline__ void phase_moe_dn(const Params& p, unsigned char* lds, int l) {
    const WS w{p.ws};
    const XcdIter xi = xcd_iter();
    int ntl[NCLS]; int tot = 0;
#pragma unroll
    for (int c = 0; c < NCLS; ++c) { ntl[c] = (w.cnt(l)[c] + 127) >> 7; tot += ntl[c]; }
    const int nmg = (tot + xi.nx - 1) / xi.nx, nunit = nmg * 8;
    for (int u = xi.local; u < nunit; u += xi.nloc) {
        const int mg = (u >> 3) * xi.nx + xi.xcd, nt = u & 7;
        if (mg >= tot) continue;
        int cls = 0, mt = 0, run = 0;
#pragma unroll
        for (int c = 0; c < NCLS; ++c) { if (mg >= run && mg < run + ntl[c]) { cls = c; mt = mg - run; } run += ntl[c]; }
        const int cnt = w.cnt(l)[cls];
        int elo, ehi; cls_experts(cls, elo, ehi);
        SrcA A; SrcB B;
        src_plain<2>(A, w.act(), mg * 128, 512);
        src_split<2>(B, w.wt_dn(l, elo), 256, w.wt_dn(l, ehi), 256, nt * 128, 256);
        EpiDown ep{&p, w.mod(l), w.list() + (size_t)cls * LISTCAP, cnt, mt * 128, nt * 128};
        gemm_tile<1>(lds, A, B, 512, ep);
    }
}

template <bool DRY>
__device__ __forceinline__ void phase_ln2(const Params& p, int l) {
    const WS w{p.ws};
    const int tid = threadIdx.x, lane = tid & 63, wid = tid >> 6;
    const int nrows = l == 0 ? NROW : NLAT;
    const float* lng = p.in[32] + l * D; const float* lnb = p.in[33] + l * D;
    const float* mdn = w.mod(1);
    const int nwv = gridDim.x * NWV, rpw = (nrows + nwv - 1) / nwv;
    int row = (blockIdx.x * NWV + wid) * rpw;
    const int rend = min(nrows, row + rpw);
    float4 pg[4], pb[4], psh[4], psc[4];
#pragma unroll
    for (int i = 0; i < 4; ++i) { pg[i] = *(const float4*)(lng + i * 256 + lane * 4); pb[i] = *(const float4*)(lnb + i * 256 + lane * 4); psh[i] = pg[i]; psc[i] = pg[i]; }
    int mcur = -1;
    float4 vn[4];
    if (row < rend) {
        const float* R0 = Rrow(p, row);
#pragma unroll
        for (int i = 0; i < 4; ++i) vn[i] = *(const float4*)(R0 + i * 256 + lane * 4);
    }
    for (; row < rend; ++row) {
        float* R = Rrow(p, row);
        const int m = modrow(row);
        if (l == 0 && m != mcur) {
            mcur = m;
#pragma unroll
            for (int i = 0; i < 4; ++i) { psh[i] = *(const float4*)(mdn + (size_t)m * 6144 + i * 256 + lane * 4); psc[i] = *(const float4*)(mdn + (size_t)m * 6144 + 1024 + i * 256 + lane * 4); }
        }
        float4 v[4];
#pragma unroll
        for (int i = 0; i < 4; ++i) v[i] = vn[i];
        if (row + 1 < rend) {
            const float* Rn = Rrow(p, row + 1);
#pragma unroll
            for (int i = 0; i < 4; ++i) vn[i] = *(const float4*)(Rn + i * 256 + lane * 4);
        }
        float s = 0.f;
#pragma unroll
        for (int i = 0; i < 4; ++i) s += (v[i].x + v[i].y) + (v[i].z + v[i].w);
        const float mean = wave_sum(s) * (1.0f / 1024.0f);
        float q = 0.f;
#pragma unroll
        for (int i = 0; i < 4; ++i) { const float a = v[i].x - mean, b = v[i].y - mean, c = v[i].z - mean, d = v[i].w - mean; q += (a * a + b * b) + (c * c + d * d); }
        const float rs = rsqrtf(wave_sum(q) * (1.0f / 1024.0f) + LN_EPS);
#pragma unroll
        for (int i = 0; i < 4; ++i) {
            const int col = i * 256 + lane * 4;
            const float4 g = pg[i], b = pb[i];
            float4 x;
            x.x = (v[i].x - mean) * rs * g.x + b.x; x.y = (v[i].y - mean) * rs * g.y + b.y; x.z = (v[i].z - mean) * rs * g.z + b.z; x.w = (v[i].w - mean) * rs * g.w + b.w;
            if (!DRY) *(float4*)(R + col) = x; else { KEEP(x.x); KEEP(x.y); KEEP(x.z); KEEP(x.w); }
            if (l == 0) {
                const float4 sh = psh[i], sc = psc[i];
                uint2 o; o.x = pack2(x.x * (1.f + sc.x) + sh.x, x.y * (1.f + sc.y) + sh.y); o.y = pack2(x.z * (1.f + sc.z) + sh.z, x.w * (1.f + sc.w) + sh.w);
                if (!DRY) *(uint2*)(w.hb() + (size_t)row * D + col) = o; else { KEEP(o.x); KEEP(o.y); }
            }
        }
    }
}

#define XB_TMO      128
#define XB_XCNT(j)  (256  + 64 * (j))
#define XB_XSUB(j)  (1280 + 64 * (j))
#define XB_XGEN(j)  (2304 + 64 * (j))
#define XB_TOP      3328
#define XB_TOPGEN   3392
#define XB_SPIN_CAP (1u << 20)
__device__ __forceinline__ unsigned xb_ld(unsigned* p)              { return __hip_atomic_load(p, __ATOMIC_RELAXED, __HIP_MEMORY_SCOPE_AGENT); }
__device__ __forceinline__ unsigned xb_add(unsigned* p, unsigned v) { return __hip_atomic_fetch_add(p, v, __ATOMIC_RELAXED, __HIP_MEMORY_SCOPE_AGENT); }
__device__ __forceinline__ unsigned xb_xcc_id() { return (unsigned)__builtin_amdgcn_s_getreg((3 << 11) | 20) & 0xFu; }
#define XB_SPIN(cond, bar) do { unsigned _sp = 0; while (cond) { __builtin_amdgcn_s_sleep(1); \
    if ((++_sp & 255u) == 0u) { if (xb_ld(&(bar)[XB_TMO])) break; if (_sp > XB_SPIN_CAP) { atomicAdd(&(bar)[XB_TMO], 1u); break; } } } } while (0)
struct XcdBarrier { unsigned* bar; unsigned x, nloc, nx; };
__device__ __forceinline__ void xcd_barrier_post(XcdBarrier& b, unsigned* bar) {
    b.bar = bar; b.x = xb_xcc_id(); b.nloc = 0u; b.nx = 0u;
    if (threadIdx.x == 0) (void)xb_add(&bar[XB_XCNT(b.x)], 1u);
}
__device__ __forceinline__ void xcd_barrier_complete(unsigned* bar, unsigned x, unsigned& nloc, unsigned& nx) {
    const unsigned G = gridDim.x;
    unsigned sum, cnt, mine, sp = 0u;
    for (;;) {
        sum = 0u; cnt = 0u; mine = 0u;
#pragma unroll
        for (unsigned j = 0; j < 16; ++j) { const unsigned c = xb_ld(&bar[XB_XCNT(j)]); sum += c; cnt += (c > 0u) ? 1u : 0u; mine = (j == x) ? c : mine; }
        if (sum == G) break;
        __builtin_amdgcn_s_sleep(1);
        if ((++sp & 255u) == 0u) { if (xb_ld(&bar[XB_TMO])) break; if (sp > XB_SPIN_CAP) { atomicAdd(&bar[XB_TMO], 1u); break; } }
    }
    nloc = mine > 0u ? mine : 1u; nx = cnt > 0u ? cnt : 1u;
}
__device__ __forceinline__ void xcd_barrier(XcdBarrier& b) {
    asm volatile("s_waitcnt vmcnt(0)" ::: "memory");
    __syncthreads();
    if (threadIdx.x == 0) {
        unsigned* bar = b.bar;
        __builtin_amdgcn_s_waitcnt(0);
        if (b.nloc == 0u) xcd_barrier_complete(bar, b.x, b.nloc, b.nx);
        const unsigned nloc = b.nloc, nx = b.nx;
        const unsigned old = xb_add(&bar[XB_XSUB(b.x)], 1u);
        const unsigned gen = old / nloc;
        if (old + 1u == (gen + 1u) * nloc) {
            __builtin_amdgcn_fence(__ATOMIC_RELEASE, "agent");
            asm volatile("s_waitcnt vmcnt(0)" ::: "memory");
            const unsigned og = xb_add(&bar[XB_TOP], 1u);
            const unsigned tg = og / nx;
            if (og + 1u == (tg + 1u) * nx) xb_add(&bar[XB_TOPGEN], 1u);
            else XB_SPIN(xb_ld(&bar[XB_TOPGEN]) == tg, bar);
            __builtin_amdgcn_fence(__ATOMIC_ACQUIRE, "agent");
            xb_add(&bar[XB_XGEN(b.x)], 1u);
            asm volatile("s_waitcnt vmcnt(0)" ::: "memory");
        } else {
            XB_SPIN(xb_ld(&bar[XB_XGEN(b.x)]) == gen, bar);
            __builtin_amdgcn_fence(__ATOMIC_ACQUIRE, "agent");
            asm volatile("s_waitcnt vmcnt(0)" ::: "memory");
        }
    }
    __syncthreads();
}

constexpr int NPHASE = 2 + 2 * 10;
__global__ void __launch_bounds__(NTHR, 2) mega(Params p, int ph_lo, int ph_hi) {
    extern __shared__ __attribute__((aligned(16))) unsigned char lds[];
    XcdBarrier xb; xcd_barrier_post(xb, (unsigned*)(p.ws + OFF_BAR));
#define RUN(idx, ...) if (ph_lo <= (idx) && (idx) < ph_hi) { __VA_ARGS__; if ((idx) + 1 < ph_hi) for (int rb_ = 0; rb_ < REP_BAR; ++rb_) xcd_barrier(xb); }
    RUN(0, phase_pro_a(p, lds))
    RUN(1, for (int r_ = 0; r_ < REP_PROBC; ++r_) phase_pro_b(p, lds))
#define LAYER(l) \
    RUN(2 + 10 * l + 0, phase_inproj(p, lds, l)) \
    RUN(2 + 10 * l + 1, phase_s1(p, lds, l)) \
    RUN(2 + 10 * l + 2, phase_s2(p, lds, l); if (l == 0) w2_toeplitz_fill(p)) \
    RUN(2 + 10 * l + 3, phase_s3(p, lds, l)) \
    RUN(2 + 10 * l + 4, phase_glu(p, lds, l)) \
    RUN(2 + 10 * l + 5, phase_outproj(p, lds, l)) \
    RUN(2 + 10 * l + 6, if (DRY_LN1) phase_ln1<true>(p, lds, l); phase_ln1<false>(p, lds, l)) \
    RUN(2 + 10 * l + 7, phase_moe_gu(p, lds, l)) \
    RUN(2 + 10 * l + 8, phase_moe_dn(p, lds, l)) \
    RUN(2 + 10 * l + 9, if (DRY_LN2) phase_ln2<true>(p, l); phase_ln2<false>(p, l))
    LAYER(0)
    LAYER(1)
#undef LAYER
#undef RUN
}

extern "C" void kernel_launch(void* const* d_in, const int* in_sizes, int n_in, void* d_out, int out_size, void* d_ws, size_t ws_size, hipStream_t stream) {
    static int grid_blocks = 0;
    if (grid_blocks == 0) {
        if (n_in != 34 || out_size != NLAT * D || ws_size < WS_END) {
            fprintf(stderr, "kernel_launch: unexpected shapes (n_in %d out %d ws %zu need %zu)\n", n_in, out_size, ws_size, (size_t)WS_END);
            grid_blocks = -1; return;
        }
        int dev = 0, cus = 0, per_cu = 0;
        hipGetDevice(&dev);
        hipDeviceGetAttribute(&cus, hipDeviceAttributeMultiprocessorCount, dev);
        if (hipFuncSetAttribute((const void*)mega, hipFuncAttributeMaxDynamicSharedMemorySize, LDS_BYTES) != hipSuccess) fprintf(stderr, "kernel_launch: hipFuncSetAttribute failed\n");
        hipOccupancyMaxActiveBlocksPerMultiprocessor(&per_cu, (const void*)mega, NTHR, LDS_BYTES);
        if (per_cu < 1) per_cu = 1;
        if (per_cu > 1) per_cu = 1;
        grid_blocks = cus * per_cu;
        fprintf(stderr, "kernel_launch: cus %d per_cu %d grid %d ws need %zu have %zu\n", cus, per_cu, grid_blocks, (size_t)WS_END, ws_size);
    }
    if (grid_blocks < 0) return;
    Params p{};
    for (int i = 0; i < 34; ++i) p.in[i] = (const float*)d_in[i];
    p.out = (float*)d_out; p.ws = (unsigned char*)d_ws;
    if (hipMemsetAsync((unsigned char*)d_ws + OFF_BAR, 0, SZ_BAR, stream) != hipSuccess) fprintf(stderr, "memset failed\n");
#if FUSED
    int lo = 0, hi = NPHASE;
    void* args[] = {&p, &lo, &hi};
    hipError_t e = hipLaunchCooperativeKernel((const void*)mega, dim3(grid_blocks), dim3(NTHR), args, LDS_BYTES, stream);
    if (e != hipSuccess) fprintf(stderr, "cooperative launch failed: %s (grid %d)\n", hipGetErrorString(e), grid_blocks);
#else
    for (int ph = 0; ph < NPHASE; ++ph) hipLaunchKernelGGL(mega, dim3(grid_blocks), dim3(NTHR), LDS_BYTES, stream, p, ph, ph + 1);
#endif
}
```

```cpp
#include <hip/hip_runtime.h>
#include <cstdio>
#include <cstdint>

#ifndef FUSED
#define FUSED 1
#endif
#define REP_INPROJ 1
#define REP_S1 1
#define REP_S3 1
#define REP_GLU 1
#define REP_OUT0 1
#define REP_GU 1
#define REP_CONV 1
#define REP_S2 1
#define REP_PRO 1
#define REP_BAR 1
#define PH_REP_IDX -1
#define PROBE_MODE 1
#define PROBE_TINY 0
#define REP_PROBC 1
#define REP_PB_K 1
#define REP_PB_M 1
#define REP_PB_H 1
#define DRY_LN1 0
#define DRY_LN2 0
#define KEEP(x) asm volatile("" :: "v"(x))

typedef unsigned short bf16_t;
typedef __attribute__((ext_vector_type(8))) short bf16x8;
typedef __attribute__((ext_vector_type(16))) float f32x16;

constexpr int D = 1024, NB = 8, SEQ = 2048, CTX = 256;
constexpr int NLAT = NB * SEQ, NCTX = NB * CTX, NROW = NLAT + NCTX;
constexpr int DIN = 1792, DS5 = 512, NG = 32, PS = 64;
constexpr int TCH = 16, NT = 256;
constexpr int NCOL = NROW / TCH;
constexpr int NCOL_LAT = NLAT / TCH;
constexpr int CH_LAT = SEQ / TCH, CH_CTX = CTX / TCH;
constexpr int NSTEP = CH_LAT + CH_CTX;
constexpr int NSEG = 8, SEGLEN = NSTEP / NSEG;
constexpr int NCLS = 24, LISTCAP = NROW;
constexpr int MAXMT = NROW / 128 + NCLS;
constexpr int KSPLIT_MOD = 32;
constexpr int NTHR = 512, NWV = 8;
constexpr float LN_EPS = 1e-5f;
constexpr float DN_ALPHA = 1.4142135623730951f;
constexpr int NPOW = 18;

constexpr size_t AL(size_t x) { return (x + 255) & ~(size_t)255; }
constexpr size_t SZ_WT_IN = (size_t)2 * DIN * D * 2;
constexpr size_t SZ_WT_GLU = (size_t)2 * 512 * 512 * 2;
constexpr size_t SZ_WT_O = (size_t)2 * D * D * 2;
constexpr size_t SZ_WT_GU = (size_t)2 * 16 * 512 * 1024 * 2;
constexpr size_t SZ_WT_DN = (size_t)2 * 16 * 1024 * 256 * 2;
constexpr size_t SZ_MOD = (size_t)2 * 9 * 6144 * 4;
constexpr size_t SZ_LAMPOW = (size_t)2 * 2 * NG * PS * NPOW * 8;
constexpr size_t SZ_BBAR = (size_t)2 * 2 * NG * PS * 16 * 8;
constexpr size_t SZ_KFULL = (size_t)2 * NG * 32 * 256 * 4;
constexpr size_t SZ_M1 = (size_t)2 * NG * 256 * 256 * 2;
constexpr size_t SZ_W2 = (size_t)2 * NG * 256 * 512 * 2;
constexpr size_t SZ_HB = (size_t)NROW * D * 2;
constexpr size_t SZ_UG = (size_t)NG * NROW * 16 * 2;
constexpr size_t SZ_ZR = (size_t)NROW * 1280 * 2;
constexpr size_t SZ_S = (size_t)NG * NCOL * 256 * 4;
constexpr size_t SZ_RCTX = (size_t)NCTX * D * 4;
constexpr size_t SZ_CNT = 256 * 4;
constexpr size_t SZ_LIST = (size_t)NCLS * LISTCAP * 4;
constexpr size_t SZ_LW = (size_t)NCLS * LISTCAP * 8;

constexpr size_t OFF_WT_IN = 0;
constexpr size_t OFF_WT_GLU = OFF_WT_IN + AL(SZ_WT_IN);
constexpr size_t OFF_WT_O = OFF_WT_GLU + AL(SZ_WT_GLU);
constexpr size_t OFF_WT_GU = OFF_WT_O + AL(SZ_WT_O);
constexpr size_t OFF_WT_DN = OFF_WT_GU + AL(SZ_WT_GU);
constexpr size_t OFF_MOD = OFF_WT_DN + AL(SZ_WT_DN);
constexpr size_t OFF_LAMPOW = OFF_MOD + AL(SZ_MOD);
constexpr size_t OFF_BBAR = OFF_LAMPOW + AL(SZ_LAMPOW);
constexpr size_t OFF_KFULL = OFF_BBAR + AL(SZ_BBAR);
constexpr size_t OFF_M1 = OFF_KFULL + AL(SZ_KFULL);
constexpr size_t OFF_W2 = OFF_M1 + AL(SZ_M1);
constexpr size_t OFF_HB = OFF_W2 + AL(SZ_W2);
constexpr size_t OFF_UG = OFF_HB + AL(SZ_HB);
constexpr size_t OFF_ZR = OFF_UG + AL(SZ_UG);
constexpr size_t OFF_S = OFF_ZR + AL(SZ_ZR);
constexpr size_t OFF_RCTX = OFF_S + AL(SZ_S);
constexpr size_t OFF_CNT = OFF_RCTX + AL(SZ_RCTX);
constexpr size_t OFF_LIST = OFF_CNT + AL(SZ_CNT);
constexpr size_t OFF_LW = OFF_LIST + AL(SZ_LIST);
constexpr size_t OFF_BAR = OFF_LW + AL(SZ_LW);
constexpr size_t SZ_BAR = 3456 * 4;
constexpr size_t WS_END = OFF_BAR + AL(SZ_BAR);
static_assert((size_t)KSPLIT_MOD * 2 * 9 * 6144 * 4 <= SZ_ZR, "modp alias");
static_assert((size_t)NG * NCOL * 256 * 2 <= SZ_ZR, "hprev alias");
static_assert((size_t)NROW * 512 * 2 <= SZ_S && (size_t)MAXMT * 128 * 512 * 2 <= SZ_S, "Y/act alias");
static_assert(WS_END <= (size_t)256 * 1024 * 1024, "workspace over 256 MiB");

constexpr int STAGE_BYTES = 49152, LDS_BYTES = 163840;

struct Params {
    const float* in[34];
    float* out;
    unsigned char* ws;
};

__device__ __forceinline__ unsigned f2bf(float f) { unsigned u = __float_as_uint(f); u += 0x7fffu + ((u >> 16) & 1u); return u >> 16; }
__device__ __forceinline__ float bf2f(unsigned h) { return __uint_as_float(h << 16); }
__device__ __forceinline__ unsigned pack2(float a, float b) { return f2bf(a) | (f2bf(b) << 16); }
__device__ __forceinline__ float bflo(unsigned w) { return __uint_as_float(w << 16); }
__device__ __forceinline__ float bfhi(unsigned w) { return __uint_as_float(w & 0xffff0000u); }
__device__ __forceinline__ float wave_sum(float v) {
#pragma unroll
    for (int o = 32; o >= 1; o >>= 1) v += __shfl_xor(v, o);
    return v;
}
template <int CTRL>
__device__ __forceinline__ float dpp_f(float v) { return __int_as_float(__builtin_amdgcn_update_dpp(0, __float_as_int(v), CTRL, 0xf, 0xf, true)); }
__device__ __forceinline__ float row_sum16(float v) {
    v += dpp_f<0xB1>(v);
    v += dpp_f<0x4E>(v);
    v += dpp_f<0x124>(v);
    v += dpp_f<0x128>(v);
    return v;
}
__device__ __forceinline__ float rl_f(float v, int l) { return __int_as_float(__builtin_amdgcn_readlane(__float_as_int(v), l)); }
__device__ __forceinline__ float wave_sum_fast(float v) {
    v = row_sum16(v);
    return (rl_f(v, 0) + rl_f(v, 16)) + (rl_f(v, 32) + rl_f(v, 48));
}
__device__ __forceinline__ float sigmoidf_(float x) { return 1.0f / (1.0f + __expf(-x)); }
__device__ __forceinline__ float siluf_(float x) { return x / (1.0f + __expf(-x)); }
__device__ __forceinline__ float gelu_tanh(float x) {
    const float z = 0.7978845608028654f * (x + 0.044715f * x * x * x);
    const float e = __expf(2.0f * z);
    const float t = 1.0f - 2.0f / (1.0f + e);
    return 0.5f * x * (1.0f + t);
}
__device__ __forceinline__ int modrow(int row) { return row < NLAT ? (row >> 11) : 8; }

struct SrcA { const bf16_t* p0[4]; const bf16_t* p1[4]; int split; };
struct SrcB { const bf16_t* p0[2]; const bf16_t* p1[2]; int split; };
#define LDS_AS __attribute__((address_space(3)))

template <int MF, class EPI, int MODE = 0>
__device__ __forceinline__ void gemm_tile(unsigned char* lds, const SrcA& A, const SrcB& B, const int K, const EPI& epi) {
    const int tid = threadIdx.x, lane = tid & 63, wid = __builtin_amdgcn_readfirstlane(tid >> 6), wm = wid >> 1, wn = wid & 1;
    const int l31 = lane & 31, hh = lane >> 5, sw = (l31 >> 1) & 7;
    const int xbase = (wm * 32 * MF + l31) * 128, wbase = 32768 + (wn * 64 + l31) * 128;
    LDS_AS unsigned char* ldsw = (LDS_AS unsigned char*)lds + wid * 1024;
    f32x16 acc[MF][2];
#pragma unroll
    for (int i = 0; i < MF; ++i)
#pragma unroll
        for (int j = 0; j < 2; ++j)
#pragma unroll
            for (int e = 0; e < 16; ++e) acc[i][j][e] = 0.f;
    const int nk = K >> 6;
#define G_PIECE_A(k_, bufo_, j_) if (MODE != 3) __builtin_amdgcn_global_load_lds((const unsigned*)((k_) < A.split ? A.p0[j_] + (k_) : A.p1[j_] + ((k_) - A.split)), (LDS_AS unsigned*)(ldsw + (bufo_) + (j_) * 8192), 16, 0, 0)
#define G_PIECE_B(k_, bufo_, j_) if (MODE != 3) __builtin_amdgcn_global_load_lds((const unsigned*)((k_) < B.split ? B.p0[j_] + (k_) : B.p1[j_] + ((k_) - B.split)), (LDS_AS unsigned*)(ldsw + (bufo_) + 32768 + (j_) * 8192), 16, 0, 0)
#define G_STAGE(kt_, bufo_) do { const int k_ = (kt_) * 64; \
        _Pragma("unroll") for (int j = 0; j < 2 * MF; ++j) G_PIECE_A(k_, bufo_, j); \
        _Pragma("unroll") for (int j = 0; j < 2; ++j) G_PIECE_B(k_, bufo_, j); } while (0)
#define LDFRAG(ks_, W0_, W1_, X_) do { const int co_ = (((ks_) * 2 + hh) ^ sw) << 4; \
        W0_ = *(const bf16x8*)(lds + cur + wbase + co_); W1_ = *(const bf16x8*)(lds + cur + wbase + 4096 + co_); \
        _Pragma("unroll") for (int mt = 0; mt < MF; ++mt) X_[mt] = *(const bf16x8*)(lds + cur + xbase + mt * 4096 + co_); } while (0)
#define DOMFMA(W0_, W1_, X_) do { if (MODE == 2) { asm volatile("" :: "v"(W0_), "v"(W1_)); _Pragma("unroll") for (int mt = 0; mt < MF; ++mt) asm volatile("" :: "v"(X_[mt])); } else _Pragma("unroll") for (int mt = 0; mt < MF; ++mt) { \
        acc[mt][0] = __builtin_amdgcn_mfma_f32_32x32x16_bf16(W0_, X_[mt], acc[mt][0], 0, 0, 0); \
        acc[mt][1] = __builtin_amdgcn_mfma_f32_32x32x16_bf16(W1_, X_[mt], acc[mt][1], 0, 0, 0); } } while (0)
#define SCHED_FENCE __builtin_amdgcn_sched_barrier(0)
    asm volatile("s_waitcnt vmcnt(0)" ::: "memory");
    __builtin_amdgcn_s_barrier();
    asm volatile("" ::: "memory");
    G_STAGE(0, 0);
    if (nk > 1) G_STAGE(1, STAGE_BYTES);
    int cur = 0, nxt = 2 * STAGE_BYTES;
    for (int kt = 0; kt < nk; ++kt) {
        if (kt + 1 < nk) { if (MF == 2) asm volatile("s_waitcnt vmcnt(6)" ::: "memory"); else asm volatile("s_waitcnt vmcnt(4)" ::: "memory"); }
        else asm volatile("s_waitcnt vmcnt(0)" ::: "memory");
        __builtin_amdgcn_s_barrier();
        asm volatile("" ::: "memory");
        const bool st = kt + 2 < nk;
        const int kn = (kt + 2) * 64;
        bf16x8 wa0, wa1, xa[MF], wb0, wb1, xb[MF];
        LDFRAG(0, wa0, wa1, xa);
        LDFRAG(1, wb0, wb1, xb);
        SCHED_FENCE;
        DOMFMA(wa0, wa1, xa);
        if (st) { if (MF == 2) { G_PIECE_A(kn, nxt, 0); G_PIECE_A(kn, nxt, 1); } else { G_PIECE_A(kn, nxt, 0); } }
        SCHED_FENCE;
        LDFRAG(2, wa0, wa1, xa);
        SCHED_FENCE;
        DOMFMA(wb0, wb1, xb);
        if (st) { if (MF == 2) { G_PIECE_A(kn, nxt, 2); G_PIECE_A(kn, nxt, 3); } else { G_PIECE_A(kn, nxt, 1); } }
        SCHED_FENCE;
        LDFRAG(3, wb0, wb1, xb);
        SCHED_FENCE;
        DOMFMA(wa0, wa1, xa);
        if (st) { if (MF == 2) { G_PIECE_B(kn, nxt, 0); G_PIECE_B(kn, nxt, 1); } else { G_PIECE_B(kn, nxt, 0); } }
        SCHED_FENCE;
        DOMFMA(wb0, wb1, xb);
        if (st) { if (MF == 1) { G_PIECE_B(kn, nxt, 1); } }
        SCHED_FENCE;
        cur = (cur == 2 * STAGE_BYTES) ? 0 : cur + STAGE_BYTES;
        nxt = (nxt == 2 * STAGE_BYTES) ? 0 : nxt + STAGE_BYTES;
    }
#undef G_STAGE
#undef G_PIECE_A
#undef G_PIECE_B
#undef LDFRAG
#undef DOMFMA
    if (MODE == 0) epi(acc, wm * 32 * MF + l31, wn * 64 + hh * 4);
    else { _Pragma("unroll") for (int i = 0; i < MF; ++i) { asm volatile("" :: "v"(acc[i][0]), "v"(acc[i][1])); } }
}

template <int NJ, class S>
__device__ __forceinline__ void src_plain(S& s, const bf16_t* base, int row0, int ld) {
    const int lr = threadIdx.x >> 3, lc = (threadIdx.x & 7) ^ ((lr >> 1) & 7);
#pragma unroll
    for (int j = 0; j < NJ; ++j) { s.p0[j] = base + (size_t)(row0 + lr + 64 * j) * ld + lc * 8; s.p1[j] = s.p0[j]; }
    s.split = 1 << 30;
}
template <int NJ, class S>
__device__ __forceinline__ void src_split(S& s, const bf16_t* base0, int ld0, const bf16_t* base1, int ld1, int row0, int split) {
    const int lr = threadIdx.x >> 3, lc = (threadIdx.x & 7) ^ ((lr >> 1) & 7);
#pragma unroll
    for (int j = 0; j < NJ; ++j) { s.p0[j] = base0 + (size_t)(row0 + lr + 64 * j) * ld0 + lc * 8; s.p1[j] = base1 + (size_t)(row0 + lr + 64 * j) * ld1 + lc * 8; }
    s.split = split;
}
struct XcdIter { int nx, xcd, local, nloc; };
__device__ __forceinline__ XcdIter xcd_iter() {
    XcdIter it; it.nx = (gridDim.x & 7) == 0 ? 8 : 1; it.xcd = blockIdx.x % it.nx; it.local = blockIdx.x / it.nx; it.nloc = gridDim.x / it.nx; return it;
}

#define ACC_FOREACH(MF_, acc, r0, c0, ...) \
    _Pragma("unroll") for (int mt_ = 0; mt_ < MF_; ++mt_) \
    _Pragma("unroll") for (int nt_ = 0; nt_ < 2; ++nt_) \
    _Pragma("unroll") for (int q_ = 0; q_ < 4; ++q_) { \
        const int rl = (r0) + mt_ * 32, cl = (c0) + nt_ * 32 + q_ * 8; \
        const float v0 = acc[mt_][nt_][q_ * 4 + 0], v1 = acc[mt_][nt_][q_ * 4 + 1], v2 = acc[mt_][nt_][q_ * 4 + 2], v3 = acc[mt_][nt_][q_ * 4 + 3]; \
        __VA_ARGS__ }

struct WS {
    unsigned char* b;
    __device__ bf16_t* wt_in(int l) const { return (bf16_t*)(b + OFF_WT_IN) + (size_t)l * DIN * D; }
    __device__ bf16_t* wt_glu(int l) const { return (bf16_t*)(b + OFF_WT_GLU) + (size_t)l * 512 * 512; }
    __device__ bf16_t* wt_o(int l) const { return (bf16_t*)(b + OFF_WT_O) + (size_t)l * D * D; }
    __device__ bf16_t* wt_gu(int l, int e) const { return (bf16_t*)(b + OFF_WT_GU) + (size_t)(l * 16 + e) * 512 * 1024; }
    __device__ bf16_t* wt_dn(int l, int e) const { return (bf16_t*)(b + OFF_WT_DN) + (size_t)(l * 16 + e) * 1024 * 256; }
    __device__ float* mod(int l) const { return (float*)(b + OFF_MOD) + (size_t)l * 9 * 6144; }
    __device__ float* modp() const { return (float*)(b + OFF_ZR); }
    __device__ float2* lampow(int l, int d, int g) const { return (float2*)(b + OFF_LAMPOW) + (size_t)((l * 2 + d) * NG + g) * PS * NPOW; }
    __device__ float2* bbar(int l, int d, int g) const { return (float2*)(b + OFF_BBAR) + (size_t)((l * 2 + d) * NG + g) * PS * 16; }
    __device__ float* kfull(int l, int g) const { return (float*)(b + OFF_KFULL) + (size_t)(l * NG + g) * 32 * 256; }
    __device__ bf16_t* m1(int l, int g) const { return (bf16_t*)(b + OFF_M1) + (size_t)(l * NG + g) * 256 * 256; }
    __device__ bf16_t* w2(int l, int g) const { return (bf16_t*)(b + OFF_W2) + (size_t)(l * NG + g) * 256 * 512; }
    __device__ bf16_t* hb() const { return (bf16_t*)(b + OFF_HB); }
    __device__ bf16_t* ug() const { return (bf16_t*)(b + OFF_UG); }
    __device__ bf16_t* zr() const { return (bf16_t*)(b + OFF_ZR); }
    __device__ bf16_t* hprev() const { return (bf16_t*)(b + OFF_ZR); }
    __device__ float* S() const { return (float*)(b + OFF_S); }
    __device__ bf16_t* Y() const { return (bf16_t*)(b + OFF_S); }
    __device__ bf16_t* act() const { return (bf16_t*)(b + OFF_S); }
    __device__ float* rctx() const { return (float*)(b + OFF_RCTX); }
    __device__ int* cnt(int l) const { return (int*)(b + OFF_CNT) + l * 32; }
    __device__ int* list() const { return (int*)(b + OFF_LIST); }
    __device__ float2* lw() const { return (float2*)(b + OFF_LW); }
};
__device__ __forceinline__ float* Rrow(const Params& p, int row) {
    return row < NLAT ? p.out + (size_t)row * D : (float*)(p.ws + OFF_RCTX) + (size_t)(row - NLAT) * D;
}

__device__ __forceinline__ void transpose_tile(unsigned char* lds, const float* src, int ldsrc, int k0, int n0, bf16_t* dst, int lddst, int rowmode) {
    float* tile = (float*)lds;
    const int tid = threadIdx.x;
    __syncthreads();
#pragma unroll
    for (int pass = 0; pass < 2; ++pass) {
        const int k = pass * 32 + (tid >> 4), n4 = (tid & 15) * 4;
        const float4 v = *(const float4*)(src + (size_t)(k0 + k) * ldsrc + n0 + n4);
        tile[k * 65 + n4 + 0] = v.x; tile[k * 65 + n4 + 1] = v.y; tile[k * 65 + n4 + 2] = v.z; tile[k * 65 + n4 + 3] = v.w;
    }
    __syncthreads();
    {
        const int n = tid & 63, kc = tid >> 6;
        float f[8];
#pragma unroll
        for (int i = 0; i < 8; ++i) f[i] = tile[(kc * 8 + i) * 65 + n];
        const int ng = n0 + n;
        int drow = ng;
        if (rowmode == 1) drow = ((ng >> 3) << 4) + (ng & 7);
        else if (rowmode == 2) drow = ((ng >> 3) << 4) + 8 + (ng & 7);
        uint4 o; o.x = pack2(f[0], f[1]); o.y = pack2(f[2], f[3]); o.z = pack2(f[4], f[5]); o.w = pack2(f[6], f[7]);
        *(uint4*)(dst + (size_t)drow * lddst + k0 + kc * 8) = o;
    }
}

__device__ __forceinline__ void phase_pro_a(const Params& p, unsigned char* lds) {
    const WS w{p.ws};
    const int tid = threadIdx.x;
    if (blockIdx.x == 0 && tid < 64) ((int*)(p.ws + OFF_CNT))[tid] = 0;
    constexpr int N_MOD = 2 * 3 * KSPLIT_MOD, N_TAB = 16, N_WT = 2 * 3840;
    for (int rep = 0; rep < REP_PRO; ++rep)
    for (int it = blockIdx.x; it < N_MOD + N_TAB + N_WT; it += gridDim.x) {
        if (it < N_MOD) {
            const int l = it / (3 * KSPLIT_MOD), rem = it % (3 * KSPLIT_MOD), cb = rem / KSPLIT_MOD, ks = rem % KSPLIT_MOD;
            float* sc = (float*)lds;
            __syncthreads();
            for (int i = tid; i < 9 * 32; i += NTHR) {
                const int r = i >> 5, kk = i & 31, k = ks * 32 + kk;
                const float cv = r < 8 ? p.in[1][r * D + k] : p.in[3][k];
                sc[i] = siluf_(cv);
            }
            __syncthreads();
            float acc[9][4];
#pragma unroll
            for (int r = 0; r < 9; ++r) { acc[r][0] = acc[r][1] = acc[r][2] = acc[r][3] = 0.f; }
            const float* wm = p.in[4] + ((size_t)l * D + ks * 32) * 6144 + cb * 2048 + tid * 4;
#pragma unroll 8
            for (int kk = 0; kk < 32; ++kk) {
                const float4 v = *(const float4*)(wm + (size_t)kk * 6144);
#pragma unroll
                for (int r = 0; r < 9; ++r) { const float s = sc[r * 32 + kk]; acc[r][0] += s * v.x; acc[r][1] += s * v.y; acc[r][2] += s * v.z; acc[r][3] += s * v.w; }
            }
            float* mp = w.modp() + ((size_t)(ks * 2 + l) * 9) * 6144 + cb * 2048 + tid * 4;
#pragma unroll
            for (int r = 0; r < 9; ++r) *(float4*)(mp + (size_t)r * 6144) = make_float4(acc[r][0], acc[r][1], acc[r][2], acc[r][3]);
        } else if (it < N_MOD + N_TAB) {
            const int id = (it - N_MOD) * NTHR + tid;
            const int pp = id & 63, g = (id >> 6) & 31, d = (id >> 11) & 1, l = id >> 12;
            const int i3 = (l * 2 + d) * NG + g;
            const double dt = exp((double)p.in[9][i3]);
            const double are = (double)p.in[7][i3 * PS + pp], aim = (double)p.in[8][i3 * PS + pp];
            float2* lp = w.lampow(l, d, g) + pp * NPOW;
            double lbr = 0, lbi = 0;
            for (int k = 0; k < NPOW; ++k) {
                const double kk = (k == 17) ? (double)(TCH * SEGLEN) : (double)k;
                const double mag = exp(kk * are * dt);
                double s, c; sincos(kk * aim * dt, &s, &c);
                lp[k] = make_float2((float)(mag * c), (float)(mag * s));
                if (k == 1) { lbr = mag * c; lbi = mag * s; }
            }
            const double nr = lbr - 1.0, ni = lbi, den = are * are + aim * aim;
            const double cr = (nr * are + ni * aim) / den, ci = (ni * are - nr * aim) / den;
            float2* bb = w.bbar(l, d, g) + pp * 16;
            for (int n = 0; n < 16; ++n) {
                const double br = (double)p.in[10][(size_t)(i3 * PS + pp) * 16 + n], bi = (double)p.in[11][(size_t)(i3 * PS + pp) * 16 + n];
                bb[n] = make_float2((float)(cr * br - ci * bi), (float)(cr * bi + ci * br));
            }
        } else {
            int t = it - N_MOD - N_TAB;
            const int l = t / 3840; t %= 3840;
            if (t < 448) { const int kt = t / 28, nt = t % 28; transpose_tile(lds, p.in[6] + (size_t)l * D * DIN, DIN, kt * 64, nt * 64, w.wt_in(l), D, 0); }
            else if (t < 512) { t -= 448; const int kt = t / 8, nt = t % 8; transpose_tile(lds, p.in[15] + (size_t)l * 512 * 512, 512, kt * 64, nt * 64, w.wt_glu(l), 512, 0); }
            else if (t < 768) { t -= 512; const int kt = t / 16, nt = t % 16; transpose_tile(lds, p.in[22] + (size_t)l * D * D, D, kt * 64, nt * 64, w.wt_o(l), D, 0); }
            else if (t < 1792) { t -= 768; const int e = t / 64, r = t % 64, kt = r / 4, nt = r % 4; transpose_tile(lds, p.in[29] + (size_t)(l * 16 + e) * D * 256, 256, kt * 64, nt * 64, w.wt_gu(l, e), D, 1); }
            else if (t < 2816) { t -= 1792; const int e = t / 64, r = t % 64, kt = r / 4, nt = r % 4; transpose_tile(lds, p.in[30] + (size_t)(l * 16 + e) * D * 256, 256, kt * 64, nt * 64, w.wt_gu(l, e), D, 2); }
            else { t -= 2816; const int e = t / 64, r = t % 64, kt = r / 16, nt = r % 16; transpose_tile(lds, p.in[31] + (size_t)(l * 16 + e) * 256 * D, D, kt * 64, nt * 64, w.wt_dn(l, e), 256, 0); }
        }
    }
}

__device__ __forceinline__ void phase_pro_b(const Params& p, unsigned char* lds) {
    const WS w{p.ws};
    const int tid = threadIdx.x;
    const int gt = blockIdx.x * NTHR + tid, gs = gridDim.x * NTHR;
    for (int rep = 0; rep < REP_PB_K; ++rep)
    for (int it = blockIdx.x; it < 2 * NG * 2; it += gridDim.x) {
        const int d = it & 1, g = (it >> 1) & 31, l = it >> 6;
        float2* Lp = (float2*)lds;
        float2* Bb = Lp + 64 * 16;
        float2* Cc = Bb + 64 * 16;
        __syncthreads();
        const float2* lp = w.lampow(l, d, g); const float2* bb = w.bbar(l, d, g);
        const float* cre = p.in[12] + (size_t)((l * 2 + d) * NG + g) * 16 * PS; const float* cim = p.in[13] + (size_t)((l * 2 + d) * NG + g) * 16 * PS;
        for (int i = tid; i < 1024; i += NTHR) {
            Lp[i] = lp[(i >> 4) * NPOW + (i & 15)];
            Bb[i] = bb[i];
            Cc[i] = make_float2(cre[i], cim[i]);
        }
        __syncthreads();
        const int no = (tid >> 4) & 15, ni = tid & 15, th = tid >> 8;
        float acc[8];
#pragma unroll
        for (int t = 0; t < 8; ++t) acc[t] = 0.f;
        for (int pp = 0; pp < PS; ++pp) {
            const float2 c = Cc[no * 64 + pp], b = Bb[pp * 16 + ni];
            const float cr = c.x * b.x - c.y * b.y, ci = c.x * b.y + c.y * b.x;
#pragma unroll
            for (int t = 0; t < 8; ++t) { const float2 L = Lp[pp * 16 + th * 8 + t]; acc[t] += cr * L.x - ci * L.y; }
        }
        if (d == 0 && th == 0) acc[0] += (no == ni) ? p.in[14][l * DS5 + g * 16 + no] : 0.f;
        float* kf = w.kfull(l, g);
#pragma unroll
        for (int t = 0; t < 8; ++t) {
            const int tau = th * 8 + t;
            const int ti = d == 0 ? 15 + tau : (tau == 0 ? 31 : 15 - tau);
            kf[(ti * 16 + no) * 16 + ni] = acc[t];
        }
    }
    for (int rep = 0; rep < REP_PB_M; ++rep) {
    for (int i = gt; i < 2 * 9 * 6144; i += gs) {
        const int l = i / (9 * 6144), n = i % 6144;
        float s = p.in[5][l * 6144 + n];
        const float* mp = w.modp() + i;
#pragma unroll
        for (int ks = 0; ks < KSPLIT_MOD; ++ks) s += mp[(size_t)ks * 2 * 9 * 6144];
        ((float*)(p.ws + OFF_MOD))[i] = s;
    }
    for (int i = gt; i < 2 * NG * 256 * 32; i += gs) {
        const int c8 = i & 31, row = (i >> 5) & 255, lg = i >> 13, g = lg & 31, l = lg >> 5;
        const int d = row >> 7, pp = (row & 127) >> 1, c = row & 1, j = c8 >> 1, n0 = (c8 & 1) * 8;
        const int e = d == 0 ? (TCH - 1 - j) : j;
        const float2 L = w.lampow(l, d, g)[pp * NPOW + e];
        const float2* bb = w.bbar(l, d, g) + pp * 16 + n0;
        float f[8];
#pragma unroll
        for (int n = 0; n < 8; ++n) { const float2 Bv = bb[n]; f[n] = c == 0 ? (L.x * Bv.x - L.y * Bv.y) : (L.x * Bv.y + L.y * Bv.x); }
        uint4 o; o.x = pack2(f[0], f[1]); o.y = pack2(f[2], f[3]); o.z = pack2(f[4], f[5]); o.w = pack2(f[6], f[7]);
        *(uint4*)(w.m1(l, g) + (size_t)row * 256 + c8 * 8) = o;
    }
    for (int i = gt; i < 2 * NG * 256 * 32; i += gs) {
        const int c8 = i & 31, r = (i >> 5) & 255, lg = i >> 13, g = lg & 31, l = lg >> 5;
        const int jo = r >> 4, no = r & 15;
        const int kk = c8 * 8, d = kk >> 7, p0 = (kk & 127) >> 1;
        const int e = d == 0 ? (jo + 1) : (TCH - jo);
        const float* cre = p.in[12] + ((size_t)((l * 2 + d) * NG + g) * 16 + no) * PS;
        const float* cim = p.in[13] + ((size_t)((l * 2 + d) * NG + g) * 16 + no) * PS;
        const float2* lp = w.lampow(l, d, g);
        float f[8];
#pragma unroll
        for (int q = 0; q < 4; ++q) {
            const int pp = p0 + q;
            const float2 L = lp[pp * NPOW + e];
            const float cr = cre[pp], ci = cim[pp];
            f[2 * q] = cr * L.x - ci * L.y;
            f[2 * q + 1] = -(cr * L.y + ci * L.x);
        }
        uint4 o; o.x = pack2(f[0], f[1]); o.y = pack2(f[2], f[3]); o.z = pack2(f[4], f[5]); o.w = pack2(f[6], f[7]);
        *(uint4*)(w.w2(l, g) + (size_t)r * 512 + 256 + c8 * 8) = o;
    }
    }
    {
        float* shsc = (float*)lds;
        for (int rep = 0; rep < REP_PB_H; ++rep)
        for (int it = blockIdx.x; it < NROW / 32; it += gridDim.x) {
            const int row0 = it * 32, m = modrow(row0);
            __syncthreads();
            for (int i = tid; i < 2048; i += NTHR) {
                float sacc = p.in[5][i];
                const float* mp = w.modp() + (size_t)m * 6144 + i;
#pragma unroll
                for (int ks = 0; ks < KSPLIT_MOD; ++ks) sacc += mp[(size_t)ks * 2 * 9 * 6144];
                shsc[i] = sacc;
            }
            __syncthreads();
            for (int i0 = tid; i0 < 32 * 128; i0 += 4 * NTHR) {
                float4 a[4], b[4];
#pragma unroll
                for (int u = 0; u < 4; ++u) {
                    const int i = i0 + u * NTHR, row = row0 + (i >> 7), c8 = (i & 127) * 8;
                    const float* xs = row < NLAT ? p.in[0] + (size_t)row * D : p.in[2] + (size_t)(row - NLAT) * D;
                    a[u] = *(const float4*)(xs + c8); b[u] = *(const float4*)(xs + c8 + 4);
                }
#pragma unroll
                for (int u = 0; u < 4; ++u) {
                    const int i = i0 + u * NTHR, row = row0 + (i >> 7), c8 = (i & 127) * 8;
                    const float4 s0 = *(const float4*)(shsc + c8), s1 = *(const float4*)(shsc + c8 + 4), c0 = *(const float4*)(shsc + 1024 + c8), c1 = *(const float4*)(shsc + 1024 + c8 + 4);
                    uint4 o;
                    o.x = pack2(a[u].x * (1.f + c0.x) + s0.x, a[u].y * (1.f + c0.y) + s0.y);
                    o.y = pack2(a[u].z * (1.f + c0.z) + s0.z, a[u].w * (1.f + c0.w) + s0.w);
                    o.z = pack2(b[u].x * (1.f + c1.x) + s1.x, b[u].y * (1.f + c1.y) + s1.y);
                    o.w = pack2(b[u].z * (1.f + c1.z) + s1.z, b[u].w * (1.f + c1.w) + s1.w);
                    *(uint4*)(w.hb() + (size_t)row * D + c8) = o;
                }
            }
        }
    }
}

__device__ __forceinline__ void w2_toeplitz_fill(const Params& p) {
    const WS w{p.ws};
    const int gt = blockIdx.x * NTHR + threadIdx.x, gs = gridDim.x * NTHR;
    for (int i = gt; i < 2 * NG * 256 * 32; i += gs) {
        const int c8 = i & 31, r = (i >> 5) & 255, lg = i >> 13, g = lg & 31, l = lg >> 5;
        const int jo = r >> 4, no = r & 15, ji = c8 >> 1, n0 = (c8 & 1) * 8;
        const float* kf = w.kfull(l, g) + ((size_t)(jo - ji + 15) * 16 + no) * 16 + n0;
        float f[8];
#pragma unroll
        for (int n = 0; n < 8; ++n) f[n] = kf[n];
        if (jo == ji) {
            const float* k2 = w.kfull(l, g) + ((size_t)31 * 16 + no) * 16 + n0;
#pragma unroll
            for (int n = 0; n < 8; ++n) f[n] += k2[n];
        }
        uint4 o; o.x = pack2(f[0], f[1]); o.y = pack2(f[2], f[3]); o.z = pack2(f[4], f[5]); o.w = pack2(f[6], f[7]);
        *(uint4*)(w.w2(l, g) + (size_t)r * 512 + c8 * 8) = o;
    }
}

struct EpiInproj {
    bf16_t* ug; bf16_t* zr; int m0, n0;
    __device__ __forceinline__ void operator()(const f32x16 (&acc)[2][2], int r0, int c0) const {
        ACC_FOREACH(2, acc, r0, c0, {
            const int row = m0 + rl, col = n0 + cl;
            uint2 o; o.x = pack2(v0, v1); o.y = pack2(v2, v3);
            if (col < DS5) *(uint2*)(ug + ((size_t)(col >> 4) * NROW + row) * 16 + (col & 15)) = o;
            else *(uint2*)(zr + (size_t)row * 1280 + (col - DS5)) = o;
        })
    }
};
__device__ __forceinline__ void phase_inproj(const Params& p, unsigned char* lds, int l) {
    const WS w{p.ws};
    const XcdIter xi = xcd_iter();
    const int nlat = 64 / xi.nx, nctx = 8 / xi.nx, ctxn = l == 0 ? 14 : 4;
    const int nunit = nlat * 14 + nctx * ctxn;
    for (int rep = 0; rep < REP_INPROJ; ++rep)
    for (int u = xi.local; u < nunit; u += xi.nloc) {
        int mt, nt;
        if (u < nlat * 14) { mt = (u / 14) * xi.nx + xi.xcd; nt = u % 14; }
        else { const int v = u - nlat * 14; mt = 64 + (v / ctxn) * xi.nx + xi.xcd; nt = v % ctxn; }
        SrcA A; SrcB B;
        if (rep == 0) {
            src_plain<4>(A, w.hb(), mt * 256, D);
            src_plain<2>(B, w.wt_in(l), nt * 128, D);
            EpiInproj e{w.ug(), w.zr(), mt * 256, nt * 128};
            gemm_tile<2>(lds, A, B, D, e);
        } else {
            src_plain<4>(A, w.hb(), PROBE_TINY ? 0 : mt * 256, D);
            src_plain<2>(B, w.wt_in(l), PROBE_TINY ? 0 : nt * 128, D);
            EpiInproj e{w.ug(), w.zr(), mt * 256, nt * 128};
            gemm_tile<2, EpiInproj, PROBE_MODE>(lds, A, B, D, e);
        }
    }
}

struct EpiS1 {
    float* S; int m0, n0;
    __device__ __forceinline__ void operator()(const f32x16 (&acc)[1][2], int r0, int c0) const {
        ACC_FOREACH(1, acc, r0, c0, {
            *(float4*)(S + (size_t)(m0 + rl) * 256 + n0 + cl) = make_float4(v0, v1, v2, v3);
        })
    }
};

__device__ __forceinline__ void conv_sc(const Params& p, int l, int nrows) {
    const WS w{p.ws};
    const float* wsc = p.in[17] + (size_t)l * 3 * 256;
    const int gt = blockIdx.x * NTHR + threadIdx.x, gs = gridDim.x * NTHR;
    for (int i = gt; i < nrows * 16; i += gs) {
        const int row = i >> 4, c16 = (i & 15) * 16;
        int pos, len;
        if (row < NLAT) { pos = row & 63; len = 64; } else { pos = (row - NLAT) & 255; len = 256; }
        const bf16_t* zr = w.zr() + (size_t)row * 1280;
        uint4 cg[3][2], vv[3][2];
#pragma unroll
        for (int j = 0; j < 3; ++j) {
            const bool ok = (pos + j - 1 >= 0) && (pos + j - 1 < len);
#pragma unroll
            for (int u = 0; u < 2; ++u) {
                if (ok) { cg[j][u] = *(const uint4*)(zr + (ptrdiff_t)(j - 1) * 1280 + 256 + c16 + u * 8); vv[j][u] = *(const uint4*)(zr + (ptrdiff_t)(j - 1) * 1280 + 512 + c16 + u * 8); }
                else { cg[j][u] = make_uint4(0, 0, 0, 0); vv[j][u] = make_uint4(0, 0, 0, 0); }
            }
        }
        uint4 bg[2];
#pragma unroll
        for (int u = 0; u < 2; ++u) bg[u] = *(const uint4*)(zr + c16 + u * 8);
#pragma unroll
        for (int u = 0; u < 2; ++u) {
            float accv[8];
#pragma unroll
            for (int e = 0; e < 8; ++e) accv[e] = 0.f;
#pragma unroll
            for (int j = 0; j < 3; ++j) {
                const float4 wa = *(const float4*)(wsc + j * 256 + c16 + u * 8), wb = *(const float4*)(wsc + j * 256 + c16 + u * 8 + 4);
                const uint4 c = cg[j][u], v = vv[j][u];
                accv[0] += wa.x * bflo(c.x) * bflo(v.x); accv[1] += wa.y * bfhi(c.x) * bfhi(v.x);
                accv[2] += wa.z * bflo(c.y) * bflo(v.y); accv[3] += wa.w * bfhi(c.y) * bfhi(v.y);
                accv[4] += wb.x * bflo(c.z) * bflo(v.z); accv[5] += wb.y * bfhi(c.z) * bfhi(v.z);
                accv[6] += wb.z * bflo(c.w) * bflo(v.w); accv[7] += wb.w * bfhi(c.w) * bfhi(v.w);
            }
            uint4 o;
            o.x = pack2(accv[0] * bflo(bg[u].x), accv[1] * bfhi(bg[u].x));
            o.y = pack2(accv[2] * bflo(bg[u].y), accv[3] * bfhi(bg[u].y));
            o.z = pack2(accv[4] * bflo(bg[u].z), accv[5] * bfhi(bg[u].z));
            o.w = pack2(accv[6] * bflo(bg[u].w), accv[7] * bfhi(bg[u].w));
            *(uint4*)(w.hb() + (size_t)row * D + 512 + c16 + u * 8) = o;
        }
    }
}

__device__ __forceinline__ void conv_cf(const Params& p, unsigned char* lds, int l, bool with_ctx) {
    const WS w{p.ws};
    float* P = (float*)lds;
    const int tid = threadIdx.x, lane = tid & 63, wid = tid >> 6;
    const float* wdw = p.in[18] + (size_t)l * 31 * 256 + lane * 4;
    const float4 bdw = *(const float4*)(p.in[19] + l * 256 + lane * 4);
    const float4 lg = *(const float4*)(p.in[20] + l * 256 + lane * 4);
    const float4 lb = *(const float4*)(p.in[21] + l * 256 + lane * 4);
    const int nitem = 512 + (with_ctx ? 64 : 0);
    for (int it = blockIdx.x; it < nitem; it += gridDim.x) {
        const bool lat = it < 512;
        int base, nslot, s0 = 0;
        if (lat) { base = (it >> 6) * SEQ + (it & 63); nslot = 32; }
        else { const int j = it - 512; s0 = (j & 7) * 32; base = NLAT + (j >> 3) * CTX; nslot = 62; }
        __syncthreads();
        for (int task = tid; task < nslot * 32; task += NTHR) {
            const int slot = task >> 5, c8 = (task & 31) * 8;
            int row; bool valid = true;
            if (lat) row = base + slot * 64;
            else { const int sq = s0 - 15 + slot; valid = sq >= 0 && sq < CTX; row = base + sq; }
            float f[8];
            if (valid) {
                const bf16_t* zr = w.zr() + (size_t)row * 1280;
                const uint4 ga = *(const uint4*)(zr + 768 + c8), gb = *(const uint4*)(zr + 1024 + c8);
                f[0] = bflo(ga.x) * sigmoidf_(bflo(gb.x)); f[1] = bfhi(ga.x) * sigmoidf_(bfhi(gb.x));
                f[2] = bflo(ga.y) * sigmoidf_(bflo(gb.y)); f[3] = bfhi(ga.y) * sigmoidf_(bfhi(gb.y));
                f[4] = bflo(ga.z) * sigmoidf_(bflo(gb.z)); f[5] = bfhi(ga.z) * sigmoidf_(bfhi(gb.z));
                f[6] = bflo(ga.w) * sigmoidf_(bflo(gb.w)); f[7] = bfhi(ga.w) * sigmoidf_(bfhi(gb.w));
            } else {
#pragma unroll
                for (int e = 0; e < 8; ++e) f[e] = 0.f;
            }
            *(float4*)(P + slot * 256 + c8) = make_float4(f[0], f[1], f[2], f[3]);
            *(float4*)(P + slot * 256 + c8 + 4) = make_float4(f[4], f[5], f[6], f[7]);
        }
        __syncthreads();
        constexpr int OPW = 32 / NWV;
        const int o0 = wid * OPW;
        float4 a[OPW];
#pragma unroll
        for (int o = 0; o < OPW; ++o) a[o] = bdw;
        if (lat) {
#pragma unroll 1
            for (int k = 0; k < 31; ++k) {
                const float4 wv = *(const float4*)(wdw + k * 256);
#pragma unroll
                for (int o = 0; o < OPW; ++o) {
                    const int rr = o0 + o + k - 15;
                    if (rr >= 0 && rr < 32) {
                        const float4 pv = *(const float4*)(P + rr * 256 + lane * 4);
                        a[o].x += wv.x * pv.x; a[o].y += wv.y * pv.y; a[o].z += wv.z * pv.z; a[o].w += wv.w * pv.w;
                    }
                }
            }
        } else {
#pragma unroll 1
            for (int k = 0; k < 31; ++k) {
                const float4 wv = *(const float4*)(wdw + k * 256);
#pragma unroll
                for (int o = 0; o < OPW; ++o) {
                    const float4 pv = *(const float4*)(P + (o0 + o + k) * 256 + lane * 4);
                    a[o].x += wv.x * pv.x; a[o].y += wv.y * pv.y; a[o].z += wv.z * pv.z; a[o].w += wv.w * pv.w;
                }
            }
        }
#pragma unroll
        for (int o = 0; o < OPW; ++o) {
            const int row = lat ? base + (o0 + o) * 64 : base + s0 + o0 + o;
            const float mean = wave_sum_fast(a[o].x + a[o].y + a[o].z + a[o].w) * (1.0f / 256.0f);
            const float dx = a[o].x - mean, dy = a[o].y - mean, dz = a[o].z - mean, dw = a[o].w - mean;
            const float var = wave_sum_fast(dx * dx + dy * dy + dz * dz + dw * dw) * (1.0f / 256.0f);
            const float rs = rsqrtf(var + LN_EPS);
            const float y0 = siluf_(dx * rs * lg.x + lb.x), y1 = siluf_(dy * rs * lg.y + lb.y), y2 = siluf_(dz * rs * lg.z + lb.z), y3 = siluf_(dw * rs * lg.w + lb.w);
            uint2 ov; ov.x = pack2(y0, y1); ov.y = pack2(y2, y3);
            *(uint2*)(w.hb() + (size_t)row * D + 768 + lane * 4) = ov;
        }
    }
}

__device__ __forceinline__ void phase_s1(const Params& p, unsigned char* lds, int l) {
    const WS w{p.ws};
    const XcdIter xi = xcd_iter();
    const int nunit = (NG / xi.nx) * 18;
    for (int rep = 0; rep < REP_S1; ++rep)
    for (int u = xi.local; u < nunit; u += xi.nloc) {
        const int g = (u / 18) * xi.nx + xi.xcd, r = u % 18, mt = r >> 1, nt = r & 1;
        SrcA A; SrcB B;
        src_plain<2>(A, w.ug() + (size_t)g * NROW * 16, mt * 128, 256);
        src_plain<2>(B, w.m1(l, g), nt * 128, 256);
        EpiS1 e{w.S() + (size_t)g * NCOL * 256, mt * 128, nt * 128};
        gemm_tile<1>(lds, A, B, 256, e);
    }
    for (int rep = 0; rep < REP_CONV; ++rep) {
    conv_sc(p, l, l == 0 ? NROW : NLAT);
    conv_cf(p, lds, l, l == 0);
    }
}

__device__ __forceinline__ int chunk_col(int d, int b, int step) {
    if (step < CH_CTX) { const int c = d == 0 ? step : (CH_CTX - 1 - step); return NCOL_LAT + b * CH_CTX + c; }
    const int s = step - CH_CTX; const int c = d == 0 ? s : (CH_LAT - 1 - s); return b * CH_LAT + c;
}
__device__ __forceinline__ void phase_s2(const Params& p, unsigned char* lds, int l) {
    const WS w{p.ws};
    float2* Fs = (float2*)lds;
    const int tid = threadIdx.x, seg = tid >> 6, pp = tid & 63;
    for (int rep = 0; rep < REP_S2; ++rep)
    for (int it = blockIdx.x; it < NG * 2 * NB; it += gridDim.x) {
        const int b = it & 7, d = (it >> 3) & 1, g = it >> 4;
        const float2 A = w.lampow(l, d, g)[pp * NPOW + 16], A18 = w.lampow(l, d, g)[pp * NPOW + 17];
        const float* S = w.S() + (size_t)g * NCOL * 256 + d * 128 + 2 * pp;
        bf16_t* Hp = w.hprev() + (size_t)g * NCOL * 256 + d * 128 + 2 * pp;
        float2 s[SEGLEN];
#pragma unroll
        for (int i = 0; i < SEGLEN; ++i) s[i] = *(const float2*)(S + (size_t)chunk_col(d, b, seg * SEGLEN + i) * 256);
        float2 F = make_float2(0.f, 0.f);
#pragma unroll
        for (int i = 0; i < SEGLEN; ++i) { const float fr = A.x * F.x - A.y * F.y + s[i].x, fi = A.x * F.y + A.y * F.x + s[i].y; F.x = fr; F.y = fi; }
        __syncthreads();
        Fs[seg * 64 + pp] = F;
        __syncthreads();
        float2 H = make_float2(0.f, 0.f);
        for (int q = 0; q < seg; ++q) { const float2 f = Fs[q * 64 + pp]; const float hr = A18.x * H.x - A18.y * H.y + f.x, hi = A18.x * H.y + A18.y * H.x + f.y; H.x = hr; H.y = hi; }
#pragma unroll
        for (int i = 0; i < SEGLEN; ++i) {
            *(unsigned*)(Hp + (size_t)chunk_col(d, b, seg * SEGLEN + i) * 256) = pack2(H.x, H.y);
            const float hr = A.x * H.x - A.y * H.y + s[i].x, hi = A.x * H.y + A.y * H.x + s[i].y; H.x = hr; H.y = hi;
        }
    }
}

struct EpiS3 {
    bf16_t* Y; int m0, n0, g;
    __device__ __forceinline__ void operator()(const f32x16 (&acc)[1][2], int r0, int c0) const {
        ACC_FOREACH(1, acc, r0, c0, {
            const int col = n0 + cl, tok = (m0 + rl) * TCH + (col >> 4);
            uint2 o; o.x = pack2(gelu_tanh(v0), gelu_tanh(v1)); o.y = pack2(gelu_tanh(v2), gelu_tanh(v3));
            *(uint2*)(Y + (size_t)tok * DS5 + g * 16 + (col & 15)) = o;
        })
    }
};
__device__ __forceinline__ void phase_s3(const Params& p, unsigned char* lds, int l) {
    const WS w{p.ws};
    const XcdIter xi = xcd_iter();
    const int nmt = l == 0 ? 9 : 8, nunit = (NG / xi.nx) * nmt * 2;
    for (int rep = 0; rep < REP_S3; ++rep)
    for (int u = xi.local; u < nunit; u += xi.nloc) {
        const int g = (u / (nmt * 2)) * xi.nx + xi.xcd, r = u % (nmt * 2), mt = r >> 1, nt = r & 1;
        SrcA A; SrcB B;
        src_split<2>(A, w.ug() + (size_t)g * NROW * 16, 256, w.hprev() + (size_t)g * NCOL * 256, 256, mt * 128, 256);
        src_plain<2>(B, w.w2(l, g), nt * 128, 512);
        EpiS3 e{w.Y(), mt * 128, nt * 128, g};
        gemm_tile<1>(lds, A, B, 512, e);
    }
}

struct EpiGlu {
    const bf16_t* Y; bf16_t* hb; const float* bg; int m0, n0;
    __device__ __forceinline__ void operator()(const f32x16 (&acc)[1][2], int r0, int c0) const {
        ACC_FOREACH(1, acc, r0, c0, {
            const int row = m0 + rl, col = n0 + cl;
            const uint2 t = *(const uint2*)(Y + (size_t)row * DS5 + col);
            const float4 b = *(const float4*)(bg + col);
            uint2 o;
            o.x = pack2(bflo(t.x) * sigmoidf_(v0 + b.x), bfhi(t.x) * sigmoidf_(v1 + b.y));
            o.y = pack2(bflo(t.y) * sigmoidf_(v2 + b.z), bfhi(t.y) * sigmoidf_(v3 + b.w));
            *(uint2*)(hb + (size_t)row * D + col) = o;
        })
    }
};
__device__ __forceinline__ void phase_glu(const Params& p, unsigned char* lds, int l) {
    const WS w{p.ws};
    const XcdIter xi = xcd_iter();
    const int nmt = (l == 0 ? 144 : 128) / xi.nx, nunit = nmt * 4;
    for (int rep = 0; rep < REP_GLU; ++rep)
    for (int u = xi.local; u < nunit; u += xi.nloc) {
        const int mt = (u >> 2) * xi.nx + xi.xcd, nt = u & 3;
        SrcA A; SrcB B;
        src_plain<2>(A, w.Y(), mt * 128, DS5);
        src_plain<2>(B, w.wt_glu(l), nt * 128, 512);
        EpiGlu e{w.Y(), w.hb(), p.in[16] + l * DS5, mt * 128, nt * 128};
        gemm_tile<1>(lds, A, B, 512, e);
    }
}

struct EpiOut {
    bf16_t* y; int m0, n0;
    __device__ __forceinline__ void operator()(const f32x16 (&acc)[2][2], int r0, int c0) const {
        ACC_FOREACH(2, acc, r0, c0, {
            uint2 o; o.x = pack2(v0, v1); o.y = pack2(v2, v3);
            *(uint2*)(y + (size_t)(m0 + rl) * D + n0 + cl) = o;
        })
    }
};
__device__ __forceinline__ void phase_outproj(const Params& p, unsigned char* lds, int l) {
    const WS w{p.ws};
    const XcdIter xi = xcd_iter();
    const int nmt = (l == 0 ? 72 : 64) / xi.nx, nunit = nmt * 8;
    for (int rep = 0; rep < (l == 0 ? REP_OUT0 : 1); ++rep)
    for (int u = xi.local; u < nunit; u += xi.nloc) {
        const int mt = (u >> 3) * xi.nx + xi.xcd, nt = u & 7;
        SrcA A; SrcB B;
        src_plain<4>(A, w.hb(), mt * 256, D);
        src_plain<2>(B, w.wt_o(l), nt * 128, D);
        EpiOut e{w.zr(), mt * 256, nt * 128};
        gemm_tile<2>(lds, A, B, D, e);
    }
}

template <bool DRY>
__device__ __forceinline__ void phase_ln1(const Params& p, unsigned char* lds, int l) {
    const WS w{p.ws};
    const int tid = threadIdx.x, lane = tid & 63, wid = tid >> 6;
    float* wl = (float*)lds;
    __syncthreads();
#pragma unroll
    for (int kk = 0; kk < 2; ++kk) {
        const int k = tid + NTHR * kk;
        const int s = ((k >> 8) * 4 + (k & 3)) * 64 + ((k >> 2) & 63);
        const float4 g = *(const float4*)(p.in[25] + ((size_t)l * D + k) * 4);
        const float4* ex = (const float4*)(p.in[27] + ((size_t)l * D + k) * 16);
        const float4 e0 = ex[0], e1 = ex[1], e2 = ex[2], e3 = ex[3];
        *(float4*)(wl + (0 * 1024 + s) * 4) = g;
        *(float4*)(wl + (1 * 1024 + s) * 4) = e0;
        *(float4*)(wl + (2 * 1024 + s) * 4) = e1;
        *(float4*)(wl + (3 * 1024 + s) * 4) = e2;
        *(float4*)(wl + (4 * 1024 + s) * 4) = e3;
    }
    __syncthreads();
    const int nrows = l == 0 ? NROW : NLAT;
    const float* md = w.mod(l);
    const float* lng = p.in[23] + l * D; const float* lnb = p.in[24] + l * D;
    const float brg0 = p.in[26][l * 4 + 0], brg1 = p.in[26][l * 4 + 1], brg2 = p.in[26][l * 4 + 2], brg3 = p.in[26][l * 4 + 3];
    float bre[16];
#pragma unroll
    for (int i = 0; i < 16; ++i) bre[i] = p.in[28][l * 16 + i];
    int k_cls = 0, k_row = 0, nkeep = 0; float k_wlo = 0.f, k_whi = 0.f;
    const int nwv = gridDim.x * NWV, rpw = (nrows + nwv - 1) / nwv;
    int row = (blockIdx.x * NWV + wid) * rpw;
    const int rend = min(nrows, row + rpw);
    float4 pg[4], pb[4], psh[4], psc[4], pg1[4];
#pragma unroll
    for (int i = 0; i < 4; ++i) { pg[i] = *(const float4*)(lng + i * 256 + lane * 4); pb[i] = *(const float4*)(lnb + i * 256 + lane * 4); psh[i] = pg[i]; psc[i] = pg[i]; pg1[i] = pg[i]; }
    const bf16_t* ybuf = w.zr();
    int mcur = -1;
    float4 vn[4]; uint2 yn[4];
    if (row < rend) {
        const float* R0 = l == 0 ? (row < NLAT ? p.in[0] + (size_t)row * D : p.in[2] + (size_t)(row - NLAT) * D) : Rrow(p, row);
#pragma unroll
        for (int i = 0; i < 4; ++i) { vn[i] = *(const float4*)(R0 + i * 256 + lane * 4); yn[i] = *(const uint2*)(ybuf + (size_t)row * D + i * 256 + lane * 4); }
    }
    for (; row < rend; ++row) {
        float* R = Rrow(p, row);
        const int m = modrow(row);
        if (m != mcur) {
            mcur = m;
#pragma unroll
            for (int i = 0; i < 4; ++i) { psh[i] = *(const float4*)(md + (size_t)m * 6144 + 3072 + i * 256 + lane * 4); psc[i] = *(const float4*)(md + (size_t)m * 6144 + 4096 + i * 256 + lane * 4); pg1[i] = *(const float4*)(md + (size_t)m * 6144 + 2048 + i * 256 + lane * 4); }
        }
        float h[16];
        float4 v[4];
#pragma unroll
        for (int i = 0; i < 4; ++i) {
            const float4 g1 = pg1[i]; const uint2 yy = yn[i];
            v[i].x = DN_ALPHA * vn[i].x + g1.x * bflo(yy.x); v[i].y = DN_ALPHA * vn[i].y + g1.y * bfhi(yy.x);
            v[i].z = DN_ALPHA * vn[i].z + g1.z * bflo(yy.y); v[i].w = DN_ALPHA * vn[i].w + g1.w * bfhi(yy.y);
        }
        if (row + 1 < rend) {
            const int rn = row + 1;
            const float* Rn = l == 0 ? (rn < NLAT ? p.in[0] + (size_t)rn * D : p.in[2] + (size_t)(rn - NLAT) * D) : Rrow(p, rn);
#pragma unroll
            for (int i = 0; i < 4; ++i) { vn[i] = *(const float4*)(Rn + i * 256 + lane * 4); yn[i] = *(const uint2*)(ybuf + (size_t)rn * D + i * 256 + lane * 4); }
        }
        float s = 0.f;
#pragma unroll
        for (int i = 0; i < 4; ++i) s += (v[i].x + v[i].y) + (v[i].z + v[i].w);
        const float mean = wave_sum_fast(s) * (1.0f / 1024.0f);
        float q = 0.f;
#pragma unroll
        for (int i = 0; i < 4; ++i) { const float a = v[i].x - mean, b = v[i].y - mean, c = v[i].z - mean, d = v[i].w - mean; q += (a * a + b * b) + (c * c + d * d); }
        const float rs = rsqrtf(wave_sum_fast(q) * (1.0f / 1024.0f) + LN_EPS);
#pragma unroll
        for (int i = 0; i < 4; ++i) {
            const int col = i * 256 + lane * 4;
            const float4 g = pg[i], b = pb[i], sh = psh[i], sc = psc[i];
            float4 x;
            x.x = (v[i].x - mean) * rs * g.x + b.x; x.y = (v[i].y - mean) * rs * g.y + b.y; x.z = (v[i].z - mean) * rs * g.z + b.z; x.w = (v[i].w - mean) * rs * g.w + b.w;
            if (!DRY) *(float4*)(R + col) = x; else { KEEP(x.x); KEEP(x.y); KEEP(x.z); KEEP(x.w); }
            h[i * 4 + 0] = x.x * (1.f + sc.x) + sh.x; h[i * 4 + 1] = x.y * (1.f + sc.y) + sh.y; h[i * 4 + 2] = x.z * (1.f + sc.z) + sh.z; h[i * 4 + 3] = x.w * (1.f + sc.w) + sh.w;
            uint2 o; o.x = pack2(h[i * 4 + 0], h[i * 4 + 1]); o.y = pack2(h[i * 4 + 2], h[i * 4 + 3]);
            if (!DRY) *(uint2*)(w.hb() + (size_t)row * D + col) = o; else { KEEP(o.x); KEEP(o.y); }
        }
        float* red = (float*)(lds + 81920) + wid * (64 * 24);
#pragma unroll 1
        for (int o4 = 0; o4 < 5; ++o4) {
            float a0 = 0.f, a1 = 0.f, a2 = 0.f, a3 = 0.f;
#pragma unroll
            for (int e = 0; e < 16; ++e) {
                const float4 wv = *(const float4*)(wl + ((o4 * 1024) + e * 64 + lane) * 4);
                a0 += h[e] * wv.x; a1 += h[e] * wv.y; a2 += h[e] * wv.z; a3 += h[e] * wv.w;
            }
            *(float4*)(red + lane * 24 + o4 * 4) = make_float4(a0, a1, a2, a3);
        }
        float mylg = 0.f;
        {
            const int oo = lane < 20 ? lane : 0;
            float t0 = 0.f, t1 = 0.f, t2 = 0.f, t3 = 0.f;
#pragma unroll
            for (int j = 0; j < 64; j += 4) { t0 += red[(j + 0) * 24 + oo]; t1 += red[(j + 1) * 24 + oo]; t2 += red[(j + 2) * 24 + oo]; t3 += red[(j + 3) * 24 + oo]; }
            mylg = (t0 + t1) + (t2 + t3);
        }
        float lg[20];
#pragma unroll
        for (int i = 0; i < 20; ++i) lg[i] = rl_f(mylg, i);
        {
            float gl[4];
            gl[0] = lg[0] + brg0; gl[1] = lg[1] + brg1; gl[2] = lg[2] + brg2; gl[3] = lg[3] + brg3;
            int gi = 0; float gm = gl[0];
#pragma unroll
            for (int i = 1; i < 4; ++i) if (gl[i] > gm) { gm = gl[i]; gi = i; }
            float den = 0.f;
#pragma unroll
            for (int i = 0; i < 4; ++i) den += __expf(gl[i] - gm);
            const float gw = 1.0f / den;
            float el[4];
#pragma unroll
            for (int i = 0; i < 4; ++i) {
                float t = lg[4 + i] + bre[i];
                if (gi == 1) t = lg[8 + i] + bre[4 + i]; else if (gi == 2) t = lg[12 + i] + bre[8 + i]; else if (gi == 3) t = lg[16 + i] + bre[12 + i];
                el[i] = t;
            }
            int i1 = 0; float m1 = el[0];
#pragma unroll
            for (int i = 1; i < 4; ++i) if (el[i] > m1) { m1 = el[i]; i1 = i; }
            int i2 = -1; float m2 = -3.0e38f;
#pragma unroll
            for (int i = 0; i < 4; ++i) if (i != i1 && el[i] > m2) { m2 = el[i]; i2 = i; }
            const float e2 = __expf(m2 - m1);
            const float w1 = gw / (1.0f + e2), w2 = gw * e2 / (1.0f + e2);
            const int lo = i1 < i2 ? i1 : i2, hi = i1 < i2 ? i2 : i1;
            const float wlo = i1 < i2 ? w1 : w2, whi = i1 < i2 ? w2 : w1;
            const int pair = lo == 0 ? (hi - 1) : (lo == 1 ? (hi + 1) : 5);
            const int cls = gi * 6 + pair;
            if (lane == nkeep) { k_cls = cls; k_row = row; k_wlo = wlo; k_whi = whi; }
            ++nkeep;
        }
        if (nkeep == 64) {
            if (!DRY) { const int pos = atomicAdd(w.cnt(l) + k_cls, 1); w.list()[(size_t)k_cls * LISTCAP + pos] = k_row; w.lw()[(size_t)k_cls * LISTCAP + pos] = make_float2(k_wlo, k_whi); }
            nkeep = 0;
        }
    }
    if (lane < nkeep) {
        if (!DRY) {
            const int pos = atomicAdd(w.cnt(l) + k_cls, 1);
            w.list()[(size_t)k_cls * LISTCAP + pos] = k_row;
            w.lw()[(size_t)k_cls * LISTCAP + pos] = make_float2(k_wlo, k_whi);
        } else { KEEP(k_cls); KEEP(k_wlo); KEEP(k_whi); }
    }
}

__device__ __forceinline__ void cls_experts(int cls, int& elo, int& ehi) {
    const int g = cls / 6, pr = cls % 6;
    const int lo = pr < 3 ? 0 : (pr < 5 ? 1 : 2);
    const int hi = pr < 3 ? pr + 1 : (pr < 5 ? pr - 1 : 3);
    elo = g * 4 + lo; ehi = g * 4 + hi;
}

struct EpiGU {
    bf16_t* act; const float2* lw; int cnt, pos0, orow0, half, fcol0;
    __device__ __forceinline__ void operator()(const f32x16 (&acc)[1][2], int r0, int c0) const {
        const int hh4 = c0 & 4, wn64 = c0 & 64;
        const int rl = r0, pos = pos0 + rl;
        float wt = 0.f;
        if (pos < cnt) { const float2 ww = lw[pos]; wt = half ? ww.y : ww.x; }
#pragma unroll
        for (int nt = 0; nt < 2; ++nt)
#pragma unroll
            for (int qp = 0; qp < 2; ++qp) {
                const int f = fcol0 + ((wn64 + nt * 32) >> 1) + qp * 8 + hh4;
                const int qg = qp * 2, qu = qp * 2 + 1;
                const float a0 = siluf_(acc[0][nt][qg * 4 + 0]) * acc[0][nt][qu * 4 + 0] * wt;
                const float a1 = siluf_(acc[0][nt][qg * 4 + 1]) * acc[0][nt][qu * 4 + 1] * wt;
                const float a2 = siluf_(acc[0][nt][qg * 4 + 2]) * acc[0][nt][qu * 4 + 2] * wt;
                const float a3 = siluf_(acc[0][nt][qg * 4 + 3]) * acc[0][nt][qu * 4 + 3] * wt;
                uint2 o; o.x = pack2(a0, a1); o.y = pack2(a2, a3);
                *(uint2*)(act + (size_t)(orow0 + rl) * 512 + half * 256 + f) = o;
            }
    }
};
__device__ __forceinline__ void phase_moe_gu(const Params& p, unsigned char* lds, int l) {
    const WS w{p.ws};
    const XcdIter xi = xcd_iter();
    int ntl[NCLS]; int tot = 0;
#pragma unroll
    for (int c = 0; c < NCLS; ++c) { ntl[c] = (w.cnt(l)[c] + 127) >> 7; tot += ntl[c]; }
    const int nmg = (tot + xi.nx - 1) / xi.nx, nunit = nmg * 8;
    const int lr = threadIdx.x >> 3, lc = (threadIdx.x & 7) ^ ((lr >> 1) & 7);
    for (int rep = 0; rep < REP_GU; ++rep)
    for (int u = xi.local; u < nunit; u += xi.nloc) {
        const int mg = (u >> 3) * xi.nx + xi.xcd, nt = u & 7;
        if (mg >= tot) continue;
        int cls = 0, mt = 0, run = 0;
#pragma unroll
        for (int c = 0; c < NCLS; ++c) { if (mg >= run && mg < run + ntl[c]) { cls = c; mt = mg - run; } run += ntl[c]; }
        const int cnt = w.cnt(l)[cls];
        int elo, ehi; cls_experts(cls, elo, ehi);
        const int half = nt >> 2, e = half ? ehi : elo;
        const int* lst = w.list() + (size_t)cls * LISTCAP;
        SrcA A; SrcB B;
#pragma unroll
        for (int j = 0; j < 2; ++j) {
            int pos = mt * 128 + lr + 64 * j; if (pos >= cnt) pos = 0;
            const int tok = lst[pos];
            A.p0[j] = w.hb() + (size_t)tok * D + lc * 8; A.p1[j] = A.p0[j];
        }
        A.split = 1 << 30;
        src_plain<2>(B, w.wt_gu(l, e), (nt & 3) * 128, D);
        EpiGU ep{w.act(), w.lw() + (size_t)cls * LISTCAP, cnt, mt * 128, mg * 128, half, (nt & 3) * 64};
        gemm_tile<1>(lds, A, B, D, ep);
    }
}

struct EpiDown {
    bf16_t* y; const int* lst; int cnt, pos0, n0;
    __device__ __forceinline__ void operator()(const f32x16 (&acc)[1][2], int r0, int c0) const {
        const int pos = pos0 + r0;
        if (pos < cnt) {
            const int row = lst[pos];
#pragma unroll
            for (int nt = 0; nt < 2; ++nt)
#pragma unroll
                for (int q = 0; q < 4; ++q) {
                    const int col = n0 + c0 + nt * 32 + q * 8;
                    uint2 o; o.x = pack2(acc[0][nt][q * 4 + 0], acc[0][nt][q * 4 + 1]); o.y = pack2(acc[0][nt][q * 4 + 2], acc[0][nt][q * 4 + 3]);
                    *(uint2*)(y + (size_t)row * D + col) = o;
                }
        }
    }
};
__device__ __forceinline__ void phase_moe_dn(const Params& p, unsigned char* lds, int l) {
    const WS w{p.ws};
    const XcdIter xi = xcd_iter();
    int ntl[NCLS]; int tot = 0;
#pragma unroll
    for (int c = 0; c < NCLS; ++c) { ntl[c] = (w.cnt(l)[c] + 127) >> 7; tot += ntl[c]; }
    const int nmg = (tot + xi.nx - 1) / xi.nx, nunit = nmg * 8;
    for (int u = xi.local; u < nunit; u += xi.nloc) {
        const int mg = (u >> 3) * xi.nx + xi.xcd, nt = u & 7;
        if (mg >= tot) continue;
        int cls = 0, mt = 0, run = 0;
#pragma unroll
        for (int c = 0; c < NCLS; ++c) { if (mg >= run && mg < run + ntl[c]) { cls = c; mt = mg - run; } run += ntl[c]; }
        const int cnt = w.cnt(l)[cls];
        int elo, ehi; cls_experts(cls, elo, ehi);
        SrcA A; SrcB B;
        src_plain<2>(A, w.act(), mg * 128, 512);
        src_split<2>(B, w.wt_dn(l, elo), 256, w.wt_dn(l, ehi), 256, nt * 128, 256);
        EpiDown ep{w.zr(), w.list() + (size_t)cls * LISTCAP, cnt, mt * 128, nt * 128};
        gemm_tile<1>(lds, A, B, 512, ep);
    }
}

template <bool DRY>
__device__ __forceinline__ void phase_ln2(const Params& p, int l) {
    const WS w{p.ws};
    const int tid = threadIdx.x, lane = tid & 63, wid = tid >> 6;
    const int nrows = l == 0 ? NROW : NLAT;
    const float* lng = p.in[32] + l * D; const float* lnb = p.in[33] + l * D;
    const float* mdn = w.mod(1); const float* mdc = w.mod(l);
    const bf16_t* ybuf = w.zr();
    const int nwv = gridDim.x * NWV, rpw = (nrows + nwv - 1) / nwv;
    int row = (blockIdx.x * NWV + wid) * rpw;
    const int rend = min(nrows, row + rpw);
    float4 pg[4], pb[4], psh[4], psc[4], pg2[4];
#pragma unroll
    for (int i = 0; i < 4; ++i) { pg[i] = *(const float4*)(lng + i * 256 + lane * 4); pb[i] = *(const float4*)(lnb + i * 256 + lane * 4); psh[i] = pg[i]; psc[i] = pg[i]; pg2[i] = pg[i]; }
    int mcur = -1;
    float4 vn[4]; uint2 yn[4];
    if (row < rend) {
        const float* R0 = Rrow(p, row);
#pragma unroll
        for (int i = 0; i < 4; ++i) { vn[i] = *(const float4*)(R0 + i * 256 + lane * 4); yn[i] = *(const uint2*)(ybuf + (size_t)row * D + i * 256 + lane * 4); }
    }
    for (; row < rend; ++row) {
        float* R = Rrow(p, row);
        const int m = modrow(row);
        if (m != mcur) {
            mcur = m;
#pragma unroll
            for (int i = 0; i < 4; ++i) {
                pg2[i] = *(const float4*)(mdc + (size_t)m * 6144 + 5120 + i * 256 + lane * 4);
                if (l == 0) { psh[i] = *(const float4*)(mdn + (size_t)m * 6144 + i * 256 + lane * 4); psc[i] = *(const float4*)(mdn + (size_t)m * 6144 + 1024 + i * 256 + lane * 4); }
            }
        }
        float4 v[4];
#pragma unroll
        for (int i = 0; i < 4; ++i) {
            const float4 g2 = pg2[i]; const uint2 yy = yn[i];
            v[i].x = DN_ALPHA * vn[i].x + g2.x * bflo(yy.x); v[i].y = DN_ALPHA * vn[i].y + g2.y * bfhi(yy.x);
            v[i].z = DN_ALPHA * vn[i].z + g2.z * bflo(yy.y); v[i].w = DN_ALPHA * vn[i].w + g2.w * bfhi(yy.y);
        }
        if (row + 1 < rend) {
            const float* Rn = Rrow(p, row + 1);
#pragma unroll
            for (int i = 0; i < 4; ++i) { vn[i] = *(const float4*)(Rn + i * 256 + lane * 4); yn[i] = *(const uint2*)(ybuf + (size_t)(row + 1) * D + i * 256 + lane * 4); }
        }
        float s = 0.f;
#pragma unroll
        for (int i = 0; i < 4; ++i) s += (v[i].x + v[i].y) + (v[i].z + v[i].w);
        const float mean = wave_sum_fast(s) * (1.0f / 1024.0f);
        float q = 0.f;
#pragma unroll
        for (int i = 0; i < 4; ++i) { const float a = v[i].x - mean, b = v[i].y - mean, c = v[i].z - mean, d = v[i].w - mean; q += (a * a + b * b) + (c * c + d * d); }
        const float rs = rsqrtf(wave_sum_fast(q) * (1.0f / 1024.0f) + LN_EPS);
#pragma unroll
        for (int i = 0; i < 4; ++i) {
            const int col = i * 256 + lane * 4;
            const float4 g = pg[i], b = pb[i];
            float4 x;
            x.x = (v[i].x - mean) * rs * g.x + b.x; x.y = (v[i].y - mean) * rs * g.y + b.y; x.z = (v[i].z - mean) * rs * g.z + b.z; x.w = (v[i].w - mean) * rs * g.w + b.w;
            if (!DRY) *(float4*)(R + col) = x; else { KEEP(x.x); KEEP(x.y); KEEP(x.z); KEEP(x.w); }
            if (l == 0) {
                const float4 sh = psh[i], sc = psc[i];
                uint2 o; o.x = pack2(x.x * (1.f + sc.x) + sh.x, x.y * (1.f + sc.y) + sh.y); o.y = pack2(x.z * (1.f + sc.z) + sh.z, x.w * (1.f + sc.w) + sh.w);
                if (!DRY) *(uint2*)(w.hb() + (size_t)row * D + col) = o; else { KEEP(o.x); KEEP(o.y); }
            }
        }
    }
}

#define XB_TMO      128
#define XB_XCNT(j)  (256  + 64 * (j))
#define XB_XSUB(j)  (1280 + 64 * (j))
#define XB_XGEN(j)  (2304 + 64 * (j))
#define XB_TOP      3328
#define XB_TOPGEN   3392
#define XB_SPIN_CAP (1u << 20)
__device__ __forceinline__ unsigned xb_ld(unsigned* p)              { return __hip_atomic_load(p, __ATOMIC_RELAXED, __HIP_MEMORY_SCOPE_AGENT); }
__device__ __forceinline__ unsigned xb_add(unsigned* p, unsigned v) { return __hip_atomic_fetch_add(p, v, __ATOMIC_RELAXED, __HIP_MEMORY_SCOPE_AGENT); }
__device__ __forceinline__ unsigned xb_xcc_id() { return (unsigned)__builtin_amdgcn_s_getreg((3 << 11) | 20) & 0xFu; }
#define XB_SPIN(cond, bar) do { unsigned _sp = 0; while (cond) { __builtin_amdgcn_s_sleep(1); \
    if ((++_sp & 255u) == 0u) { if (xb_ld(&(bar)[XB_TMO])) break; if (_sp > XB_SPIN_CAP) { atomicAdd(&(bar)[XB_TMO], 1u); break; } } } } while (0)
struct XcdBarrier { unsigned* bar; unsigned x, nloc, nx; };
__device__ __forceinline__ void xcd_barrier_post(XcdBarrier& b, unsigned* bar) {
    b.bar = bar; b.x = xb_xcc_id(); b.nloc = 0u; b.nx = 0u;
    if (threadIdx.x == 0) (void)xb_add(&bar[XB_XCNT(b.x)], 1u);
}
__device__ __forceinline__ void xcd_barrier_complete(unsigned* bar, unsigned x, unsigned& nloc, unsigned& nx) {
    const unsigned G = gridDim.x;
    unsigned sum, cnt, mine, sp = 0u;
    for (;;) {
        sum = 0u; cnt = 0u; mine = 0u;
#pragma unroll
        for (unsigned j = 0; j < 16; ++j) { const unsigned c = xb_ld(&bar[XB_XCNT(j)]); sum += c; cnt += (c > 0u) ? 1u : 0u; mine = (j == x) ? c : mine; }
        if (sum == G) break;
        __builtin_amdgcn_s_sleep(1);
        if ((++sp & 255u) == 0u) { if (xb_ld(&bar[XB_TMO])) break; if (sp > XB_SPIN_CAP) { atomicAdd(&bar[XB_TMO], 1u); break; } }
    }
    nloc = mine > 0u ? mine : 1u; nx = cnt > 0u ? cnt : 1u;
}
__device__ __forceinline__ void xcd_barrier(XcdBarrier& b) {
    asm volatile("s_waitcnt vmcnt(0)" ::: "memory");
    __syncthreads();
    if (threadIdx.x == 0) {
        unsigned* bar = b.bar;
        __builtin_amdgcn_s_waitcnt(0);
        if (b.nloc == 0u) xcd_barrier_complete(bar, b.x, b.nloc, b.nx);
        const unsigned nloc = b.nloc, nx = b.nx;
        const unsigned old = xb_add(&bar[XB_XSUB(b.x)], 1u);
        const unsigned gen = old / nloc;
        if (old + 1u == (gen + 1u) * nloc) {
            __builtin_amdgcn_fence(__ATOMIC_RELEASE, "agent");
            asm volatile("s_waitcnt vmcnt(0)" ::: "memory");
            const unsigned og = xb_add(&bar[XB_TOP], 1u);
            const unsigned tg = og / nx;
            if (og + 1u == (tg + 1u) * nx) xb_add(&bar[XB_TOPGEN], 1u);
            else XB_SPIN(xb_ld(&bar[XB_TOPGEN]) == tg, bar);
            __builtin_amdgcn_fence(__ATOMIC_ACQUIRE, "agent");
            xb_add(&bar[XB_XGEN(b.x)], 1u);
            asm volatile("s_waitcnt vmcnt(0)" ::: "memory");
        } else {
            XB_SPIN(xb_ld(&bar[XB_XGEN(b.x)]) == gen, bar);
            __builtin_amdgcn_fence(__ATOMIC_ACQUIRE, "agent");
            asm volatile("s_waitcnt vmcnt(0)" ::: "memory");
        }
    }
    __syncthreads();
}

constexpr int NPHASE = 2 + 2 * 10;
__global__ void __launch_bounds__(NTHR, 2) mega(Params p, int ph_lo, int ph_hi) {
    extern __shared__ __attribute__((aligned(16))) unsigned char lds[];
    XcdBarrier xb; xcd_barrier_post(xb, (unsigned*)(p.ws + OFF_BAR));
#define RUN(idx, ...) if (ph_lo <= (idx) && (idx) < ph_hi) { const int nrep_ = (PH_REP_IDX >= 0 && ((idx) >= 2 ? ((idx) - 2) % 10 == PH_REP_IDX : (idx) + 100 == PH_REP_IDX)) ? 2 : 1; for (int rr_ = 0; rr_ < nrep_; ++rr_) { __VA_ARGS__; if ((idx) + 1 < ph_hi || rr_ + 1 < nrep_) for (int rb_ = 0; rb_ < REP_BAR; ++rb_) xcd_barrier(xb); } }
    RUN(0, phase_pro_a(p, lds))
    RUN(1, for (int r_ = 0; r_ < REP_PROBC; ++r_) phase_pro_b(p, lds))
#define LAYER(l) \
    RUN(2 + 10 * l + 0, phase_inproj(p, lds, l)) \
    RUN(2 + 10 * l + 1, phase_s1(p, lds, l)) \
    RUN(2 + 10 * l + 2, phase_s2(p, lds, l); if (l == 0) w2_toeplitz_fill(p)) \
    RUN(2 + 10 * l + 3, phase_s3(p, lds, l)) \
    RUN(2 + 10 * l + 4, phase_glu(p, lds, l)) \
    RUN(2 + 10 * l + 5, phase_outproj(p, lds, l)) \
    RUN(2 + 10 * l + 6, if (DRY_LN1) phase_ln1<true>(p, lds, l); phase_ln1<false>(p, lds, l)) \
    RUN(2 + 10 * l + 7, phase_moe_gu(p, lds, l)) \
    RUN(2 + 10 * l + 8, phase_moe_dn(p, lds, l)) \
    RUN(2 + 10 * l + 9, if (DRY_LN2) phase_ln2<true>(p, l); phase_ln2<false>(p, l))
    LAYER(0)
    LAYER(1)
#undef LAYER
#undef RUN
}

extern "C" void kernel_launch(void* const* d_in, const int* in_sizes, int n_in, void* d_out, int out_size, void* d_ws, size_t ws_size, hipStream_t stream) {
    static int grid_blocks = 0;
    if (grid_blocks == 0) {
        if (n_in != 34 || out_size != NLAT * D || ws_size < WS_END) {
            fprintf(stderr, "kernel_launch: unexpected shapes (n_in %d out %d ws %zu need %zu)\n", n_in, out_size, ws_size, (size_t)WS_END);
            grid_blocks = -1; return;
        }
        int dev = 0, cus = 0, per_cu = 0;
        hipGetDevice(&dev);
        hipDeviceGetAttribute(&cus, hipDeviceAttributeMultiprocessorCount, dev);
        if (hipFuncSetAttribute((const void*)mega, hipFuncAttributeMaxDynamicSharedMemorySize, LDS_BYTES) != hipSuccess) fprintf(stderr, "kernel_launch: hipFuncSetAttribute failed\n");
        hipOccupancyMaxActiveBlocksPerMultiprocessor(&per_cu, (const void*)mega, NTHR, LDS_BYTES);
        if (per_cu < 1) per_cu = 1;
        if (per_cu > 1) per_cu = 1;
        grid_blocks = cus * per_cu;
        fprintf(stderr, "kernel_launch: cus %d per_cu %d grid %d ws need %zu have %zu\n", cus, per_cu, grid_blocks, (size_t)WS_END, ws_size);
    }
    if (grid_blocks < 0) return;
    Params p{};
    for (int i = 0; i < 34; ++i) p.in[i] = (const float*)d_in[i];
    p.out = (float*)d_out; p.ws = (unsigned char*)d_ws;
    if (hipMemsetAsync((unsigned char*)d_ws + OFF_BAR, 0, SZ_BAR, stream) != hipSuccess) fprintf(stderr, "memset failed\n");
#if FUSED
    int lo = 0, hi = NPHASE;
    void* args[] = {&p, &lo, &hi};
    hipError_t e = hipLaunchCooperativeKernel((const void*)mega, dim3(grid_blocks), dim3(NTHR), args, LDS_BYTES, stream);
    if (e != hipSuccess) fprintf(stderr, "cooperative launch failed: %s (grid %d)\n", hipGetErrorString(e), grid_blocks);
#else
    for (int ph = 0; ph < NPHASE; ++ph) hipLaunchKernelGGL(mega, dim3(grid_blocks), dim3(NTHR), LDS_BYTES, stream, p, ph, ph + 1);
#endif
}
```

```cpp
#include <hip/hip_runtime.h>
#include <cstdio>
#include <cstdint>

#ifndef FUSED
#define FUSED 1
#endif
#define REP_INPROJ 1
#define REP_S1 1
#define REP_S3 1
#define REP_GLU 1
#define REP_OUT0 1
#define REP_GU 1
#define REP_CONV 1
#define REP_CSC 1
#define REP_CCF 1
#define CCF_PM 0
#define REP_S2 1
#define REP_PRO 1
#define REP_BAR 1
#define PH_REP_IDX -1
#define PROBE_MODE 1
#define PROBE_TINY 0
#define REP_PROBC 1
#define REP_PB_K 1
#define REP_PB_M 1
#define REP_PB_H 1
#define DRY_LN1 0
#define DRY_LN2 0
#define KEEP(x) asm volatile("" :: "v"(x))

typedef unsigned short bf16_t;
typedef __attribute__((ext_vector_type(8))) short bf16x8;
typedef __attribute__((ext_vector_type(16))) float f32x16;

constexpr int D = 1024, NB = 8, SEQ = 2048, CTX = 256;
constexpr int NLAT = NB * SEQ, NCTX = NB * CTX, NROW = NLAT + NCTX;
constexpr int DIN = 1792, DS5 = 512, NG = 32, PS = 64;
constexpr int TCH = 16, NT = 256;
constexpr int NCOL = NROW / TCH;
constexpr int NCOL_LAT = NLAT / TCH;
constexpr int CH_LAT = SEQ / TCH, CH_CTX = CTX / TCH;
constexpr int NSTEP = CH_LAT + CH_CTX;
constexpr int NSEG = 8, SEGLEN = NSTEP / NSEG;
constexpr int NCLS = 24, LISTCAP = NROW;
constexpr int MAXMT = NROW / 128 + NCLS;
constexpr int KSPLIT_MOD = 32;
constexpr int NTHR = 512, NWV = 8;
constexpr float LN_EPS = 1e-5f;
constexpr float DN_ALPHA = 1.4142135623730951f;
constexpr int NPOW = 18;

constexpr size_t AL(size_t x) { return (x + 255) & ~(size_t)255; }
constexpr size_t SZ_WT_IN = (size_t)2 * DIN * D * 2;
constexpr size_t SZ_WT_GLU = (size_t)2 * 512 * 512 * 2;
constexpr size_t SZ_WT_O = (size_t)2 * D * D * 2;
constexpr size_t SZ_WT_GU = (size_t)2 * 16 * 512 * 1024 * 2;
constexpr size_t SZ_WT_DN = (size_t)2 * 16 * 1024 * 256 * 2;
constexpr size_t SZ_MOD = (size_t)2 * 9 * 6144 * 4;
constexpr size_t SZ_LAMPOW = (size_t)2 * 2 * NG * PS * NPOW * 8;
constexpr size_t SZ_BBAR = (size_t)2 * 2 * NG * PS * 16 * 8;
constexpr size_t SZ_KFULL = (size_t)2 * NG * 32 * 256 * 4;
constexpr size_t SZ_M1 = (size_t)2 * NG * 256 * 256 * 2;
constexpr size_t SZ_W2 = (size_t)2 * NG * 256 * 512 * 2;
constexpr size_t SZ_HB = (size_t)NROW * D * 2;
constexpr size_t SZ_UG = (size_t)NG * NROW * 16 * 2;
constexpr size_t SZ_ZR = (size_t)NROW * 1280 * 2;
constexpr size_t SZ_S = (size_t)NG * NCOL * 256 * 4;
constexpr size_t SZ_RCTX = (size_t)NCTX * D * 4;
constexpr size_t SZ_CNT = 256 * 4;
constexpr size_t SZ_LIST = (size_t)NCLS * LISTCAP * 4;
constexpr size_t SZ_LW = (size_t)NCLS * LISTCAP * 8;

constexpr size_t OFF_WT_IN = 0;
constexpr size_t OFF_WT_GLU = OFF_WT_IN + AL(SZ_WT_IN);
constexpr size_t OFF_WT_O = OFF_WT_GLU + AL(SZ_WT_GLU);
constexpr size_t OFF_WT_GU = OFF_WT_O + AL(SZ_WT_O);
constexpr size_t OFF_WT_DN = OFF_WT_GU + AL(SZ_WT_GU);
constexpr size_t OFF_MOD = OFF_WT_DN + AL(SZ_WT_DN);
constexpr size_t OFF_LAMPOW = OFF_MOD + AL(SZ_MOD);
constexpr size_t OFF_BBAR = OFF_LAMPOW + AL(SZ_LAMPOW);
constexpr size_t OFF_KFULL = OFF_BBAR + AL(SZ_BBAR);
constexpr size_t OFF_M1 = OFF_KFULL + AL(SZ_KFULL);
constexpr size_t OFF_W2 = OFF_M1 + AL(SZ_M1);
constexpr size_t OFF_HB = OFF_W2 + AL(SZ_W2);
constexpr size_t OFF_UG = OFF_HB + AL(SZ_HB);
constexpr size_t OFF_ZR = OFF_UG + AL(SZ_UG);
constexpr size_t OFF_S = OFF_ZR + AL(SZ_ZR);
constexpr size_t OFF_RCTX = OFF_S + AL(SZ_S);
constexpr size_t OFF_CNT = OFF_RCTX + AL(SZ_RCTX);
constexpr size_t OFF_LIST = OFF_CNT + AL(SZ_CNT);
constexpr size_t OFF_LW = OFF_LIST + AL(SZ_LIST);
constexpr size_t OFF_BAR = OFF_LW + AL(SZ_LW);
constexpr size_t SZ_BAR = 3456 * 4;
constexpr size_t WS_END = OFF_BAR + AL(SZ_BAR);
static_assert((size_t)KSPLIT_MOD * 2 * 9 * 6144 * 4 <= SZ_ZR, "modp alias");
static_assert((size_t)NG * NCOL * 256 * 2 <= SZ_ZR, "hprev alias");
static_assert((size_t)NROW * 512 * 2 <= SZ_S && (size_t)MAXMT * 128 * 512 * 2 <= SZ_S, "Y/act alias");
static_assert(WS_END <= (size_t)256 * 1024 * 1024, "workspace over 256 MiB");

constexpr int STAGE_BYTES = 49152, LDS_BYTES = 163840;

struct Params {
    const float* in[34];
    float* out;
    unsigned char* ws;
};

__device__ __forceinline__ unsigned f2bf(float f) { unsigned u = __float_as_uint(f); u += 0x7fffu + ((u >> 16) & 1u); return u >> 16; }
__device__ __forceinline__ float bf2f(unsigned h) { return __uint_as_float(h << 16); }
__device__ __forceinline__ unsigned pack2(float a, float b) { return f2bf(a) | (f2bf(b) << 16); }
__device__ __forceinline__ float bflo(unsigned w) { return __uint_as_float(w << 16); }
__device__ __forceinline__ float bfhi(unsigned w) { return __uint_as_float(w & 0xffff0000u); }
__device__ __forceinline__ float wave_sum(float v) {
#pragma unroll
    for (int o = 32; o >= 1; o >>= 1) v += __shfl_xor(v, o);
    return v;
}
__device__ __forceinline__ void lds_barrier() { asm volatile("s_waitcnt lgkmcnt(0)" ::: "memory"); __builtin_amdgcn_s_barrier(); asm volatile("" ::: "memory"); }
template <int CTRL>
__device__ __forceinline__ float dpp_f(float v) { return __int_as_float(__builtin_amdgcn_update_dpp(0, __float_as_int(v), CTRL, 0xf, 0xf, true)); }
__device__ __forceinline__ float row_sum16(float v) {
    v += dpp_f<0xB1>(v);
    v += dpp_f<0x4E>(v);
    v += dpp_f<0x124>(v);
    v += dpp_f<0x128>(v);
    return v;
}
__device__ __forceinline__ float rl_f(float v, int l) { return __int_as_float(__builtin_amdgcn_readlane(__float_as_int(v), l)); }
__device__ __forceinline__ float wave_sum_fast(float v) {
    v = row_sum16(v);
    return (rl_f(v, 0) + rl_f(v, 16)) + (rl_f(v, 32) + rl_f(v, 48));
}
__device__ __forceinline__ float sigmoidf_(float x) { return 1.0f / (1.0f + __expf(-x)); }
__device__ __forceinline__ float siluf_(float x) { return x / (1.0f + __expf(-x)); }
__device__ __forceinline__ float gelu_tanh(float x) {
    const float z = 0.7978845608028654f * (x + 0.044715f * x * x * x);
    const float e = __expf(2.0f * z);
    const float t = 1.0f - 2.0f / (1.0f + e);
    return 0.5f * x * (1.0f + t);
}
__device__ __forceinline__ int modrow(int row) { return row < NLAT ? (row >> 11) : 8; }

struct SrcA { const bf16_t* p0[4]; const bf16_t* p1[4]; int split; };
struct SrcB { const bf16_t* p0[2]; const bf16_t* p1[2]; int split; };
#define LDS_AS __attribute__((address_space(3)))

template <int MF, class EPI, int MODE = 0>
__device__ __forceinline__ void gemm_tile(unsigned char* lds, const SrcA& A, const SrcB& B, const int K, const EPI& epi) {
    const int tid = threadIdx.x, lane = tid & 63, wid = __builtin_amdgcn_readfirstlane(tid >> 6), wm = wid >> 1, wn = wid & 1;
    const int l31 = lane & 31, hh = lane >> 5, sw = (l31 >> 1) & 7;
    const int xbase = (wm * 32 * MF + l31) * 128, wbase = 32768 + (wn * 64 + l31) * 128;
    LDS_AS unsigned char* ldsw = (LDS_AS unsigned char*)lds + wid * 1024;
    f32x16 acc[MF][2];
#pragma unroll
    for (int i = 0; i < MF; ++i)
#pragma unroll
        for (int j = 0; j < 2; ++j)
#pragma unroll
            for (int e = 0; e < 16; ++e) acc[i][j][e] = 0.f;
    const int nk = K >> 6;
#define G_PIECE_A(k_, bufo_, j_) if (MODE != 3) __builtin_amdgcn_global_load_lds((const unsigned*)((k_) < A.split ? A.p0[j_] + (k_) : A.p1[j_] + ((k_) - A.split)), (LDS_AS unsigned*)(ldsw + (bufo_) + (j_) * 8192), 16, 0, 0)
#define G_PIECE_B(k_, bufo_, j_) if (MODE != 3) __builtin_amdgcn_global_load_lds((const unsigned*)((k_) < B.split ? B.p0[j_] + (k_) : B.p1[j_] + ((k_) - B.split)), (LDS_AS unsigned*)(ldsw + (bufo_) + 32768 + (j_) * 8192), 16, 0, 0)
#define G_STAGE(kt_, bufo_) do { const int k_ = (kt_) * 64; \
        _Pragma("unroll") for (int j = 0; j < 2 * MF; ++j) G_PIECE_A(k_, bufo_, j); \
        _Pragma("unroll") for (int j = 0; j < 2; ++j) G_PIECE_B(k_, bufo_, j); } while (0)
#define LDFRAG(ks_, W0_, W1_, X_) do { const int co_ = (((ks_) * 2 + hh) ^ sw) << 4; \
        W0_ = *(const bf16x8*)(lds + cur + wbase + co_); W1_ = *(const bf16x8*)(lds + cur + wbase + 4096 + co_); \
        _Pragma("unroll") for (int mt = 0; mt < MF; ++mt) X_[mt] = *(const bf16x8*)(lds + cur + xbase + mt * 4096 + co_); } while (0)
#define DOMFMA(W0_, W1_, X_) do { if (MODE == 2) { asm volatile("" :: "v"(W0_), "v"(W1_)); _Pragma("unroll") for (int mt = 0; mt < MF; ++mt) asm volatile("" :: "v"(X_[mt])); } else _Pragma("unroll") for (int mt = 0; mt < MF; ++mt) { \
        acc[mt][0] = __builtin_amdgcn_mfma_f32_32x32x16_bf16(W0_, X_[mt], acc[mt][0], 0, 0, 0); \
        acc[mt][1] = __builtin_amdgcn_mfma_f32_32x32x16_bf16(W1_, X_[mt], acc[mt][1], 0, 0, 0); } } while (0)
#define SCHED_FENCE __builtin_amdgcn_sched_barrier(0)
    asm volatile("s_waitcnt vmcnt(0)" ::: "memory");
    __builtin_amdgcn_s_barrier();
    asm volatile("" ::: "memory");
    G_STAGE(0, 0);
    if (nk > 1) G_STAGE(1, STAGE_BYTES);
    int cur = 0, nxt = 2 * STAGE_BYTES;
    for (int kt = 0; kt < nk; ++kt) {
        if (kt + 1 < nk) { if (MF == 2) asm volatile("s_waitcnt vmcnt(6)" ::: "memory"); else asm volatile("s_waitcnt vmcnt(4)" ::: "memory"); }
        else asm volatile("s_waitcnt vmcnt(0)" ::: "memory");
        __builtin_amdgcn_s_barrier();
        asm volatile("" ::: "memory");
        const bool st = kt + 2 < nk;
        const int kn = (kt + 2) * 64;
        bf16x8 wa0, wa1, xa[MF], wb0, wb1, xb[MF];
        LDFRAG(0, wa0, wa1, xa);
        LDFRAG(1, wb0, wb1, xb);
        SCHED_FENCE;
        DOMFMA(wa0, wa1, xa);
        if (st) { if (MF == 2) { G_PIECE_A(kn, nxt, 0); G_PIECE_A(kn, nxt, 1); } else { G_PIECE_A(kn, nxt, 0); } }
        SCHED_FENCE;
        LDFRAG(2, wa0, wa1, xa);
        SCHED_FENCE;
        DOMFMA(wb0, wb1, xb);
        if (st) { if (MF == 2) { G_PIECE_A(kn, nxt, 2); G_PIECE_A(kn, nxt, 3); } else { G_PIECE_A(kn, nxt, 1); } }
        SCHED_FENCE;
        LDFRAG(3, wb0, wb1, xb);
        SCHED_FENCE;
        DOMFMA(wa0, wa1, xa);
        if (st) { if (MF == 2) { G_PIECE_B(kn, nxt, 0); G_PIECE_B(kn, nxt, 1); } else { G_PIECE_B(kn, nxt, 0); } }
        SCHED_FENCE;
        DOMFMA(wb0, wb1, xb);
        if (st) { if (MF == 1) { G_PIECE_B(kn, nxt, 1); } }
        SCHED_FENCE;
        cur = (cur == 2 * STAGE_BYTES) ? 0 : cur + STAGE_BYTES;
        nxt = (nxt == 2 * STAGE_BYTES) ? 0 : nxt + STAGE_BYTES;
    }
#undef G_STAGE
#undef G_PIECE_A
#undef G_PIECE_B
#undef LDFRAG
#undef DOMFMA
    if (MODE == 0) epi(acc, wm * 32 * MF + l31, wn * 64 + hh * 4);
    else { _Pragma("unroll") for (int i = 0; i < MF; ++i) { asm volatile("" :: "v"(acc[i][0]), "v"(acc[i][1])); } }
}

template <int MF, class EPI, class GET>
__device__ __forceinline__ void gemm_stream(unsigned char* lds, const int K, const GET& get) {
    const int tid = threadIdx.x, lane = tid & 63, wid = __builtin_amdgcn_readfirstlane(tid >> 6), wm = wid >> 1, wn = wid & 1;
    const int l31 = lane & 31, hh = lane >> 5, sw = (l31 >> 1) & 7;
    const int xbase = (wm * 32 * MF + l31) * 128, wbase = 32768 + (wn * 64 + l31) * 128;
    LDS_AS unsigned char* ldsw = (LDS_AS unsigned char*)lds + wid * 1024;
    const int nk = K >> 6;
    SrcA Ac, An; SrcB Bc, Bn; EPI ec, en;
    bool have = get(0, Ac, Bc, ec);
    if (!have) return;
#define S_PIECE_A(S_, k_, bufo_, j_) __builtin_amdgcn_global_load_lds((const unsigned*)((k_) < S_.split ? S_.p0[j_] + (k_) : S_.p1[j_] + ((k_) - S_.split)), (LDS_AS unsigned*)(ldsw + (bufo_) + (j_) * 8192), 16, 0, 0)
#define S_PIECE_B(S_, k_, bufo_, j_) __builtin_amdgcn_global_load_lds((const unsigned*)((k_) < S_.split ? S_.p0[j_] + (k_) : S_.p1[j_] + ((k_) - S_.split)), (LDS_AS unsigned*)(ldsw + (bufo_) + 32768 + (j_) * 8192), 16, 0, 0)
#define LDFRAG(ks_, W0_, W1_, X_) do { const int co_ = (((ks_) * 2 + hh) ^ sw) << 4; \
        W0_ = *(const bf16x8*)(lds + cur + wbase + co_); W1_ = *(const bf16x8*)(lds + cur + wbase + 4096 + co_); \
        _Pragma("unroll") for (int mt = 0; mt < MF; ++mt) X_[mt] = *(const bf16x8*)(lds + cur + xbase + mt * 4096 + co_); } while (0)
#define DOMFMA(W0_, W1_, X_) do { _Pragma("unroll") for (int mt = 0; mt < MF; ++mt) { \
        acc[mt][0] = __builtin_amdgcn_mfma_f32_32x32x16_bf16(W0_, X_[mt], acc[mt][0], 0, 0, 0); \
        acc[mt][1] = __builtin_amdgcn_mfma_f32_32x32x16_bf16(W1_, X_[mt], acc[mt][1], 0, 0, 0); } } while (0)
    asm volatile("s_waitcnt vmcnt(0)" ::: "memory");
    __builtin_amdgcn_s_barrier();
    asm volatile("" ::: "memory");
#pragma unroll
    for (int j = 0; j < 2 * MF; ++j) S_PIECE_A(Ac, 0, 0, j);
#pragma unroll
    for (int j = 0; j < 2; ++j) S_PIECE_B(Bc, 0, 0, j);
#pragma unroll
    for (int j = 0; j < 2 * MF; ++j) S_PIECE_A(Ac, 64, STAGE_BYTES, j);
#pragma unroll
    for (int j = 0; j < 2; ++j) S_PIECE_B(Bc, 64, STAGE_BYTES, j);
    int cur = 0, nxt = 2 * STAGE_BYTES;
    for (int ui = 0; have; ++ui) {
        const bool haveN = get(ui + 1, An, Bn, en);
        f32x16 acc[MF][2];
#pragma unroll
        for (int i = 0; i < MF; ++i)
#pragma unroll
            for (int j = 0; j < 2; ++j)
#pragma unroll
                for (int e = 0; e < 16; ++e) acc[i][j][e] = 0.f;
        for (int kt = 0; kt < nk; ++kt) {
            if (kt + 1 < nk || haveN) { if (MF == 2) asm volatile("s_waitcnt vmcnt(6)" ::: "memory"); else asm volatile("s_waitcnt vmcnt(4)" ::: "memory"); }
            else asm volatile("s_waitcnt vmcnt(0)" ::: "memory");
            __builtin_amdgcn_s_barrier();
            asm volatile("" ::: "memory");
            const bool fromN = kt + 2 >= nk;
            const bool st = !fromN || haveN;
            const int kn = (fromN ? kt + 2 - nk : kt + 2) * 64;
            SrcA As; SrcB Bs;
#pragma unroll
            for (int j = 0; j < 2 * MF; ++j) { As.p0[j] = fromN ? An.p0[j] : Ac.p0[j]; As.p1[j] = fromN ? An.p1[j] : Ac.p1[j]; }
#pragma unroll
            for (int j = 0; j < 2; ++j) { Bs.p0[j] = fromN ? Bn.p0[j] : Bc.p0[j]; Bs.p1[j] = fromN ? Bn.p1[j] : Bc.p1[j]; }
            As.split = fromN ? An.split : Ac.split; Bs.split = fromN ? Bn.split : Bc.split;
            bf16x8 wa0, wa1, xa[MF], wb0, wb1, xb[MF];
            LDFRAG(0, wa0, wa1, xa);
            LDFRAG(1, wb0, wb1, xb);
            SCHED_FENCE;
            DOMFMA(wa0, wa1, xa);
            if (st) { if (MF == 2) { S_PIECE_A(As, kn, nxt, 0); S_PIECE_A(As, kn, nxt, 1); } else { S_PIECE_A(As, kn, nxt, 0); } }
            SCHED_FENCE;
            LDFRAG(2, wa0, wa1, xa);
            SCHED_FENCE;
            DOMFMA(wb0, wb1, xb);
            if (st) { if (MF == 2) { S_PIECE_A(As, kn, nxt, 2); S_PIECE_A(As, kn, nxt, 3); } else { S_PIECE_A(As, kn, nxt, 1); } }
            SCHED_FENCE;
            LDFRAG(3, wb0, wb1, xb);
            SCHED_FENCE;
            DOMFMA(wa0, wa1, xa);
            if (st) { S_PIECE_B(Bs, kn, nxt, 0); if (MF == 2) S_PIECE_B(Bs, kn, nxt, 1); }
            SCHED_FENCE;
            DOMFMA(wb0, wb1, xb);
            if (st) { if (MF == 1) S_PIECE_B(Bs, kn, nxt, 1); }
            SCHED_FENCE;
            cur = (cur == 2 * STAGE_BYTES) ? 0 : cur + STAGE_BYTES;
            nxt = (nxt == 2 * STAGE_BYTES) ? 0 : nxt + STAGE_BYTES;
        }
        ec(acc, wm * 32 * MF + l31, wn * 64 + hh * 4);
        have = haveN;
        if (haveN) {
#pragma unroll
            for (int j = 0; j < 2 * MF; ++j) { Ac.p0[j] = An.p0[j]; Ac.p1[j] = An.p1[j]; }
#pragma unroll
            for (int j = 0; j < 2; ++j) { Bc.p0[j] = Bn.p0[j]; Bc.p1[j] = Bn.p1[j]; }
            Ac.split = An.split; Bc.split = Bn.split; ec = en;
        }
    }
#undef S_PIECE_A
#undef S_PIECE_B
#undef LDFRAG
#undef DOMFMA
}

template <int NJ, class S>
__device__ __forceinline__ void src_plain(S& s, const bf16_t* base, int row0, int ld) {
    const int lr = threadIdx.x >> 3, lc = (threadIdx.x & 7) ^ ((lr >> 1) & 7);
#pragma unroll
    for (int j = 0; j < NJ; ++j) { s.p0[j] = base + (size_t)(row0 + lr + 64 * j) * ld + lc * 8; s.p1[j] = s.p0[j]; }
    s.split = 1 << 30;
}
template <int NJ, class S>
__device__ __forceinline__ void src_split(S& s, const bf16_t* base0, int ld0, const bf16_t* base1, int ld1, int row0, int split) {
    const int lr = threadIdx.x >> 3, lc = (threadIdx.x & 7) ^ ((lr >> 1) & 7);
#pragma unroll
    for (int j = 0; j < NJ; ++j) { s.p0[j] = base0 + (size_t)(row0 + lr + 64 * j) * ld0 + lc * 8; s.p1[j] = base1 + (size_t)(row0 + lr + 64 * j) * ld1 + lc * 8; }
    s.split = split;
}
struct XcdIter { int nx, xcd, local, nloc; };
__device__ __forceinline__ XcdIter xcd_iter() {
    XcdIter it; it.nx = (gridDim.x & 7) == 0 ? 8 : 1; it.xcd = blockIdx.x % it.nx; it.local = blockIdx.x / it.nx; it.nloc = gridDim.x / it.nx; return it;
}

#define ACC_FOREACH(MF_, acc, r0, c0, ...) \
    _Pragma("unroll") for (int mt_ = 0; mt_ < MF_; ++mt_) \
    _Pragma("unroll") for (int nt_ = 0; nt_ < 2; ++nt_) \
    _Pragma("unroll") for (int q_ = 0; q_ < 4; ++q_) { \
        const int rl = (r0) + mt_ * 32, cl = (c0) + nt_ * 32 + q_ * 8; \
        const float v0 = acc[mt_][nt_][q_ * 4 + 0], v1 = acc[mt_][nt_][q_ * 4 + 1], v2 = acc[mt_][nt_][q_ * 4 + 2], v3 = acc[mt_][nt_][q_ * 4 + 3]; \
        __VA_ARGS__ }

struct WS {
    unsigned char* b;
    __device__ bf16_t* wt_in(int l) const { return (bf16_t*)(b + OFF_WT_IN) + (size_t)l * DIN * D; }
    __device__ bf16_t* wt_glu(int l) const { return (bf16_t*)(b + OFF_WT_GLU) + (size_t)l * 512 * 512; }
    __device__ bf16_t* wt_o(int l) const { return (bf16_t*)(b + OFF_WT_O) + (size_t)l * D * D; }
    __device__ bf16_t* wt_gu(int l, int e) const { return (bf16_t*)(b + OFF_WT_GU) + (size_t)(l * 16 + e) * 512 * 1024; }
    __device__ bf16_t* wt_dn(int l, int e) const { return (bf16_t*)(b + OFF_WT_DN) + (size_t)(l * 16 + e) * 1024 * 256; }
    __device__ float* mod(int l) const { return (float*)(b + OFF_MOD) + (size_t)l * 9 * 6144; }
    __device__ float* modp() const { return (float*)(b + OFF_ZR); }
    __device__ float2* lampow(int l, int d, int g) const { return (float2*)(b + OFF_LAMPOW) + (size_t)((l * 2 + d) * NG + g) * PS * NPOW; }
    __device__ float2* bbar(int l, int d, int g) const { return (float2*)(b + OFF_BBAR) + (size_t)((l * 2 + d) * NG + g) * PS * 16; }
    __device__ float* kfull(int l, int g) const { return (float*)(b + OFF_KFULL) + (size_t)(l * NG + g) * 32 * 256; }
    __device__ bf16_t* m1(int l, int g) const { return (bf16_t*)(b + OFF_M1) + (size_t)(l * NG + g) * 256 * 256; }
    __device__ bf16_t* w2(int l, int g) const { return (bf16_t*)(b + OFF_W2) + (size_t)(l * NG + g) * 256 * 512; }
    __device__ bf16_t* hb() const { return (bf16_t*)(b + OFF_HB); }
    __device__ bf16_t* ug() const { return (bf16_t*)(b + OFF_UG); }
    __device__ bf16_t* zr() const { return (bf16_t*)(b + OFF_ZR); }
    __device__ bf16_t* hprev() const { return (bf16_t*)(b + OFF_ZR); }
    __device__ float* S() const { return (float*)(b + OFF_S); }
    __device__ bf16_t* Y() const { return (bf16_t*)(b + OFF_S); }
    __device__ bf16_t* act() const { return (bf16_t*)(b + OFF_S); }
    __device__ float* rctx() const { return (float*)(b + OFF_RCTX); }
    __device__ int* cnt(int l) const { return (int*)(b + OFF_CNT) + l * 32; }
    __device__ int* list() const { return (int*)(b + OFF_LIST); }
    __device__ float2* lw() const { return (float2*)(b + OFF_LW); }
};
__device__ __forceinline__ float* Rrow(const Params& p, int row) {
    return row < NLAT ? p.out + (size_t)row * D : (float*)(p.ws + OFF_RCTX) + (size_t)(row - NLAT) * D;
}

__device__ __forceinline__ void transpose_tile(unsigned char* lds, const float* src, int ldsrc, int k0, int n0, bf16_t* dst, int lddst, int rowmode) {
    float* tile = (float*)lds;
    const int tid = threadIdx.x;
    __syncthreads();
#pragma unroll
    for (int pass = 0; pass < 2; ++pass) {
        const int k = pass * 32 + (tid >> 4), n4 = (tid & 15) * 4;
        const float4 v = *(const float4*)(src + (size_t)(k0 + k) * ldsrc + n0 + n4);
        tile[k * 65 + n4 + 0] = v.x; tile[k * 65 + n4 + 1] = v.y; tile[k * 65 + n4 + 2] = v.z; tile[k * 65 + n4 + 3] = v.w;
    }
    __syncthreads();
    {
        const int n = tid & 63, kc = tid >> 6;
        float f[8];
#pragma unroll
        for (int i = 0; i < 8; ++i) f[i] = tile[(kc * 8 + i) * 65 + n];
        const int ng = n0 + n;
        int drow = ng;
        if (rowmode == 1) drow = ((ng >> 3) << 4) + (ng & 7);
        else if (rowmode == 2) drow = ((ng >> 3) << 4) + 8 + (ng & 7);
        uint4 o; o.x = pack2(f[0], f[1]); o.y = pack2(f[2], f[3]); o.z = pack2(f[4], f[5]); o.w = pack2(f[6], f[7]);
        *(uint4*)(dst + (size_t)drow * lddst + k0 + kc * 8) = o;
    }
}

struct WTile { const float* src; bf16_t* dst; int ldsrc, lddst, k0, n0, rowmode; };
__device__ __forceinline__ WTile wtile_decode(const Params& p, int l, int t) {
    const WS w{p.ws};
    WTile r;
    if (t < 448) { const int kt = t / 28, nt = t % 28; r = WTile{p.in[6] + (size_t)l * D * DIN, w.wt_in(l), DIN, D, kt * 64, nt * 64, 0}; }
    else if (t < 512) { t -= 448; const int kt = t / 8, nt = t % 8; r = WTile{p.in[15] + (size_t)l * 512 * 512, w.wt_glu(l), 512, 512, kt * 64, nt * 64, 0}; }
    else if (t < 768) { t -= 512; const int kt = t / 16, nt = t % 16; r = WTile{p.in[22] + (size_t)l * D * D, w.wt_o(l), D, D, kt * 64, nt * 64, 0}; }
    else if (t < 1792) { t -= 768; const int e = t / 64, q = t % 64, kt = q / 4, nt = q % 4; r = WTile{p.in[29] + (size_t)(l * 16 + e) * D * 256, w.wt_gu(l, e), 256, D, kt * 64, nt * 64, 1}; }
    else if (t < 2816) { t -= 1792; const int e = t / 64, q = t % 64, kt = q / 4, nt = q % 4; r = WTile{p.in[30] + (size_t)(l * 16 + e) * D * 256, w.wt_gu(l, e), 256, D, kt * 64, nt * 64, 2}; }
    else { t -= 2816; const int e = t / 64, q = t % 64, kt = q / 16, nt = q % 16; r = WTile{p.in[31] + (size_t)(l * 16 + e) * 256 * D, w.wt_dn(l, e), D, 256, kt * 64, nt * 64, 0}; }
    return r;
}
template <class IDX>
__device__ __forceinline__ void transpose_stream(const Params& p, unsigned char* lds, int count, const IDX& idx) {
    const int tid = threadIdx.x;
    auto dec = [&](int j) -> WTile { const int i = idx(j); return i < 0 ? wtile_decode(p, 0, -i - 1) : (i < 3072 ? wtile_decode(p, 0, 768 + i) : wtile_decode(p, 1, i - 3072)); };
    if (count <= 0) return;
    lds_barrier();
    const int lk = tid >> 4, ln4 = (tid & 15) * 4;
    const int sn = tid & 63, skc = tid >> 6;
    WTile cur = dec(0);
    float4 v0 = *(const float4*)(cur.src + (size_t)(cur.k0 + lk) * cur.ldsrc + cur.n0 + ln4);
    float4 v1 = *(const float4*)(cur.src + (size_t)(cur.k0 + lk + 32) * cur.ldsrc + cur.n0 + ln4);
    for (int j = 0; j < count; ++j) {
        float* tile = (float*)lds + (j & 1) * (64 * 65);
        WTile nx = cur; float4 w0 = v0, w1 = v1;
        if (j + 1 < count) {
            nx = dec(j + 1);
            w0 = *(const float4*)(nx.src + (size_t)(nx.k0 + lk) * nx.ldsrc + nx.n0 + ln4);
            w1 = *(const float4*)(nx.src + (size_t)(nx.k0 + lk + 32) * nx.ldsrc + nx.n0 + ln4);
        }
        tile[lk * 65 + ln4 + 0] = v0.x; tile[lk * 65 + ln4 + 1] = v0.y; tile[lk * 65 + ln4 + 2] = v0.z; tile[lk * 65 + ln4 + 3] = v0.w;
        tile[(lk + 32) * 65 + ln4 + 0] = v1.x; tile[(lk + 32) * 65 + ln4 + 1] = v1.y; tile[(lk + 32) * 65 + ln4 + 2] = v1.z; tile[(lk + 32) * 65 + ln4 + 3] = v1.w;
        lds_barrier();
        float f[8];
#pragma unroll
        for (int i = 0; i < 8; ++i) f[i] = tile[(skc * 8 + i) * 65 + sn];
        const int ng = cur.n0 + sn;
        int drow = ng;
        if (cur.rowmode == 1) drow = ((ng >> 3) << 4) + (ng & 7);
        else if (cur.rowmode == 2) drow = ((ng >> 3) << 4) + 8 + (ng & 7);
        uint4 o; o.x = pack2(f[0], f[1]); o.y = pack2(f[2], f[3]); o.z = pack2(f[4], f[5]); o.w = pack2(f[6], f[7]);
        *(uint4*)(cur.dst + (size_t)drow * cur.lddst + cur.k0 + skc * 8) = o;
        cur = nx; v0 = w0; v1 = w1;
    }
    lds_barrier();
}
__device__ __forceinline__ void deferred_wtiles(const Params& p, unsigned char* lds, int slot) {
    const XcdIter xi = xcd_iter();
    if (xi.nx != 8 || xi.nloc != 32) {
        if (slot == 0) { const int b = blockIdx.x, g = gridDim.x; transpose_stream(p, lds, (6912 - b + g - 1) / g, [=](int j) { return b + j * g; }); }
        return;
    }
    if (xi.local < 8) return;
    const int ib = (xi.local - 8) * 8 + xi.xcd;
    const int per = slot == 0 ? 2 : (slot == 3 ? 20 : 7);
    const int base = (slot == 0 ? 0 : (slot == 1 ? 2 : (slot == 2 ? 9 : 16))) * 192;
    transpose_stream(p, lds, per, [=](int j) { return base + j * 192 + ib; });
}

__device__ __forceinline__ void phase_pro_a(const Params& p, unsigned char* lds) {
    const WS w{p.ws};
    const int tid = threadIdx.x;
    if (blockIdx.x == 0 && tid < 64) ((int*)(p.ws + OFF_CNT))[tid] = 0;
    constexpr int N_MOD = 2 * 3 * KSPLIT_MOD, N_TAB = (2 * 2 * NG * PS * 34 + NTHR - 1) / NTHR, N_WT = 768;
    for (int rep = 0; rep < REP_PRO; ++rep)
    for (int it = blockIdx.x; it < N_MOD + N_TAB; it += gridDim.x) {
        if (it < N_MOD) {
            const int l = it / (3 * KSPLIT_MOD), rem = it % (3 * KSPLIT_MOD), cb = rem / KSPLIT_MOD, ks = rem % KSPLIT_MOD;
            float* sc = (float*)lds;
            __syncthreads();
            for (int i = tid; i < 9 * 32; i += NTHR) {
                const int r = i >> 5, kk = i & 31, k = ks * 32 + kk;
                const float cv = r < 8 ? p.in[1][r * D + k] : p.in[3][k];
                sc[i] = siluf_(cv);
            }
            __syncthreads();
            float acc[9][4];
#pragma unroll
            for (int r = 0; r < 9; ++r) { acc[r][0] = acc[r][1] = acc[r][2] = acc[r][3] = 0.f; }
            const float* wm = p.in[4] + ((size_t)l * D + ks * 32) * 6144 + cb * 2048 + tid * 4;
#pragma unroll 8
            for (int kk = 0; kk < 32; ++kk) {
                const float4 v = *(const float4*)(wm + (size_t)kk * 6144);
#pragma unroll
                for (int r = 0; r < 9; ++r) { const float s = sc[r * 32 + kk]; acc[r][0] += s * v.x; acc[r][1] += s * v.y; acc[r][2] += s * v.z; acc[r][3] += s * v.w; }
            }
            float* mp = w.modp() + ((size_t)(ks * 2 + l) * 9) * 6144 + cb * 2048 + tid * 4;
#pragma unroll
            for (int r = 0; r < 9; ++r) *(float4*)(mp + (size_t)r * 6144) = make_float4(acc[r][0], acc[r][1], acc[r][2], acc[r][3]);
        } else if (it < N_MOD + N_TAB) {
            const int id = (it - N_MOD) * NTHR + tid;
            if (id < 2 * 2 * NG * PS * 34) {
                const int item = id % 34, q = id / 34;
                const int pp = q & 63, g = (q >> 6) & 31, d = (q >> 11) & 1, l = q >> 12;
                const int i3 = (l * 2 + d) * NG + g;
                const double dt = exp((double)p.in[9][i3]);
                const double are = (double)p.in[7][i3 * PS + pp], aim = (double)p.in[8][i3 * PS + pp];
                const double kk = item < 17 ? (double)item : (item == 17 ? (double)(TCH * SEGLEN) : 1.0);
                const double mag = exp(kk * are * dt);
                double sn, cs; sincos(kk * aim * dt, &sn, &cs);
                if (item < 18) {
                    w.lampow(l, d, g)[pp * NPOW + item] = make_float2((float)(mag * cs), (float)(mag * sn));
                } else {
                    const int n = item - 18;
                    const double lbr = mag * cs, lbi = mag * sn;
                    const double nr = lbr - 1.0, ni = lbi, den = are * are + aim * aim;
                    const double cr = (nr * are + ni * aim) / den, ci = (ni * are - nr * aim) / den;
                    const double br = (double)p.in[10][(size_t)(i3 * PS + pp) * 16 + n], bi = (double)p.in[11][(size_t)(i3 * PS + pp) * 16 + n];
                    w.bbar(l, d, g)[pp * 16 + n] = make_float2((float)(cr * br - ci * bi), (float)(cr * bi + ci * br));
                }
            }
        }
    }
    { const int b = blockIdx.x, g = gridDim.x; transpose_stream(p, lds, (768 - b + g - 1) / g, [=](int j) { return -(b + j * g) - 1; }); }
}

__device__ __forceinline__ void phase_pro_b(const Params& p, unsigned char* lds) {
    const WS w{p.ws};
    const int tid = threadIdx.x;
    const int gt = blockIdx.x * NTHR + tid, gs = gridDim.x * NTHR;
    for (int rep = 0; rep < REP_PB_K; ++rep)
    for (int it = blockIdx.x; it < 2 * NG * 2; it += gridDim.x) {
        const int d = it & 1, g = (it >> 1) & 31, l = it >> 6;
        float2* Lp = (float2*)lds;
        float2* Bb = Lp + 64 * 16;
        float2* Cc = Bb + 64 * 16;
        __syncthreads();
        const float2* lp = w.lampow(l, d, g); const float2* bb = w.bbar(l, d, g);
        const float* cre = p.in[12] + (size_t)((l * 2 + d) * NG + g) * 16 * PS; const float* cim = p.in[13] + (size_t)((l * 2 + d) * NG + g) * 16 * PS;
        for (int i = tid; i < 1024; i += NTHR) {
            Lp[i] = lp[(i >> 4) * NPOW + (i & 15)];
            Bb[i] = bb[i];
            Cc[i] = make_float2(cre[i], cim[i]);
        }
        __syncthreads();
        const int no = (tid >> 4) & 15, ni = tid & 15, th = tid >> 8;
        float acc[8];
#pragma unroll
        for (int t = 0; t < 8; ++t) acc[t] = 0.f;
        for (int pp = 0; pp < PS; ++pp) {
            const float2 c = Cc[no * 64 + pp], b = Bb[pp * 16 + ni];
            const float cr = c.x * b.x - c.y * b.y, ci = c.x * b.y + c.y * b.x;
#pragma unroll
            for (int t = 0; t < 8; ++t) { const float2 L = Lp[pp * 16 + th * 8 + t]; acc[t] += cr * L.x - ci * L.y; }
        }
        if (d == 0 && th == 0) acc[0] += (no == ni) ? p.in[14][l * DS5 + g * 16 + no] : 0.f;
        float* kf = w.kfull(l, g);
#pragma unroll
        for (int t = 0; t < 8; ++t) {
            const int tau = th * 8 + t;
            const int ti = d == 0 ? 15 + tau : (tau == 0 ? 31 : 15 - tau);
            kf[(ti * 16 + no) * 16 + ni] = acc[t];
        }
    }
    for (int rep = 0; rep < REP_PB_M; ++rep) {
    for (int i = gt; i < 2 * 9 * 6144; i += gs) {
        const int l = i / (9 * 6144), n = i % 6144;
        float s = p.in[5][l * 6144 + n];
        const float* mp = w.modp() + i;
#pragma unroll
        for (int ks = 0; ks < KSPLIT_MOD; ++ks) s += mp[(size_t)ks * 2 * 9 * 6144];
        ((float*)(p.ws + OFF_MOD))[i] = s;
    }
    for (int i = gt; i < 2 * NG * 256 * 32; i += gs) {
        const int c8 = i & 31, row = (i >> 5) & 255, lg = i >> 13, g = lg & 31, l = lg >> 5;
        const int d = row >> 7, pp = (row & 127) >> 1, c = row & 1, j = c8 >> 1, n0 = (c8 & 1) * 8;
        const int e = d == 0 ? (TCH - 1 - j) : j;
        const float2 L = w.lampow(l, d, g)[pp * NPOW + e];
        const float2* bb = w.bbar(l, d, g) + pp * 16 + n0;
        float f[8];
#pragma unroll
        for (int n = 0; n < 8; ++n) { const float2 Bv = bb[n]; f[n] = c == 0 ? (L.x * Bv.x - L.y * Bv.y) : (L.x * Bv.y + L.y * Bv.x); }
        uint4 o; o.x = pack2(f[0], f[1]); o.y = pack2(f[2], f[3]); o.z = pack2(f[4], f[5]); o.w = pack2(f[6], f[7]);
        *(uint4*)(w.m1(l, g) + (size_t)row * 256 + c8 * 8) = o;
    }
    for (int i = gt; i < 2 * NG * 256 * 32; i += gs) {
        const int c8 = i & 31, r = (i >> 5) & 255, lg = i >> 13, g = lg & 31, l = lg >> 5;
        const int jo = r >> 4, no = r & 15;
        const int kk = c8 * 8, d = kk >> 7, p0 = (kk & 127) >> 1;
        const int e = d == 0 ? (jo + 1) : (TCH - jo);
        const float* cre = p.in[12] + ((size_t)((l * 2 + d) * NG + g) * 16 + no) * PS;
        const float* cim = p.in[13] + ((size_t)((l * 2 + d) * NG + g) * 16 + no) * PS;
        const float2* lp = w.lampow(l, d, g);
        float f[8];
#pragma unroll
        for (int q = 0; q < 4; ++q) {
            const int pp = p0 + q;
            const float2 L = lp[pp * NPOW + e];
            const float cr = cre[pp], ci = cim[pp];
            f[2 * q] = cr * L.x - ci * L.y;
            f[2 * q + 1] = -(cr * L.y + ci * L.x);
        }
        uint4 o; o.x = pack2(f[0], f[1]); o.y = pack2(f[2], f[3]); o.z = pack2(f[4], f[5]); o.w = pack2(f[6], f[7]);
        *(uint4*)(w.w2(l, g) + (size_t)r * 512 + 256 + c8 * 8) = o;
    }
    }
    {
        float* shsc = (float*)lds;
        for (int rep = 0; rep < REP_PB_H; ++rep)
        for (int it = blockIdx.x; it < NROW / 32; it += gridDim.x) {
            const int row0 = it * 32, m = modrow(row0);
            __syncthreads();
            for (int i = tid; i < 2048; i += NTHR) {
                float sacc = p.in[5][i];
                const float* mp = w.modp() + (size_t)m * 6144 + i;
#pragma unroll
                for (int ks = 0; ks < KSPLIT_MOD; ++ks) sacc += mp[(size_t)ks * 2 * 9 * 6144];
                shsc[i] = sacc;
            }
            __syncthreads();
            for (int i0 = tid; i0 < 32 * 128; i0 += 4 * NTHR) {
                float4 a[4], b[4];
#pragma unroll
                for (int u = 0; u < 4; ++u) {
                    const int i = i0 + u * NTHR, row = row0 + (i >> 7), c8 = (i & 127) * 8;
                    const float* xs = row < NLAT ? p.in[0] + (size_t)row * D : p.in[2] + (size_t)(row - NLAT) * D;
                    a[u] = *(const float4*)(xs + c8); b[u] = *(const float4*)(xs + c8 + 4);
                }
#pragma unroll
                for (int u = 0; u < 4; ++u) {
                    const int i = i0 + u * NTHR, row = row0 + (i >> 7), c8 = (i & 127) * 8;
                    const float4 s0 = *(const float4*)(shsc + c8), s1 = *(const float4*)(shsc + c8 + 4), c0 = *(const float4*)(shsc + 1024 + c8), c1 = *(const float4*)(shsc + 1024 + c8 + 4);
                    uint4 o;
                    o.x = pack2(a[u].x * (1.f + c0.x) + s0.x, a[u].y * (1.f + c0.y) + s0.y);
                    o.y = pack2(a[u].z * (1.f + c0.z) + s0.z, a[u].w * (1.f + c0.w) + s0.w);
                    o.z = pack2(b[u].x * (1.f + c1.x) + s1.x, b[u].y * (1.f + c1.y) + s1.y);
                    o.w = pack2(b[u].z * (1.f + c1.z) + s1.z, b[u].w * (1.f + c1.w) + s1.w);
                    *(uint4*)(w.hb() + (size_t)row * D + c8) = o;
                }
            }
        }
    }
}

__device__ __forceinline__ void w2_toeplitz_fill(const Params& p) {
    const WS w{p.ws};
    const int gt = blockIdx.x * NTHR + threadIdx.x, gs = gridDim.x * NTHR;
    for (int i = gt; i < 2 * NG * 256 * 32; i += gs) {
        const int c8 = i & 31, r = (i >> 5) & 255, lg = i >> 13, g = lg & 31, l = lg >> 5;
        const int jo = r >> 4, no = r & 15, ji = c8 >> 1, n0 = (c8 & 1) * 8;
        const float* kf = w.kfull(l, g) + ((size_t)(jo - ji + 15) * 16 + no) * 16 + n0;
        float f[8];
#pragma unroll
        for (int n = 0; n < 8; ++n) f[n] = kf[n];
        if (jo == ji) {
            const float* k2 = w.kfull(l, g) + ((size_t)31 * 16 + no) * 16 + n0;
#pragma unroll
            for (int n = 0; n < 8; ++n) f[n] += k2[n];
        }
        uint4 o; o.x = pack2(f[0], f[1]); o.y = pack2(f[2], f[3]); o.z = pack2(f[4], f[5]); o.w = pack2(f[6], f[7]);
        *(uint4*)(w.w2(l, g) + (size_t)r * 512 + c8 * 8) = o;
    }
}

struct EpiInproj {
    bf16_t* ug; bf16_t* zr; int m0, n0;
    __device__ __forceinline__ void operator()(const f32x16 (&acc)[2][2], int r0, int c0) const {
        ACC_FOREACH(2, acc, r0, c0, {
            const int row = m0 + rl, col = n0 + cl;
            uint2 o; o.x = pack2(v0, v1); o.y = pack2(v2, v3);
            if (col < DS5) *(uint2*)(ug + ((size_t)(col >> 4) * NROW + row) * 16 + (col & 15)) = o;
            else *(uint2*)(zr + (size_t)row * 1280 + (col - DS5)) = o;
        })
    }
};
__device__ __forceinline__ void phase_inproj(const Params& p, unsigned char* lds, int l) {
    const WS w{p.ws};
    const XcdIter xi = xcd_iter();
    const int nlat = 64 / xi.nx, nctx = 8 / xi.nx, ctxn = l == 0 ? 14 : 4;
    const int nunit = nlat * 14 + nctx * ctxn;
    auto get = [&](int i, SrcA& A, SrcB& B, EpiInproj& e) -> bool {
        const int u = xi.local + i * xi.nloc;
        if (u >= nunit) return false;
        int mt, nt;
        if (u < nlat * 14) { mt = (u / 14) * xi.nx + xi.xcd; nt = u % 14; }
        else { const int v = u - nlat * 14; mt = 64 + (v / ctxn) * xi.nx + xi.xcd; nt = v % ctxn; }
        src_plain<4>(A, w.hb(), mt * 256, D);
        src_plain<2>(B, w.wt_in(l), nt * 128, D);
        e = EpiInproj{w.ug(), w.zr(), mt * 256, nt * 128};
        return true;
    };
    gemm_stream<2, EpiInproj>(lds, D, get);
}

struct EpiS1 {
    float* S; int m0, n0;
    __device__ __forceinline__ void operator()(const f32x16 (&acc)[1][2], int r0, int c0) const {
        ACC_FOREACH(1, acc, r0, c0, {
            *(float4*)(S + (size_t)(m0 + rl) * 256 + n0 + cl) = make_float4(v0, v1, v2, v3);
        })
    }
};

__device__ __forceinline__ void conv_sc(const Params& p, int l, int nrows) {
    const WS w{p.ws};
    const float* wsc = p.in[17] + (size_t)l * 3 * 256;
    const int gt = blockIdx.x * NTHR + threadIdx.x, gs = gridDim.x * NTHR;
    for (int i = gt; i < nrows * 16; i += gs) {
        const int row = i >> 4, c16 = (i & 15) * 16;
        int pos, len;
        if (row < NLAT) { pos = row & 63; len = 64; } else { pos = (row - NLAT) & 255; len = 256; }
        const bf16_t* zr = w.zr() + (size_t)row * 1280;
        uint4 cg[3][2], vv[3][2];
#pragma unroll
        for (int j = 0; j < 3; ++j) {
            const bool ok = (pos + j - 1 >= 0) && (pos + j - 1 < len);
#pragma unroll
            for (int u = 0; u < 2; ++u) {
                if (ok) { cg[j][u] = *(const uint4*)(zr + (ptrdiff_t)(j - 1) * 1280 + 256 + c16 + u * 8); vv[j][u] = *(const uint4*)(zr + (ptrdiff_t)(j - 1) * 1280 + 512 + c16 + u * 8); }
                else { cg[j][u] = make_uint4(0, 0, 0, 0); vv[j][u] = make_uint4(0, 0, 0, 0); }
            }
        }
        uint4 bg[2];
#pragma unroll
        for (int u = 0; u < 2; ++u) bg[u] = *(const uint4*)(zr + c16 + u * 8);
#pragma unroll
        for (int u = 0; u < 2; ++u) {
            float accv[8];
#pragma unroll
            for (int e = 0; e < 8; ++e) accv[e] = 0.f;
#pragma unroll
            for (int j = 0; j < 3; ++j) {
                const float4 wa = *(const float4*)(wsc + j * 256 + c16 + u * 8), wb = *(const float4*)(wsc + j * 256 + c16 + u * 8 + 4);
                const uint4 c = cg[j][u], v = vv[j][u];
                accv[0] += wa.x * bflo(c.x) * bflo(v.x); accv[1] += wa.y * bfhi(c.x) * bfhi(v.x);
                accv[2] += wa.z * bflo(c.y) * bflo(v.y); accv[3] += wa.w * bfhi(c.y) * bfhi(v.y);
                accv[4] += wb.x * bflo(c.z) * bflo(v.z); accv[5] += wb.y * bfhi(c.z) * bfhi(v.z);
                accv[6] += wb.z * bflo(c.w) * bflo(v.w); accv[7] += wb.w * bfhi(c.w) * bfhi(v.w);
            }
            uint4 o;
            o.x = pack2(accv[0] * bflo(bg[u].x), accv[1] * bfhi(bg[u].x));
            o.y = pack2(accv[2] * bflo(bg[u].y), accv[3] * bfhi(bg[u].y));
            o.z = pack2(accv[4] * bflo(bg[u].z), accv[5] * bfhi(bg[u].z));
            o.w = pack2(accv[6] * bflo(bg[u].w), accv[7] * bfhi(bg[u].w));
            *(uint4*)(w.hb() + (size_t)row * D + 512 + c16 + u * 8) = o;
        }
    }
}

template <int PM>
__device__ __forceinline__ void conv_cf(const Params& p, unsigned char* lds, int l, bool with_ctx) {
    const WS w{p.ws};
    float* P = (float*)lds;
    const int tid = threadIdx.x, lane = tid & 63, wid = __builtin_amdgcn_readfirstlane(tid >> 6);
    float4 wv[31];
#pragma unroll
    for (int k = 0; k < 31; ++k) wv[k] = *(const float4*)(p.in[18] + (size_t)l * 31 * 256 + k * 256 + lane * 4);
    const float4 bdw = *(const float4*)(p.in[19] + l * 256 + lane * 4);
    const float4 lg = *(const float4*)(p.in[20] + l * 256 + lane * 4);
    const float4 lb = *(const float4*)(p.in[21] + l * 256 + lane * 4);
    const int nitem = 512 + (with_ctx ? 64 : 0);
    uint4 rga[4], rgb[4];
    auto item_geom = [&](int it, bool& lat, int& base, int& nslot, int& s0) {
        lat = it < 512; s0 = 0;
        if (lat) { base = (it >> 6) * SEQ + (it & 63); nslot = 32; }
        else { const int j = it - 512; s0 = (j & 7) * 32; base = NLAT + (j >> 3) * CTX; nslot = 62; }
    };
    auto issue = [&](int it) {
        bool lat; int base, nslot, s0; item_geom(it, lat, base, nslot, s0);
#pragma unroll
        for (int t = 0; t < 4; ++t) {
            const int task = tid + t * NTHR, slot = task >> 5, c8 = (task & 31) * 8;
            int row; bool valid = slot < nslot;
            if (lat) row = base + slot * 64;
            else { const int sq = s0 - 15 + slot; valid = valid && sq >= 0 && sq < CTX; row = base + sq; }
            if (valid) {
                const bf16_t* zr = w.zr() + (size_t)row * 1280;
                rga[t] = *(const uint4*)(zr + 768 + c8); rgb[t] = *(const uint4*)(zr + 1024 + c8);
            } else { rga[t] = make_uint4(0, 0, 0, 0); rgb[t] = make_uint4(0, 0, 0, 0); }
        }
    };
    const int rb = gridDim.x - 1 - blockIdx.x;
    if (rb < nitem) issue(rb);
    for (int it = rb; it < nitem; it += gridDim.x) {
        bool lat; int base, nslot, s0; item_geom(it, lat, base, nslot, s0);
        lds_barrier();
#pragma unroll
        for (int t = 0; t < 4; ++t) {
            const int task = tid + t * NTHR, slot = task >> 5, c8 = (task & 31) * 8;
            if (PM == 3) { KEEP(rga[t].x); KEEP(rgb[t].x); }
            if (PM != 3 && slot < nslot) {
                const uint4 ga = rga[t], gb = rgb[t];
                float f[8];
                f[0] = bflo(ga.x) * sigmoidf_(bflo(gb.x)); f[1] = bfhi(ga.x) * sigmoidf_(bfhi(gb.x));
                f[2] = bflo(ga.y) * sigmoidf_(bflo(gb.y)); f[3] = bfhi(ga.y) * sigmoidf_(bfhi(gb.y));
                f[4] = bflo(ga.z) * sigmoidf_(bflo(gb.z)); f[5] = bfhi(ga.z) * sigmoidf_(bfhi(gb.z));
                f[6] = bflo(ga.w) * sigmoidf_(bflo(gb.w)); f[7] = bfhi(ga.w) * sigmoidf_(bfhi(gb.w));
                *(float4*)(P + slot * 256 + c8) = make_float4(f[0], f[1], f[2], f[3]);
                *(float4*)(P + slot * 256 + c8 + 4) = make_float4(f[4], f[5], f[6], f[7]);
            }
        }
        if (it + (int)gridDim.x < nitem) issue(it + gridDim.x);
        lds_barrier();
        constexpr int OPW = 32 / NWV;
        const int o0 = wid * OPW;
        float4 a[OPW];
#pragma unroll
        for (int o = 0; o < OPW; ++o) a[o] = bdw;
        if (PM != 1) {
#pragma unroll
            for (int i = 0; i < OPW + 30; ++i) {
                const int rr = lat ? o0 - 15 + i : o0 + i;
                if (!lat || (rr >= 0 && rr < 32)) {
                    const float4 pv = *(const float4*)(P + rr * 256 + lane * 4);
#pragma unroll
                    for (int o = 0; o < OPW; ++o) {
                        const int k = i - o;
                        if (k >= 0 && k < 31) { a[o].x += wv[k].x * pv.x; a[o].y += wv[k].y * pv.y; a[o].z += wv[k].z * pv.z; a[o].w += wv[k].w * pv.w; }
                    }
                }
            }
        }
        if (PM == 2) {
#pragma unroll
            for (int o = 0; o < OPW; ++o) { KEEP(a[o].x); KEEP(a[o].y); KEEP(a[o].z); KEEP(a[o].w); }
        } else
#pragma unroll
        for (int o = 0; o < OPW; ++o) {
            const int row = lat ? base + (o0 + o) * 64 : base + s0 + o0 + o;
            const float mean = wave_sum_fast(a[o].x + a[o].y + a[o].z + a[o].w) * (1.0f / 256.0f);
            const float dx = a[o].x - mean, dy = a[o].y - mean, dz = a[o].z - mean, dw = a[o].w - mean;
            const float var = wave_sum_fast(dx * dx + dy * dy + dz * dz + dw * dw) * (1.0f / 256.0f);
            const float rs = rsqrtf(var + LN_EPS);
            const float y0 = siluf_(dx * rs * lg.x + lb.x), y1 = siluf_(dy * rs * lg.y + lb.y), y2 = siluf_(dz * rs * lg.z + lb.z), y3 = siluf_(dw * rs * lg.w + lb.w);
            uint2 ov; ov.x = pack2(y0, y1); ov.y = pack2(y2, y3);
            if (PM == 0) *(uint2*)(w.hb() + (size_t)row * D + 768 + lane * 4) = ov; else { KEEP(ov.x); KEEP(ov.y); }
        }
    }
}

__device__ __forceinline__ void phase_s1(const Params& p, unsigned char* lds, int l) {
    const WS w{p.ws};
    const XcdIter xi = xcd_iter();
    const int nunit = (NG / xi.nx) * 18;
    auto get = [&](int i, SrcA& A, SrcB& B, EpiS1& e) -> bool {
        const int u = xi.local + i * xi.nloc;
        if (u >= nunit) return false;
        const int g = (u / 18) * xi.nx + xi.xcd, r = u % 18, mt = r >> 1, nt = r & 1;
        src_plain<2>(A, w.ug() + (size_t)g * NROW * 16, mt * 128, 256);
        src_plain<2>(B, w.m1(l, g), nt * 128, 256);
        e = EpiS1{w.S() + (size_t)g * NCOL * 256, mt * 128, nt * 128};
        return true;
    };
    gemm_stream<1, EpiS1>(lds, 256, get);
    __syncthreads();
    if (l == 0) deferred_wtiles(p, lds, 0);
    for (int rep = 0; rep < REP_CONV; ++rep) {
    for (int r2 = 0; r2 < REP_CSC; ++r2) conv_sc(p, l, l == 0 ? NROW : NLAT);
    conv_cf<0>(p, lds, l, l == 0);
    if (REP_CCF > 1) conv_cf<CCF_PM>(p, lds, l, l == 0);
    }
}

__device__ __forceinline__ int chunk_col(int d, int b, int step) {
    if (step < CH_CTX) { const int c = d == 0 ? step : (CH_CTX - 1 - step); return NCOL_LAT + b * CH_CTX + c; }
    const int s = step - CH_CTX; const int c = d == 0 ? s : (CH_LAT - 1 - s); return b * CH_LAT + c;
}
__device__ __forceinline__ void phase_s2(const Params& p, unsigned char* lds, int l) {
    const WS w{p.ws};
    float2* Fs = (float2*)lds;
    const int tid = threadIdx.x, seg = tid >> 6, pp = tid & 63;
    for (int rep = 0; rep < REP_S2; ++rep)
    for (int it = blockIdx.x; it < NG * 2 * NB; it += gridDim.x) {
        const int b = it & 7, d = (it >> 3) & 1, g = it >> 4;
        const float2 A = w.lampow(l, d, g)[pp * NPOW + 16], A18 = w.lampow(l, d, g)[pp * NPOW + 17];
        const float* S = w.S() + (size_t)g * NCOL * 256 + d * 128 + 2 * pp;
        bf16_t* Hp = w.hprev() + (size_t)g * NCOL * 256 + d * 128 + 2 * pp;
        float2 s[SEGLEN];
#pragma unroll
        for (int i = 0; i < SEGLEN; ++i) s[i] = *(const float2*)(S + (size_t)chunk_col(d, b, seg * SEGLEN + i) * 256);
        float2 F = make_float2(0.f, 0.f);
#pragma unroll
        for (int i = 0; i < SEGLEN; ++i) { const float fr = A.x * F.x - A.y * F.y + s[i].x, fi = A.x * F.y + A.y * F.x + s[i].y; F.x = fr; F.y = fi; }
        __syncthreads();
        Fs[seg * 64 + pp] = F;
        __syncthreads();
        float2 H = make_float2(0.f, 0.f);
        for (int q = 0; q < seg; ++q) { const float2 f = Fs[q * 64 + pp]; const float hr = A18.x * H.x - A18.y * H.y + f.x, hi = A18.x * H.y + A18.y * H.x + f.y; H.x = hr; H.y = hi; }
#pragma unroll
        for (int i = 0; i < SEGLEN; ++i) {
            *(unsigned*)(Hp + (size_t)chunk_col(d, b, seg * SEGLEN + i) * 256) = pack2(H.x, H.y);
            const float hr = A.x * H.x - A.y * H.y + s[i].x, hi = A.x * H.y + A.y * H.x + s[i].y; H.x = hr; H.y = hi;
        }
    }
}

struct EpiS3 {
    bf16_t* Y; int m0, n0, g;
    __device__ __forceinline__ void operator()(const f32x16 (&acc)[1][2], int r0, int c0) const {
        ACC_FOREACH(1, acc, r0, c0, {
            const int col = n0 + cl, tok = (m0 + rl) * TCH + (col >> 4);
            uint2 o; o.x = pack2(gelu_tanh(v0), gelu_tanh(v1)); o.y = pack2(gelu_tanh(v2), gelu_tanh(v3));
            *(uint2*)(Y + (size_t)tok * DS5 + g * 16 + (col & 15)) = o;
        })
    }
};
__device__ __forceinline__ void phase_s3(const Params& p, unsigned char* lds, int l) {
    const WS w{p.ws};
    const XcdIter xi = xcd_iter();
    const int nmt = l == 0 ? 9 : 8, nunit = (NG / xi.nx) * nmt * 2;
    auto get = [&](int i, SrcA& A, SrcB& B, EpiS3& e) -> bool {
        const int u = xi.local + i * xi.nloc;
        if (u >= nunit) return false;
        const int g = (u / (nmt * 2)) * xi.nx + xi.xcd, r = u % (nmt * 2), mt = r >> 1, nt = r & 1;
        src_split<2>(A, w.ug() + (size_t)g * NROW * 16, 256, w.hprev() + (size_t)g * NCOL * 256, 256, mt * 128, 256);
        src_plain<2>(B, w.w2(l, g), nt * 128, 512);
        e = EpiS3{w.Y(), mt * 128, nt * 128, g};
        return true;
    };
    gemm_stream<1, EpiS3>(lds, 512, get);
    if (l == 0) deferred_wtiles(p, lds, 1);
}

struct EpiGlu {
    const bf16_t* Y; bf16_t* hb; const float* bg; int m0, n0;
    __device__ __forceinline__ void operator()(const f32x16 (&acc)[1][2], int r0, int c0) const {
        ACC_FOREACH(1, acc, r0, c0, {
            const int row = m0 + rl, col = n0 + cl;
            const uint2 t = *(const uint2*)(Y + (size_t)row * DS5 + col);
            const float4 b = *(const float4*)(bg + col);
            uint2 o;
            o.x = pack2(bflo(t.x) * sigmoidf_(v0 + b.x), bfhi(t.x) * sigmoidf_(v1 + b.y));
            o.y = pack2(bflo(t.y) * sigmoidf_(v2 + b.z), bfhi(t.y) * sigmoidf_(v3 + b.w));
            *(uint2*)(hb + (size_t)row * D + col) = o;
        })
    }
};
__device__ __forceinline__ void phase_glu(const Params& p, unsigned char* lds, int l) {
    const WS w{p.ws};
    const XcdIter xi = xcd_iter();
    const int nmt = (l == 0 ? 144 : 128) / xi.nx, nunit = nmt * 4;
    auto get = [&](int i, SrcA& A, SrcB& B, EpiGlu& e) -> bool {
        const int u = xi.local + i * xi.nloc;
        if (u >= nunit) return false;
        const int mt = (u >> 2) * xi.nx + xi.xcd, nt = u & 3;
        src_plain<2>(A, w.Y(), mt * 128, DS5);
        src_plain<2>(B, w.wt_glu(l), nt * 128, 512);
        e = EpiGlu{w.Y(), w.hb(), p.in[16] + l * DS5, mt * 128, nt * 128};
        return true;
    };
    gemm_stream<1, EpiGlu>(lds, 512, get);
    if (l == 0) deferred_wtiles(p, lds, 2);
}

struct EpiOut {
    bf16_t* y; int m0, n0;
    __device__ __forceinline__ void operator()(const f32x16 (&acc)[2][2], int r0, int c0) const {
        ACC_FOREACH(2, acc, r0, c0, {
            uint2 o; o.x = pack2(v0, v1); o.y = pack2(v2, v3);
            *(uint2*)(y + (size_t)(m0 + rl) * D + n0 + cl) = o;
        })
    }
};
__device__ __forceinline__ void phase_outproj(const Params& p, unsigned char* lds, int l) {
    const WS w{p.ws};
    const XcdIter xi = xcd_iter();
    const int nmt = (l == 0 ? 72 : 64) / xi.nx, nunit = nmt * 8;
    auto get = [&](int i, SrcA& A, SrcB& B, EpiOut& e) -> bool {
        const int u = xi.local + i * xi.nloc;
        if (u >= nunit) return false;
        const int mt = (u >> 3) * xi.nx + xi.xcd, nt = u & 7;
        src_plain<4>(A, w.hb(), mt * 256, D);
        src_plain<2>(B, w.wt_o(l), nt * 128, D);
        e = EpiOut{w.zr(), mt * 256, nt * 128};
        return true;
    };
    gemm_stream<2, EpiOut>(lds, D, get);
    if (l == 0) deferred_wtiles(p, lds, 3);
}

template <bool DRY>
__device__ __forceinline__ void phase_ln1(const Params& p, unsigned char* lds, int l) {
    const WS w{p.ws};
    const int tid = threadIdx.x, lane = tid & 63, wid = tid >> 6;
    float* wl = (float*)lds;
    __syncthreads();
#pragma unroll
    for (int kk = 0; kk < 2; ++kk) {
        const int k = tid + NTHR * kk;
        const int s = ((k >> 8) * 4 + (k & 3)) * 64 + ((k >> 2) & 63);
        const float4 g = *(const float4*)(p.in[25] + ((size_t)l * D + k) * 4);
        const float4* ex = (const float4*)(p.in[27] + ((size_t)l * D + k) * 16);
        const float4 e0 = ex[0], e1 = ex[1], e2 = ex[2], e3 = ex[3];
        *(float4*)(wl + (0 * 1024 + s) * 4) = g;
        *(float4*)(wl + (1 * 1024 + s) * 4) = e0;
        *(float4*)(wl + (2 * 1024 + s) * 4) = e1;
        *(float4*)(wl + (3 * 1024 + s) * 4) = e2;
        *(float4*)(wl + (4 * 1024 + s) * 4) = e3;
    }
    __syncthreads();
    const int nrows = l == 0 ? NROW : NLAT;
    const float* md = w.mod(l);
    const float* lng = p.in[23] + l * D; const float* lnb = p.in[24] + l * D;
    const float brg0 = p.in[26][l * 4 + 0], brg1 = p.in[26][l * 4 + 1], brg2 = p.in[26][l * 4 + 2], brg3 = p.in[26][l * 4 + 3];
    float bre[16];
#pragma unroll
    for (int i = 0; i < 16; ++i) bre[i] = p.in[28][l * 16 + i];
    int k_cls = 0, k_row = 0, nkeep = 0; float k_wlo = 0.f, k_whi = 0.f;
    const int nwv = gridDim.x * NWV, rpw = (nrows + nwv - 1) / nwv;
    int row = (blockIdx.x * NWV + wid) * rpw;
    const int rend = min(nrows, row + rpw);
    float4 pg[4], pb[4], psh[4], psc[4], pg1[4];
#pragma unroll
    for (int i = 0; i < 4; ++i) { pg[i] = *(const float4*)(lng + i * 256 + lane * 4); pb[i] = *(const float4*)(lnb + i * 256 + lane * 4); psh[i] = pg[i]; psc[i] = pg[i]; pg1[i] = pg[i]; }
    const bf16_t* ybuf = w.zr();
    int mcur = -1;
    float4 vn[4]; uint2 yn[4];
    if (row < rend) {
        const float* R0 = l == 0 ? (row < NLAT ? p.in[0] + (size_t)row * D : p.in[2] + (size_t)(row - NLAT) * D) : Rrow(p, row);
#pragma unroll
        for (int i = 0; i < 4; ++i) { vn[i] = *(const float4*)(R0 + i * 256 + lane * 4); yn[i] = *(const uint2*)(ybuf + (size_t)row * D + i * 256 + lane * 4); }
    }
    for (; row < rend; ++row) {
        float* R = Rrow(p, row);
        const int m = modrow(row);
        if (m != mcur) {
            mcur = m;
#pragma unroll
            for (int i = 0; i < 4; ++i) { psh[i] = *(const float4*)(md + (size_t)m * 6144 + 3072 + i * 256 + lane * 4); psc[i] = *(const float4*)(md + (size_t)m * 6144 + 4096 + i * 256 + lane * 4); pg1[i] = *(const float4*)(md + (size_t)m * 6144 + 2048 + i * 256 + lane * 4); }
        }
        float h[16];
        float4 v[4];
#pragma unroll
        for (int i = 0; i < 4; ++i) {
            const float4 g1 = pg1[i]; const uint2 yy = yn[i];
            v[i].x = DN_ALPHA * vn[i].x + g1.x * bflo(yy.x); v[i].y = DN_ALPHA * vn[i].y + g1.y * bfhi(yy.x);
            v[i].z = DN_ALPHA * vn[i].z + g1.z * bflo(yy.y); v[i].w = DN_ALPHA * vn[i].w + g1.w * bfhi(yy.y);
        }
        if (row + 1 < rend) {
            const int rn = row + 1;
            const float* Rn = l == 0 ? (rn < NLAT ? p.in[0] + (size_t)rn * D : p.in[2] + (size_t)(rn - NLAT) * D) : Rrow(p, rn);
#pragma unroll
            for (int i = 0; i < 4; ++i) { vn[i] = *(const float4*)(Rn + i * 256 + lane * 4); yn[i] = *(const uint2*)(ybuf + (size_t)rn * D + i * 256 + lane * 4); }
        }
        float s = 0.f;
#pragma unroll
        for (int i = 0; i < 4; ++i) s += (v[i].x + v[i].y) + (v[i].z + v[i].w);
        const float mean = wave_sum_fast(s) * (1.0f / 1024.0f);
        float q = 0.f;
#pragma unroll
        for (int i = 0; i < 4; ++i) { const float a = v[i].x - mean, b = v[i].y - mean, c = v[i].z - mean, d = v[i].w - mean; q += (a * a + b * b) + (c * c + d * d); }
        const float rs = rsqrtf(wave_sum_fast(q) * (1.0f / 1024.0f) + LN_EPS);
#pragma unroll
        for (int i = 0; i < 4; ++i) {
            const int col = i * 256 + lane * 4;
            const float4 g = pg[i], b = pb[i], sh = psh[i], sc = psc[i];
            float4 x;
            x.x = (v[i].x - mean) * rs * g.x + b.x; x.y = (v[i].y - mean) * rs * g.y + b.y; x.z = (v[i].z - mean) * rs * g.z + b.z; x.w = (v[i].w - mean) * rs * g.w + b.w;
            if (!DRY) *(float4*)(R + col) = x; else { KEEP(x.x); KEEP(x.y); KEEP(x.z); KEEP(x.w); }
            h[i * 4 + 0] = x.x * (1.f + sc.x) + sh.x; h[i * 4 + 1] = x.y * (1.f + sc.y) + sh.y; h[i * 4 + 2] = x.z * (1.f + sc.z) + sh.z; h[i * 4 + 3] = x.w * (1.f + sc.w) + sh.w;
            uint2 o; o.x = pack2(h[i * 4 + 0], h[i * 4 + 1]); o.y = pack2(h[i * 4 + 2], h[i * 4 + 3]);
            if (!DRY) *(uint2*)(w.hb() + (size_t)row * D + col) = o; else { KEEP(o.x); KEEP(o.y); }
        }
        float* red = (float*)(lds + 81920) + wid * (64 * 24);
#pragma unroll 1
        for (int o4 = 0; o4 < 5; ++o4) {
            float a0 = 0.f, a1 = 0.f, a2 = 0.f, a3 = 0.f;
#pragma unroll
            for (int e = 0; e < 16; ++e) {
                const float4 wv = *(const float4*)(wl + ((o4 * 1024) + e * 64 + lane) * 4);
                a0 += h[e] * wv.x; a1 += h[e] * wv.y; a2 += h[e] * wv.z; a3 += h[e] * wv.w;
            }
            *(float4*)(red + lane * 24 + o4 * 4) = make_float4(a0, a1, a2, a3);
        }
        float mylg = 0.f;
        {
            const int oo = lane < 20 ? lane : 0;
            float t0 = 0.f, t1 = 0.f, t2 = 0.f, t3 = 0.f;
#pragma unroll
            for (int j = 0; j < 64; j += 4) { t0 += red[(j + 0) * 24 + oo]; t1 += red[(j + 1) * 24 + oo]; t2 += red[(j + 2) * 24 + oo]; t3 += red[(j + 3) * 24 + oo]; }
            mylg = (t0 + t1) + (t2 + t3);
        }
        float lg[20];
#pragma unroll
        for (int i = 0; i < 20; ++i) lg[i] = rl_f(mylg, i);
        {
            float gl[4];
            gl[0] = lg[0] + brg0; gl[1] = lg[1] + brg1; gl[2] = lg[2] + brg2; gl[3] = lg[3] + brg3;
            int gi = 0; float gm = gl[0];
#pragma unroll
            for (int i = 1; i < 4; ++i) if (gl[i] > gm) { gm = gl[i]; gi = i; }
            float den = 0.f;
#pragma unroll
            for (int i = 0; i < 4; ++i) den += __expf(gl[i] - gm);
            const float gw = 1.0f / den;
            float el[4];
#pragma unroll
            for (int i = 0; i < 4; ++i) {
                float t = lg[4 + i] + bre[i];
                if (gi == 1) t = lg[8 + i] + bre[4 + i]; else if (gi == 2) t = lg[12 + i] + bre[8 + i]; else if (gi == 3) t = lg[16 + i] + bre[12 + i];
                el[i] = t;
            }
            int i1 = 0; float m1 = el[0];
#pragma unroll
            for (int i = 1; i < 4; ++i) if (el[i] > m1) { m1 = el[i]; i1 = i; }
            int i2 = -1; float m2 = -3.0e38f;
#pragma unroll
            for (int i = 0; i < 4; ++i) if (i != i1 && el[i] > m2) { m2 = el[i]; i2 = i; }
            const float e2 = __expf(m2 - m1);
            const float w1 = gw / (1.0f + e2), w2 = gw * e2 / (1.0f + e2);
            const int lo = i1 < i2 ? i1 : i2, hi = i1 < i2 ? i2 : i1;
            const float wlo = i1 < i2 ? w1 : w2, whi = i1 < i2 ? w2 : w1;
            const int pair = lo == 0 ? (hi - 1) : (lo == 1 ? (hi + 1) : 5);
            const int cls = gi * 6 + pair;
            if (lane == nkeep) { k_cls = cls; k_row = row; k_wlo = wlo; k_whi = whi; }
            ++nkeep;
        }
        if (nkeep == 64) {
            if (!DRY) { const int pos = atomicAdd(w.cnt(l) + k_cls, 1); w.list()[(size_t)k_cls * LISTCAP + pos] = k_row; w.lw()[(size_t)k_cls * LISTCAP + pos] = make_float2(k_wlo, k_whi); }
            nkeep = 0;
        }
    }
    if (lane < nkeep) {
        if (!DRY) {
            const int pos = atomicAdd(w.cnt(l) + k_cls, 1);
            w.list()[(size_t)k_cls * LISTCAP + pos] = k_row;
            w.lw()[(size_t)k_cls * LISTCAP + pos] = make_float2(k_wlo, k_whi);
        } else { KEEP(k_cls); KEEP(k_wlo); KEEP(k_whi); }
    }
}

__device__ __forceinline__ void cls_experts(int cls, int& elo, int& ehi) {
    const int g = cls / 6, pr = cls % 6;
    const int lo = pr < 3 ? 0 : (pr < 5 ? 1 : 2);
    const int hi = pr < 3 ? pr + 1 : (pr < 5 ? pr - 1 : 3);
    elo = g * 4 + lo; ehi = g * 4 + hi;
}

struct EpiGU {
    bf16_t* act; const float2* lw; int cnt, pos0, orow0, half, fcol0;
    __device__ __forceinline__ void operator()(const f32x16 (&acc)[1][2], int r0, int c0) const {
        const int hh4 = c0 & 4, wn64 = c0 & 64;
        const int rl = r0, pos = pos0 + rl;
        float wt = 0.f;
        if (pos < cnt) { const float2 ww = lw[pos]; wt = half ? ww.y : ww.x; }
#pragma unroll
        for (int nt = 0; nt < 2; ++nt)
#pragma unroll
            for (int qp = 0; qp < 2; ++qp) {
                const int f = fcol0 + ((wn64 + nt * 32) >> 1) + qp * 8 + hh4;
                const int qg = qp * 2, qu = qp * 2 + 1;
                const float a0 = siluf_(acc[0][nt][qg * 4 + 0]) * acc[0][nt][qu * 4 + 0] * wt;
                const float a1 = siluf_(acc[0][nt][qg * 4 + 1]) * acc[0][nt][qu * 4 + 1] * wt;
                const float a2 = siluf_(acc[0][nt][qg * 4 + 2]) * acc[0][nt][qu * 4 + 2] * wt;
                const float a3 = siluf_(acc[0][nt][qg * 4 + 3]) * acc[0][nt][qu * 4 + 3] * wt;
                uint2 o; o.x = pack2(a0, a1); o.y = pack2(a2, a3);
                *(uint2*)(act + (size_t)(orow0 + rl) * 512 + half * 256 + f) = o;
            }
    }
};
__device__ __forceinline__ void phase_moe_gu(const Params& p, unsigned char* lds, int l) {
    const WS w{p.ws};
    const XcdIter xi = xcd_iter();
    int ntl[NCLS]; int tot = 0;
#pragma unroll
    for (int c = 0; c < NCLS; ++c) { ntl[c] = (w.cnt(l)[c] + 127) >> 7; tot += ntl[c]; }
    const int nmg = (tot + xi.nx - 1) / xi.nx, nunit = nmg * 8;
    const int lr = threadIdx.x >> 3, lc = (threadIdx.x & 7) ^ ((lr >> 1) & 7);
    auto get = [&](int i, SrcA& A, SrcB& B, EpiGU& ep) -> bool {
        const int u = xi.local + i * xi.nloc;
        if (u >= nunit) return false;
        const int mg = (u >> 3) * xi.nx + xi.xcd, nt = u & 7;
        if (mg >= tot) return false;
        int cls = 0, mt = 0, run = 0;
#pragma unroll
        for (int c = 0; c < NCLS; ++c) { if (mg >= run && mg < run + ntl[c]) { cls = c; mt = mg - run; } run += ntl[c]; }
        const int cnt = w.cnt(l)[cls];
        int elo, ehi; cls_experts(cls, elo, ehi);
        const int half = nt >> 2, e = half ? ehi : elo;
        const int* lst = w.list() + (size_t)cls * LISTCAP;
#pragma unroll
        for (int j = 0; j < 2; ++j) {
            int pos = mt * 128 + lr + 64 * j; if (pos >= cnt) pos = 0;
            const int tok = lst[pos];
            A.p0[j] = w.hb() + (size_t)tok * D + lc * 8; A.p1[j] = A.p0[j];
        }
        A.split = 1 << 30;
        src_plain<2>(B, w.wt_gu(l, e), (nt & 3) * 128, D);
        ep = EpiGU{w.act(), w.lw() + (size_t)cls * LISTCAP, cnt, mt * 128, mg * 128, half, (nt & 3) * 64};
        return true;
    };
    gemm_stream<1, EpiGU>(lds, D, get);
}

struct EpiDown {
    bf16_t* y; const int* lst; int cnt, pos0, n0;
    __device__ __forceinline__ void operator()(const f32x16 (&acc)[1][2], int r0, int c0) const {
        const int pos = pos0 + r0;
        if (pos < cnt) {
            const int row = lst[pos];
#pragma unroll
            for (int nt = 0; nt < 2; ++nt)
#pragma unroll
                for (int q = 0; q < 4; ++q) {
                    const int col = n0 + c0 + nt * 32 + q * 8;
                    uint2 o; o.x = pack2(acc[0][nt][q * 4 + 0], acc[0][nt][q * 4 + 1]); o.y = pack2(acc[0][nt][q * 4 + 2], acc[0][nt][q * 4 + 3]);
                    *(uint2*)(y + (size_t)row * D + col) = o;
                }
        }
    }
};
__device__ __forceinline__ void phase_moe_dn(const Params& p, unsigned char* lds, int l) {
    const WS w{p.ws};
    const XcdIter xi = xcd_iter();
    int ntl[NCLS]; int tot = 0;
#pragma unroll
    for (int c = 0; c < NCLS; ++c) { ntl[c] = (w.cnt(l)[c] + 127) >> 7; tot += ntl[c]; }
    const int nmg = (tot + xi.nx - 1) / xi.nx, nunit = nmg * 8;
    auto get = [&](int i, SrcA& A, SrcB& B, EpiDown& ep) -> bool {
        const int u = xi.local + i * xi.nloc;
        if (u >= nunit) return false;
        const int mg = (u >> 3) * xi.nx + xi.xcd, nt = u & 7;
        if (mg >= tot) return false;
        int cls = 0, mt = 0, run = 0;
#pragma unroll
        for (int c = 0; c < NCLS; ++c) { if (mg >= run && mg < run + ntl[c]) { cls = c; mt = mg - run; } run += ntl[c]; }
        const int cnt = w.cnt(l)[cls];
        int elo, ehi; cls_experts(cls, elo, ehi);
        src_plain<2>(A, w.act(), mg * 128, 512);
        src_split<2>(B, w.wt_dn(l, elo), 256, w.wt_dn(l, ehi), 256, nt * 128, 256);
        ep = EpiDown{w.zr(), w.list() + (size_t)cls * LISTCAP, cnt, mt * 128, nt * 128};
        return true;
    };
    gemm_stream<1, EpiDown>(lds, 512, get);
}

template <bool DRY>
__device__ __forceinline__ void phase_ln2(const Params& p, int l) {
    const WS w{p.ws};
    const int tid = threadIdx.x, lane = tid & 63, wid = tid >> 6;
    const int nrows = l == 0 ? NROW : NLAT;
    const float* lng = p.in[32] + l * D; const float* lnb = p.in[33] + l * D;
    const float* mdn = w.mod(1); const float* mdc = w.mod(l);
    const bf16_t* ybuf = w.zr();
    const int nwv = gridDim.x * NWV, rpw = (nrows + nwv - 1) / nwv;
    int row = (blockIdx.x * NWV + wid) * rpw;
    const int rend = min(nrows, row + rpw);
    float4 pg[4], pb[4], psh[4], psc[4], pg2[4];
#pragma unroll
    for (int i = 0; i < 4; ++i) { pg[i] = *(const float4*)(lng + i * 256 + lane * 4); pb[i] = *(const float4*)(lnb + i * 256 + lane * 4); psh[i] = pg[i]; psc[i] = pg[i]; pg2[i] = pg[i]; }
    int mcur = -1;
    float4 vn[4]; uint2 yn[4];
    if (row < rend) {
        const float* R0 = Rrow(p, row);
#pragma unroll
        for (int i = 0; i < 4; ++i) { vn[i] = *(const float4*)(R0 + i * 256 + lane * 4); yn[i] = *(const uint2*)(ybuf + (size_t)row * D + i * 256 + lane * 4); }
    }
    for (; row < rend; ++row) {
        float* R = Rrow(p, row);
        const int m = modrow(row);
        if (m != mcur) {
            mcur = m;
#pragma unroll
            for (int i = 0; i < 4; ++i) {
                pg2[i] = *(const float4*)(mdc + (size_t)m * 6144 + 5120 + i * 256 + lane * 4);
                if (l == 0) { psh[i] = *(const float4*)(mdn + (size_t)m * 6144 + i * 256 + lane * 4); psc[i] = *(const float4*)(mdn + (size_t)m * 6144 + 1024 + i * 256 + lane * 4); }
            }
        }
        float4 v[4];
#pragma unroll
        for (int i = 0; i < 4; ++i) {
            const float4 g2 = pg2[i]; const uint2 yy = yn[i];
            v[i].x = DN_ALPHA * vn[i].x + g2.x * bflo(yy.x); v[i].y = DN_ALPHA * vn[i].y + g2.y * bfhi(yy.x);
            v[i].z = DN_ALPHA * vn[i].z + g2.z * bflo(yy.y); v[i].w = DN_ALPHA * vn[i].w + g2.w * bfhi(yy.y);
        }
        if (row + 1 < rend) {
            const float* Rn = Rrow(p, row + 1);
#pragma unroll
            for (int i = 0; i < 4; ++i) { vn[i] = *(const float4*)(Rn + i * 256 + lane * 4); yn[i] = *(const uint2*)(ybuf + (size_t)(row + 1) * D + i * 256 + lane * 4); }
        }
        float s = 0.f;
#pragma unroll
        for (int i = 0; i < 4; ++i) s += (v[i].x + v[i].y) + (v[i].z + v[i].w);
        const float mean = wave_sum_fast(s) * (1.0f / 1024.0f);
        float q = 0.f;
#pragma unroll
        for (int i = 0; i < 4; ++i) { const float a = v[i].x - mean, b = v[i].y - mean, c = v[i].z - mean, d = v[i].w - mean; q += (a * a + b * b) + (c * c + d * d); }
        const float rs = rsqrtf(wave_sum_fast(q) * (1.0f / 1024.0f) + LN_EPS);
#pragma unroll
        for (int i = 0; i < 4; ++i) {
            const int col = i * 256 + lane * 4;
            const float4 g = pg[i], b = pb[i];
            float4 x;
            x.x = (v[i].x - mean) * rs * g.x + b.x; x.y = (v[i].y - mean) * rs * g.y + b.y; x.z = (v[i].z - mean) * rs * g.z + b.z; x.w = (v[i].w - mean) * rs * g.w + b.w;
            if (!DRY) *(float4*)(R + col) = x; else { KEEP(x.x); KEEP(x.y); KEEP(x.z); KEEP(x.w); }
            if (l == 0) {
                const float4 sh = psh[i], sc = psc[i];
                uint2 o; o.x = pack2(x.x * (1.f + sc.x) + sh.x, x.y * (1.f + sc.y) + sh.y); o.y = pack2(x.z * (1.f + sc.z) + sh.z, x.w * (1.f + sc.w) + sh.w);
                if (!DRY) *(uint2*)(w.hb() + (size_t)row * D + col) = o; else { KEEP(o.x); KEEP(o.y); }
            }
        }
    }
}

#define XB_TMO      128
#define XB_XCNT(j)  (256  + 64 * (j))
#define XB_XSUB(j)  (1280 + 64 * (j))
#define XB_XGEN(j)  (2304 + 64 * (j))
#define XB_TOP      3328
#define XB_TOPGEN   3392
#define XB_SPIN_CAP (1u << 20)
__device__ __forceinline__ unsigned xb_ld(unsigned* p)              { return __hip_atomic_load(p, __ATOMIC_RELAXED, __HIP_MEMORY_SCOPE_AGENT); }
__device__ __forceinline__ unsigned xb_add(unsigned* p, unsigned v) { return __hip_atomic_fetch_add(p, v, __ATOMIC_RELAXED, __HIP_MEMORY_SCOPE_AGENT); }
__device__ __forceinline__ unsigned xb_xcc_id() { return (unsigned)__builtin_amdgcn_s_getreg((3 << 11) | 20) & 0xFu; }
#define XB_SPIN(cond, bar) do { unsigned _sp = 0; while (cond) { __builtin_amdgcn_s_sleep(1); \
    if ((++_sp & 255u) == 0u) { if (xb_ld(&(bar)[XB_TMO])) break; if (_sp > XB_SPIN_CAP) { atomicAdd(&(bar)[XB_TMO], 1u); break; } } } } while (0)
struct XcdBarrier { unsigned* bar; unsigned x, nloc, nx; };
__device__ __forceinline__ void xcd_barrier_post(XcdBarrier& b, unsigned* bar) {
    b.bar = bar; b.x = xb_xcc_id(); b.nloc = 0u; b.nx = 0u;
    if (threadIdx.x == 0) (void)xb_add(&bar[XB_XCNT(b.x)], 1u);
}
__device__ __forceinline__ void xcd_barrier_complete(unsigned* bar, unsigned x, unsigned& nloc, unsigned& nx) {
    const unsigned G = gridDim.x;
    unsigned sum, cnt, mine, sp = 0u;
    for (;;) {
        sum = 0u; cnt = 0u; mine = 0u;
#pragma unroll
        for (unsigned j = 0; j < 16; ++j) { const unsigned c = xb_ld(&bar[XB_XCNT(j)]); sum += c; cnt += (c > 0u) ? 1u : 0u; mine = (j == x) ? c : mine; }
        if (sum == G) break;
        __builtin_amdgcn_s_sleep(1);
        if ((++sp & 255u) == 0u) { if (xb_ld(&bar[XB_TMO])) break; if (sp > XB_SPIN_CAP) { atomicAdd(&bar[XB_TMO], 1u); break; } }
    }
    nloc = mine > 0u ? mine : 1u; nx = cnt > 0u ? cnt : 1u;
}
__device__ __forceinline__ void xcd_barrier(XcdBarrier& b) {
    asm volatile("s_waitcnt vmcnt(0)" ::: "memory");
    __syncthreads();
    if (threadIdx.x == 0) {
        unsigned* bar = b.bar;
        __builtin_amdgcn_s_waitcnt(0);
        if (b.nloc == 0u) xcd_barrier_complete(bar, b.x, b.nloc, b.nx);
        const unsigned nloc = b.nloc, nx = b.nx;
        const unsigned old = xb_add(&bar[XB_XSUB(b.x)], 1u);
        const unsigned gen = old / nloc;
        if (old + 1u == (gen + 1u) * nloc) {
            __builtin_amdgcn_fence(__ATOMIC_RELEASE, "agent");
            asm volatile("s_waitcnt vmcnt(0)" ::: "memory");
            const unsigned og = xb_add(&bar[XB_TOP], 1u);
            const unsigned tg = og / nx;
            if (og + 1u == (tg + 1u) * nx) xb_add(&bar[XB_TOPGEN], 1u);
            else XB_SPIN(xb_ld(&bar[XB_TOPGEN]) == tg, bar);
            __builtin_amdgcn_fence(__ATOMIC_ACQUIRE, "agent");
            xb_add(&bar[XB_XGEN(b.x)], 1u);
            asm volatile("s_waitcnt vmcnt(0)" ::: "memory");
        } else {
            XB_SPIN(xb_ld(&bar[XB_XGEN(b.x)]) == gen, bar);
            __builtin_amdgcn_fence(__ATOMIC_ACQUIRE, "agent");
            asm volatile("s_waitcnt vmcnt(0)" ::: "memory");
        }
    }
    __syncthreads();
}

constexpr int NPHASE = 2 + 2 * 10;
__global__ void __launch_bounds__(NTHR, 2) mega(Params p, int ph_lo, int ph_hi) {
    extern __shared__ __attribute__((aligned(16))) unsigned char lds[];
    XcdBarrier xb; xcd_barrier_post(xb, (unsigned*)(p.ws + OFF_BAR));
#define RUN(idx, ...) if (ph_lo <= (idx) && (idx) < ph_hi) { const int nrep_ = (PH_REP_IDX >= 0 && ((idx) >= 2 ? ((idx) - 2) % 10 == PH_REP_IDX : (idx) + 100 == PH_REP_IDX)) ? 2 : 1; for (int rr_ = 0; rr_ < nrep_; ++rr_) { __VA_ARGS__; if ((idx) + 1 < ph_hi || rr_ + 1 < nrep_) for (int rb_ = 0; rb_ < REP_BAR; ++rb_) xcd_barrier(xb); } }
    RUN(0, phase_pro_a(p, lds))
    RUN(1, for (int r_ = 0; r_ < REP_PROBC; ++r_) phase_pro_b(p, lds))
#define LAYER(l) \
    RUN(2 + 10 * l + 0, phase_inproj(p, lds, l)) \
    RUN(2 + 10 * l + 1, phase_s1(p, lds, l)) \
    RUN(2 + 10 * l + 2, phase_s2(p, lds, l); if (l == 0) w2_toeplitz_fill(p)) \
    RUN(2 + 10 * l + 3, phase_s3(p, lds, l)) \
    RUN(2 + 10 * l + 4, phase_glu(p, lds, l)) \
    RUN(2 + 10 * l + 5, phase_outproj(p, lds, l)) \
    RUN(2 + 10 * l + 6, if (DRY_LN1) phase_ln1<true>(p, lds, l); phase_ln1<false>(p, lds, l)) \
    RUN(2 + 10 * l + 7, phase_moe_gu(p, lds, l)) \
    RUN(2 + 10 * l + 8, phase_moe_dn(p, lds, l)) \
    RUN(2 + 10 * l + 9, if (DRY_LN2) phase_ln2<true>(p, l); phase_ln2<false>(p, l))
    LAYER(0)
    LAYER(1)
#undef LAYER
#undef RUN
}

extern "C" void kernel_launch(void* const* d_in, const int* in_sizes, int n_in, void* d_out, int out_size, void* d_ws, size_t ws_size, hipStream_t stream) {
    static int grid_blocks = 0;
    if (grid_blocks == 0) {
        if (n_in != 34 || out_size != NLAT * D || ws_size < WS_END) {
            fprintf(stderr, "kernel_launch: unexpected shapes (n_in %d out %d ws %zu need %zu)\n", n_in, out_size, ws_size, (size_t)WS_END);
            grid_blocks = -1; return;
        }
        int dev = 0, cus = 0, per_cu = 0;
        hipGetDevice(&dev);
        hipDeviceGetAttribute(&cus, hipDeviceAttributeMultiprocessorCount, dev);
        if (hipFuncSetAttribute((const void*)mega, hipFuncAttributeMaxDynamicSharedMemorySize, LDS_BYTES) != hipSuccess) fprintf(stderr, "kernel_launch: hipFuncSetAttribute failed\n");
        hipOccupancyMaxActiveBlocksPerMultiprocessor(&per_cu, (const void*)mega, NTHR, LDS_BYTES);
        if (per_cu < 1) per_cu = 1;
        if (per_cu > 1) per_cu = 1;
        grid_blocks = cus * per_cu;
        fprintf(stderr, "kernel_launch: cus %d per_cu %d grid %d ws need %zu have %zu\n", cus, per_cu, grid_blocks, (size_t)WS_END, ws_size);
    }
    if (grid_blocks < 0) return;
    Params p{};
    for (int i = 0; i < 34; ++i) p.in[i] = (const float*)d_in[i];
    p.out = (float*)d_out; p.ws = (unsigned char*)d_ws;
    if (hipMemsetAsync((unsigned char*)d_ws + OFF_BAR, 0, SZ_BAR, stream) != hipSuccess) fprintf(stderr, "memset failed\n");
#if FUSED
    int lo = 0, hi = NPHASE;
    void* args[] = {&p, &lo, &hi};
    hipError_t e = hipLaunchCooperativeKernel((const void*)mega, dim3(grid_blocks), dim3(NTHR), args, LDS_BYTES, stream);
    if (e != hipSuccess) fprintf(stderr, "cooperative launch failed: %s (grid %d)\n", hipGetErrorString(e), grid_blocks);
#else
    for (int ph = 0; ph < NPHASE; ++ph) hipLaunchKernelGGL(mega, dim3(grid_blocks), dim3(NTHR), LDS_BYTES, stream, p, ph, ph + 1);
#endif
}
```

```cpp
#include <hip/hip_runtime.h>
#include <cstdio>
#include <cstdint>

#ifndef FUSED
#define FUSED 1
#endif
#define REP_INPROJ 1
#define REP_S1 1
#define REP_S3 1
#define REP_GLU 1
#define REP_OUT0 1
#define REP_GU 1
#define REP_CONV 1
#define REP_CSC 1
#define REP_CCF 1
#define CCF_PM 0
#define REP_S2 1
#define REP_PRO 1
#define REP_BAR 1
#define PROBE_PH -1
#define PROBE_AMP 8
#define PH_REP_IDX -1
#define PROBE_MODE 1
#define PROBE_TINY 0
#define REP_PROBC 1
#define REP_PB_K 1
#define REP_PB_M 1
#define REP_PB_H 1
#define DRY_LN1 0
#define DRY_LN2 0
#define DRY_NOROUTER 0
#define KEEP(x) asm volatile("" :: "v"(x))

typedef unsigned short bf16_t;
typedef __attribute__((ext_vector_type(8))) short bf16x8;
typedef __attribute__((ext_vector_type(16))) float f32x16;

constexpr int D = 1024, NB = 8, SEQ = 2048, CTX = 256;
constexpr int NLAT = NB * SEQ, NCTX = NB * CTX, NROW = NLAT + NCTX;
constexpr int DIN = 1792, DS5 = 512, NG = 32, PS = 64;
constexpr int TCH = 16, NT = 256;
constexpr int NCOL = NROW / TCH;
constexpr int NCOL_LAT = NLAT / TCH;
constexpr int CH_LAT = SEQ / TCH, CH_CTX = CTX / TCH;
constexpr int NSTEP = CH_LAT + CH_CTX;
constexpr int NSEG = 8, SEGLEN = NSTEP / NSEG;
constexpr int NCLS = 24, LISTCAP = NROW;
constexpr int MAXMT = NROW / 128 + NCLS;
constexpr int KSPLIT_MOD = 32;
constexpr int NTHR = 512, NWV = 8;
constexpr float LN_EPS = 1e-5f;
constexpr float DN_ALPHA = 1.4142135623730951f;
constexpr int NPOW = 18;

constexpr size_t AL(size_t x) { return (x + 255) & ~(size_t)255; }
constexpr size_t SZ_WT_IN = (size_t)2 * DIN * D * 2;
constexpr size_t SZ_WT_GLU = (size_t)2 * 512 * 512 * 2;
constexpr size_t SZ_WT_O = (size_t)2 * D * D * 2;
constexpr size_t SZ_WT_GU = (size_t)2 * 16 * 512 * 1024 * 2;
constexpr size_t SZ_WT_DN = (size_t)2 * 16 * 1024 * 256 * 2;
constexpr size_t SZ_MOD = (size_t)2 * 9 * 6144 * 4;
constexpr size_t SZ_LAMPOW = (size_t)2 * 2 * NG * PS * NPOW * 8;
constexpr size_t SZ_BBAR = (size_t)2 * 2 * NG * PS * 16 * 8;
constexpr size_t SZ_KFULL = (size_t)2 * NG * 32 * 256 * 4;
constexpr size_t SZ_M1 = (size_t)2 * NG * 256 * 256 * 2;
constexpr size_t SZ_W2 = (size_t)2 * NG * 256 * 512 * 2;
constexpr size_t SZ_HB = (size_t)NROW * D * 2;
constexpr size_t SZ_UG = (size_t)NG * NROW * 16 * 2;
constexpr size_t SZ_ZR = (size_t)NROW * 1280 * 2;
constexpr size_t SZ_S = (size_t)NG * NCOL * 256 * 4;
constexpr size_t SZ_RCTX = (size_t)NCTX * D * 4;
constexpr size_t SZ_CNT = 256 * 4;
constexpr size_t SZ_LIST = (size_t)NCLS * LISTCAP * 4;
constexpr size_t SZ_LW = (size_t)NCLS * LISTCAP * 8;

constexpr size_t OFF_WT_IN = 0;
constexpr size_t OFF_WT_GLU = OFF_WT_IN + AL(SZ_WT_IN);
constexpr size_t OFF_WT_O = OFF_WT_GLU + AL(SZ_WT_GLU);
constexpr size_t OFF_WT_GU = OFF_WT_O + AL(SZ_WT_O);
constexpr size_t OFF_WT_DN = OFF_WT_GU + AL(SZ_WT_GU);
constexpr size_t OFF_MOD = OFF_WT_DN + AL(SZ_WT_DN);
constexpr size_t OFF_LAMPOW = OFF_MOD + AL(SZ_MOD);
constexpr size_t OFF_BBAR = OFF_LAMPOW + AL(SZ_LAMPOW);
constexpr size_t OFF_KFULL = OFF_BBAR + AL(SZ_BBAR);
constexpr size_t OFF_M1 = OFF_KFULL + AL(SZ_KFULL);
constexpr size_t OFF_W2 = OFF_M1 + AL(SZ_M1);
constexpr size_t OFF_HB = OFF_W2 + AL(SZ_W2);
constexpr size_t OFF_UG = OFF_HB + AL(SZ_HB);
constexpr size_t OFF_ZR = OFF_UG + AL(SZ_UG);
constexpr size_t OFF_S = OFF_ZR + AL(SZ_ZR);
constexpr size_t OFF_RCTX = OFF_S + AL(SZ_S);
constexpr size_t OFF_CNT = OFF_RCTX + AL(SZ_RCTX);
constexpr size_t OFF_LIST = OFF_CNT + AL(SZ_CNT);
constexpr size_t OFF_LW = OFF_LIST + AL(SZ_LIST);
constexpr size_t OFF_BAR = OFF_LW + AL(SZ_LW);
constexpr size_t SZ_BAR = 3456 * 4;
constexpr size_t WS_END = OFF_BAR + AL(SZ_BAR);
static_assert((size_t)KSPLIT_MOD * 2 * 9 * 6144 * 4 <= SZ_ZR, "modp alias");
static_assert((size_t)NG * NCOL * 256 * 2 <= SZ_ZR, "hprev alias");
static_assert((size_t)NROW * 512 * 2 <= SZ_S && (size_t)MAXMT * 128 * 512 * 2 <= SZ_S, "Y/act alias");
static_assert(WS_END <= (size_t)256 * 1024 * 1024, "workspace over 256 MiB");

constexpr int STAGE_BYTES = 49152, LDS_BYTES = 163840;

struct Params {
    const float* in[34];
    float* out;
    unsigned char* ws;
};

__device__ __forceinline__ unsigned f2bf(float f) { unsigned u = __float_as_uint(f); u += 0x7fffu + ((u >> 16) & 1u); return u >> 16; }
__device__ __forceinline__ float bf2f(unsigned h) { return __uint_as_float(h << 16); }
__device__ __forceinline__ unsigned pack2(float a, float b) { return f2bf(a) | (f2bf(b) << 16); }
__device__ __forceinline__ float bflo(unsigned w) { return __uint_as_float(w << 16); }
__device__ __forceinline__ float bfhi(unsigned w) { return __uint_as_float(w & 0xffff0000u); }
__device__ __forceinline__ float wave_sum(float v) {
#pragma unroll
    for (int o = 32; o >= 1; o >>= 1) v += __shfl_xor(v, o);
    return v;
}
__device__ __forceinline__ void lds_barrier() { asm volatile("s_waitcnt lgkmcnt(0)" ::: "memory"); __builtin_amdgcn_s_barrier(); asm volatile("" ::: "memory"); }
template <int CTRL>
__device__ __forceinline__ float dpp_f(float v) { return __int_as_float(__builtin_amdgcn_update_dpp(0, __float_as_int(v), CTRL, 0xf, 0xf, true)); }
__device__ __forceinline__ float row_sum16(float v) {
    v += dpp_f<0xB1>(v);
    v += dpp_f<0x4E>(v);
    v += dpp_f<0x124>(v);
    v += dpp_f<0x128>(v);
    return v;
}
__device__ __forceinline__ float rl_f(float v, int l) { return __int_as_float(__builtin_amdgcn_readlane(__float_as_int(v), l)); }
__device__ __forceinline__ float wave_sum_fast(float v) {
    v = row_sum16(v);
    return (rl_f(v, 0) + rl_f(v, 16)) + (rl_f(v, 32) + rl_f(v, 48));
}
__device__ __forceinline__ float sigmoidf_(float x) { return 1.0f / (1.0f + __expf(-x)); }
__device__ __forceinline__ float siluf_(float x) { return x / (1.0f + __expf(-x)); }
__device__ __forceinline__ float gelu_tanh(float x) {
    const float z = 0.7978845608028654f * (x + 0.044715f * x * x * x);
    const float e = __expf(2.0f * z);
    const float t = 1.0f - 2.0f / (1.0f + e);
    return 0.5f * x * (1.0f + t);
}
__device__ __forceinline__ int modrow(int row) { return row < NLAT ? (row >> 11) : 8; }

struct SrcA { const bf16_t* p0[4]; const bf16_t* p1[4]; int split; };
struct SrcB { const bf16_t* p0[2]; const bf16_t* p1[2]; int split; };
#define LDS_AS __attribute__((address_space(3)))

template <int MF, class EPI, int MODE = 0>
__device__ __forceinline__ void gemm_tile(unsigned char* lds, const SrcA& A, const SrcB& B, const int K, const EPI& epi) {
    const int tid = threadIdx.x, lane = tid & 63, wid = __builtin_amdgcn_readfirstlane(tid >> 6), wm = wid >> 1, wn = wid & 1;
    const int l31 = lane & 31, hh = lane >> 5, sw = (l31 >> 1) & 7;
    const int xbase = (wm * 32 * MF + l31) * 128, wbase = 32768 + (wn * 64 + l31) * 128;
    LDS_AS unsigned char* ldsw = (LDS_AS unsigned char*)lds + wid * 1024;
    f32x16 acc[MF][2];
#pragma unroll
    for (int i = 0; i < MF; ++i)
#pragma unroll
        for (int j = 0; j < 2; ++j)
#pragma unroll
            for (int e = 0; e < 16; ++e) acc[i][j][e] = 0.f;
    const int nk = K >> 6;
#define G_PIECE_A(k_, bufo_, j_) if (MODE != 3) __builtin_amdgcn_global_load_lds((const unsigned*)((k_) < A.split ? A.p0[j_] + (k_) : A.p1[j_] + ((k_) - A.split)), (LDS_AS unsigned*)(ldsw + (bufo_) + (j_) * 8192), 16, 0, 0)
#define G_PIECE_B(k_, bufo_, j_) if (MODE != 3) __builtin_amdgcn_global_load_lds((const unsigned*)((k_) < B.split ? B.p0[j_] + (k_) : B.p1[j_] + ((k_) - B.split)), (LDS_AS unsigned*)(ldsw + (bufo_) + 32768 + (j_) * 8192), 16, 0, 0)
#define G_STAGE(kt_, bufo_) do { const int k_ = (kt_) * 64; \
        _Pragma("unroll") for (int j = 0; j < 2 * MF; ++j) G_PIECE_A(k_, bufo_, j); \
        _Pragma("unroll") for (int j = 0; j < 2; ++j) G_PIECE_B(k_, bufo_, j); } while (0)
#define LDFRAG(ks_, W0_, W1_, X_) do { const int co_ = (((ks_) * 2 + hh) ^ sw) << 4; \
        W0_ = *(const bf16x8*)(lds + cur + wbase + co_); W1_ = *(const bf16x8*)(lds + cur + wbase + 4096 + co_); \
        _Pragma("unroll") for (int mt = 0; mt < MF; ++mt) X_[mt] = *(const bf16x8*)(lds + cur + xbase + mt * 4096 + co_); } while (0)
#define DOMFMA(W0_, W1_, X_) do { if (MODE == 2) { asm volatile("" :: "v"(W0_), "v"(W1_)); _Pragma("unroll") for (int mt = 0; mt < MF; ++mt) asm volatile("" :: "v"(X_[mt])); } else _Pragma("unroll") for (int mt = 0; mt < MF; ++mt) { \
        acc[mt][0] = __builtin_amdgcn_mfma_f32_32x32x16_bf16(W0_, X_[mt], acc[mt][0], 0, 0, 0); \
        acc[mt][1] = __builtin_amdgcn_mfma_f32_32x32x16_bf16(W1_, X_[mt], acc[mt][1], 0, 0, 0); } } while (0)
#define SCHED_FENCE __builtin_amdgcn_sched_barrier(0)
    asm volatile("s_waitcnt vmcnt(0)" ::: "memory");
    __builtin_amdgcn_s_barrier();
    asm volatile("" ::: "memory");
    G_STAGE(0, 0);
    if (nk > 1) G_STAGE(1, STAGE_BYTES);
    int cur = 0, nxt = 2 * STAGE_BYTES;
    for (int kt = 0; kt < nk; ++kt) {
        if (kt + 1 < nk) { if (MF == 2) asm volatile("s_waitcnt vmcnt(6)" ::: "memory"); else asm volatile("s_waitcnt vmcnt(4)" ::: "memory"); }
        else asm volatile("s_waitcnt vmcnt(0)" ::: "memory");
        __builtin_amdgcn_s_barrier();
        asm volatile("" ::: "memory");
        const bool st = kt + 2 < nk;
        const int kn = (kt + 2) * 64;
        bf16x8 wa0, wa1, xa[MF], wb0, wb1, xb[MF];
        LDFRAG(0, wa0, wa1, xa);
        LDFRAG(1, wb0, wb1, xb);
        SCHED_FENCE;
        DOMFMA(wa0, wa1, xa);
        if (st) { if (MF == 2) { G_PIECE_A(kn, nxt, 0); G_PIECE_A(kn, nxt, 1); } else { G_PIECE_A(kn, nxt, 0); } }
        SCHED_FENCE;
        LDFRAG(2, wa0, wa1, xa);
        SCHED_FENCE;
        DOMFMA(wb0, wb1, xb);
        if (st) { if (MF == 2) { G_PIECE_A(kn, nxt, 2); G_PIECE_A(kn, nxt, 3); } else { G_PIECE_A(kn, nxt, 1); } }
        SCHED_FENCE;
        LDFRAG(3, wb0, wb1, xb);
        SCHED_FENCE;
        DOMFMA(wa0, wa1, xa);
        if (st) { if (MF == 2) { G_PIECE_B(kn, nxt, 0); G_PIECE_B(kn, nxt, 1); } else { G_PIECE_B(kn, nxt, 0); } }
        SCHED_FENCE;
        DOMFMA(wb0, wb1, xb);
        if (st) { if (MF == 1) { G_PIECE_B(kn, nxt, 1); } }
        SCHED_FENCE;
        cur = (cur == 2 * STAGE_BYTES) ? 0 : cur + STAGE_BYTES;
        nxt = (nxt == 2 * STAGE_BYTES) ? 0 : nxt + STAGE_BYTES;
    }
#undef G_STAGE
#undef G_PIECE_A
#undef G_PIECE_B
#undef LDFRAG
#undef DOMFMA
    if (MODE == 0) epi(acc, wm * 32 * MF + l31, wn * 64 + hh * 4);
    else { _Pragma("unroll") for (int i = 0; i < MF; ++i) { asm volatile("" :: "v"(acc[i][0]), "v"(acc[i][1])); } }
}

template <int MF, class EPI, class GET>
__device__ __forceinline__ void gemm_stream(unsigned char* lds, const int K, const GET& get) {
    const int tid = threadIdx.x, lane = tid & 63, wid = __builtin_amdgcn_readfirstlane(tid >> 6), wm = wid >> 1, wn = wid & 1;
    const int l31 = lane & 31, hh = lane >> 5, sw = (l31 >> 1) & 7;
    const int xbase = (wm * 32 * MF + l31) * 128, wbase = 32768 + (wn * 64 + l31) * 128;
    LDS_AS unsigned char* ldsw = (LDS_AS unsigned char*)lds + wid * 1024;
    const int nk = K >> 6;
    SrcA Ac, An; SrcB Bc, Bn; EPI ec, en;
    bool have = get(0, Ac, Bc, ec);
    if (!have) return;
#define S_PIECE_A(S_, k_, bufo_, j_) __builtin_amdgcn_global_load_lds((const unsigned*)((k_) < S_.split ? S_.p0[j_] + (k_) : S_.p1[j_] + ((k_) - S_.split)), (LDS_AS unsigned*)(ldsw + (bufo_) + (j_) * 8192), 16, 0, 0)
#define S_PIECE_B(S_, k_, bufo_, j_) __builtin_amdgcn_global_load_lds((const unsigned*)((k_) < S_.split ? S_.p0[j_] + (k_) : S_.p1[j_] + ((k_) - S_.split)), (LDS_AS unsigned*)(ldsw + (bufo_) + 32768 + (j_) * 8192), 16, 0, 0)
#define LDFRAG(ks_, W0_, W1_, X_) do { const int co_ = (((ks_) * 2 + hh) ^ sw) << 4; \
        W0_ = *(const bf16x8*)(lds + cur + wbase + co_); W1_ = *(const bf16x8*)(lds + cur + wbase + 4096 + co_); \
        _Pragma("unroll") for (int mt = 0; mt < MF; ++mt) X_[mt] = *(const bf16x8*)(lds + cur + xbase + mt * 4096 + co_); } while (0)
#define DOMFMA(W0_, W1_, X_) do { _Pragma("unroll") for (int mt = 0; mt < MF; ++mt) { \
        acc[mt][0] = __builtin_amdgcn_mfma_f32_32x32x16_bf16(W0_, X_[mt], acc[mt][0], 0, 0, 0); \
        acc[mt][1] = __builtin_amdgcn_mfma_f32_32x32x16_bf16(W1_, X_[mt], acc[mt][1], 0, 0, 0); } } while (0)
    asm volatile("s_waitcnt vmcnt(0)" ::: "memory");
    __builtin_amdgcn_s_barrier();
    asm volatile("" ::: "memory");
#pragma unroll
    for (int j = 0; j < 2 * MF; ++j) S_PIECE_A(Ac, 0, 0, j);
#pragma unroll
    for (int j = 0; j < 2; ++j) S_PIECE_B(Bc, 0, 0, j);
#pragma unroll
    for (int j = 0; j < 2 * MF; ++j) S_PIECE_A(Ac, 64, STAGE_BYTES, j);
#pragma unroll
    for (int j = 0; j < 2; ++j) S_PIECE_B(Bc, 64, STAGE_BYTES, j);
    int cur = 0, nxt = 2 * STAGE_BYTES;
    for (int ui = 0; have; ++ui) {
        const bool haveN = get(ui + 1, An, Bn, en);
        f32x16 acc[MF][2];
#pragma unroll
        for (int i = 0; i < MF; ++i)
#pragma unroll
            for (int j = 0; j < 2; ++j)
#pragma unroll
                for (int e = 0; e < 16; ++e) acc[i][j][e] = 0.f;
        for (int kt = 0; kt < nk; ++kt) {
            if (kt + 1 < nk || haveN) { if (MF == 2) asm volatile("s_waitcnt vmcnt(6)" ::: "memory"); else asm volatile("s_waitcnt vmcnt(4)" ::: "memory"); }
            else asm volatile("s_waitcnt vmcnt(0)" ::: "memory");
            __builtin_amdgcn_s_barrier();
            asm volatile("" ::: "memory");
            const bool fromN = kt + 2 >= nk;
            const bool st = !fromN || haveN;
            const int kn = (fromN ? kt + 2 - nk : kt + 2) * 64;
            SrcA As; SrcB Bs;
#pragma unroll
            for (int j = 0; j < 2 * MF; ++j) { As.p0[j] = fromN ? An.p0[j] : Ac.p0[j]; As.p1[j] = fromN ? An.p1[j] : Ac.p1[j]; }
#pragma unroll
            for (int j = 0; j < 2; ++j) { Bs.p0[j] = fromN ? Bn.p0[j] : Bc.p0[j]; Bs.p1[j] = fromN ? Bn.p1[j] : Bc.p1[j]; }
            As.split = fromN ? An.split : Ac.split; Bs.split = fromN ? Bn.split : Bc.split;
            bf16x8 wa0, wa1, xa[MF], wb0, wb1, xb[MF];
            LDFRAG(0, wa0, wa1, xa);
            LDFRAG(1, wb0, wb1, xb);
            SCHED_FENCE;
            DOMFMA(wa0, wa1, xa);
            if (st) { if (MF == 2) { S_PIECE_A(As, kn, nxt, 0); S_PIECE_A(As, kn, nxt, 1); } else { S_PIECE_A(As, kn, nxt, 0); } }
            SCHED_FENCE;
            LDFRAG(2, wa0, wa1, xa);
            SCHED_FENCE;
            DOMFMA(wb0, wb1, xb);
            if (st) { if (MF == 2) { S_PIECE_A(As, kn, nxt, 2); S_PIECE_A(As, kn, nxt, 3); } else { S_PIECE_A(As, kn, nxt, 1); } }
            SCHED_FENCE;
            LDFRAG(3, wb0, wb1, xb);
            SCHED_FENCE;
            DOMFMA(wa0, wa1, xa);
            if (st) { S_PIECE_B(Bs, kn, nxt, 0); if (MF == 2) S_PIECE_B(Bs, kn, nxt, 1); }
            SCHED_FENCE;
            DOMFMA(wb0, wb1, xb);
            if (st) { if (MF == 1) S_PIECE_B(Bs, kn, nxt, 1); }
            SCHED_FENCE;
            cur = (cur == 2 * STAGE_BYTES) ? 0 : cur + STAGE_BYTES;
            nxt = (nxt == 2 * STAGE_BYTES) ? 0 : nxt + STAGE_BYTES;
        }
        ec(acc, wm * 32 * MF + l31, wn * 64 + hh * 4);
        have = haveN;
        if (haveN) {
#pragma unroll
            for (int j = 0; j < 2 * MF; ++j) { Ac.p0[j] = An.p0[j]; Ac.p1[j] = An.p1[j]; }
#pragma unroll
            for (int j = 0; j < 2; ++j) { Bc.p0[j] = Bn.p0[j]; Bc.p1[j] = Bn.p1[j]; }
            Ac.split = An.split; Bc.split = Bn.split; ec = en;
        }
    }
#undef S_PIECE_A
#undef S_PIECE_B
#undef LDFRAG
#undef DOMFMA
}

template <int NJ, class S>
__device__ __forceinline__ void src_plain(S& s, const bf16_t* base, int row0, int ld) {
    const int lr = threadIdx.x >> 3, lc = (threadIdx.x & 7) ^ ((lr >> 1) & 7);
#pragma unroll
    for (int j = 0; j < NJ; ++j) { s.p0[j] = base + (size_t)(row0 + lr + 64 * j) * ld + lc * 8; s.p1[j] = s.p0[j]; }
    s.split = 1 << 30;
}
template <int NJ, class S>
__device__ __forceinline__ void src_split(S& s, const bf16_t* base0, int ld0, const bf16_t* base1, int ld1, int row0, int split) {
    const int lr = threadIdx.x >> 3, lc = (threadIdx.x & 7) ^ ((lr >> 1) & 7);
#pragma unroll
    for (int j = 0; j < NJ; ++j) { s.p0[j] = base0 + (size_t)(row0 + lr + 64 * j) * ld0 + lc * 8; s.p1[j] = base1 + (size_t)(row0 + lr + 64 * j) * ld1 + lc * 8; }
    s.split = split;
}
struct XcdIter { int nx, xcd, local, nloc; };
__device__ __forceinline__ XcdIter xcd_iter() {
    XcdIter it; it.nx = (gridDim.x & 7) == 0 ? 8 : 1; it.xcd = blockIdx.x % it.nx; it.local = blockIdx.x / it.nx; it.nloc = gridDim.x / it.nx; return it;
}

#define ACC_FOREACH(MF_, acc, r0, c0, ...) \
    _Pragma("unroll") for (int mt_ = 0; mt_ < MF_; ++mt_) \
    _Pragma("unroll") for (int nt_ = 0; nt_ < 2; ++nt_) \
    _Pragma("unroll") for (int q_ = 0; q_ < 4; ++q_) { \
        const int rl = (r0) + mt_ * 32, cl = (c0) + nt_ * 32 + q_ * 8; \
        const float v0 = acc[mt_][nt_][q_ * 4 + 0], v1 = acc[mt_][nt_][q_ * 4 + 1], v2 = acc[mt_][nt_][q_ * 4 + 2], v3 = acc[mt_][nt_][q_ * 4 + 3]; \
        __VA_ARGS__ }

struct WS {
    unsigned char* b;
    __device__ bf16_t* wt_in(int l) const { return (bf16_t*)(b + OFF_WT_IN) + (size_t)l * DIN * D; }
    __device__ bf16_t* wt_glu(int l) const { return (bf16_t*)(b + OFF_WT_GLU) + (size_t)l * 512 * 512; }
    __device__ bf16_t* wt_o(int l) const { return (bf16_t*)(b + OFF_WT_O) + (size_t)l * D * D; }
    __device__ bf16_t* wt_gu(int l, int e) const { return (bf16_t*)(b + OFF_WT_GU) + (size_t)(l * 16 + e) * 512 * 1024; }
    __device__ bf16_t* wt_dn(int l, int e) const { return (bf16_t*)(b + OFF_WT_DN) + (size_t)(l * 16 + e) * 1024 * 256; }
    __device__ float* mod(int l) const { return (float*)(b + OFF_MOD) + (size_t)l * 9 * 6144; }
    __device__ float* modp() const { return (float*)(b + OFF_ZR); }
    __device__ float2* lampow(int l, int d, int g) const { return (float2*)(b + OFF_LAMPOW) + (size_t)((l * 2 + d) * NG + g) * PS * NPOW; }
    __device__ float2* bbar(int l, int d, int g) const { return (float2*)(b + OFF_BBAR) + (size_t)((l * 2 + d) * NG + g) * PS * 16; }
    __device__ float* kfull(int l, int g) const { return (float*)(b + OFF_KFULL) + (size_t)(l * NG + g) * 32 * 256; }
    __device__ bf16_t* m1(int l, int g) const { return (bf16_t*)(b + OFF_M1) + (size_t)(l * NG + g) * 256 * 256; }
    __device__ bf16_t* w2(int l, int g) const { return (bf16_t*)(b + OFF_W2) + (size_t)(l * NG + g) * 256 * 512; }
    __device__ bf16_t* hb() const { return (bf16_t*)(b + OFF_HB); }
    __device__ bf16_t* ug() const { return (bf16_t*)(b + OFF_UG); }
    __device__ bf16_t* zr() const { return (bf16_t*)(b + OFF_ZR); }
    __device__ bf16_t* hprev() const { return (bf16_t*)(b + OFF_ZR); }
    __device__ float* S() const { return (float*)(b + OFF_S); }
    __device__ bf16_t* Y() const { return (bf16_t*)(b + OFF_S); }
    __device__ bf16_t* act() const { return (bf16_t*)(b + OFF_S); }
    __device__ float* rctx() const { return (float*)(b + OFF_RCTX); }
    __device__ int* cnt(int l) const { return (int*)(b + OFF_CNT) + l * 32; }
    __device__ int* list() const { return (int*)(b + OFF_LIST); }
    __device__ float2* lw() const { return (float2*)(b + OFF_LW); }
};
__device__ __forceinline__ float* Rrow(const Params& p, int row) {
    return row < NLAT ? p.out + (size_t)row * D : (float*)(p.ws + OFF_RCTX) + (size_t)(row - NLAT) * D;
}

__device__ __forceinline__ void transpose_tile(unsigned char* lds, const float* src, int ldsrc, int k0, int n0, bf16_t* dst, int lddst, int rowmode) {
    float* tile = (float*)lds;
    const int tid = threadIdx.x;
    __syncthreads();
#pragma unroll
    for (int pass = 0; pass < 2; ++pass) {
        const int k = pass * 32 + (tid >> 4), n4 = (tid & 15) * 4;
        const float4 v = *(const float4*)(src + (size_t)(k0 + k) * ldsrc + n0 + n4);
        tile[k * 65 + n4 + 0] = v.x; tile[k * 65 + n4 + 1] = v.y; tile[k * 65 + n4 + 2] = v.z; tile[k * 65 + n4 + 3] = v.w;
    }
    __syncthreads();
    {
        const int n = tid & 63, kc = tid >> 6;
        float f[8];
#pragma unroll
        for (int i = 0; i < 8; ++i) f[i] = tile[(kc * 8 + i) * 65 + n];
        const int ng = n0 + n;
        int drow = ng;
        if (rowmode == 1) drow = ((ng >> 3) << 4) + (ng & 7);
        else if (rowmode == 2) drow = ((ng >> 3) << 4) + 8 + (ng & 7);
        uint4 o; o.x = pack2(f[0], f[1]); o.y = pack2(f[2], f[3]); o.z = pack2(f[4], f[5]); o.w = pack2(f[6], f[7]);
        *(uint4*)(dst + (size_t)drow * lddst + k0 + kc * 8) = o;
    }
}

struct WTile { const float* src; bf16_t* dst; int ldsrc, lddst, k0, n0, rowmode; };
__device__ __forceinline__ WTile wtile_decode(const Params& p, int l, int t) {
    const WS w{p.ws};
    WTile r;
    if (t < 448) { const int kt = t / 28, nt = t % 28; r = WTile{p.in[6] + (size_t)l * D * DIN, w.wt_in(l), DIN, D, kt * 64, nt * 64, 0}; }
    else if (t < 512) { t -= 448; const int kt = t / 8, nt = t % 8; r = WTile{p.in[15] + (size_t)l * 512 * 512, w.wt_glu(l), 512, 512, kt * 64, nt * 64, 0}; }
    else if (t < 768) { t -= 512; const int kt = t / 16, nt = t % 16; r = WTile{p.in[22] + (size_t)l * D * D, w.wt_o(l), D, D, kt * 64, nt * 64, 0}; }
    else if (t < 1792) { t -= 768; const int e = t / 64, q = t % 64, kt = q / 4, nt = q % 4; r = WTile{p.in[29] + (size_t)(l * 16 + e) * D * 256, w.wt_gu(l, e), 256, D, kt * 64, nt * 64, 1}; }
    else if (t < 2816) { t -= 1792; const int e = t / 64, q = t % 64, kt = q / 4, nt = q % 4; r = WTile{p.in[30] + (size_t)(l * 16 + e) * D * 256, w.wt_gu(l, e), 256, D, kt * 64, nt * 64, 2}; }
    else { t -= 2816; const int e = t / 64, q = t % 64, kt = q / 16, nt = q % 16; r = WTile{p.in[31] + (size_t)(l * 16 + e) * 256 * D, w.wt_dn(l, e), D, 256, kt * 64, nt * 64, 0}; }
    return r;
}
template <class IDX>
__device__ __forceinline__ void transpose_stream(const Params& p, unsigned char* lds, int count, const IDX& idx) {
    const int tid = threadIdx.x;
    auto dec = [&](int j) -> WTile { const int i = idx(j); return i < 0 ? wtile_decode(p, 0, -i - 1) : (i < 3072 ? wtile_decode(p, 0, 768 + i) : wtile_decode(p, 1, i - 3072)); };
    if (count <= 0) return;
    lds_barrier();
    const int lk = tid >> 4, ln4 = (tid & 15) * 4;
    const int sn = tid & 63, skc = tid >> 6;
    WTile cur = dec(0);
    float4 v0 = *(const float4*)(cur.src + (size_t)(cur.k0 + lk) * cur.ldsrc + cur.n0 + ln4);
    float4 v1 = *(const float4*)(cur.src + (size_t)(cur.k0 + lk + 32) * cur.ldsrc + cur.n0 + ln4);
    for (int j = 0; j < count; ++j) {
        float* tile = (float*)lds + (j & 1) * (64 * 65);
        WTile nx = cur; float4 w0 = v0, w1 = v1;
        if (j + 1 < count) {
            nx = dec(j + 1);
            w0 = *(const float4*)(nx.src + (size_t)(nx.k0 + lk) * nx.ldsrc + nx.n0 + ln4);
            w1 = *(const float4*)(nx.src + (size_t)(nx.k0 + lk + 32) * nx.ldsrc + nx.n0 + ln4);
        }
        tile[lk * 65 + ln4 + 0] = v0.x; tile[lk * 65 + ln4 + 1] = v0.y; tile[lk * 65 + ln4 + 2] = v0.z; tile[lk * 65 + ln4 + 3] = v0.w;
        tile[(lk + 32) * 65 + ln4 + 0] = v1.x; tile[(lk + 32) * 65 + ln4 + 1] = v1.y; tile[(lk + 32) * 65 + ln4 + 2] = v1.z; tile[(lk + 32) * 65 + ln4 + 3] = v1.w;
        lds_barrier();
        float f[8];
#pragma unroll
        for (int i = 0; i < 8; ++i) f[i] = tile[(skc * 8 + i) * 65 + sn];
        const int ng = cur.n0 + sn;
        int drow = ng;
        if (cur.rowmode == 1) drow = ((ng >> 3) << 4) + (ng & 7);
        else if (cur.rowmode == 2) drow = ((ng >> 3) << 4) + 8 + (ng & 7);
        uint4 o; o.x = pack2(f[0], f[1]); o.y = pack2(f[2], f[3]); o.z = pack2(f[4], f[5]); o.w = pack2(f[6], f[7]);
        *(uint4*)(cur.dst + (size_t)drow * cur.lddst + cur.k0 + skc * 8) = o;
        cur = nx; v0 = w0; v1 = w1;
    }
    lds_barrier();
}
__device__ __forceinline__ void deferred_wtiles(const Params& p, unsigned char* lds, int slot) {
    return;
    const XcdIter xi = xcd_iter();
    if (xi.nx != 8 || xi.nloc != 32) {
        if (slot == 0) { const int b = blockIdx.x, g = gridDim.x; transpose_stream(p, lds, (6912 - b + g - 1) / g, [=](int j) { return b + j * g; }); }
        return;
    }
    if (xi.local < 8) return;
    const int ib = (xi.local - 8) * 8 + xi.xcd;
    const int per = slot == 0 ? 2 : (slot == 3 ? 20 : 7);
    const int base = (slot == 0 ? 0 : (slot == 1 ? 2 : (slot == 2 ? 9 : 16))) * 192;
    transpose_stream(p, lds, per, [=](int j) { return base + j * 192 + ib; });
}

__device__ __forceinline__ void phase_pro_a(const Params& p, unsigned char* lds) {
    const WS w{p.ws};
    const int tid = threadIdx.x;
    if (blockIdx.x == 0 && tid < 64) ((int*)(p.ws + OFF_CNT))[tid] = 0;
    constexpr int N_MOD = 2 * 3 * KSPLIT_MOD, N_TAB = (2 * 2 * NG * PS * 34 + NTHR - 1) / NTHR, N_WT = 768;
    for (int rep = 0; rep < REP_PRO; ++rep)
    for (int it = blockIdx.x; it < N_MOD + N_TAB; it += gridDim.x) {
        if (it < N_MOD) {
            const int l = it / (3 * KSPLIT_MOD), rem = it % (3 * KSPLIT_MOD), cb = rem / KSPLIT_MOD, ks = rem % KSPLIT_MOD;
            float* sc = (float*)lds;
            __syncthreads();
            for (int i = tid; i < 9 * 32; i += NTHR) {
                const int r = i >> 5, kk = i & 31, k = ks * 32 + kk;
                const float cv = r < 8 ? p.in[1][r * D + k] : p.in[3][k];
                sc[i] = siluf_(cv);
            }
            __syncthreads();
            float acc[9][4];
#pragma unroll
            for (int r = 0; r < 9; ++r) { acc[r][0] = acc[r][1] = acc[r][2] = acc[r][3] = 0.f; }
            const float* wm = p.in[4] + ((size_t)l * D + ks * 32) * 6144 + cb * 2048 + tid * 4;
#pragma unroll 8
            for (int kk = 0; kk < 32; ++kk) {
                const float4 v = *(const float4*)(wm + (size_t)kk * 6144);
#pragma unroll
                for (int r = 0; r < 9; ++r) { const float s = sc[r * 32 + kk]; acc[r][0] += s * v.x; acc[r][1] += s * v.y; acc[r][2] += s * v.z; acc[r][3] += s * v.w; }
            }
            float* mp = w.modp() + ((size_t)(ks * 2 + l) * 9) * 6144 + cb * 2048 + tid * 4;
#pragma unroll
            for (int r = 0; r < 9; ++r) *(float4*)(mp + (size_t)r * 6144) = make_float4(acc[r][0], acc[r][1], acc[r][2], acc[r][3]);
        } else if (it < N_MOD + N_TAB) {
            const int id = (it - N_MOD) * NTHR + tid;
            if (id < 2 * 2 * NG * PS * 34) {
                const int item = id % 34, q = id / 34;
                const int pp = q & 63, g = (q >> 6) & 31, d = (q >> 11) & 1, l = q >> 12;
                const int i3 = (l * 2 + d) * NG + g;
                const double dt = exp((double)p.in[9][i3]);
                const double are = (double)p.in[7][i3 * PS + pp], aim = (double)p.in[8][i3 * PS + pp];
                const double kk = item < 17 ? (double)item : (item == 17 ? (double)(TCH * SEGLEN) : 1.0);
                const double mag = exp(kk * are * dt);
                double sn, cs; sincos(kk * aim * dt, &sn, &cs);
                if (item < 18) {
                    w.lampow(l, d, g)[pp * NPOW + item] = make_float2((float)(mag * cs), (float)(mag * sn));
                } else {
                    const int n = item - 18;
                    const double lbr = mag * cs, lbi = mag * sn;
                    const double nr = lbr - 1.0, ni = lbi, den = are * are + aim * aim;
                    const double cr = (nr * are + ni * aim) / den, ci = (ni * are - nr * aim) / den;
                    const double br = (double)p.in[10][(size_t)(i3 * PS + pp) * 16 + n], bi = (double)p.in[11][(size_t)(i3 * PS + pp) * 16 + n];
                    w.bbar(l, d, g)[pp * 16 + n] = make_float2((float)(cr * br - ci * bi), (float)(cr * bi + ci * br));
                }
            }
        }
    }
    { const int b = blockIdx.x, g = gridDim.x; transpose_stream(p, lds, (7680 - b + g - 1) / g, [=](int j) { const int t = b + j * g; return t < 768 ? -t - 1 : t - 768; }); }
}

__device__ __forceinline__ void phase_pro_b(const Params& p, unsigned char* lds) {
    const WS w{p.ws};
    const int tid = threadIdx.x;
    const int gt = blockIdx.x * NTHR + tid, gs = gridDim.x * NTHR;
    for (int rep = 0; rep < REP_PB_K; ++rep)
    for (int it = blockIdx.x; it < 2 * NG * 2; it += gridDim.x) {
        const int d = it & 1, g = (it >> 1) & 31, l = it >> 6;
        float2* Lp = (float2*)lds;
        float2* Bb = Lp + 64 * 16;
        float2* Cc = Bb + 64 * 16;
        __syncthreads();
        const float2* lp = w.lampow(l, d, g); const float2* bb = w.bbar(l, d, g);
        const float* cre = p.in[12] + (size_t)((l * 2 + d) * NG + g) * 16 * PS; const float* cim = p.in[13] + (size_t)((l * 2 + d) * NG + g) * 16 * PS;
        for (int i = tid; i < 1024; i += NTHR) {
            Lp[i] = lp[(i >> 4) * NPOW + (i & 15)];
            Bb[i] = bb[i];
            Cc[i] = make_float2(cre[i], cim[i]);
        }
        __syncthreads();
        const int no = (tid >> 4) & 15, ni = tid & 15, th = tid >> 8;
        float acc[8];
#pragma unroll
        for (int t = 0; t < 8; ++t) acc[t] = 0.f;
        for (int pp = 0; pp < PS; ++pp) {
            const float2 c = Cc[no * 64 + pp], b = Bb[pp * 16 + ni];
            const float cr = c.x * b.x - c.y * b.y, ci = c.x * b.y + c.y * b.x;
#pragma unroll
            for (int t = 0; t < 8; ++t) { const float2 L = Lp[pp * 16 + th * 8 + t]; acc[t] += cr * L.x - ci * L.y; }
        }
        if (d == 0 && th == 0) acc[0] += (no == ni) ? p.in[14][l * DS5 + g * 16 + no] : 0.f;
        float* kf = w.kfull(l, g);
#pragma unroll
        for (int t = 0; t < 8; ++t) {
            const int tau = th * 8 + t;
            const int ti = d == 0 ? 15 + tau : (tau == 0 ? 31 : 15 - tau);
            kf[(ti * 16 + no) * 16 + ni] = acc[t];
        }
    }
    for (int rep = 0; rep < REP_PB_M; ++rep) {
    for (int i = gt; i < 2 * 9 * 6144; i += gs) {
        const int l = i / (9 * 6144), n = i % 6144;
        float s = p.in[5][l * 6144 + n];
        const float* mp = w.modp() + i;
#pragma unroll
        for (int ks = 0; ks < KSPLIT_MOD; ++ks) s += mp[(size_t)ks * 2 * 9 * 6144];
        ((float*)(p.ws + OFF_MOD))[i] = s;
    }
    for (int i = gt; i < 2 * NG * 256 * 32; i += gs) {
        const int c8 = i & 31, row = (i >> 5) & 255, lg = i >> 13, g = lg & 31, l = lg >> 5;
        const int d = row >> 7, pp = (row & 127) >> 1, c = row & 1, j = c8 >> 1, n0 = (c8 & 1) * 8;
        const int e = d == 0 ? (TCH - 1 - j) : j;
        const float2 L = w.lampow(l, d, g)[pp * NPOW + e];
        const float2* bb = w.bbar(l, d, g) + pp * 16 + n0;
        float f[8];
#pragma unroll
        for (int n = 0; n < 8; ++n) { const float2 Bv = bb[n]; f[n] = c == 0 ? (L.x * Bv.x - L.y * Bv.y) : (L.x * Bv.y + L.y * Bv.x); }
        uint4 o; o.x = pack2(f[0], f[1]); o.y = pack2(f[2], f[3]); o.z = pack2(f[4], f[5]); o.w = pack2(f[6], f[7]);
        *(uint4*)(w.m1(l, g) + (size_t)row * 256 + c8 * 8) = o;
    }
    for (int i = gt; i < 2 * NG * 256 * 32; i += gs) {
        const int c8 = i & 31, r = (i >> 5) & 255, lg = i >> 13, g = lg & 31, l = lg >> 5;
        const int jo = r >> 4, no = r & 15;
        const int kk = c8 * 8, d = kk >> 7, p0 = (kk & 127) >> 1;
        const int e = d == 0 ? (jo + 1) : (TCH - jo);
        const float* cre = p.in[12] + ((size_t)((l * 2 + d) * NG + g) * 16 + no) * PS;
        const float* cim = p.in[13] + ((size_t)((l * 2 + d) * NG + g) * 16 + no) * PS;
        const float2* lp = w.lampow(l, d, g);
        float f[8];
#pragma unroll
        for (int q = 0; q < 4; ++q) {
            const int pp = p0 + q;
            const float2 L = lp[pp * NPOW + e];
            const float cr = cre[pp], ci = cim[pp];
            f[2 * q] = cr * L.x - ci * L.y;
            f[2 * q + 1] = -(cr * L.y + ci * L.x);
        }
        uint4 o; o.x = pack2(f[0], f[1]); o.y = pack2(f[2], f[3]); o.z = pack2(f[4], f[5]); o.w = pack2(f[6], f[7]);
        *(uint4*)(w.w2(l, g) + (size_t)r * 512 + 256 + c8 * 8) = o;
    }
    }
    {
        float* shsc = (float*)lds;
        for (int rep = 0; rep < REP_PB_H; ++rep)
        for (int it = blockIdx.x; it < NROW / 32; it += gridDim.x) {
            const int row0 = it * 32, m = modrow(row0);
            __syncthreads();
            for (int i = tid; i < 2048; i += NTHR) {
                float sacc = p.in[5][i];
                const float* mp = w.modp() + (size_t)m * 6144 + i;
#pragma unroll
                for (int ks = 0; ks < KSPLIT_MOD; ++ks) sacc += mp[(size_t)ks * 2 * 9 * 6144];
                shsc[i] = sacc;
            }
            __syncthreads();
            for (int i0 = tid; i0 < 32 * 128; i0 += 4 * NTHR) {
                float4 a[4], b[4];
#pragma unroll
                for (int u = 0; u < 4; ++u) {
                    const int i = i0 + u * NTHR, row = row0 + (i >> 7), c8 = (i & 127) * 8;
                    const float* xs = row < NLAT ? p.in[0] + (size_t)row * D : p.in[2] + (size_t)(row - NLAT) * D;
                    a[u] = *(const float4*)(xs + c8); b[u] = *(const float4*)(xs + c8 + 4);
                }
#pragma unroll
                for (int u = 0; u < 4; ++u) {
                    const int i = i0 + u * NTHR, row = row0 + (i >> 7), c8 = (i & 127) * 8;
                    const float4 s0 = *(const float4*)(shsc + c8), s1 = *(const float4*)(shsc + c8 + 4), c0 = *(const float4*)(shsc + 1024 + c8), c1 = *(const float4*)(shsc + 1024 + c8 + 4);
                    uint4 o;
                    o.x = pack2(a[u].x * (1.f + c0.x) + s0.x, a[u].y * (1.f + c0.y) + s0.y);
                    o.y = pack2(a[u].z * (1.f + c0.z) + s0.z, a[u].w * (1.f + c0.w) + s0.w);
                    o.z = pack2(b[u].x * (1.f + c1.x) + s1.x, b[u].y * (1.f + c1.y) + s1.y);
                    o.w = pack2(b[u].z * (1.f + c1.z) + s1.z, b[u].w * (1.f + c1.w) + s1.w);
                    *(uint4*)(w.hb() + (size_t)row * D + c8) = o;
                }
            }
        }
    }
}

__device__ __forceinline__ void w2_toeplitz_fill(const Params& p) {
    const WS w{p.ws};
    const int gt = blockIdx.x * NTHR + threadIdx.x, gs = gridDim.x * NTHR;
    for (int i = gt; i < 2 * NG * 256 * 32; i += gs) {
        const int c8 = i & 31, r = (i >> 5) & 255, lg = i >> 13, g = lg & 31, l = lg >> 5;
        const int jo = r >> 4, no = r & 15, ji = c8 >> 1, n0 = (c8 & 1) * 8;
        const float* kf = w.kfull(l, g) + ((size_t)(jo - ji + 15) * 16 + no) * 16 + n0;
        float f[8];
#pragma unroll
        for (int n = 0; n < 8; ++n) f[n] = kf[n];
        if (jo == ji) {
            const float* k2 = w.kfull(l, g) + ((size_t)31 * 16 + no) * 16 + n0;
#pragma unroll
            for (int n = 0; n < 8; ++n) f[n] += k2[n];
        }
        uint4 o; o.x = pack2(f[0], f[1]); o.y = pack2(f[2], f[3]); o.z = pack2(f[4], f[5]); o.w = pack2(f[6], f[7]);
        *(uint4*)(w.w2(l, g) + (size_t)r * 512 + c8 * 8) = o;
    }
}

struct EpiInproj {
    bf16_t* ug; bf16_t* zr; int m0, n0;
    __device__ __forceinline__ void operator()(const f32x16 (&acc)[2][2], int r0, int c0) const {
        ACC_FOREACH(2, acc, r0, c0, {
            const int row = m0 + rl, col = n0 + cl;
            uint2 o; o.x = pack2(v0, v1); o.y = pack2(v2, v3);
            if (col < DS5) *(uint2*)(ug + ((size_t)(col >> 4) * NROW + row) * 16 + (col & 15)) = o;
            else *(uint2*)(zr + (size_t)row * 1280 + (col - DS5)) = o;
        })
    }
};
__device__ __forceinline__ void phase_inproj(const Params& p, unsigned char* lds, int l) {
    const WS w{p.ws};
    const XcdIter xi = xcd_iter();
    const int nlat = 64 / xi.nx, nctx = 8 / xi.nx, ctxn = l == 0 ? 14 : 4;
    const int nunit = nlat * 14 + nctx * ctxn;
    auto get = [&](int i, SrcA& A, SrcB& B, EpiInproj& e) -> bool {
        const int u = xi.local + i * xi.nloc;
        if (u >= nunit) return false;
        int mt, nt;
        if (u < nlat * 14) { mt = (u / 14) * xi.nx + xi.xcd; nt = u % 14; }
        else { const int v = u - nlat * 14; mt = 64 + (v / ctxn) * xi.nx + xi.xcd; nt = v % ctxn; }
        src_plain<4>(A, w.hb(), mt * 256, D);
        src_plain<2>(B, w.wt_in(l), nt * 128, D);
        e = EpiInproj{w.ug(), w.zr(), mt * 256, nt * 128};
        return true;
    };
    gemm_stream<2, EpiInproj>(lds, D, get);
}

struct EpiS1 {
    float* S; int m0, n0;
    __device__ __forceinline__ void operator()(const f32x16 (&acc)[1][2], int r0, int c0) const {
        ACC_FOREACH(1, acc, r0, c0, {
            *(float4*)(S + (size_t)(m0 + rl) * 256 + n0 + cl) = make_float4(v0, v1, v2, v3);
        })
    }
};

__device__ __forceinline__ void conv_sc(const Params& p, int l, int nrows) {
    const WS w{p.ws};
    const float* wsc = p.in[17] + (size_t)l * 3 * 256;
    const int gt = blockIdx.x * NTHR + threadIdx.x, gs = gridDim.x * NTHR;
    for (int i = gt; i < nrows * 16; i += gs) {
        const int row = i >> 4, c16 = (i & 15) * 16;
        int pos, len;
        if (row < NLAT) { pos = row & 63; len = 64; } else { pos = (row - NLAT) & 255; len = 256; }
        const bf16_t* zr = w.zr() + (size_t)row * 1280;
        uint4 cg[3][2], vv[3][2];
#pragma unroll
        for (int j = 0; j < 3; ++j) {
            const bool ok = (pos + j - 1 >= 0) && (pos + j - 1 < len);
#pragma unroll
            for (int u = 0; u < 2; ++u) {
                if (ok) { cg[j][u] = *(const uint4*)(zr + (ptrdiff_t)(j - 1) * 1280 + 256 + c16 + u * 8); vv[j][u] = *(const uint4*)(zr + (ptrdiff_t)(j - 1) * 1280 + 512 + c16 + u * 8); }
                else { cg[j][u] = make_uint4(0, 0, 0, 0); vv[j][u] = make_uint4(0, 0, 0, 0); }
            }
        }
        uint4 bg[2];
#pragma unroll
        for (int u = 0; u < 2; ++u) bg[u] = *(const uint4*)(zr + c16 + u * 8);
#pragma unroll
        for (int u = 0; u < 2; ++u) {
            float accv[8];
#pragma unroll
            for (int e = 0; e < 8; ++e) accv[e] = 0.f;
#pragma unroll
            for (int j = 0; j < 3; ++j) {
                const float4 wa = *(const float4*)(wsc + j * 256 + c16 + u * 8), wb = *(const float4*)(wsc + j * 256 + c16 + u * 8 + 4);
                const uint4 c = cg[j][u], v = vv[j][u];
                accv[0] += wa.x * bflo(c.x) * bflo(v.x); accv[1] += wa.y * bfhi(c.x) * bfhi(v.x);
                accv[2] += wa.z * bflo(c.y) * bflo(v.y); accv[3] += wa.w * bfhi(c.y) * bfhi(v.y);
                accv[4] += wb.x * bflo(c.z) * bflo(v.z); accv[5] += wb.y * bfhi(c.z) * bfhi(v.z);
                accv[6] += wb.z * bflo(c.w) * bflo(v.w); accv[7] += wb.w * bfhi(c.w) * bfhi(v.w);
            }
            uint4 o;
            o.x = pack2(accv[0] * bflo(bg[u].x), accv[1] * bfhi(bg[u].x));
            o.y = pack2(accv[2] * bflo(bg[u].y), accv[3] * bfhi(bg[u].y));
            o.z = pack2(accv[4] * bflo(bg[u].z), accv[5] * bfhi(bg[u].z));
            o.w = pack2(accv[6] * bflo(bg[u].w), accv[7] * bfhi(bg[u].w));
            *(uint4*)(w.hb() + (size_t)row * D + 512 + c16 + u * 8) = o;
        }
    }
}

template <int PM>
__device__ __forceinline__ void conv_cf(const Params& p, unsigned char* lds, int l, bool with_ctx) {
    const WS w{p.ws};
    float* P = (float*)lds;
    const int tid = threadIdx.x, lane = tid & 63, wid = __builtin_amdgcn_readfirstlane(tid >> 6);
    float4 wv[31];
#pragma unroll
    for (int k = 0; k < 31; ++k) wv[k] = *(const float4*)(p.in[18] + (size_t)l * 31 * 256 + k * 256 + lane * 4);
    const float4 bdw = *(const float4*)(p.in[19] + l * 256 + lane * 4);
    const float4 lg = *(const float4*)(p.in[20] + l * 256 + lane * 4);
    const float4 lb = *(const float4*)(p.in[21] + l * 256 + lane * 4);
    const int nitem = 512 + (with_ctx ? 64 : 0);
    uint4 rga[4], rgb[4];
    auto item_geom = [&](int it, bool& lat, int& base, int& nslot, int& s0) {
        lat = it < 512; s0 = 0;
        if (lat) { base = (it >> 6) * SEQ + (it & 63); nslot = 32; }
        else { const int j = it - 512; s0 = (j & 7) * 32; base = NLAT + (j >> 3) * CTX; nslot = 62; }
    };
    auto issue = [&](int it) {
        bool lat; int base, nslot, s0; item_geom(it, lat, base, nslot, s0);
#pragma unroll
        for (int t = 0; t < 4; ++t) {
            const int task = tid + t * NTHR, slot = task >> 5, c8 = (task & 31) * 8;
            int row; bool valid = slot < nslot;
            if (lat) row = base + slot * 64;
            else { const int sq = s0 - 15 + slot; valid = valid && sq >= 0 && sq < CTX; row = base + sq; }
            if (valid) {
                const bf16_t* zr = w.zr() + (size_t)row * 1280;
                rga[t] = *(const uint4*)(zr + 768 + c8); rgb[t] = *(const uint4*)(zr + 1024 + c8);
            } else { rga[t] = make_uint4(0, 0, 0, 0); rgb[t] = make_uint4(0, 0, 0, 0); }
        }
    };
    const int rb = gridDim.x - 1 - blockIdx.x;
    if (rb < nitem) issue(rb);
    for (int it = rb; it < nitem; it += gridDim.x) {
        bool lat; int base, nslot, s0; item_geom(it, lat, base, nslot, s0);
        lds_barrier();
#pragma unroll
        for (int t = 0; t < 4; ++t) {
            const int task = tid + t * NTHR, slot = task >> 5, c8 = (task & 31) * 8;
            if (PM == 3) { KEEP(rga[t].x); KEEP(rgb[t].x); }
            if (PM != 3 && slot < nslot) {
                const uint4 ga = rga[t], gb = rgb[t];
                float f[8];
                f[0] = bflo(ga.x) * sigmoidf_(bflo(gb.x)); f[1] = bfhi(ga.x) * sigmoidf_(bfhi(gb.x));
                f[2] = bflo(ga.y) * sigmoidf_(bflo(gb.y)); f[3] = bfhi(ga.y) * sigmoidf_(bfhi(gb.y));
                f[4] = bflo(ga.z) * sigmoidf_(bflo(gb.z)); f[5] = bfhi(ga.z) * sigmoidf_(bfhi(gb.z));
                f[6] = bflo(ga.w) * sigmoidf_(bflo(gb.w)); f[7] = bfhi(ga.w) * sigmoidf_(bfhi(gb.w));
                *(float4*)(P + slot * 256 + c8) = make_float4(f[0], f[1], f[2], f[3]);
                *(float4*)(P + slot * 256 + c8 + 4) = make_float4(f[4], f[5], f[6], f[7]);
            }
        }
        if (it + (int)gridDim.x < nitem) issue(it + gridDim.x);
        lds_barrier();
        constexpr int OPW = 32 / NWV;
        const int o0 = wid * OPW;
        float4 a[OPW];
#pragma unroll
        for (int o = 0; o < OPW; ++o) a[o] = bdw;
        if (PM != 1) {
#pragma unroll
            for (int i = 0; i < OPW + 30; ++i) {
                const int rr = lat ? o0 - 15 + i : o0 + i;
                if (!lat || (rr >= 0 && rr < 32)) {
                    const float4 pv = *(const float4*)(P + rr * 256 + lane * 4);
#pragma unroll
                    for (int o = 0; o < OPW; ++o) {
                        const int k = i - o;
                        if (k >= 0 && k < 31) { a[o].x += wv[k].x * pv.x; a[o].y += wv[k].y * pv.y; a[o].z += wv[k].z * pv.z; a[o].w += wv[k].w * pv.w; }
                    }
                }
            }
        }
        if (PM == 2) {
#pragma unroll
            for (int o = 0; o < OPW; ++o) { KEEP(a[o].x); KEEP(a[o].y); KEEP(a[o].z); KEEP(a[o].w); }
        } else
#pragma unroll
        for (int o = 0; o < OPW; ++o) {
            const int row = lat ? base + (o0 + o) * 64 : base + s0 + o0 + o;
            const float mean = wave_sum_fast(a[o].x + a[o].y + a[o].z + a[o].w) * (1.0f / 256.0f);
            const float dx = a[o].x - mean, dy = a[o].y - mean, dz = a[o].z - mean, dw = a[o].w - mean;
            const float var = wave_sum_fast(dx * dx + dy * dy + dz * dz + dw * dw) * (1.0f / 256.0f);
            const float rs = rsqrtf(var + LN_EPS);
            const float y0 = siluf_(dx * rs * lg.x + lb.x), y1 = siluf_(dy * rs * lg.y + lb.y), y2 = siluf_(dz * rs * lg.z + lb.z), y3 = siluf_(dw * rs * lg.w + lb.w);
            uint2 ov; ov.x = pack2(y0, y1); ov.y = pack2(y2, y3);
            if (PM == 0) *(uint2*)(w.hb() + (size_t)row * D + 768 + lane * 4) = ov; else { KEEP(ov.x); KEEP(ov.y); }
        }
    }
}

__device__ __forceinline__ void phase_s1(const Params& p, unsigned char* lds, int l) {
    const WS w{p.ws};
    const XcdIter xi = xcd_iter();
    const int nunit = (NG / xi.nx) * 18;
    auto get = [&](int i, SrcA& A, SrcB& B, EpiS1& e) -> bool {
        const int u = xi.local + i * xi.nloc;
        if (u >= nunit) return false;
        const int g = (u / 18) * xi.nx + xi.xcd, r = u % 18, mt = r >> 1, nt = r & 1;
        src_plain<2>(A, w.ug() + (size_t)g * NROW * 16, mt * 128, 256);
        src_plain<2>(B, w.m1(l, g), nt * 128, 256);
        e = EpiS1{w.S() + (size_t)g * NCOL * 256, mt * 128, nt * 128};
        return true;
    };
    gemm_stream<1, EpiS1>(lds, 256, get);
    __syncthreads();
    if (l == 0) deferred_wtiles(p, lds, 0);
    for (int rep = 0; rep < REP_CONV; ++rep) {
    for (int r2 = 0; r2 < REP_CSC; ++r2) conv_sc(p, l, l == 0 ? NROW : NLAT);
    conv_cf<0>(p, lds, l, l == 0);
    if (REP_CCF > 1) conv_cf<CCF_PM>(p, lds, l, l == 0);
    }
}

__device__ __forceinline__ int chunk_col(int d, int b, int step) {
    if (step < CH_CTX) { const int c = d == 0 ? step : (CH_CTX - 1 - step); return NCOL_LAT + b * CH_CTX + c; }
    const int s = step - CH_CTX; const int c = d == 0 ? s : (CH_LAT - 1 - s); return b * CH_LAT + c;
}
__device__ __forceinline__ void phase_s2(const Params& p, unsigned char* lds, int l) {
    const WS w{p.ws};
    float2* Fs = (float2*)lds;
    const int tid = threadIdx.x, seg = tid >> 6, pp = tid & 63;
    for (int rep = 0; rep < REP_S2; ++rep)
    for (int it = blockIdx.x; it < NG * 2 * NB; it += gridDim.x) {
        const int b = it & 7, d = (it >> 3) & 1, g = it >> 4;
        const float2 A = w.lampow(l, d, g)[pp * NPOW + 16], A18 = w.lampow(l, d, g)[pp * NPOW + 17];
        const float* S = w.S() + (size_t)g * NCOL * 256 + d * 128 + 2 * pp;
        bf16_t* Hp = w.hprev() + (size_t)g * NCOL * 256 + d * 128 + 2 * pp;
        float2 s[SEGLEN];
#pragma unroll
        for (int i = 0; i < SEGLEN; ++i) s[i] = *(const float2*)(S + (size_t)chunk_col(d, b, seg * SEGLEN + i) * 256);
        float2 F = make_float2(0.f, 0.f);
#pragma unroll
        for (int i = 0; i < SEGLEN; ++i) { const float fr = A.x * F.x - A.y * F.y + s[i].x, fi = A.x * F.y + A.y * F.x + s[i].y; F.x = fr; F.y = fi; }
        __syncthreads();
        Fs[seg * 64 + pp] = F;
        __syncthreads();
        float2 H = make_float2(0.f, 0.f);
        for (int q = 0; q < seg; ++q) { const float2 f = Fs[q * 64 + pp]; const float hr = A18.x * H.x - A18.y * H.y + f.x, hi = A18.x * H.y + A18.y * H.x + f.y; H.x = hr; H.y = hi; }
#pragma unroll
        for (int i = 0; i < SEGLEN; ++i) {
            *(unsigned*)(Hp + (size_t)chunk_col(d, b, seg * SEGLEN + i) * 256) = pack2(H.x, H.y);
            const float hr = A.x * H.x - A.y * H.y + s[i].x, hi = A.x * H.y + A.y * H.x + s[i].y; H.x = hr; H.y = hi;
        }
    }
}

struct EpiS3 {
    bf16_t* Y; int m0, n0, g;
    __device__ __forceinline__ void operator()(const f32x16 (&acc)[1][2], int r0, int c0) const {
        ACC_FOREACH(1, acc, r0, c0, {
            const int col = n0 + cl, tok = (m0 + rl) * TCH + (col >> 4);
            uint2 o; o.x = pack2(gelu_tanh(v0), gelu_tanh(v1)); o.y = pack2(gelu_tanh(v2), gelu_tanh(v3));
            *(uint2*)(Y + (size_t)tok * DS5 + g * 16 + (col & 15)) = o;
        })
    }
};
__device__ __forceinline__ void phase_s3(const Params& p, unsigned char* lds, int l) {
    const WS w{p.ws};
    const XcdIter xi = xcd_iter();
    const int nmt = l == 0 ? 9 : 8, nunit = (NG / xi.nx) * nmt * 2;
    auto get = [&](int i, SrcA& A, SrcB& B, EpiS3& e) -> bool {
        const int u = xi.local + i * xi.nloc;
        if (u >= nunit) return false;
        const int g = (u / (nmt * 2)) * xi.nx + xi.xcd, r = u % (nmt * 2), mt = r >> 1, nt = r & 1;
        src_split<2>(A, w.ug() + (size_t)g * NROW * 16, 256, w.hprev() + (size_t)g * NCOL * 256, 256, mt * 128, 256);
        src_plain<2>(B, w.w2(l, g), nt * 128, 512);
        e = EpiS3{w.Y(), mt * 128, nt * 128, g};
        return true;
    };
    gemm_stream<1, EpiS3>(lds, 512, get);
    if (l == 0) deferred_wtiles(p, lds, 1);
}

struct EpiGlu {
    const bf16_t* Y; bf16_t* hb; const float* bg; int m0, n0;
    __device__ __forceinline__ void operator()(const f32x16 (&acc)[1][2], int r0, int c0) const {
        ACC_FOREACH(1, acc, r0, c0, {
            const int row = m0 + rl, col = n0 + cl;
            const uint2 t = *(const uint2*)(Y + (size_t)row * DS5 + col);
            const float4 b = *(const float4*)(bg + col);
            uint2 o;
            o.x = pack2(bflo(t.x) * sigmoidf_(v0 + b.x), bfhi(t.x) * sigmoidf_(v1 + b.y));
            o.y = pack2(bflo(t.y) * sigmoidf_(v2 + b.z), bfhi(t.y) * sigmoidf_(v3 + b.w));
            *(uint2*)(hb + (size_t)row * D + col) = o;
        })
    }
};
__device__ __forceinline__ void phase_glu(const Params& p, unsigned char* lds, int l) {
    const WS w{p.ws};
    const XcdIter xi = xcd_iter();
    const int nmt = (l == 0 ? 144 : 128) / xi.nx, nunit = nmt * 4;
    auto get = [&](int i, SrcA& A, SrcB& B, EpiGlu& e) -> bool {
        const int u = xi.local + i * xi.nloc;
        if (u >= nunit) return false;
        const int mt = (u >> 2) * xi.nx + xi.xcd, nt = u & 3;
        src_plain<2>(A, w.Y(), mt * 128, DS5);
        src_plain<2>(B, w.wt_glu(l), nt * 128, 512);
        e = EpiGlu{w.Y(), w.hb(), p.in[16] + l * DS5, mt * 128, nt * 128};
        return true;
    };
    gemm_stream<1, EpiGlu>(lds, 512, get);
    if (l == 0) deferred_wtiles(p, lds, 2);
}

struct EpiOut {
    bf16_t* y; int m0, n0;
    __device__ __forceinline__ void operator()(const f32x16 (&acc)[2][2], int r0, int c0) const {
        ACC_FOREACH(2, acc, r0, c0, {
            uint2 o; o.x = pack2(v0, v1); o.y = pack2(v2, v3);
            *(uint2*)(y + (size_t)(m0 + rl) * D + n0 + cl) = o;
        })
    }
};
__device__ __forceinline__ void phase_outproj(const Params& p, unsigned char* lds, int l) {
    const WS w{p.ws};
    const XcdIter xi = xcd_iter();
    const int nmt = (l == 0 ? 72 : 64) / xi.nx, nunit = nmt * 8;
    auto get = [&](int i, SrcA& A, SrcB& B, EpiOut& e) -> bool {
        const int u = xi.local + i * xi.nloc;
        if (u >= nunit) return false;
        const int mt = (u >> 3) * xi.nx + xi.xcd, nt = u & 7;
        src_plain<4>(A, w.hb(), mt * 256, D);
        src_plain<2>(B, w.wt_o(l), nt * 128, D);
        e = EpiOut{w.zr(), mt * 256, nt * 128};
        return true;
    };
    gemm_stream<2, EpiOut>(lds, D, get);
    if (l == 0) deferred_wtiles(p, lds, 3);
}

template <bool DRY>
__device__ __forceinline__ void phase_ln1(const Params& p, unsigned char* lds, int l) {
    const WS w{p.ws};
    const int tid = threadIdx.x, lane = tid & 63, wid = tid >> 6;
    float* wl = (float*)lds;
    __syncthreads();
#pragma unroll
    for (int kk = 0; kk < 2; ++kk) {
        const int k = tid + NTHR * kk;
        const int s = ((k >> 8) * 4 + (k & 3)) * 64 + ((k >> 2) & 63);
        const float4 g = *(const float4*)(p.in[25] + ((size_t)l * D + k) * 4);
        const float4* ex = (const float4*)(p.in[27] + ((size_t)l * D + k) * 16);
        const float4 e0 = ex[0], e1 = ex[1], e2 = ex[2], e3 = ex[3];
        *(float4*)(wl + (0 * 1024 + s) * 4) = g;
        *(float4*)(wl + (1 * 1024 + s) * 4) = e0;
        *(float4*)(wl + (2 * 1024 + s) * 4) = e1;
        *(float4*)(wl + (3 * 1024 + s) * 4) = e2;
        *(float4*)(wl + (4 * 1024 + s) * 4) = e3;
    }
    __syncthreads();
    const int nrows = l == 0 ? NROW : NLAT;
    const float* md = w.mod(l);
    const float* lng = p.in[23] + l * D; const float* lnb = p.in[24] + l * D;
    const float brg0 = p.in[26][l * 4 + 0], brg1 = p.in[26][l * 4 + 1], brg2 = p.in[26][l * 4 + 2], brg3 = p.in[26][l * 4 + 3];
    float bre[16];
#pragma unroll
    for (int i = 0; i < 16; ++i) bre[i] = p.in[28][l * 16 + i];
    int k_cls = 0, k_row = 0, nkeep = 0; float k_wlo = 0.f, k_whi = 0.f;
    const int nwv = gridDim.x * NWV, rpw = (nrows + nwv - 1) / nwv;
    int row = (blockIdx.x * NWV + wid) * rpw;
    const int rend = min(nrows, row + rpw);
    float4 pg[4], pb[4], psh[4], psc[4];
#pragma unroll
    for (int i = 0; i < 4; ++i) { pg[i] = *(const float4*)(lng + i * 256 + lane * 4); pb[i] = *(const float4*)(lnb + i * 256 + lane * 4); psh[i] = pg[i]; psc[i] = pg[i]; }
    const bf16_t* ybuf = w.zr();
    int mcur = -1;
    float4 vn[4]; uint2 yn[4];
    if (row < rend) {
        const float* R0 = l == 0 ? (row < NLAT ? p.in[0] + (size_t)row * D : p.in[2] + (size_t)(row - NLAT) * D) : Rrow(p, row);
#pragma unroll
        for (int i = 0; i < 4; ++i) { vn[i] = *(const float4*)(R0 + i * 256 + lane * 4); yn[i] = *(const uint2*)(ybuf + (size_t)row * D + i * 256 + lane * 4); }
    }
    for (; row < rend; ++row) {
        float* R = Rrow(p, row);
        const int m = modrow(row);
        if (m != mcur) {
            mcur = m;
#pragma unroll
            for (int i = 0; i < 4; ++i) { psh[i] = *(const float4*)(md + (size_t)m * 6144 + 3072 + i * 256 + lane * 4); psc[i] = *(const float4*)(md + (size_t)m * 6144 + 4096 + i * 256 + lane * 4); }
        }
        float h[16];
        float4 v[4];
#pragma unroll
        for (int i = 0; i < 4; ++i) {
            const float4 g1 = *(const float4*)(md + (size_t)m * 6144 + 2048 + i * 256 + lane * 4); const uint2 yy = yn[i];
            v[i].x = DN_ALPHA * vn[i].x + g1.x * bflo(yy.x); v[i].y = DN_ALPHA * vn[i].y + g1.y * bfhi(yy.x);
            v[i].z = DN_ALPHA * vn[i].z + g1.z * bflo(yy.y); v[i].w = DN_ALPHA * vn[i].w + g1.w * bfhi(yy.y);
        }
        if (row + 1 < rend) {
            const int rn = row + 1;
            const float* Rn = l == 0 ? (rn < NLAT ? p.in[0] + (size_t)rn * D : p.in[2] + (size_t)(rn - NLAT) * D) : Rrow(p, rn);
#pragma unroll
            for (int i = 0; i < 4; ++i) { vn[i] = *(const float4*)(Rn + i * 256 + lane * 4); yn[i] = *(const uint2*)(ybuf + (size_t)rn * D + i * 256 + lane * 4); }
        }
        float s = 0.f;
#pragma unroll
        for (int i = 0; i < 4; ++i) s += (v[i].x + v[i].y) + (v[i].z + v[i].w);
        const float mean = wave_sum_fast(s) * (1.0f / 1024.0f);
        float q = 0.f;
#pragma unroll
        for (int i = 0; i < 4; ++i) { const float a = v[i].x - mean, b = v[i].y - mean, c = v[i].z - mean, d = v[i].w - mean; q += (a * a + b * b) + (c * c + d * d); }
        const float rs = rsqrtf(wave_sum_fast(q) * (1.0f / 1024.0f) + LN_EPS);
#pragma unroll
        for (int i = 0; i < 4; ++i) {
            const int col = i * 256 + lane * 4;
            const float4 g = pg[i], b = pb[i], sh = psh[i], sc = psc[i];
            float4 x;
            x.x = (v[i].x - mean) * rs * g.x + b.x; x.y = (v[i].y - mean) * rs * g.y + b.y; x.z = (v[i].z - mean) * rs * g.z + b.z; x.w = (v[i].w - mean) * rs * g.w + b.w;
            if (!DRY) *(float4*)(R + col) = x; else { KEEP(x.x); KEEP(x.y); KEEP(x.z); KEEP(x.w); }
            h[i * 4 + 0] = x.x * (1.f + sc.x) + sh.x; h[i * 4 + 1] = x.y * (1.f + sc.y) + sh.y; h[i * 4 + 2] = x.z * (1.f + sc.z) + sh.z; h[i * 4 + 3] = x.w * (1.f + sc.w) + sh.w;
            uint2 o; o.x = pack2(h[i * 4 + 0], h[i * 4 + 1]); o.y = pack2(h[i * 4 + 2], h[i * 4 + 3]);
            if (!DRY) *(uint2*)(w.hb() + (size_t)row * D + col) = o; else { KEEP(o.x); KEEP(o.y); }
        }
        if (DRY && DRY_NOROUTER) {
#pragma unroll
            for (int e = 0; e < 16; ++e) KEEP(h[e]);
        } else {
        float gl[4];
        {
            float a0 = 0.f, a1 = 0.f, a2 = 0.f, a3 = 0.f;
#pragma unroll
            for (int e = 0; e < 16; ++e) {
                const float4 wv = *(const float4*)(wl + (e * 64 + lane) * 4);
                a0 += h[e] * wv.x; a1 += h[e] * wv.y; a2 += h[e] * wv.z; a3 += h[e] * wv.w;
            }
            gl[0] = wave_sum_fast(a0) + brg0; gl[1] = wave_sum_fast(a1) + brg1; gl[2] = wave_sum_fast(a2) + brg2; gl[3] = wave_sum_fast(a3) + brg3;
        }
        {
            int gi = 0; float gm = gl[0];
#pragma unroll
            for (int i = 1; i < 4; ++i) if (gl[i] > gm) { gm = gl[i]; gi = i; }
            gi = __builtin_amdgcn_readfirstlane(gi);
            float den = 0.f;
#pragma unroll
            for (int i = 0; i < 4; ++i) den += __expf(gl[i] - gm);
            const float gw = 1.0f / den;
            float el[4];
            {
                const float* wg = wl + (size_t)(1 + gi) * 4096;
                float a0 = 0.f, a1 = 0.f, a2 = 0.f, a3 = 0.f;
#pragma unroll
                for (int e = 0; e < 16; ++e) {
                    const float4 wv = *(const float4*)(wg + (e * 64 + lane) * 4);
                    a0 += h[e] * wv.x; a1 += h[e] * wv.y; a2 += h[e] * wv.z; a3 += h[e] * wv.w;
                }
                const float b0 = gi == 0 ? bre[0] : (gi == 1 ? bre[4] : (gi == 2 ? bre[8] : bre[12]));
                const float b1 = gi == 0 ? bre[1] : (gi == 1 ? bre[5] : (gi == 2 ? bre[9] : bre[13]));
                const float b2 = gi == 0 ? bre[2] : (gi == 1 ? bre[6] : (gi == 2 ? bre[10] : bre[14]));
                const float b3 = gi == 0 ? bre[3] : (gi == 1 ? bre[7] : (gi == 2 ? bre[11] : bre[15]));
                el[0] = wave_sum_fast(a0) + b0; el[1] = wave_sum_fast(a1) + b1; el[2] = wave_sum_fast(a2) + b2; el[3] = wave_sum_fast(a3) + b3;
            }
            int i1 = 0; float m1 = el[0];
#pragma unroll
            for (int i = 1; i < 4; ++i) if (el[i] > m1) { m1 = el[i]; i1 = i; }
            int i2 = -1; float m2 = -3.0e38f;
#pragma unroll
            for (int i = 0; i < 4; ++i) if (i != i1 && el[i] > m2) { m2 = el[i]; i2 = i; }
            const float e2 = __expf(m2 - m1);
            const float w1 = gw / (1.0f + e2), w2 = gw * e2 / (1.0f + e2);
            const int lo = i1 < i2 ? i1 : i2, hi = i1 < i2 ? i2 : i1;
            const float wlo = i1 < i2 ? w1 : w2, whi = i1 < i2 ? w2 : w1;
            const int pair = lo == 0 ? (hi - 1) : (lo == 1 ? (hi + 1) : 5);
            const int cls = gi * 6 + pair;
            if (lane == nkeep) { k_cls = cls; k_row = row; k_wlo = wlo; k_whi = whi; }
            ++nkeep;
        }
        }
        if (nkeep == 64) {
            if (!DRY) { const int pos = atomicAdd(w.cnt(l) + k_cls, 1); w.list()[(size_t)k_cls * LISTCAP + pos] = k_row; w.lw()[(size_t)k_cls * LISTCAP + pos] = make_float2(k_wlo, k_whi); }
            nkeep = 0;
        }
    }
    {
        int* hist = (int*)(lds + 81920);
        int* hbase = hist + 32;
        __syncthreads();
        if (tid < 64) hist[tid] = 0;
        __syncthreads();
        int rk = 0;
        if (lane < nkeep && !DRY) rk = atomicAdd(&hist[k_cls], 1);
        __syncthreads();
        if (tid < NCLS && !DRY) { const int c = hist[tid]; hbase[tid] = c > 0 ? atomicAdd(w.cnt(l) + tid, c) : 0; }
        __syncthreads();
        if (lane < nkeep) {
            if (!DRY) {
                const int pos = hbase[k_cls] + rk;
                w.list()[(size_t)k_cls * LISTCAP + pos] = k_row;
                w.lw()[(size_t)k_cls * LISTCAP + pos] = make_float2(k_wlo, k_whi);
            } else { KEEP(k_cls); KEEP(k_wlo); KEEP(k_whi); }
        }
    }
}

__device__ __forceinline__ void cls_experts(int cls, int& elo, int& ehi) {
    const int g = cls / 6, pr = cls % 6;
    const int lo = pr < 3 ? 0 : (pr < 5 ? 1 : 2);
    const int hi = pr < 3 ? pr + 1 : (pr < 5 ? pr - 1 : 3);
    elo = g * 4 + lo; ehi = g * 4 + hi;
}

struct EpiGU {
    bf16_t* act; const float2* lw; int cnt, pos0, orow0, half, fcol0;
    __device__ __forceinline__ void operator()(const f32x16 (&acc)[1][2], int r0, int c0) const {
        const int hh4 = c0 & 4, wn64 = c0 & 64;
        const int rl = r0, pos = pos0 + rl;
        float wt = 0.f;
        if (pos < cnt) { const float2 ww = lw[pos]; wt = half ? ww.y : ww.x; }
#pragma unroll
        for (int nt = 0; nt < 2; ++nt)
#pragma unroll
            for (int qp = 0; qp < 2; ++qp) {
                const int f = fcol0 + ((wn64 + nt * 32) >> 1) + qp * 8 + hh4;
                const int qg = qp * 2, qu = qp * 2 + 1;
                const float a0 = siluf_(acc[0][nt][qg * 4 + 0]) * acc[0][nt][qu * 4 + 0] * wt;
                const float a1 = siluf_(acc[0][nt][qg * 4 + 1]) * acc[0][nt][qu * 4 + 1] * wt;
                const float a2 = siluf_(acc[0][nt][qg * 4 + 2]) * acc[0][nt][qu * 4 + 2] * wt;
                const float a3 = siluf_(acc[0][nt][qg * 4 + 3]) * acc[0][nt][qu * 4 + 3] * wt;
                uint2 o; o.x = pack2(a0, a1); o.y = pack2(a2, a3);
                *(uint2*)(act + (size_t)(orow0 + rl) * 512 + half * 256 + f) = o;
            }
    }
};
__device__ __forceinline__ void phase_moe_gu(const Params& p, unsigned char* lds, int l) {
    const WS w{p.ws};
    const XcdIter xi = xcd_iter();
    int ntl[NCLS]; int tot = 0;
#pragma unroll
    for (int c = 0; c < NCLS; ++c) { ntl[c] = (w.cnt(l)[c] + 127) >> 7; tot += ntl[c]; }
    const int nmg = (tot + xi.nx - 1) / xi.nx, nunit = nmg * 8;
    const int lr = threadIdx.x >> 3, lc = (threadIdx.x & 7) ^ ((lr >> 1) & 7);
    auto get = [&](int i, SrcA& A, SrcB& B, EpiGU& ep) -> bool {
        const int u = xi.local + i * xi.nloc;
        if (u >= nunit) return false;
        const int mg = (u >> 3) * xi.nx + xi.xcd, nt = u & 7;
        if (mg >= tot) return false;
        int cls = 0, mt = 0, run = 0;
#pragma unroll
        for (int c = 0; c < NCLS; ++c) { if (mg >= run && mg < run + ntl[c]) { cls = c; mt = mg - run; } run += ntl[c]; }
        const int cnt = w.cnt(l)[cls];
        int elo, ehi; cls_experts(cls, elo, ehi);
        const int half = nt >> 2, e = half ? ehi : elo;
        const int* lst = w.list() + (size_t)cls * LISTCAP;
#pragma unroll
        for (int j = 0; j < 2; ++j) {
            int pos = mt * 128 + lr + 64 * j; if (pos >= cnt) pos = 0;
            const int tok = lst[pos];
            A.p0[j] = w.hb() + (size_t)tok * D + lc * 8; A.p1[j] = A.p0[j];
        }
        A.split = 1 << 30;
        src_plain<2>(B, w.wt_gu(l, e), (nt & 3) * 128, D);
        ep = EpiGU{w.act(), w.lw() + (size_t)cls * LISTCAP, cnt, mt * 128, mg * 128, half, (nt & 3) * 64};
        return true;
    };
    gemm_stream<1, EpiGU>(lds, D, get);
}

struct EpiDown {
    bf16_t* y; const int* lst; int cnt, pos0, n0;
    __device__ __forceinline__ void operator()(const f32x16 (&acc)[1][2], int r0, int c0) const {
        const int pos = pos0 + r0;
        if (pos < cnt) {
            const int row = lst[pos];
#pragma unroll
            for (int nt = 0; nt < 2; ++nt)
#pragma unroll
                for (int q = 0; q < 4; ++q) {
                    const int col = n0 + c0 + nt * 32 + q * 8;
                    uint2 o; o.x = pack2(acc[0][nt][q * 4 + 0], acc[0][nt][q * 4 + 1]); o.y = pack2(acc[0][nt][q * 4 + 2], acc[0][nt][q * 4 + 3]);
                    *(uint2*)(y + (size_t)row * D + col) = o;
                }
        }
    }
};
__device__ __forceinline__ void phase_moe_dn(const Params& p, unsigned char* lds, int l) {
    const WS w{p.ws};
    const XcdIter xi = xcd_iter();
    int ntl[NCLS]; int tot = 0;
#pragma unroll
    for (int c = 0; c < NCLS; ++c) { ntl[c] = (w.cnt(l)[c] + 127) >> 7; tot += ntl[c]; }
    const int nmg = (tot + xi.nx - 1) / xi.nx, nunit = nmg * 8;
    auto get = [&](int i, SrcA& A, SrcB& B, EpiDown& ep) -> bool {
        const int u = xi.local + i * xi.nloc;
        if (u >= nunit) return false;
        const int mg = (u >> 3) * xi.nx + xi.xcd, nt = u & 7;
        if (mg >= tot) return false;
        int cls = 0, mt = 0, run = 0;
#pragma unroll
        for (int c = 0; c < NCLS; ++c) { if (mg >= run && mg < run + ntl[c]) { cls = c; mt = mg - run; } run += ntl[c]; }
        const int cnt = w.cnt(l)[cls];
        int elo, ehi; cls_experts(cls, elo, ehi);
        src_plain<2>(A, w.act(), mg * 128, 512);
        src_split<2>(B, w.wt_dn(l, elo), 256, w.wt_dn(l, ehi), 256, nt * 128, 256);
        ep = EpiDown{w.zr(), w.list() + (size_t)cls * LISTCAP, cnt, mt * 128, nt * 128};
        return true;
    };
    gemm_stream<1, EpiDown>(lds, 512, get);
}

template <bool DRY>
__device__ __forceinline__ void phase_ln2(const Params& p, int l) {
    const WS w{p.ws};
    const int tid = threadIdx.x, lane = tid & 63, wid = tid >> 6;
    const int nrows = l == 0 ? NROW : NLAT;
    const float* lng = p.in[32] + l * D; const float* lnb = p.in[33] + l * D;
    const float* mdn = w.mod(1); const float* mdc = w.mod(l);
    const bf16_t* ybuf = w.zr();
    const int nwv = gridDim.x * NWV, rpw = (nrows + nwv - 1) / nwv;
    int row = (blockIdx.x * NWV + wid) * rpw;
    const int rend = min(nrows, row + rpw);
    float4 pg[4], pb[4], psh[4], psc[4], pg2[4];
#pragma unroll
    for (int i = 0; i < 4; ++i) { pg[i] = *(const float4*)(lng + i * 256 + lane * 4); pb[i] = *(const float4*)(lnb + i * 256 + lane * 4); psh[i] = pg[i]; psc[i] = pg[i]; pg2[i] = pg[i]; }
    int mcur = -1;
    float4 vn[4]; uint2 yn[4];
    if (row < rend) {
        const float* R0 = Rrow(p, row);
#pragma unroll
        for (int i = 0; i < 4; ++i) { vn[i] = *(const float4*)(R0 + i * 256 + lane * 4); yn[i] = *(const uint2*)(ybuf + (size_t)row * D + i * 256 + lane * 4); }
    }
    for (; row < rend; ++row) {
        float* R = Rrow(p, row);
        const int m = modrow(row);
        if (m != mcur) {
            mcur = m;
#pragma unroll
            for (int i = 0; i < 4; ++i) {
                pg2[i] = *(const float4*)(mdc + (size_t)m * 6144 + 5120 + i * 256 + lane * 4);
                if (l == 0) { psh[i] = *(const float4*)(mdn + (size_t)m * 6144 + i * 256 + lane * 4); psc[i] = *(const float4*)(mdn + (size_t)m * 6144 + 1024 + i * 256 + lane * 4); }
            }
        }
        float4 v[4];
#pragma unroll
        for (int i = 0; i < 4; ++i) {
            const float4 g2 = pg2[i]; const uint2 yy = yn[i];
            v[i].x = DN_ALPHA * vn[i].x + g2.x * bflo(yy.x); v[i].y = DN_ALPHA * vn[i].y + g2.y * bfhi(yy.x);
            v[i].z = DN_ALPHA * vn[i].z + g2.z * bflo(yy.y); v[i].w = DN_ALPHA * vn[i].w + g2.w * bfhi(yy.y);
        }
        if (row + 1 < rend) {
            const float* Rn = Rrow(p, row + 1);
#pragma unroll
            for (int i = 0; i < 4; ++i) { vn[i] = *(const float4*)(Rn + i * 256 + lane * 4); yn[i] = *(const uint2*)(ybuf + (size_t)(row + 1) * D + i * 256 + lane * 4); }
        }
        float s = 0.f;
#pragma unroll
        for (int i = 0; i < 4; ++i) s += (v[i].x + v[i].y) + (v[i].z + v[i].w);
        const float mean = wave_sum_fast(s) * (1.0f / 1024.0f);
        float q = 0.f;
#pragma unroll
        for (int i = 0; i < 4; ++i) { const float a = v[i].x - mean, b = v[i].y - mean, c = v[i].z - mean, d = v[i].w - mean; q += (a * a + b * b) + (c * c + d * d); }
        const float rs = rsqrtf(wave_sum_fast(q) * (1.0f / 1024.0f) + LN_EPS);
#pragma unroll
        for (int i = 0; i < 4; ++i) {
            const int col = i * 256 + lane * 4;
            const float4 g = pg[i], b = pb[i];
            float4 x;
            x.x = (v[i].x - mean) * rs * g.x + b.x; x.y = (v[i].y - mean) * rs * g.y + b.y; x.z = (v[i].z - mean) * rs * g.z + b.z; x.w = (v[i].w - mean) * rs * g.w + b.w;
            if (!DRY) *(float4*)(R + col) = x; else { KEEP(x.x); KEEP(x.y); KEEP(x.z); KEEP(x.w); }
            if (l == 0) {
                const float4 sh = psh[i], sc = psc[i];
                uint2 o; o.x = pack2(x.x * (1.f + sc.x) + sh.x, x.y * (1.f + sc.y) + sh.y); o.y = pack2(x.z * (1.f + sc.z) + sh.z, x.w * (1.f + sc.w) + sh.w);
                if (!DRY) *(uint2*)(w.hb() + (size_t)row * D + col) = o; else { KEEP(o.x); KEEP(o.y); }
            }
        }
    }
}

#define XB_TMO      128
#define XB_XCNT(j)  (256  + 64 * (j))
#define XB_XSUB(j)  (1280 + 64 * (j))
#define XB_XGEN(j)  (2304 + 64 * (j))
#define XB_TOP      3328
#define XB_TOPGEN   3392
#define XB_SPIN_CAP (1u << 20)
__device__ __forceinline__ unsigned xb_ld(unsigned* p)              { return __hip_atomic_load(p, __ATOMIC_RELAXED, __HIP_MEMORY_SCOPE_AGENT); }
__device__ __forceinline__ unsigned xb_add(unsigned* p, unsigned v) { return __hip_atomic_fetch_add(p, v, __ATOMIC_RELAXED, __HIP_MEMORY_SCOPE_AGENT); }
__device__ __forceinline__ unsigned xb_xcc_id() { return (unsigned)__builtin_amdgcn_s_getreg((3 << 11) | 20) & 0xFu; }
#define XB_SPIN(cond, bar) do { unsigned _sp = 0; while (cond) { __builtin_amdgcn_s_sleep(1); \
    if ((++_sp & 255u) == 0u) { if (xb_ld(&(bar)[XB_TMO])) break; if (_sp > XB_SPIN_CAP) { atomicAdd(&(bar)[XB_TMO], 1u); break; } } } } while (0)
struct XcdBarrier { unsigned* bar; unsigned x, nloc, nx; };
__device__ __forceinline__ void xcd_barrier_post(XcdBarrier& b, unsigned* bar) {
    b.bar = bar; b.x = xb_xcc_id(); b.nloc = 0u; b.nx = 0u;
    if (threadIdx.x == 0) (void)xb_add(&bar[XB_XCNT(b.x)], 1u);
}
__device__ __forceinline__ void xcd_barrier_complete(unsigned* bar, unsigned x, unsigned& nloc, unsigned& nx) {
    const unsigned G = gridDim.x;
    unsigned sum, cnt, mine, sp = 0u;
    for (;;) {
        sum = 0u; cnt = 0u; mine = 0u;
#pragma unroll
        for (unsigned j = 0; j < 16; ++j) { const unsigned c = xb_ld(&bar[XB_XCNT(j)]); sum += c; cnt += (c > 0u) ? 1u : 0u; mine = (j == x) ? c : mine; }
        if (sum == G) break;
        __builtin_amdgcn_s_sleep(1);
        if ((++sp & 255u) == 0u) { if (xb_ld(&bar[XB_TMO])) break; if (sp > XB_SPIN_CAP) { atomicAdd(&bar[XB_TMO], 1u); break; } }
    }
    nloc = mine > 0u ? mine : 1u; nx = cnt > 0u ? cnt : 1u;
}
__device__ __forceinline__ void xcd_barrier(XcdBarrier& b) {
    asm volatile("s_waitcnt vmcnt(0)" ::: "memory");
    __syncthreads();
    if (threadIdx.x == 0) {
        unsigned* bar = b.bar;
        __builtin_amdgcn_s_waitcnt(0);
        if (b.nloc == 0u) xcd_barrier_complete(bar, b.x, b.nloc, b.nx);
        const unsigned nloc = b.nloc, nx = b.nx;
        const unsigned old = xb_add(&bar[XB_XSUB(b.x)], 1u);
        const unsigned gen = old / nloc;
        if (old + 1u == (gen + 1u) * nloc) {
            __builtin_amdgcn_fence(__ATOMIC_RELEASE, "agent");
            asm volatile("s_waitcnt vmcnt(0)" ::: "memory");
            const unsigned og = xb_add(&bar[XB_TOP], 1u);
            const unsigned tg = og / nx;
            if (og + 1u == (tg + 1u) * nx) xb_add(&bar[XB_TOPGEN], 1u);
            else XB_SPIN(xb_ld(&bar[XB_TOPGEN]) == tg, bar);
            __builtin_amdgcn_fence(__ATOMIC_ACQUIRE, "agent");
            xb_add(&bar[XB_XGEN(b.x)], 1u);
            asm volatile("s_waitcnt vmcnt(0)" ::: "memory");
        } else {
            XB_SPIN(xb_ld(&bar[XB_XGEN(b.x)]) == gen, bar);
            __builtin_amdgcn_fence(__ATOMIC_ACQUIRE, "agent");
            asm volatile("s_waitcnt vmcnt(0)" ::: "memory");
        }
    }
    __syncthreads();
}

constexpr int NPHASE = 2 + 2 * 10;
__global__ void __launch_bounds__(NTHR, 2) mega(Params p, int ph_lo, int ph_hi) {
    extern __shared__ __attribute__((aligned(16))) unsigned char lds[];
    XcdBarrier xb; xcd_barrier_post(xb, (unsigned*)(p.ws + OFF_BAR));
#if PROBE_PH >= 0
    unsigned long long pt0_ = 0, pt1_ = 0;
#define RUN(idx, ...) if (ph_lo <= (idx) && (idx) < ph_hi) { if ((idx) == PROBE_PH) pt0_ = __builtin_amdgcn_s_memrealtime(); __VA_ARGS__; if ((idx) + 1 < ph_hi || (idx) == PROBE_PH) xcd_barrier(xb); if ((idx) == PROBE_PH) pt1_ = __builtin_amdgcn_s_memrealtime(); }
#else
#define RUN(idx, ...) if (ph_lo <= (idx) && (idx) < ph_hi) { __VA_ARGS__; if ((idx) + 1 < ph_hi) xcd_barrier(xb); }
#endif
    RUN(0, phase_pro_a(p, lds))
    RUN(1, for (int r_ = 0; r_ < REP_PROBC; ++r_) phase_pro_b(p, lds))
#define LAYER(l) \
    RUN(2 + 10 * l + 0, phase_inproj(p, lds, l)) \
    RUN(2 + 10 * l + 1, phase_s1(p, lds, l)) \
    RUN(2 + 10 * l + 2, phase_s2(p, lds, l); if (l == 0) w2_toeplitz_fill(p)) \
    RUN(2 + 10 * l + 3, phase_s3(p, lds, l)) \
    RUN(2 + 10 * l + 4, phase_glu(p, lds, l)) \
    RUN(2 + 10 * l + 5, phase_outproj(p, lds, l)) \
    RUN(2 + 10 * l + 6, if (DRY_LN1) phase_ln1<true>(p, lds, l); phase_ln1<false>(p, lds, l)) \
    RUN(2 + 10 * l + 7, phase_moe_gu(p, lds, l)) \
    RUN(2 + 10 * l + 8, phase_moe_dn(p, lds, l)) \
    RUN(2 + 10 * l + 9, if (DRY_LN2) phase_ln2<true>(p, l); phase_ln2<false>(p, l))
    LAYER(0)
    LAYER(1)
#undef LAYER
#undef RUN
#if PROBE_PH >= 0
    if (blockIdx.x == 0) { const unsigned long long te_ = __builtin_amdgcn_s_memrealtime(), dd_ = (pt1_ - pt0_) * PROBE_AMP; while (__builtin_amdgcn_s_memrealtime() - te_ < dd_) __builtin_amdgcn_s_sleep(8); }
#endif
}

extern "C" void kernel_launch(void* const* d_in, const int* in_sizes, int n_in, void* d_out, int out_size, void* d_ws, size_t ws_size, hipStream_t stream) {
    static int grid_blocks = 0;
    if (grid_blocks == 0) {
        if (n_in != 34 || out_size != NLAT * D || ws_size < WS_END) {
            fprintf(stderr, "kernel_launch: unexpected shapes (n_in %d out %d ws %zu need %zu)\n", n_in, out_size, ws_size, (size_t)WS_END);
            grid_blocks = -1; return;
        }
        int dev = 0, cus = 0, per_cu = 0;
        hipGetDevice(&dev);
        hipDeviceGetAttribute(&cus, hipDeviceAttributeMultiprocessorCount, dev);
        if (hipFuncSetAttribute((const void*)mega, hipFuncAttributeMaxDynamicSharedMemorySize, LDS_BYTES) != hipSuccess) fprintf(stderr, "kernel_launch: hipFuncSetAttribute failed\n");
        hipOccupancyMaxActiveBlocksPerMultiprocessor(&per_cu, (const void*)mega, NTHR, LDS_BYTES);
        if (per_cu < 1) per_cu = 1;
        if (per_cu > 1) per_cu = 1;
        grid_blocks = cus * per_cu;
        fprintf(stderr, "kernel_launch: cus %d per_cu %d grid %d ws need %zu have %zu\n", cus, per_cu, grid_blocks, (size_t)WS_END, ws_size);
    }
    if (grid_blocks < 0) return;
    Params p{};
    for (int i = 0; i < 34; ++i) p.in[i] = (const float*)d_in[i];
    p.out = (float*)d_out; p.ws = (unsigned char*)d_ws;
    if (hipMemsetAsync((unsigned char*)d_ws + OFF_BAR, 0, SZ_BAR, stream) != hipSuccess) fprintf(stderr, "memset failed\n");
#if FUSED
    int lo = 0, hi = NPHASE;
    void* args[] = {&p, &lo, &hi};
    hipError_t e = hipLaunchCooperativeKernel((const void*)mega, dim3(grid_blocks), dim3(NTHR), args, LDS_BYTES, stream);
    if (e != hipSuccess) fprintf(stderr, "cooperative launch failed: %s (grid %d)\n", hipGetErrorString(e), grid_blocks);
#else
    for (int ph = 0; ph < NPHASE; ++ph) hipLaunchKernelGGL(mega, dim3(grid_blocks), dim3(NTHR), LDS_BYTES, stream, p, ph, ph + 1);
#endif
}
```

```cpp
#include <hip/hip_runtime.h>
#include <cstdio>
#include <cstdint>

#ifndef FUSED
#define FUSED 1
#endif

typedef unsigned short bf16_t;
typedef __attribute__((ext_vector_type(8))) short bf16x8;
typedef __attribute__((ext_vector_type(16))) float f32x16;

constexpr int D = 1024, NB = 8, SEQ = 2048, CTX = 256;
constexpr int NLAT = NB * SEQ, NCTX = NB * CTX, NROW = NLAT + NCTX;
constexpr int DIN = 1792, DS5 = 512, NG = 32, PS = 64;
constexpr int TCH = 16, NT = 256;
constexpr int NCOL = NROW / TCH;
constexpr int NCOL_LAT = NLAT / TCH;
constexpr int CH_LAT = SEQ / TCH, CH_CTX = CTX / TCH;
constexpr int NSTEP = CH_LAT + CH_CTX;
constexpr int NSEG = 8, SEGLEN = NSTEP / NSEG;
constexpr int NCLS = 24, LISTCAP = NROW;
constexpr int MAXMT = NROW / 128 + NCLS;
constexpr int KSPLIT_MOD = 32;
constexpr int NTHR = 512, NWV = 8;
constexpr float LN_EPS = 1e-5f;
constexpr float DN_ALPHA = 1.4142135623730951f;
constexpr int NPOW = 18;

constexpr size_t AL(size_t x) { return (x + 255) & ~(size_t)255; }
constexpr size_t SZ_WT_IN = (size_t)2 * DIN * D * 2;
constexpr size_t SZ_WT_GLU = (size_t)2 * 512 * 512 * 2;
constexpr size_t SZ_WT_O = (size_t)2 * D * D * 2;
constexpr size_t SZ_WT_GU = (size_t)2 * 16 * 512 * 1024 * 2;
constexpr size_t SZ_WT_DN = (size_t)2 * 16 * 1024 * 256 * 2;
constexpr size_t SZ_MOD = (size_t)2 * 9 * 6144 * 4;
constexpr size_t SZ_LAMPOW = (size_t)2 * 2 * NG * PS * NPOW * 8;
constexpr size_t SZ_BBAR = (size_t)2 * 2 * NG * PS * 16 * 8;
constexpr size_t SZ_KFULL = (size_t)2 * NG * 32 * 256 * 4;
constexpr size_t SZ_M1 = (size_t)2 * NG * 256 * 256 * 2;
constexpr size_t SZ_W2 = (size_t)2 * NG * 256 * 512 * 2;
constexpr size_t SZ_HB = (size_t)NROW * D * 2;
constexpr size_t SZ_UG = (size_t)NG * NROW * 16 * 2;
constexpr size_t SZ_ZR = (size_t)NROW * 1280 * 2;
constexpr size_t SZ_S = (size_t)NG * NCOL * 256 * 4;
constexpr size_t SZ_RB2 = (size_t)(NROW / 2) * D * 2;
constexpr size_t SZ_CNT = 256 * 4;
constexpr size_t SZ_LIST = (size_t)NCLS * LISTCAP * 4;
constexpr size_t SZ_LW = (size_t)NCLS * LISTCAP * 8;

constexpr size_t OFF_WT_IN = 0;
constexpr size_t OFF_WT_GLU = OFF_WT_IN + AL(SZ_WT_IN);
constexpr size_t OFF_WT_O = OFF_WT_GLU + AL(SZ_WT_GLU);
constexpr size_t OFF_WT_GU = OFF_WT_O + AL(SZ_WT_O);
constexpr size_t OFF_WT_DN = OFF_WT_GU + AL(SZ_WT_GU);
constexpr size_t OFF_MOD = OFF_WT_DN + AL(SZ_WT_DN);
constexpr size_t OFF_LAMPOW = OFF_MOD + AL(SZ_MOD);
constexpr size_t OFF_BBAR = OFF_LAMPOW + AL(SZ_LAMPOW);
constexpr size_t OFF_KFULL = OFF_BBAR + AL(SZ_BBAR);
constexpr size_t OFF_M1 = OFF_KFULL + AL(SZ_KFULL);
constexpr size_t OFF_W2 = OFF_M1 + AL(SZ_M1);
constexpr size_t OFF_HB = OFF_W2 + AL(SZ_W2);
constexpr size_t OFF_UG = OFF_HB + AL(SZ_HB);
constexpr size_t OFF_ZR = OFF_UG + AL(SZ_UG);
constexpr size_t OFF_S = OFF_ZR + AL(SZ_ZR);
constexpr size_t OFF_RB2 = OFF_S + AL(SZ_S);
constexpr size_t OFF_CNT = OFF_RB2 + AL(SZ_RB2);
constexpr size_t OFF_LIST = OFF_CNT + AL(SZ_CNT);
constexpr size_t OFF_LW = OFF_LIST + AL(SZ_LIST);
constexpr size_t OFF_BAR = OFF_LW + AL(SZ_LW);
constexpr size_t SZ_BAR = 3456 * 4;
constexpr size_t OFF_SINK = OFF_BAR + AL(SZ_BAR);
constexpr size_t WS_END = OFF_SINK + 8192;
static_assert((size_t)KSPLIT_MOD * 2 * 9 * 6144 * 4 <= SZ_ZR, "modp alias");
static_assert((size_t)NG * NCOL * 256 * 2 <= SZ_ZR, "hprev alias");
static_assert((size_t)NROW * 512 * 2 <= SZ_S && (size_t)MAXMT * 128 * 512 * 2 <= SZ_S, "Y/act alias");
static_assert(WS_END <= (size_t)256 * 1024 * 1024, "workspace over 256 MiB");

constexpr int STAGE_BYTES = 49152, LDS_BYTES = 163840;

struct Params {
    const float* in[34];
    float* out;
    unsigned char* ws;
};

__device__ __forceinline__ unsigned f2bf(float f) { unsigned u = __float_as_uint(f); u += 0x7fffu + ((u >> 16) & 1u); return u >> 16; }
__device__ __forceinline__ float bf2f(unsigned h) { return __uint_as_float(h << 16); }
typedef __bf16 bf16x2_t __attribute__((ext_vector_type(2)));
typedef float f32x2_t __attribute__((ext_vector_type(2)));
__device__ __forceinline__ unsigned pack2(float a, float b) {
    const f32x2_t v = {a, b};
    return __builtin_bit_cast(unsigned, __builtin_convertvector(v, bf16x2_t));
}
__device__ __forceinline__ float bflo(unsigned w) { return __uint_as_float(w << 16); }
__device__ __forceinline__ float bfhi(unsigned w) { return __uint_as_float(w & 0xffff0000u); }
__device__ __forceinline__ float wave_sum(float v) {
#pragma unroll
    for (int o = 32; o >= 1; o >>= 1) v += __shfl_xor(v, o);
    return v;
}
__device__ __forceinline__ void lds_barrier() { asm volatile("s_waitcnt lgkmcnt(0)" ::: "memory"); __builtin_amdgcn_s_barrier(); asm volatile("" ::: "memory"); }
template <int CTRL>
__device__ __forceinline__ float dpp_f(float v) { return __int_as_float(__builtin_amdgcn_update_dpp(0, __float_as_int(v), CTRL, 0xf, 0xf, true)); }
__device__ __forceinline__ float row_sum16(float v) {
    v += dpp_f<0xB1>(v);
    v += dpp_f<0x4E>(v);
    v += dpp_f<0x124>(v);
    v += dpp_f<0x128>(v);
    return v;
}
__device__ __forceinline__ float rl_f(float v, int l) { return __int_as_float(__builtin_amdgcn_readlane(__float_as_int(v), l)); }
__device__ __forceinline__ float wave_sum_fast(float v) {
    v = row_sum16(v);
    return (rl_f(v, 0) + rl_f(v, 16)) + (rl_f(v, 32) + rl_f(v, 48));
}
__device__ __forceinline__ float sigmoidf_(float x) { return __builtin_amdgcn_rcpf(1.0f + __expf(-x)); }
__device__ __forceinline__ float siluf_(float x) { return x * __builtin_amdgcn_rcpf(1.0f + __expf(-x)); }
__device__ __forceinline__ float gelu_tanh(float x) {
    const float u = x * (-2.3022082f + -0.10294324f * x * x);
    return x * __builtin_amdgcn_rcpf(1.0f + __builtin_amdgcn_exp2f(u));
}
__device__ __forceinline__ int modrow(int row) { return row < NLAT ? (row >> 11) : 8; }

struct SrcA { const bf16_t* p0[4]; const bf16_t* p1[4]; int split; };
struct SrcB { const bf16_t* p0[2]; const bf16_t* p1[2]; int split; };
#define LDS_AS __attribute__((address_space(3)))

#define SCHED_FENCE __builtin_amdgcn_sched_barrier(0)
template <int MF, class EPI, class GET>
__device__ __forceinline__ void gemm_stream(unsigned char* lds, const int K, const GET& get) {
    const int tid = threadIdx.x, lane = tid & 63, wid = __builtin_amdgcn_readfirstlane(tid >> 6), wm = wid >> 1, wn = wid & 1;
    const int l31 = lane & 31, hh = lane >> 5, sw = (l31 >> 1) & 7;
    const int xbase = (wm * 32 * MF + l31) * 128, wbase = 32768 + (wn * 64 + l31) * 128;
    LDS_AS unsigned char* ldsw = (LDS_AS unsigned char*)lds + wid * 1024;
    const int nk = K >> 6;
    SrcA Ac, An; SrcB Bc, Bn; EPI ec, en;
    bool have = get(0, Ac, Bc, ec);
    if (!have) return;
#define S_PIECE_A(S_, k_, bufo_, j_) __builtin_amdgcn_global_load_lds((const unsigned*)((k_) < S_.split ? S_.p0[j_] + (k_) : S_.p1[j_] + ((k_) - S_.split)), (LDS_AS unsigned*)(ldsw + (bufo_) + (j_) * 8192), 16, 0, 0)
#define S_PIECE_B(S_, k_, bufo_, j_) __builtin_amdgcn_global_load_lds((const unsigned*)((k_) < S_.split ? S_.p0[j_] + (k_) : S_.p1[j_] + ((k_) - S_.split)), (LDS_AS unsigned*)(ldsw + (bufo_) + 32768 + (j_) * 8192), 16, 0, 0)
#define LDFRAG(ks_, W0_, W1_, X_) do { const int co_ = (((ks_) * 2 + hh) ^ sw) << 4; \
        W0_ = *(const bf16x8*)(lds + cur + wbase + co_); W1_ = *(const bf16x8*)(lds + cur + wbase + 4096 + co_); \
        _Pragma("unroll") for (int mt = 0; mt < MF; ++mt) X_[mt] = *(const bf16x8*)(lds + cur + xbase + mt * 4096 + co_); } while (0)
#define DOMFMA(W0_, W1_, X_) do { _Pragma("unroll") for (int mt = 0; mt < MF; ++mt) { \
        acc[mt][0] = __builtin_amdgcn_mfma_f32_32x32x16_bf16(W0_, X_[mt], acc[mt][0], 0, 0, 0); \
        acc[mt][1] = __builtin_amdgcn_mfma_f32_32x32x16_bf16(W1_, X_[mt], acc[mt][1], 0, 0, 0); } } while (0)
    asm volatile("s_waitcnt vmcnt(0)" ::: "memory");
    __builtin_amdgcn_s_barrier();
    asm volatile("" ::: "memory");
#pragma unroll
    for (int j = 0; j < 2 * MF; ++j) S_PIECE_A(Ac, 0, 0, j);
#pragma unroll
    for (int j = 0; j < 2; ++j) S_PIECE_B(Bc, 0, 0, j);
#pragma unroll
    for (int j = 0; j < 2 * MF; ++j) S_PIECE_A(Ac, 64, STAGE_BYTES, j);
#pragma unroll
    for (int j = 0; j < 2; ++j) S_PIECE_B(Bc, 64, STAGE_BYTES, j);
    int cur = 0, nxt = 2 * STAGE_BYTES;
    for (int ui = 0; have; ++ui) {
        const bool haveN = get(ui + 1, An, Bn, en);
        f32x16 acc[MF][2];
#pragma unroll
        for (int i = 0; i < MF; ++i)
#pragma unroll
            for (int j = 0; j < 2; ++j)
#pragma unroll
                for (int e = 0; e < 16; ++e) acc[i][j][e] = 0.f;
        for (int kt = 0; kt < nk; ++kt) {
            if (kt + 1 < nk || haveN) { if (MF == 2) asm volatile("s_waitcnt vmcnt(6)" ::: "memory"); else asm volatile("s_waitcnt vmcnt(4)" ::: "memory"); }
            else asm volatile("s_waitcnt vmcnt(0)" ::: "memory");
            __builtin_amdgcn_s_barrier();
            asm volatile("" ::: "memory");
            const bool fromN = kt + 2 >= nk;
            const bool st = !fromN || haveN;
            const int kn = (fromN ? kt + 2 - nk : kt + 2) * 64;
            SrcA As; SrcB Bs;
#pragma unroll
            for (int j = 0; j < 2 * MF; ++j) { As.p0[j] = fromN ? An.p0[j] : Ac.p0[j]; As.p1[j] = fromN ? An.p1[j] : Ac.p1[j]; }
#pragma unroll
            for (int j = 0; j < 2; ++j) { Bs.p0[j] = fromN ? Bn.p0[j] : Bc.p0[j]; Bs.p1[j] = fromN ? Bn.p1[j] : Bc.p1[j]; }
            As.split = fromN ? An.split : Ac.split; Bs.split = fromN ? Bn.split : Bc.split;
            bf16x8 wa0, wa1, xa[MF], wb0, wb1, xb[MF];
            LDFRAG(0, wa0, wa1, xa);
            LDFRAG(1, wb0, wb1, xb);
            SCHED_FENCE;
            DOMFMA(wa0, wa1, xa);
            if (st) { if (MF == 2) { S_PIECE_A(As, kn, nxt, 0); S_PIECE_A(As, kn, nxt, 1); } else { S_PIECE_A(As, kn, nxt, 0); } }
            SCHED_FENCE;
            LDFRAG(2, wa0, wa1, xa);
            SCHED_FENCE;
            DOMFMA(wb0, wb1, xb);
            if (st) { if (MF == 2) { S_PIECE_A(As, kn, nxt, 2); S_PIECE_A(As, kn, nxt, 3); } else { S_PIECE_A(As, kn, nxt, 1); } }
            SCHED_FENCE;
            LDFRAG(3, wb0, wb1, xb);
            SCHED_FENCE;
            DOMFMA(wa0, wa1, xa);
            if (st) { S_PIECE_B(Bs, kn, nxt, 0); if (MF == 2) S_PIECE_B(Bs, kn, nxt, 1); }
            SCHED_FENCE;
            DOMFMA(wb0, wb1, xb);
            if (st) { if (MF == 1) S_PIECE_B(Bs, kn, nxt, 1); }
            SCHED_FENCE;
            cur = (cur == 2 * STAGE_BYTES) ? 0 : cur + STAGE_BYTES;
            nxt = (nxt == 2 * STAGE_BYTES) ? 0 : nxt + STAGE_BYTES;
        }
        ec(acc, wm * 32 * MF + l31, wn * 64 + hh * 4);
        have = haveN;
        if (haveN) {
#pragma unroll
            for (int j = 0; j < 2 * MF; ++j) { Ac.p0[j] = An.p0[j]; Ac.p1[j] = An.p1[j]; }
#pragma unroll
            for (int j = 0; j < 2; ++j) { Bc.p0[j] = Bn.p0[j]; Bc.p1[j] = Bn.p1[j]; }
            Ac.split = An.split; Bc.split = Bn.split; ec = en;
        }
    }
#undef S_PIECE_A
#undef S_PIECE_B
#undef LDFRAG
#undef DOMFMA
}

template <int NJ, class S>
__device__ __forceinline__ void src_plain(S& s, const bf16_t* base, int row0, int ld) {
    const int lr = threadIdx.x >> 3, lc = (threadIdx.x & 7) ^ ((lr >> 1) & 7);
#pragma unroll
    for (int j = 0; j < NJ; ++j) { s.p0[j] = base + (size_t)(row0 + lr + 64 * j) * ld + lc * 8; s.p1[j] = s.p0[j]; }
    s.split = 1 << 30;
}
template <int NJ, class S>
__device__ __forceinline__ void src_split(S& s, const bf16_t* base0, int ld0, const bf16_t* base1, int ld1, int row0, int split) {
    const int lr = threadIdx.x >> 3, lc = (threadIdx.x & 7) ^ ((lr >> 1) & 7);
#pragma unroll
    for (int j = 0; j < NJ; ++j) { s.p0[j] = base0 + (size_t)(row0 + lr + 64 * j) * ld0 + lc * 8; s.p1[j] = base1 + (size_t)(row0 + lr + 64 * j) * ld1 + lc * 8; }
    s.split = split;
}
struct XcdIter { int nx, xcd, local, nloc; };
__device__ __forceinline__ XcdIter xcd_iter() {
    XcdIter it; it.nx = (gridDim.x & 7) == 0 ? 8 : 1; it.xcd = blockIdx.x % it.nx; it.local = blockIdx.x / it.nx; it.nloc = gridDim.x / it.nx; return it;
}

#define ACC_FOREACH(MF_, acc, r0, c0, ...) \
    _Pragma("unroll") for (int mt_ = 0; mt_ < MF_; ++mt_) \
    _Pragma("unroll") for (int nt_ = 0; nt_ < 2; ++nt_) \
    _Pragma("unroll") for (int q_ = 0; q_ < 4; ++q_) { \
        const int rl = (r0) + mt_ * 32, cl = (c0) + nt_ * 32 + q_ * 8; \
        const float v0 = acc[mt_][nt_][q_ * 4 + 0], v1 = acc[mt_][nt_][q_ * 4 + 1], v2 = acc[mt_][nt_][q_ * 4 + 2], v3 = acc[mt_][nt_][q_ * 4 + 3]; \
        __VA_ARGS__ }

template <int MF, class PACK, class ADDR>
__device__ __forceinline__ void epi_store16(const f32x16 (&acc)[MF][2], int r0, int c0, const PACK& pack, const ADDR& addr) {
    const int up = (c0 >> 2) & 1, cw = c0 & ~4;
    const bool odd = (r0 & 1) != 0;
#pragma unroll
    for (int mt = 0; mt < MF; ++mt)
#pragma unroll
        for (int nt = 0; nt < 2; ++nt) {
            const int rl = r0 + mt * 32;
            unsigned u[2][4];
#pragma unroll
            for (int qp = 0; qp < 2; ++qp) {
                const int ca = c0 + nt * 32 + qp * 16;
                uint2 a = pack(rl, ca, acc[mt][nt][qp * 8 + 0], acc[mt][nt][qp * 8 + 1], acc[mt][nt][qp * 8 + 2], acc[mt][nt][qp * 8 + 3]);
                uint2 b = pack(rl, ca + 8, acc[mt][nt][qp * 8 + 4], acc[mt][nt][qp * 8 + 5], acc[mt][nt][qp * 8 + 6], acc[mt][nt][qp * 8 + 7]);
                const auto sx = __builtin_amdgcn_permlane32_swap(a.x, b.x, false, false); a.x = sx[0]; b.x = sx[1];
                const auto sy = __builtin_amdgcn_permlane32_swap(a.y, b.y, false, false); a.y = sy[0]; b.y = sy[1];
                u[qp][0] = a.x; u[qp][1] = a.y; u[qp][2] = b.x; u[qp][3] = b.y;
            }
            unsigned e0[4], e1[4];
#pragma unroll
            for (int i = 0; i < 4; ++i) {
                const unsigned snd = odd ? u[0][i] : u[1][i];
                const unsigned rcv = (unsigned)__builtin_amdgcn_update_dpp(0, (int)snd, 0xB1, 0xf, 0xf, true);
                e0[i] = odd ? rcv : u[0][i];
                e1[i] = odd ? u[1][i] : rcv;
            }
            const int cc = cw + nt * 32 + (odd ? 16 : 0) + up * 8;
            *(uint4*)addr(rl & ~1, cc) = make_uint4(e0[0], e0[1], e0[2], e0[3]);
            *(uint4*)addr(rl | 1, cc) = make_uint4(e1[0], e1[1], e1[2], e1[3]);
        }
}

struct WS {
    unsigned char* b;
    __device__ bf16_t* wt_in(int l) const { return (bf16_t*)(b + OFF_WT_IN) + (size_t)l * DIN * D; }
    __device__ bf16_t* wt_glu(int l) const { return (bf16_t*)(b + OFF_WT_GLU) + (size_t)l * 512 * 512; }
    __device__ bf16_t* wt_o(int l) const { return (bf16_t*)(b + OFF_WT_O) + (size_t)l * D * D; }
    __device__ bf16_t* wt_gu(int l, int e) const { return (bf16_t*)(b + OFF_WT_GU) + (size_t)(l * 16 + e) * 512 * 1024; }
    __device__ bf16_t* wt_dn(int l, int e) const { return (bf16_t*)(b + OFF_WT_DN) + (size_t)(l * 16 + e) * 1024 * 256; }
    __device__ float* mod(int l) const { return (float*)(b + OFF_MOD) + (size_t)l * 9 * 6144; }
    __device__ float* modp() const { return (float*)(b + OFF_ZR); }
    __device__ float2* lampow(int l, int d, int g) const { return (float2*)(b + OFF_LAMPOW) + (size_t)((l * 2 + d) * NG + g) * PS * NPOW; }
    __device__ float2* bbar(int l, int d, int g) const { return (float2*)(b + OFF_BBAR) + (size_t)((l * 2 + d) * NG + g) * PS * 16; }
    __device__ float* kfull(int l, int g) const { return (float*)(b + OFF_KFULL) + (size_t)(l * NG + g) * 32 * 256; }
    __device__ bf16_t* m1(int l, int g) const { return (bf16_t*)(b + OFF_M1) + (size_t)(l * NG + g) * 256 * 256; }
    __device__ bf16_t* w2(int l, int g) const { return (bf16_t*)(b + OFF_W2) + (size_t)(l * NG + g) * 256 * 512; }
    __device__ bf16_t* hb() const { return (bf16_t*)(b + OFF_HB); }
    __device__ bf16_t* ug() const { return (bf16_t*)(b + OFF_UG); }
    __device__ bf16_t* zr() const { return (bf16_t*)(b + OFF_ZR); }
    __device__ bf16_t* hprev() const { return (bf16_t*)(b + OFF_S + (size_t)NROW * 512 * 2); }
    __device__ float* S() const { return (float*)(b + OFF_S); }
    __device__ bf16_t* Y() const { return (bf16_t*)(b + OFF_S); }
    __device__ bf16_t* act() const { return (bf16_t*)(b + OFF_S); }
    __device__ int* cnt(int l) const { return (int*)(b + OFF_CNT) + l * 32; }
    __device__ int* list() const { return (int*)(b + OFF_LIST); }
    __device__ float2* lw() const { return (float2*)(b + OFF_LW); }
};
__device__ __forceinline__ bf16_t* RBrow(const Params& p, int row) {
    return row < NROW / 2 ? (bf16_t*)(p.ws + OFF_UG) + (size_t)row * D : (bf16_t*)(p.ws + OFF_RB2) + (size_t)(row - NROW / 2) * D;
}
__device__ __forceinline__ bf16_t* X1row(const Params& p, int row) { return (bf16_t*)p.out + (size_t)row * D; }
__device__ __forceinline__ float4 bf4(uint2 u) { return make_float4(bflo(u.x), bfhi(u.x), bflo(u.y), bfhi(u.y)); }

__device__ __forceinline__ void transpose_tile(unsigned char* lds, const float* src, int ldsrc, int k0, int n0, bf16_t* dst, int lddst, int rowmode) {
    float* tile = (float*)lds;
    const int tid = threadIdx.x;
    __syncthreads();
#pragma unroll
    for (int pass = 0; pass < 2; ++pass) {
        const int k = pass * 32 + (tid >> 4), n4 = (tid & 15) * 4;
        const float4 v = *(const float4*)(src + (size_t)(k0 + k) * ldsrc + n0 + n4);
        tile[k * 65 + n4 + 0] = v.x; tile[k * 65 + n4 + 1] = v.y; tile[k * 65 + n4 + 2] = v.z; tile[k * 65 + n4 + 3] = v.w;
    }
    __syncthreads();
    {
        const int n = tid & 63, kc = tid >> 6;
        float f[8];
#pragma unroll
        for (int i = 0; i < 8; ++i) f[i] = tile[(kc * 8 + i) * 65 + n];
        const int ng = n0 + n;
        int drow = ng;
        if (rowmode == 1) drow = ((ng >> 3) << 4) + (ng & 7);
        else if (rowmode == 2) drow = ((ng >> 3) << 4) + 8 + (ng & 7);
        uint4 o; o.x = pack2(f[0], f[1]); o.y = pack2(f[2], f[3]); o.z = pack2(f[4], f[5]); o.w = pack2(f[6], f[7]);
        *(uint4*)(dst + (size_t)drow * lddst + k0 + kc * 8) = o;
    }
}

struct WTile { const float* src; bf16_t* dst; int ldsrc, lddst, k0, n0, rowmode; };
__device__ __forceinline__ WTile wtile_decode(const Params& p, int l, int t) {
    const WS w{p.ws};
    WTile r;
    if (t < 224) { const int kt = t / 14, nt = t % 14; r = WTile{p.in[6] + (size_t)l * D * DIN, w.wt_in(l), DIN, D, kt * 64, nt * 128, 0}; }
    else if (t < 256) { t -= 224; const int kt = t / 4, nt = t % 4; r = WTile{p.in[15] + (size_t)l * 512 * 512, w.wt_glu(l), 512, 512, kt * 64, nt * 128, 0}; }
    else if (t < 384) { t -= 256; const int kt = t / 8, nt = t % 8; r = WTile{p.in[22] + (size_t)l * D * D, w.wt_o(l), D, D, kt * 64, nt * 128, 0}; }
    else if (t < 896) { t -= 384; const int e = t / 32, q = t % 32, kt = q / 2, nt = q % 2; r = WTile{p.in[29] + (size_t)(l * 16 + e) * D * 256, w.wt_gu(l, e), 256, D, kt * 64, nt * 128, 1}; }
    else if (t < 1408) { t -= 896; const int e = t / 32, q = t % 32, kt = q / 2, nt = q % 2; r = WTile{p.in[30] + (size_t)(l * 16 + e) * D * 256, w.wt_gu(l, e), 256, D, kt * 64, nt * 128, 2}; }
    else { t -= 1408; const int e = t / 32, q = t % 32, kt = q / 8, nt = q % 8; r = WTile{p.in[31] + (size_t)(l * 16 + e) * 256 * D, w.wt_dn(l, e), D, 256, kt * 64, nt * 128, 0}; }
    return r;
}
template <class IDX>
__device__ __forceinline__ void transpose_stream(const Params& p, unsigned char* lds, int count, const IDX& idx) {
    const int tid = threadIdx.x;
    auto dec = [&](int j) -> WTile { const int i = idx(j); return wtile_decode(p, i / 1920, i % 1920); };
    if (count <= 0) return;
    lds_barrier();
    const int lk = tid >> 5, ln4 = (tid & 31) * 4;
    const int sn = tid & 127, skc = tid >> 7;
    WTile cur = dec(0);
    float4 v[4];
#pragma unroll
    for (int q = 0; q < 4; ++q) v[q] = *(const float4*)(cur.src + (size_t)(cur.k0 + lk + 16 * q) * cur.ldsrc + cur.n0 + ln4);
    for (int j = 0; j < count; ++j) {
        float* tile = (float*)lds + (j & 1) * (64 * 129);
        WTile nx = cur; float4 wv[4];
#pragma unroll
        for (int q = 0; q < 4; ++q) wv[q] = v[q];
        if (j + 1 < count) {
            nx = dec(j + 1);
#pragma unroll
            for (int q = 0; q < 4; ++q) wv[q] = *(const float4*)(nx.src + (size_t)(nx.k0 + lk + 16 * q) * nx.ldsrc + nx.n0 + ln4);
        }
#pragma unroll
        for (int q = 0; q < 4; ++q) {
            float* tr = tile + (lk + 16 * q) * 129 + ln4;
            tr[0] = v[q].x; tr[1] = v[q].y; tr[2] = v[q].z; tr[3] = v[q].w;
        }
        lds_barrier();
        const int ng = cur.n0 + sn;
        int drow = ng;
        if (cur.rowmode == 1) drow = ((ng >> 3) << 4) + (ng & 7);
        else if (cur.rowmode == 2) drow = ((ng >> 3) << 4) + 8 + (ng & 7);
#pragma unroll
        for (int u = 0; u < 2; ++u) {
            const int kc = skc + 4 * u;
            float f[8];
#pragma unroll
            for (int i = 0; i < 8; ++i) f[i] = tile[(kc * 8 + i) * 129 + sn];
            uint4 o; o.x = pack2(f[0], f[1]); o.y = pack2(f[2], f[3]); o.z = pack2(f[4], f[5]); o.w = pack2(f[6], f[7]);
            *(uint4*)(cur.dst + (size_t)drow * cur.lddst + cur.k0 + kc * 8) = o;
        }
        cur = nx;
#pragma unroll
        for (int q = 0; q < 4; ++q) v[q] = wv[q];
    }
    lds_barrier();
}
constexpr int N_WTILES = 3840, N_PRO_L0 = 384, N_PRO = N_PRO_L0, N_OUT0_A = 528, N_OUT0 = N_OUT0_A + 384;
__device__ __forceinline__ bool defer_ok() { return gridDim.x == 256; }
__device__ __forceinline__ void deferred_tiles(const Params& p, unsigned char* lds, const XcdIter& xi, int first_idle, int base, int per) {
    if (!defer_ok() || xi.local < first_idle) return;
    const int nb = (xi.nloc - first_idle) * xi.nx, j0 = (xi.local - first_idle) * xi.nx + xi.xcd;
    transpose_stream(p, lds, per, [=](int j) { return base + j0 + j * nb; });
}
__device__ __forceinline__ void phase_pro_a(const Params& p, unsigned char* lds) {
    const WS w{p.ws};
    const int tid = threadIdx.x;
    if (blockIdx.x == 0 && tid < 64) ((int*)(p.ws + OFF_CNT))[tid] = 0;
    constexpr int N_MOD = 2 * 96, N_TAB = (2 * 2 * NG * PS) / NTHR, N_WT = 768;
    for (int it = blockIdx.x; it < N_MOD + N_TAB; it += gridDim.x) {
        if (it < N_MOD) {
            const int l = it / 96, cg = it % 96;
            float* sc = (float*)lds;
            float* red = sc + 9 * 1024;
            __syncthreads();
            {
                float cv[18];
#pragma unroll
                for (int j = 0; j < 18; ++j) { const int i = tid + j * NTHR, r = i >> 10, k = i & 1023; cv[j] = r < 8 ? p.in[1][r * D + k] : p.in[3][k]; }
#pragma unroll
                for (int j = 0; j < 18; ++j) sc[tid + j * NTHR] = siluf_(cv[j]);
            }
            __syncthreads();
            const int kr = tid >> 4, c4 = (tid & 15) * 4;
            float acc[9][4];
#pragma unroll
            for (int r = 0; r < 9; ++r) { acc[r][0] = acc[r][1] = acc[r][2] = acc[r][3] = 0.f; }
            const float* wm = p.in[4] + ((size_t)l * D + kr) * 6144 + cg * 64 + c4;
            float4 vv[32];
#pragma unroll
            for (int kk = 0; kk < 32; ++kk) vv[kk] = *(const float4*)(wm + (size_t)kk * 32 * 6144);
#pragma unroll
            for (int kk = 0; kk < 32; ++kk) {
                const float4 v = vv[kk];
                const int k = kr + 32 * kk;
#pragma unroll
                for (int r = 0; r < 9; ++r) { const float sv = sc[r * 1024 + k]; acc[r][0] += sv * v.x; acc[r][1] += sv * v.y; acc[r][2] += sv * v.z; acc[r][3] += sv * v.w; }
            }
#pragma unroll
            for (int r = 0; r < 9; ++r) *(float4*)(red + kr * 576 + r * 64 + c4) = make_float4(acc[r][0], acc[r][1], acc[r][2], acc[r][3]);
            __syncthreads();
            for (int o = tid; o < 576; o += NTHR) {
                const int r = o >> 6, c = o & 63;
                float sacc = p.in[5][l * 6144 + cg * 64 + c];
#pragma unroll
                for (int j = 0; j < 32; ++j) sacc += red[j * 576 + o];
                w.mod(l)[(size_t)r * 6144 + cg * 64 + c] = sacc;
            }
        } else if (it < N_MOD + N_TAB) {
            const int q = (it - N_MOD) * NTHR + tid;
            const int pp = q & 63, g = (q >> 6) & 31, d = (q >> 11) & 1, l = q >> 12;
            const int i3 = (l * 2 + d) * NG + g;
            const double dt = exp((double)p.in[9][i3]);
            const double are = (double)p.in[7][i3 * PS + pp], aim = (double)p.in[8][i3 * PS + pp];
            const double mag = exp(are * dt);
            double sn, cs; sincos(aim * dt, &sn, &cs);
            const double lbr = mag * cs, lbi = mag * sn;
            float2* lp = w.lampow(l, d, g) + pp * NPOW;
            double pr = 1.0, pi = 0.0;
            for (int k = 0; k <= 16; ++k) {
                lp[k] = make_float2((float)pr, (float)pi);
                const double nr_ = pr * lbr - pi * lbi, ni_ = pr * lbi + pi * lbr; pr = nr_; pi = ni_;
            }
            double s16r, s16i;
            { double xr = 1.0, xi = 0.0; for (int k = 0; k < 16; ++k) { const double nr_ = xr * lbr - xi * lbi, ni_ = xr * lbi + xi * lbr; xr = nr_; xi = ni_; } s16r = xr; s16i = xi; }
            double xr = s16r, xi = s16i, a32r = 0, a32i = 0;
            for (int sq = 0; sq < 4; ++sq) { const double nr_ = xr * xr - xi * xi, ni_ = 2.0 * xr * xi; xr = nr_; xi = ni_; if (sq == 0) { a32r = xr; a32i = xi; } }
            static_assert(TCH * SEGLEN == 288, "scan segment power");
            lp[17] = make_float2((float)(xr * a32r - xi * a32i), (float)(xr * a32i + xi * a32r));
            const double nr = lbr - 1.0, ni = lbi, den = are * are + aim * aim;
            const double cr = (nr * are + ni * aim) / den, ci = (ni * are - nr * aim) / den;
            float2* bb = w.bbar(l, d, g) + pp * 16;
            for (int n = 0; n < 16; ++n) {
                const double br = (double)p.in[10][(size_t)(i3 * PS + pp) * 16 + n], bi = (double)p.in[11][(size_t)(i3 * PS + pp) * 16 + n];
                bb[n] = make_float2((float)(cr * br - ci * bi), (float)(cr * bi + ci * br));
            }
        }
    }
    {
        const int b = blockIdx.x, g = gridDim.x, nt = defer_ok() ? N_PRO : N_WTILES;
        constexpr int PRO_EXTRA = 8;
        const int nfree = g > N_MOD + N_TAB ? g - (N_MOD + N_TAB) : 0, nex = (nfree * PRO_EXTRA <= nt) ? nfree * PRO_EXTRA : 0, ncom = nt - nex;
        const int c0 = (ncom - b + g - 1) / g, fb = b - (N_MOD + N_TAB), c1 = (nex > 0 && fb >= 0) ? PRO_EXTRA : 0;
        transpose_stream(p, lds, c0 + c1, [=](int j) {
            const int i = j < c0 ? b + j * g : ncom + fb + (j - c0) * nfree;
            return (nt == N_WTILES || i < N_PRO_L0) ? i : 1920 + (i - N_PRO_L0); });
    }
}

#define HB_COMMON_16 11
__device__ __forceinline__ void phase_pro_b(const Params& p, unsigned char* lds) {
    const WS w{p.ws};
    const int tid = threadIdx.x;
    const int gt = blockIdx.x * NTHR + tid, gs = gridDim.x * NTHR;
    constexpr int NKF = 2 * NG * 2;
    auto do_items = [&]() {
    for (int it = blockIdx.x; it < 2 * NKF; it += gridDim.x) {
        const int h = it & 1, d = (it >> 1) & 1, g = (it >> 2) & 31, l = it >> 7;
        float2* Lp = (float2*)lds;
        float2* Bb = Lp + 64 * NPOW;
        float2* Cc = Bb + 64 * 16;
        float* red = (float*)(Cc + 1024);
        __syncthreads();
        const float2* lp = w.lampow(l, d, g); const float2* bb = w.bbar(l, d, g);
        const float* cre = p.in[12] + (size_t)((l * 2 + d) * NG + g) * 16 * PS; const float* cim = p.in[13] + (size_t)((l * 2 + d) * NG + g) * 16 * PS;
        for (int i = tid; i < 64 * NPOW; i += NTHR) Lp[i] = lp[i];
        for (int i = tid; i < 1024; i += NTHR) {
            Bb[i] = bb[i];
            Cc[i] = make_float2(cre[i], cim[i]);
        }
        __syncthreads();
        {
            const int no = (tid >> 4) & 15, ni = tid & 15, ph = tid >> 8;
            float acc[8];
#pragma unroll
            for (int t = 0; t < 8; ++t) acc[t] = 0.f;
#pragma unroll 4
            for (int pq = 0; pq < PS / 2; ++pq) {
                const int pp = ph * (PS / 2) + pq;
                const float2 c = Cc[no * 64 + pp], b = Bb[pp * 16 + ni];
                const float cr = c.x * b.x - c.y * b.y, ci = c.x * b.y + c.y * b.x;
#pragma unroll
                for (int t = 0; t < 8; ++t) { const float2 L = Lp[pp * NPOW + h * 8 + t]; acc[t] += cr * L.x - ci * L.y; }
            }
            if (ph == 1) {
#pragma unroll
                for (int t = 0; t < 8; ++t) red[t * 256 + (tid & 255)] = acc[t];
            }
            __syncthreads();
            if (ph == 0) {
#pragma unroll
                for (int t = 0; t < 8; ++t) acc[t] += red[t * 256 + tid];
                if (d == 0 && h == 0) acc[0] += (no == ni) ? p.in[14][l * DS5 + g * 16 + no] : 0.f;
                float* kf = w.kfull(l, g);
#pragma unroll
                for (int t = 0; t < 8; ++t) {
                    const int tau = h * 8 + t;
                    const int ti = d == 0 ? 15 + tau : (tau == 0 ? 31 : 15 - tau);
                    kf[(ti * 16 + no) * 16 + ni] = acc[t];
                }
            }
        }
        if (h == 0) {
#pragma unroll 2
        for (int i = tid; i < 128 * 32; i += NTHR) {
            const int c8 = i & 31, rl = i >> 5, pp = rl >> 1, c = rl & 1, j = c8 >> 1, n0 = (c8 & 1) * 8;
            const int e = d == 0 ? (TCH - 1 - j) : j;
            const float2 L = Lp[pp * NPOW + e];
            float f[8];
#pragma unroll
            for (int n = 0; n < 8; ++n) { const float2 Bv = Bb[pp * 16 + n0 + n]; f[n] = c == 0 ? (L.x * Bv.x - L.y * Bv.y) : (L.x * Bv.y + L.y * Bv.x); }
            uint4 o; o.x = pack2(f[0], f[1]); o.y = pack2(f[2], f[3]); o.z = pack2(f[4], f[5]); o.w = pack2(f[6], f[7]);
            *(uint4*)(w.m1(l, g) + (size_t)(d * 128 + rl) * 256 + c8 * 8) = o;
        }
        } else {
#pragma unroll 2
        for (int i = tid; i < 256 * 16; i += NTHR) {
            const int cc = i & 15, r = i >> 4, jo = r >> 4, no = r & 15, p0 = cc * 4;
            const int e = d == 0 ? (jo + 1) : (TCH - jo);
            float f[8];
#pragma unroll
            for (int qq = 0; qq < 4; ++qq) {
                const int pp = p0 + qq;
                const float2 L = Lp[pp * NPOW + e], c = Cc[no * 64 + pp];
                f[2 * qq] = c.x * L.x - c.y * L.y;
                f[2 * qq + 1] = -(c.x * L.y + c.y * L.x);
            }
            uint4 o; o.x = pack2(f[0], f[1]); o.y = pack2(f[2], f[3]); o.z = pack2(f[4], f[5]); o.w = pack2(f[6], f[7]);
            *(uint4*)(w.w2(l, g) + (size_t)r * 512 + 256 + d * 128 + cc * 8) = o;
        }
        }
    }
    };
    auto do_hb = [&]() {
        const float* md = w.mod(0);
        constexpr int NP = NROW * 128;
        const int nfree = (int)gridDim.x - 2 * NKF;
        const int npc = nfree > 0 ? (int)(((long long)NP * HB_COMMON_16 / 16) & ~1023) : NP;
#pragma unroll 1
        for (int pass = 0; pass < 2; ++pass) {
        if (pass == 1 && ((int)blockIdx.x < 2 * NKF || npc == NP)) break;
        const int lo = pass == 0 ? 0 : npc, hi = pass == 0 ? npc : NP;
        const int gt_ = pass == 0 ? gt : ((int)blockIdx.x - 2 * NKF) * NTHR + tid, gs_ = pass == 0 ? gs : nfree * NTHR;
        for (int i0 = lo + gt_; i0 < hi; i0 += 4 * gs_) {
            float4 a[4], b[4];
#pragma unroll
            for (int u = 0; u < 4; ++u) {
                const int i = i0 + u * gs_;
                if (i < hi) {
                    const int row = i >> 7, c8 = (i & 127) * 8;
                    const float* xs = row < NLAT ? p.in[0] + (size_t)row * D : p.in[2] + (size_t)(row - NLAT) * D;
                    a[u] = *(const float4*)(xs + c8); b[u] = *(const float4*)(xs + c8 + 4);
                }
            }
#pragma unroll
            for (int u = 0; u < 4; ++u) {
                const int i = i0 + u * gs_;
                if (i < hi) {
                    const int row = i >> 7, c8 = (i & 127) * 8, m = modrow(row);
                    const float* sh = md + (size_t)m * 6144 + c8; const float* sc = sh + 1024;
                    const float4 s0 = *(const float4*)sh, s1 = *(const float4*)(sh + 4), c0 = *(const float4*)sc, c1 = *(const float4*)(sc + 4);
                    uint4 o;
                    o.x = pack2(a[u].x * (1.f + c0.x) + s0.x, a[u].y * (1.f + c0.y) + s0.y);
                    o.y = pack2(a[u].z * (1.f + c0.z) + s0.z, a[u].w * (1.f + c0.w) + s0.w);
                    o.z = pack2(b[u].x * (1.f + c1.x) + s1.x, b[u].y * (1.f + c1.y) + s1.y);
                    o.w = pack2(b[u].z * (1.f + c1.z) + s1.z, b[u].w * (1.f + c1.w) + s1.w);
                    *(uint4*)(w.hb() + (size_t)row * D + c8) = o;
                }
            }
        }
        }
    };
    const bool hb_first = (blockIdx.x & 1) != 0;
#pragma unroll 1
    for (int step = 0; step < 2; ++step) { if ((step == 0) == hb_first) do_hb(); else do_items(); }
}

__device__ __forceinline__ void w2_toeplitz_fill(const Params& p, int l_lo, int l_hi, int gt, int gs) {
    const WS w{p.ws};
    for (int i = l_lo * (NG * 256 * 32) + gt; i < l_hi * (NG * 256 * 32); i += gs) {
        const int c8 = i & 31, r = (i >> 5) & 255, lg = i >> 13, g = lg & 31, l = lg >> 5;
        const int jo = r >> 4, no = r & 15, ji = c8 >> 1, n0 = (c8 & 1) * 8;
        const float* kf = w.kfull(l, g) + ((size_t)(jo - ji + 15) * 16 + no) * 16 + n0;
        float f[8];
#pragma unroll
        for (int n = 0; n < 8; ++n) f[n] = kf[n];
        if (jo == ji) {
            const float* k2 = w.kfull(l, g) + ((size_t)31 * 16 + no) * 16 + n0;
#pragma unroll
            for (int n = 0; n < 8; ++n) f[n] += k2[n];
        }
        uint4 o; o.x = pack2(f[0], f[1]); o.y = pack2(f[2], f[3]); o.z = pack2(f[4], f[5]); o.w = pack2(f[6], f[7]);
        *(uint4*)(w.w2(l, g) + (size_t)r * 512 + c8 * 8) = o;
    }
}

namespace pg8 {
#define PG8_LAS __attribute__((address_space(3)))
typedef unsigned short bf16_t;
typedef short bf16x8 __attribute__((ext_vector_type(8)));
typedef float f32x4 __attribute__((ext_vector_type(4)));
typedef unsigned u32x4 __attribute__((ext_vector_type(4)));
constexpr int BM = 256, BK = 64, HALF = 128, HTB = HALF * BK * 2  , STAGE_BYTES = 8 * HTB, NXCD = 8, WGM = 8;

__host__ __device__ __forceinline__ int lds_byte(int r, int c) { const int st = (r >> 4) * 2 + (c >> 5), rr = r & 15, cc = c & 31, ob = rr * 64 + cc * 2; return st * 1024 + (ob ^ (((ob >> 9) & 1) << 5)); }
__host__ __device__ __forceinline__ void stage_rc(int b, int& R, int& C) { const int st = b / 1024, sb = b % 1024, swz = sb ^ (((sb >> 9) & 1) << 5); R = (st >> 1) * 16 + swz / 64; C = (st & 1) * 32 + (swz % 64) / 2; }
__host__ __device__ __forceinline__ int perm32(int rho) { const int n = rho >> 4, i = rho & 15; return 8 * (i >> 2) + 4 * n + (i & 3); }

struct Unit { int pm, pn; };
struct Gemm { const bf16_t* A; const bf16_t* Bt; int M, N, K; };

template <class Epi, class Sched, bool ALIGN_EPI = false, bool SP2 = false>
__device__ __forceinline__ void gemm_phase(PG8_LAS unsigned char* lds, const Gemm g, const Sched& S, const Epi& E) {
    const int tid = threadIdx.x, wid = __builtin_amdgcn_readfirstlane(tid >> 6), lane = tid & 63, wr = wid >> 2, wc = wid & 3, fr = lane & 15, fq = lane >> 4;
    const int K = g.K, nt = K / BK;
    unsigned voffA[2], voffB[2];
#pragma unroll
    for (int i = 0; i < 2; ++i) { int R, C; stage_rc(tid * 16 + i * 8192, R, C); const int Rb = Epi::PERM ? ((R & ~31) + perm32(R & 31)) : R;
        voffA[i] = (unsigned)(R * K + C) * 2u; voffB[i] = (unsigned)(Rb * K + C) * 2u; }
    const size_t kstep = (size_t)(BK * 2);
    const size_t hstep = (size_t)HALF * K * 2;
    const size_t tstep = 2 * hstep;
    const unsigned ldsw = (unsigned)wid * 1024u;
    const int aoff = lds_byte(wr * 64 + fr, fq * 8), boff = lds_byte(wc * 32 + fr, fq * 8);
#define PG8_SA(b, h) (((b) * 2 + (h)) * HTB)
#define PG8_SB(b, h) ((4 + (b) * 2 + (h)) * HTB)
#define PG8_STAGE(bufoff, gbase, voff) do { _Pragma("unroll") for (int _i = 0; _i < 2; ++_i) \
        __builtin_amdgcn_global_load_lds((const unsigned*)((const char*)(gbase) + (voff)[_i]), (PG8_LAS unsigned*)(lds + (bufoff) + ldsw + _i * 8192), 16, 0, 0); } while (0)
#define PG8_LDA(dst, b, h) do { _Pragma("unroll") for (int m = 0; m < 4; ++m) _Pragma("unroll") for (int k = 0; k < 2; ++k) dst[m][k] = *(const PG8_LAS bf16x8*)(lds + PG8_SA(b, h) + aoff + m * 2048 + k * 1024); } while (0)
#define PG8_LDB(dst, b, h) do { _Pragma("unroll") for (int n = 0; n < 2; ++n) _Pragma("unroll") for (int k = 0; k < 2; ++k) dst[n][k] = *(const PG8_LAS bf16x8*)(lds + PG8_SB(b, h) + boff + n * 2048 + k * 1024); } while (0)
#define PG8_MMA(ai, bj, At, Bt) do { __builtin_amdgcn_s_setprio(1); _Pragma("unroll") for (int m = 0; m < 4; ++m) _Pragma("unroll") for (int n = 0; n < 2; ++n) _Pragma("unroll") for (int k = 0; k < 2; ++k) \
        acc[ai][bj][m][n] = __builtin_amdgcn_mfma_f32_16x16x32_bf16(Bt[n][k], At[m][k], acc[ai][bj][m][n], 0, 0, 0); __builtin_amdgcn_s_setprio(0); } while (0)
#define PG8_WAIT_V(n) asm volatile("s_waitcnt vmcnt(" #n ")" ::: "memory")
#define PG8_WAIT_L(n) asm volatile("s_waitcnt lgkmcnt(" #n ")" ::: "memory")
#define PG8_BAR __builtin_amdgcn_s_barrier()
#define PG8_SCHED __builtin_amdgcn_sched_barrier(0)
    Unit cur, nxt; int ui = 0;
    if (!S.next(0, cur)) return;
    f32x4 acc[2][2][4][2];
#pragma unroll
    for (int a = 0; a < 2; ++a)
#pragma unroll
        for (int b = 0; b < 2; ++b)
#pragma unroll
            for (int m = 0; m < 4; ++m)
#pragma unroll
                for (int n = 0; n < 2; ++n) acc[a][b][m][n] = (f32x4){0.f, 0.f, 0.f, 0.f};
    bf16x8 At[4][2], B0[2][2], B1[2][2];
    const char* cA = (const char*)g.A + (size_t)cur.pm * tstep; const char* cB = (const char*)g.Bt + (size_t)cur.pn * tstep;
    S.a_ready(cur);
    if constexpr (SP2) {
        PG8_STAGE(PG8_SB(0, 0), cB, voffB); PG8_STAGE(PG8_SB(0, 1), cB + hstep, voffB); PG8_STAGE(PG8_SA(0, 0), cA, voffA); PG8_STAGE(PG8_SA(0, 1), cA + hstep, voffA);
        if (wr == 1) PG8_BAR;
        PG8_WAIT_V(2); PG8_BAR;
        PG8_STAGE(PG8_SB(1, 0), cB + kstep, voffB); PG8_STAGE(PG8_SA(1, 0), cA + kstep, voffA); PG8_STAGE(PG8_SB(1, 1), cB + hstep + kstep, voffB);
        PG8_WAIT_V(6); PG8_BAR;
    } else {
        PG8_STAGE(PG8_SB(0, 0), cB, voffB); PG8_STAGE(PG8_SA(0, 0), cA, voffA); PG8_STAGE(PG8_SB(0, 1), cB + hstep, voffB); PG8_STAGE(PG8_SA(0, 1), cA + hstep, voffA);
        if (wr == 1) PG8_BAR;
        PG8_WAIT_V(4); PG8_BAR;
        PG8_STAGE(PG8_SB(1, 0), cB + kstep, voffB); PG8_STAGE(PG8_SA(1, 0), cA + kstep, voffA); PG8_STAGE(PG8_SB(1, 1), cB + hstep + kstep, voffB);
        PG8_WAIT_V(6); PG8_BAR;
    }
    for (;;) {
        const bool has_next = S.next(ui + 1, nxt);
        const char* nA = has_next ? (const char*)g.A + (size_t)nxt.pm * tstep : cA; const char* nB = has_next ? (const char*)g.Bt + (size_t)nxt.pn * tstep : cB;
        for (int t = 0; t < nt; t += 2) {
            const bool last = (t == nt - 2);
            const char* a1 = cA + (size_t)(t + 1) * kstep;
            const char* a2 = last ? nA : cA + (size_t)(t + 2) * kstep; const char* b2 = last ? nB : cB + (size_t)(t + 2) * kstep;
            const char* a3 = a2 + kstep; const char* b3 = b2 + kstep;
            if (last && has_next) S.a_ready(nxt);
            if constexpr (SP2) {
            PG8_LDB(B0, 0, 0); PG8_LDB(B1, 0, 1); PG8_SCHED; PG8_LDA(At, 0, 0); PG8_STAGE(PG8_SA(1, 1), a1 + hstep, voffA);
            PG8_WAIT_V(8); PG8_WAIT_L(0); PG8_BAR; PG8_MMA(0, 0, At, B0); PG8_MMA(0, 1, At, B1); PG8_BAR; PG8_SCHED;
            PG8_LDA(At, 0, 1); PG8_STAGE(PG8_SB(0, 0), b2, voffB); PG8_STAGE(PG8_SB(0, 1), b2 + hstep, voffB); PG8_STAGE(PG8_SA(0, 0), a2, voffA);
            PG8_WAIT_V(8); PG8_WAIT_L(0); PG8_BAR; PG8_MMA(1, 0, At, B0); PG8_MMA(1, 1, At, B1); PG8_BAR; PG8_SCHED;
            PG8_LDB(B0, 1, 0); PG8_LDB(B1, 1, 1); PG8_SCHED; PG8_LDA(At, 1, 0); PG8_STAGE(PG8_SA(0, 1), a2 + hstep, voffA);
            PG8_WAIT_V(8); PG8_WAIT_L(0); PG8_BAR; PG8_MMA(0, 0, At, B0); PG8_MMA(0, 1, At, B1); PG8_BAR; PG8_SCHED;
            PG8_LDA(At, 1, 1); PG8_STAGE(PG8_SB(1, 0), b3, voffB); PG8_STAGE(PG8_SB(1, 1), b3 + hstep, voffB); PG8_STAGE(PG8_SA(1, 0), a3, voffA);
            PG8_WAIT_V(8); PG8_WAIT_L(0); PG8_BAR; PG8_MMA(1, 0, At, B0); PG8_MMA(1, 1, At, B1); PG8_BAR; PG8_SCHED;
            } else {
            PG8_LDB(B0, 0, 0); PG8_SCHED; PG8_LDA(At, 0, 0); PG8_STAGE(PG8_SA(1, 1), a1 + hstep, voffA);
            PG8_WAIT_L(8); PG8_BAR; PG8_WAIT_L(0); PG8_MMA(0, 0, At, B0); PG8_BAR; PG8_SCHED;
            PG8_LDB(B1, 0, 1); PG8_STAGE(PG8_SB(0, 0), b2, voffB);
            PG8_BAR; PG8_WAIT_L(0); PG8_MMA(0, 1, At, B1); PG8_BAR;
            PG8_LDA(At, 0, 1); PG8_STAGE(PG8_SA(0, 0), a2, voffA);
            PG8_BAR; PG8_WAIT_L(0); PG8_MMA(1, 0, At, B0); PG8_BAR; PG8_SCHED;
            PG8_STAGE(PG8_SB(0, 1), b2 + hstep, voffB);
            PG8_WAIT_V(6); PG8_BAR; PG8_MMA(1, 1, At, B1); PG8_BAR;
            PG8_LDB(B0, 1, 0); PG8_SCHED; PG8_LDA(At, 1, 0); PG8_STAGE(PG8_SA(0, 1), a2 + hstep, voffA);
            PG8_WAIT_L(8); PG8_BAR; PG8_WAIT_L(0); PG8_MMA(0, 0, At, B0); PG8_BAR; PG8_SCHED;
            PG8_LDB(B1, 1, 1); PG8_STAGE(PG8_SB(1, 0), b3, voffB);
            PG8_BAR; PG8_WAIT_L(0); PG8_MMA(0, 1, At, B1); PG8_BAR;
            PG8_LDA(At, 1, 1); PG8_STAGE(PG8_SA(1, 0), a3, voffA);
            PG8_BAR; PG8_WAIT_L(0); PG8_MMA(1, 0, At, B0); PG8_BAR; PG8_SCHED;
            PG8_STAGE(PG8_SB(1, 1), b3 + hstep, voffB);
            PG8_WAIT_V(6); PG8_BAR; PG8_MMA(1, 1, At, B1); PG8_BAR;
            }
        }
        if constexpr (ALIGN_EPI) { if (wr == 0) PG8_BAR; }
        if constexpr (!Epi::AFTER_DRAIN) { E(acc, cur, wr, wc, fr, fq); S.done(cur); }
        if (!has_next) break;
#pragma unroll
        for (int a = 0; a < 2; ++a)
#pragma unroll
            for (int b = 0; b < 2; ++b)
#pragma unroll
                for (int m = 0; m < 4; ++m)
#pragma unroll
                    for (int n = 0; n < 2; ++n) acc[a][b][m][n] = (f32x4){0.f, 0.f, 0.f, 0.f};
        cur = nxt; cA = nA; cB = nB; ++ui;
        if constexpr (ALIGN_EPI) { if (wr == 1) PG8_BAR; }
    }
    PG8_WAIT_V(0);
    if constexpr (!ALIGN_EPI) { if (wr == 0) PG8_BAR; }
    PG8_BAR;
    if constexpr (Epi::AFTER_DRAIN) { E.fused(acc, cur, wr, wc, fr, fq, lds, wid, lane); S.done(cur); }
#undef PG8_SA
#undef PG8_SB
#undef PG8_STAGE
#undef PG8_LDA
#undef PG8_LDB
#undef PG8_MMA
#undef PG8_WAIT_V
#undef PG8_WAIT_L
#undef PG8_BAR
#undef PG8_SCHED
}
}

struct Pg8Sched {
    int nx, xcd, local, nloc, nlat, nnt, nctx, ctxn;
    __device__ __forceinline__ bool next(int i, pg8::Unit& u) const {
        const int v = local + i * nloc, nl = nlat * nnt;
        if (v < nl) { u.pm = (v / nnt) * nx + xcd; u.pn = v % nnt; return true; }
        const int r = v - nl;
        if (r >= nctx * ctxn) return false;
        u.pm = 64 + (r / ctxn) * nx + xcd; u.pn = r % ctxn; return true;
    }
    __device__ __forceinline__ void a_ready(const pg8::Unit&) const {}
    __device__ __forceinline__ void done(const pg8::Unit&) const {}
};
struct Pg8EpiInproj {
    static constexpr bool PERM = true, AFTER_DRAIN = false;
    bf16_t* ug; bf16_t* zr;
    __device__ __forceinline__ void operator()(const pg8::f32x4 (&acc)[2][2][4][2], const pg8::Unit& u, int wr, int wc, int fr, int fq) const {
#pragma unroll
        for (int ai = 0; ai < 2; ++ai)
#pragma unroll
            for (int m = 0; m < 4; ++m) {
                const int row = u.pm * 256 + ai * 128 + wr * 64 + m * 16 + fr;
#pragma unroll
                for (int bj = 0; bj < 2; ++bj) {
                    const int col = u.pn * 256 + bj * 128 + wc * 32 + 8 * fq;
                    const pg8::f32x4 v0 = acc[ai][bj][m][0], v1 = acc[ai][bj][m][1];
                    const uint4 o = make_uint4(pack2(v0[0], v0[1]), pack2(v0[2], v0[3]), pack2(v1[0], v1[1]), pack2(v1[2], v1[3]));
                    if (col < DS5) *(uint4*)(ug + ((size_t)(col >> 4) * NROW + row) * 16 + (col & 15)) = o;
                    else *(uint4*)(zr + (size_t)row * 1280 + (col - DS5)) = o;
                }
            }
    }
};
struct Pg8EpiRows {
    static constexpr bool PERM = true, AFTER_DRAIN = false;
    bf16_t* y; int ldc;
    __device__ __forceinline__ void operator()(const pg8::f32x4 (&acc)[2][2][4][2], const pg8::Unit& u, int wr, int wc, int fr, int fq) const {
#pragma unroll
        for (int ai = 0; ai < 2; ++ai)
#pragma unroll
            for (int m = 0; m < 4; ++m) {
                const int row = u.pm * 256 + ai * 128 + wr * 64 + m * 16 + fr;
#pragma unroll
                for (int bj = 0; bj < 2; ++bj) {
                    const int col = u.pn * 256 + bj * 128 + wc * 32 + 8 * fq;
                    const pg8::f32x4 v0 = acc[ai][bj][m][0], v1 = acc[ai][bj][m][1];
                    *(uint4*)(y + (size_t)row * ldc + col) = make_uint4(pack2(v0[0], v0[1]), pack2(v0[2], v0[3]), pack2(v1[0], v1[1]), pack2(v1[2], v1[3]));
                }
            }
    }
};

struct Pg8EpiGlu {
    static constexpr bool PERM = true, AFTER_DRAIN = false;
    const bf16_t* Y; bf16_t* hb; const float* bg;
    __device__ __forceinline__ void operator()(const pg8::f32x4 (&acc)[2][2][4][2], const pg8::Unit& u, int wr, int wc, int fr, int fq) const {
        float4 bb0[2], bb1[2];
#pragma unroll
        for (int bj = 0; bj < 2; ++bj) { const int col = u.pn * 256 + bj * 128 + wc * 32 + 8 * fq; bb0[bj] = *(const float4*)(bg + col); bb1[bj] = *(const float4*)(bg + col + 4); }
        uint4 tqa[2][4][2];
#pragma unroll
        for (int ai = 0; ai < 2; ++ai)
#pragma unroll
            for (int m = 0; m < 4; ++m)
#pragma unroll
                for (int bj = 0; bj < 2; ++bj)
                    tqa[ai][m][bj] = *(const uint4*)(Y + (size_t)(u.pm * 256 + ai * 128 + wr * 64 + m * 16 + fr) * DS5 + u.pn * 256 + bj * 128 + wc * 32 + 8 * fq);
#pragma unroll
        for (int ai = 0; ai < 2; ++ai) {
            const uint4 (&tq)[4][2] = tqa[ai];
#pragma unroll
            for (int m = 0; m < 4; ++m) {
                const int row = u.pm * 256 + ai * 128 + wr * 64 + m * 16 + fr;
#pragma unroll
                for (int bj = 0; bj < 2; ++bj) {
                    const int col = u.pn * 256 + bj * 128 + wc * 32 + 8 * fq;
                    const pg8::f32x4 v0 = acc[ai][bj][m][0], v1 = acc[ai][bj][m][1];
                    const uint4 t = tq[m][bj];
                    const float4 b0 = bb0[bj], b1 = bb1[bj];
                    uint4 o;
                    o.x = pack2(bflo(t.x) * sigmoidf_(v0[0] + b0.x), bfhi(t.x) * sigmoidf_(v0[1] + b0.y));
                    o.y = pack2(bflo(t.y) * sigmoidf_(v0[2] + b0.z), bfhi(t.y) * sigmoidf_(v0[3] + b0.w));
                    o.z = pack2(bflo(t.z) * sigmoidf_(v1[0] + b1.x), bfhi(t.z) * sigmoidf_(v1[1] + b1.y));
                    o.w = pack2(bflo(t.w) * sigmoidf_(v1[2] + b1.z), bfhi(t.w) * sigmoidf_(v1[3] + b1.w));
                    *(uint4*)(hb + (size_t)row * D + col) = o;
                }
            }
        }
    }
};

struct EpiInproj {
    bf16_t* ug; bf16_t* zr; int m0, n0;
    __device__ __forceinline__ void operator()(const f32x16 (&acc)[2][2], int r0, int c0) const {
        epi_store16<2>(acc, r0, c0,
            [&](int, int, float v0, float v1, float v2, float v3) { uint2 o; o.x = pack2(v0, v1); o.y = pack2(v2, v3); return o; },
            [&](int rl, int c8) -> bf16_t* { const int row = m0 + rl, col = n0 + c8;
                return col < DS5 ? ug + ((size_t)(col >> 4) * NROW + row) * 16 + (col & 15) : zr + (size_t)row * 1280 + (col - DS5); });
    }
};
__device__ __forceinline__ void phase_inproj(const Params& p, unsigned char* lds, int l) {
    const WS w{p.ws};
    const XcdIter xi = xcd_iter();
    const Pg8Sched S{xi.nx, xi.xcd, xi.local, xi.nloc, 64 / xi.nx, 7, 8 / xi.nx, l == 0 ? 7 : 2};
    const pg8::Gemm g{w.hb(), w.wt_in(l), NROW, DIN, D};
    const Pg8EpiInproj E{w.ug(), w.zr()};
    pg8::gemm_phase<Pg8EpiInproj, Pg8Sched, false, true>((PG8_LAS unsigned char*)lds, g, S, E);
    if (l == 1) deferred_tiles(p, lds, xi, 26, 1920 + 384, 8);
}

struct EpiS1 {
    float* S; int m0, n0;
    __device__ __forceinline__ void operator()(const f32x16 (&acc)[1][2], int r0, int c0) const {
        ACC_FOREACH(1, acc, r0, c0, {
            *(float4*)(S + (size_t)(m0 + rl) * 256 + n0 + cl) = make_float4(v0, v1, v2, v3);
        })
    }
};

__device__ __forceinline__ void conv_sc(const Params& p, int l, int nrows) {
    const WS w{p.ws};
    const float* wsc = p.in[17] + (size_t)l * 3 * 256;
    const bool wsplit = l == 0 && gridDim.x == 256;
    const int ntot = nrows * 16, ncom = wsplit ? ((ntot / 16 * 11) & ~15) : ntot;
#pragma unroll 1
    for (int pass = 0; pass < 2; ++pass) {
    if (pass == 1 && (!wsplit || blockIdx.x >= 192)) break;
    const int lo = pass == 0 ? 0 : ncom, hi = pass == 0 ? ncom : ntot;
    const int gt = blockIdx.x * NTHR + threadIdx.x, gs = (pass == 0 ? (int)gridDim.x : 192) * NTHR;
    for (int i = lo + gt; i < hi; i += gs) {
        const int row = i >> 4, c16 = (i & 15) * 16;
        int pos, len;
        if (row < NLAT) { pos = row & 63; len = 64; } else { pos = (row - NLAT) & 255; len = 256; }
        const bf16_t* zr = w.zr() + (size_t)row * 1280;
        uint4 cg[3][2], vv[3][2];
#pragma unroll
        for (int j = 0; j < 3; ++j) {
            const bool ok = (pos + j - 1 >= 0) && (pos + j - 1 < len);
#pragma unroll
            for (int u = 0; u < 2; ++u) {
                if (ok) { cg[j][u] = *(const uint4*)(zr + (ptrdiff_t)(j - 1) * 1280 + 256 + c16 + u * 8); vv[j][u] = *(const uint4*)(zr + (ptrdiff_t)(j - 1) * 1280 + 512 + c16 + u * 8); }
                else { cg[j][u] = make_uint4(0, 0, 0, 0); vv[j][u] = make_uint4(0, 0, 0, 0); }
            }
        }
        uint4 bg[2];
#pragma unroll
        for (int u = 0; u < 2; ++u) bg[u] = *(const uint4*)(zr + c16 + u * 8);
#pragma unroll
        for (int u = 0; u < 2; ++u) {
            float accv[8];
#pragma unroll
            for (int e = 0; e < 8; ++e) accv[e] = 0.f;
#pragma unroll
            for (int j = 0; j < 3; ++j) {
                const float4 wa = *(const float4*)(wsc + j * 256 + c16 + u * 8), wb = *(const float4*)(wsc + j * 256 + c16 + u * 8 + 4);
                const uint4 c = cg[j][u], v = vv[j][u];
                accv[0] += wa.x * bflo(c.x) * bflo(v.x); accv[1] += wa.y * bfhi(c.x) * bfhi(v.x);
                accv[2] += wa.z * bflo(c.y) * bflo(v.y); accv[3] += wa.w * bfhi(c.y) * bfhi(v.y);
                accv[4] += wb.x * bflo(c.z) * bflo(v.z); accv[5] += wb.y * bfhi(c.z) * bfhi(v.z);
                accv[6] += wb.z * bflo(c.w) * bflo(v.w); accv[7] += wb.w * bfhi(c.w) * bfhi(v.w);
            }
            uint4 o;
            o.x = pack2(accv[0] * bflo(bg[u].x), accv[1] * bfhi(bg[u].x));
            o.y = pack2(accv[2] * bflo(bg[u].y), accv[3] * bfhi(bg[u].y));
            o.z = pack2(accv[4] * bflo(bg[u].z), accv[5] * bfhi(bg[u].z));
            o.w = pack2(accv[6] * bflo(bg[u].w), accv[7] * bfhi(bg[u].w));
            *(uint4*)(w.hb() + (size_t)row * D + 512 + c16 + u * 8) = o;
        }
    }
    }
}

__device__ __forceinline__ void conv_cf(const Params& p, unsigned char* lds, int l, bool with_ctx) {
    const WS w{p.ws};
    float* P = (float*)lds;
    const int tid = threadIdx.x, lane = tid & 63, wid = __builtin_amdgcn_readfirstlane(tid >> 6);
    float4 wv[31];
#pragma unroll
    for (int k = 0; k < 31; ++k) wv[k] = *(const float4*)(p.in[18] + (size_t)l * 31 * 256 + k * 256 + lane * 4);
    const float4 bdw = *(const float4*)(p.in[19] + l * 256 + lane * 4);
    const float4 lg = *(const float4*)(p.in[20] + l * 256 + lane * 4);
    const float4 lb = *(const float4*)(p.in[21] + l * 256 + lane * 4);
    const int nitem = 512 + (with_ctx ? 64 : 0);
    uint4 rga[4], rgb[4];
    auto item_geom = [&](int it, bool& lat, int& base, int& nslot, int& s0) {
        lat = it < 512; s0 = 0;
        if (lat) { base = (it >> 6) * SEQ + (it & 63); nslot = 32; }
        else { const int j = it - 512; s0 = (j & 7) * 32; base = NLAT + (j >> 3) * CTX; nslot = 62; }
    };
    auto issue = [&](int it) {
        bool lat; int base, nslot, s0; item_geom(it, lat, base, nslot, s0);
#pragma unroll
        for (int t = 0; t < 4; ++t) {
            const int task = tid + t * NTHR, slot = task >> 5, c8 = (task & 31) * 8;
            int row; bool valid = slot < nslot;
            if (lat) row = base + slot * 64;
            else { const int sq = s0 - 15 + slot; valid = valid && sq >= 0 && sq < CTX; row = base + sq; }
            if (valid) {
                const bf16_t* zr = w.zr() + (size_t)row * 1280;
                rga[t] = *(const uint4*)(zr + 768 + c8); rgb[t] = *(const uint4*)(zr + 1024 + c8);
            } else { rga[t] = make_uint4(0, 0, 0, 0); rgb[t] = make_uint4(0, 0, 0, 0); }
        }
    };
    const int rb = gridDim.x - 1 - blockIdx.x;
    if (rb < nitem) issue(rb);
    for (int it = rb; it < nitem; it += gridDim.x) {
        bool lat; int base, nslot, s0; item_geom(it, lat, base, nslot, s0);
        lds_barrier();
#pragma unroll
        for (int t = 0; t < 4; ++t) {
            const int task = tid + t * NTHR, slot = task >> 5, c8 = (task & 31) * 8;
            if (slot < nslot) {
                const uint4 ga = rga[t], gb = rgb[t];
                float f[8];
                f[0] = bflo(ga.x) * sigmoidf_(bflo(gb.x)); f[1] = bfhi(ga.x) * sigmoidf_(bfhi(gb.x));
                f[2] = bflo(ga.y) * sigmoidf_(bflo(gb.y)); f[3] = bfhi(ga.y) * sigmoidf_(bfhi(gb.y));
                f[4] = bflo(ga.z) * sigmoidf_(bflo(gb.z)); f[5] = bfhi(ga.z) * sigmoidf_(bfhi(gb.z));
                f[6] = bflo(ga.w) * sigmoidf_(bflo(gb.w)); f[7] = bfhi(ga.w) * sigmoidf_(bfhi(gb.w));
                *(float4*)(P + slot * 256 + c8) = make_float4(f[0], f[1], f[2], f[3]);
                *(float4*)(P + slot * 256 + c8 + 4) = make_float4(f[4], f[5], f[6], f[7]);
            }
        }
        if (it + (int)gridDim.x < nitem) issue(it + gridDim.x);
        lds_barrier();
        constexpr int OPW = 32 / NWV;
        const int o0 = wid * OPW;
        float4 a[OPW];
#pragma unroll
        for (int o = 0; o < OPW; ++o) a[o] = bdw;
        {
#pragma unroll
            for (int i = 0; i < OPW + 30; ++i) {
                const int rr = lat ? o0 - 15 + i : o0 + i;
                if (!lat || (rr >= 0 && rr < 32)) {
                    const float4 pv = *(const float4*)(P + rr * 256 + lane * 4);
#pragma unroll
                    for (int o = 0; o < OPW; ++o) {
                        const int k = i - o;
                        if (k >= 0 && k < 31) { a[o].x += wv[k].x * pv.x; a[o].y += wv[k].y * pv.y; a[o].z += wv[k].z * pv.z; a[o].w += wv[k].w * pv.w; }
                    }
                }
            }
        }
#pragma unroll
        for (int o = 0; o < OPW; ++o) {
            const int row = lat ? base + (o0 + o) * 64 : base + s0 + o0 + o;
            const float mean = wave_sum_fast(a[o].x + a[o].y + a[o].z + a[o].w) * (1.0f / 256.0f);
            const float dx = a[o].x - mean, dy = a[o].y - mean, dz = a[o].z - mean, dw = a[o].w - mean;
            const float var = wave_sum_fast(dx * dx + dy * dy + dz * dz + dw * dw) * (1.0f / 256.0f);
            const float rs = rsqrtf(var + LN_EPS);
            const float y0 = siluf_(dx * rs * lg.x + lb.x), y1 = siluf_(dy * rs * lg.y + lb.y), y2 = siluf_(dz * rs * lg.z + lb.z), y3 = siluf_(dw * rs * lg.w + lb.w);
            uint2 ov; ov.x = pack2(y0, y1); ov.y = pack2(y2, y3);
            *(uint2*)(w.hb() + (size_t)row * D + 768 + lane * 4) = ov;
        }
    }
}

__device__ __forceinline__ int chunk_col(int d, int b, int step) {
    if (step < CH_CTX) { const int c = d == 0 ? step : (CH_CTX - 1 - step); return NCOL_LAT + b * CH_CTX + c; }
    const int s = step - CH_CTX; const int c = d == 0 ? s : (CH_LAT - 1 - s); return b * CH_LAT + c;
}
typedef __attribute__((ext_vector_type(4))) float f32x4_t;
__device__ __forceinline__ void phase_s12(const Params& p, unsigned char* lds, int l) {
    const WS w{p.ws};
    const int tid = threadIdx.x, lane = tid & 63, wid = __builtin_amdgcn_readfirstlane(tid >> 6);
    constexpr int A_BYTES = NSTEP * 512;
    float* Sl = (float*)(lds + A_BYTES);
    float2* Fs = (float2*)(lds + 2 * A_BYTES);
    const int fr = lane & 15, fq = lane >> 4;
    for (int it = blockIdx.x; it < NG * NB; it += gridDim.x) {
        const int xcd = it & 7, loc = it >> 3, g = xcd * 4 + (loc >> 3), b = loc & 7;
        const bf16_t* ugg = w.ug() + (size_t)g * NROW * 16;
        __syncthreads();
#pragma unroll
        for (int j = 0; j < 9; ++j) {
            const int k = wid * 9 + j, row = 2 * k + (lane >> 5), q = (lane & 31) ^ (row & 15);
            const int col = row < CH_CTX ? NCOL_LAT + b * CH_CTX + row : b * CH_LAT + (row - CH_CTX);
            __builtin_amdgcn_global_load_lds((const unsigned*)(ugg + (size_t)col * 256 + q * 8), (LDS_AS unsigned*)((LDS_AS unsigned char*)lds + k * 1024), 16, 0, 0);
        }
        const bf16_t* m1 = w.m1(l, g) + (size_t)(wid * 16 + fr) * 256 + fq * 8;
        bf16x8 bfr[8];
#pragma unroll
        for (int ks = 0; ks < 8; ++ks) bfr[ks] = *(const bf16x8*)(m1 + ks * 32);
#pragma unroll 1
        for (int d = 0; d < 2; ++d) {
            const float2 A = w.lampow(l, d, g)[lane * NPOW + 16], A18 = w.lampow(l, d, g)[lane * NPOW + 17];
            if (d == 0) { asm volatile("s_waitcnt vmcnt(0)" ::: "memory"); __syncthreads(); }
            f32x4_t acc[9];
#pragma unroll
            for (int m = 0; m < 9; ++m) acc[m] = (f32x4_t){0.f, 0.f, 0.f, 0.f};
#define S_LDG(dst, gi, tile_off, ksl) _Pragma("unroll") for (int m = 0; m < 3; ++m) dst[m] = *(const bf16x8*)(lds + (tile_off) + (((gi) * 3 + m) * 16 + fr) * 512 + ((((ksl) * 4 + fq) ^ fr) << 4))
            bf16x8 fb[2][3];
            S_LDG(fb[0], 0, 0, 0);
#pragma unroll
            for (int n = 0; n < 24; ++n) {
                const int ks = n / 3, gi = n % 3;
                if (n + 1 < 24) { S_LDG(fb[(n + 1) & 1], (n + 1) % 3, 0, (n + 1) / 3); }
                SCHED_FENCE;
#pragma unroll
                for (int m = 0; m < 3; ++m) acc[gi * 3 + m] = __builtin_amdgcn_mfma_f32_16x16x32_bf16(fb[n & 1][m], bfr[ks], acc[gi * 3 + m], 0, 0, 0);
                SCHED_FENCE;
            }
            if (d == 0) {
#pragma unroll
                for (int ks = 0; ks < 8; ++ks) bfr[ks] = *(const bf16x8*)(m1 + (size_t)128 * 256 + ks * 32);
            }
#pragma unroll
            for (int m = 0; m < 9; ++m)
#pragma unroll
                for (int r = 0; r < 4; ++r) Sl[(m * 16 + 4 * fq + r) * 128 + wid * 16 + fr] = acc[m][r];
            __syncthreads();
            float2 sv[SEGLEN];
#pragma unroll
            for (int i = 0; i < SEGLEN; ++i) {
                const int step = wid * SEGLEN + i;
                const int row = d == 0 ? step : (step < CH_CTX ? CH_CTX - 1 - step : NSTEP + CH_CTX - 1 - step);
                sv[i] = *(const float2*)(Sl + row * 128 + 2 * lane);
            }
            float2 F = make_float2(0.f, 0.f);
#pragma unroll
            for (int i = 0; i < SEGLEN; ++i) { const float fr_ = A.x * F.x - A.y * F.y + sv[i].x, fi_ = A.x * F.y + A.y * F.x + sv[i].y; F.x = fr_; F.y = fi_; }
            Fs[wid * 64 + lane] = F;
            __syncthreads();
            float2 H = make_float2(0.f, 0.f);
            for (int q = 0; q < wid; ++q) { const float2 f = Fs[q * 64 + lane]; const float hr = A18.x * H.x - A18.y * H.y + f.x, hi = A18.x * H.y + A18.y * H.x + f.y; H.x = hr; H.y = hi; }
            bf16_t* Hp = w.hprev() + (size_t)g * NCOL * 256 + d * 128 + 2 * lane;
#pragma unroll
            for (int i = 0; i < SEGLEN; ++i) {
                *(unsigned*)(Hp + (size_t)chunk_col(d, b, wid * SEGLEN + i) * 256) = pack2(H.x, H.y);
                const float hr = A.x * H.x - A.y * H.y + sv[i].x, hi = A.x * H.y + A.y * H.x + sv[i].y; H.x = hr; H.y = hi;
            }
        }
        asm volatile("s_waitcnt vmcnt(0)" ::: "memory");
        __syncthreads();
        {
            const bf16_t* hpg = w.hprev() + (size_t)g * NCOL * 256;
#pragma unroll
            for (int j = 0; j < 9; ++j) {
                const int k = wid * 9 + j, row = 2 * k + (lane >> 5), q = (lane & 31) ^ (row & 15);
                const int col = row < CH_CTX ? NCOL_LAT + b * CH_CTX + row : b * CH_LAT + (row - CH_CTX);
                __builtin_amdgcn_global_load_lds((const unsigned*)(hpg + (size_t)col * 256 + q * 8), (LDS_AS unsigned*)((LDS_AS unsigned char*)lds + A_BYTES + k * 1024), 16, 0, 0);
            }
        }
        {
            constexpr int WPD = 6;
            const bf16_t* w2 = w.w2(l, g) + (size_t)(wid * 32 + fr) * 512 + fq * 8;
            bf16x8 wq[WPD][2];
#pragma unroll
            for (int ks = 0; ks < WPD; ++ks) { wq[ks][0] = *(const bf16x8*)(w2 + ks * 32); wq[ks][1] = *(const bf16x8*)(w2 + (size_t)16 * 512 + ks * 32); }
            f32x4_t acc[2][9];
#pragma unroll
            for (int tt = 0; tt < 2; ++tt)
#pragma unroll
                for (int m = 0; m < 9; ++m) acc[tt][m] = (f32x4_t){0.f, 0.f, 0.f, 0.f};
            bf16x8 fb[2][3];
            S_LDG(fb[0], 0, 0, 0);
#pragma unroll
            for (int n = 0; n < 48; ++n) {
                const int ks = n / 3, gi = n % 3;
                if (n + 1 == 24) { asm volatile("s_waitcnt vmcnt(0)" ::: "memory"); __syncthreads(); }
                if (n + 1 < 48) { S_LDG(fb[(n + 1) & 1], (n + 1) % 3, (((n + 1) / 3) >> 3) * A_BYTES, ((n + 1) / 3) & 7); }
                SCHED_FENCE;
#pragma unroll
                for (int m = 0; m < 3; ++m) {
                    if (l == 1 && gi == 0 && m == 0) continue;
                    acc[0][gi * 3 + m] = __builtin_amdgcn_mfma_f32_16x16x32_bf16(wq[ks % WPD][0], fb[n & 1][m], acc[0][gi * 3 + m], 0, 0, 0);
                    acc[1][gi * 3 + m] = __builtin_amdgcn_mfma_f32_16x16x32_bf16(wq[ks % WPD][1], fb[n & 1][m], acc[1][gi * 3 + m], 0, 0, 0);
                }
                SCHED_FENCE;
                if (gi == 2 && ks + WPD < 16) {
                    wq[ks % WPD][0] = *(const bf16x8*)(w2 + (ks + WPD) * 32); wq[ks % WPD][1] = *(const bf16x8*)(w2 + (size_t)16 * 512 + (ks + WPD) * 32);
                }
            }
#pragma unroll
            for (int tt = 0; tt < 2; ++tt) {
                const int t = wid * 2 + tt;
#pragma unroll
                for (int m = 0; m < 9; ++m) {
                    if (l == 1 && m == 0) continue;
                    const int row = m * 16 + fr;
                    const int col = row < CH_CTX ? NCOL_LAT + b * CH_CTX + row : b * CH_LAT + (row - CH_CTX);
                    uint2 o; o.x = pack2(gelu_tanh(acc[tt][m][0]), gelu_tanh(acc[tt][m][1])); o.y = pack2(gelu_tanh(acc[tt][m][2]), gelu_tanh(acc[tt][m][3]));
                    *(uint2*)(w.Y() + ((size_t)col * TCH + t) * DS5 + g * 16 + 4 * fq) = o;
                }
            }
        }
    }
    __syncthreads();
    conv_sc(p, l, l == 0 ? NROW : NLAT);
    conv_cf(p, lds, l, l == 0);
}

struct EpiS3 {
    bf16_t* Y; int m0, n0, g;
    __device__ __forceinline__ void operator()(const f32x16 (&acc)[1][2], int r0, int c0) const {
        epi_store16<1>(acc, r0, c0,
            [&](int, int, float v0, float v1, float v2, float v3) { uint2 o; o.x = pack2(gelu_tanh(v0), gelu_tanh(v1)); o.y = pack2(gelu_tanh(v2), gelu_tanh(v3)); return o; },
            [&](int rl, int c8) -> bf16_t* { const int col = n0 + c8, tok = (m0 + rl) * TCH + (col >> 4); return Y + (size_t)tok * DS5 + g * 16 + (col & 15); });
    }
};
__device__ __forceinline__ void phase_s3(const Params& p, unsigned char* lds, int l) {
    const WS w{p.ws};
    const XcdIter xi = xcd_iter();
    const int nmt = l == 0 ? 9 : 8, nunit = (NG / xi.nx) * nmt * 2;
    auto get = [&](int i, SrcA& A, SrcB& B, EpiS3& e) -> bool {
        const int u = xi.local + i * xi.nloc;
        if (u >= nunit) return false;
        const int g = (u / (nmt * 2)) * xi.nx + xi.xcd, r = u % (nmt * 2), mt = r >> 1, nt = r & 1;
        src_split<2>(A, w.ug() + (size_t)g * NROW * 16, 256, w.hprev() + (size_t)g * NCOL * 256, 256, mt * 128, 256);
        src_plain<2>(B, w.w2(l, g), nt * 128, 512);
        e = EpiS3{w.Y(), mt * 128, nt * 128, g};
        return true;
    };
    gemm_stream<1, EpiS3>(lds, 512, get);
}

struct EpiGlu {
    const bf16_t* Y; bf16_t* hb; const float* bg; int m0, n0;
    __device__ __forceinline__ void operator()(const f32x16 (&acc)[1][2], int r0, int c0) const {
        epi_store16<1>(acc, r0, c0,
            [&](int rl, int cl, float v0, float v1, float v2, float v3) {
                const int row = m0 + rl, col = n0 + cl;
                const uint2 t = *(const uint2*)(Y + (size_t)row * DS5 + col);
                const float4 b = *(const float4*)(bg + col);
                uint2 o;
                o.x = pack2(bflo(t.x) * sigmoidf_(v0 + b.x), bfhi(t.x) * sigmoidf_(v1 + b.y));
                o.y = pack2(bflo(t.y) * sigmoidf_(v2 + b.z), bfhi(t.y) * sigmoidf_(v3 + b.w));
                return o; },
            [&](int rl, int c8) -> bf16_t* { return hb + (size_t)(m0 + rl) * D + n0 + c8; });
    }
};
__device__ __forceinline__ void phase_glu(const Params& p, unsigned char* lds, int l) {
    const WS w{p.ws};
    const XcdIter xi = xcd_iter();
    const Pg8Sched S{xi.nx, xi.xcd, xi.local, xi.nloc, 64 / xi.nx, 2, l == 0 ? 8 / xi.nx : 0, 2};
    const pg8::Gemm g{w.Y(), w.wt_glu(l), NROW, DS5, DS5};
    const Pg8EpiGlu E{w.Y(), w.hb(), p.in[16] + l * DS5};
    pg8::gemm_phase<Pg8EpiGlu, Pg8Sched, true, true>((PG8_LAS unsigned char*)lds, g, S, E);
    if (l == 0) deferred_tiles(p, lds, xi, 18, 384 + N_OUT0_A, 9);
    else deferred_tiles(p, lds, xi, 16, 1920 + 768, 9);
}

struct EpiOut {
    bf16_t* y; int m0, n0;
    __device__ __forceinline__ void operator()(const f32x16 (&acc)[2][2], int r0, int c0) const {
        epi_store16<2>(acc, r0, c0,
            [&](int, int, float v0, float v1, float v2, float v3) { uint2 o; o.x = pack2(v0, v1); o.y = pack2(v2, v3); return o; },
            [&](int rl, int c8) -> bf16_t* { return y + (size_t)(m0 + rl) * D + n0 + c8; });
    }
};
__device__ __forceinline__ void phase_outproj(const Params& p, unsigned char* lds, int l) {
    const WS w{p.ws};
    const XcdIter xi = xcd_iter();
    if (l == 1) {
        const Pg8Sched S{xi.nx, xi.xcd, xi.local, xi.nloc, 64 / xi.nx, 4, 0, 4};
        const pg8::Gemm g{w.hb(), w.wt_o(l), NROW, D, D};
        const Pg8EpiRows E{w.zr(), D};
        pg8::gemm_phase<Pg8EpiRows, Pg8Sched, true, true>((PG8_LAS unsigned char*)lds, g, S, E);
        return;
    }
    const int nmt = 72 / xi.nx, nunit = nmt * 8;
    auto get = [&](int i, SrcA& A, SrcB& B, EpiOut& e) -> bool {
        const int u = xi.local + i * xi.nloc;
        if (u >= nunit) return false;
        const int mt = (u >> 3) * xi.nx + xi.xcd, nt = u & 7;
        src_plain<4>(A, w.hb(), mt * 256, D);
        src_plain<2>(B, w.wt_o(l), nt * 128, D);
        e = EpiOut{w.zr(), mt * 256, nt * 128};
        return true;
    };
    gemm_stream<2, EpiOut>(lds, D, get);
    if (defer_ok() && xi.local >= 8) {
        const int nb = (xi.nloc - 8) * xi.nx, j0 = (xi.local - 8) * xi.nx + xi.xcd;
        w2_toeplitz_fill(p, 1, 2, j0 * NTHR + (int)threadIdx.x, nb * NTHR);
        transpose_stream(p, lds, (N_OUT0 - j0 + nb - 1) / nb, [=](int j) { const int k = j0 + j * nb; return k < N_OUT0_A ? 384 + k : 1920 + (k - N_OUT0_A); });
    }
}

__device__ __forceinline__ void phase_ln1(const Params& p, unsigned char* lds, int l) {
    const WS w{p.ws};
    const int tid = threadIdx.x, lane = tid & 63, wid = tid >> 6;
    float* wl = (float*)lds;
    const int nrows = l == 0 ? NROW : NLAT;
    const int nwv = gridDim.x * NWV, rpw = (nrows + nwv - 1) / nwv;
    int row = (blockIdx.x * NWV + wid) * rpw;
    const int rend = min(nrows, row + rpw);
    const bf16_t* ybuf = w.zr();
    float4 vn[4]; uint2 yn[4];
    if (row < rend) {
#pragma unroll
        for (int i = 0; i < 4; ++i) {
            if (l == 0) vn[i] = *(const float4*)((row < NLAT ? p.in[0] + (size_t)row * D : p.in[2] + (size_t)(row - NLAT) * D) + i * 256 + lane * 4);
            else { const uint2 u = *(const uint2*)(X1row(p, row) + i * 256 + lane * 4); vn[i].x = __uint_as_float(u.x); vn[i].y = __uint_as_float(u.y); }
            yn[i] = *(const uint2*)(ybuf + (size_t)row * D + i * 256 + lane * 4);
        }
    }
    __syncthreads();
#pragma unroll
    for (int kk = 0; kk < 2; ++kk) {
        const int k = tid + NTHR * kk;
        const int s = ((k >> 8) * 4 + (k & 3)) * 64 + ((k >> 2) & 63);
        const float4 g = *(const float4*)(p.in[25] + ((size_t)l * D + k) * 4);
        const float4* ex = (const float4*)(p.in[27] + ((size_t)l * D + k) * 16);
        const float4 e0 = ex[0], e1 = ex[1], e2 = ex[2], e3 = ex[3];
        *(float4*)(wl + (0 * 1024 + s) * 4) = g;
        *(float4*)(wl + (1 * 1024 + s) * 4) = e0;
        *(float4*)(wl + (2 * 1024 + s) * 4) = e1;
        *(float4*)(wl + (3 * 1024 + s) * 4) = e2;
        *(float4*)(wl + (4 * 1024 + s) * 4) = e3;
    }
    const float* md = w.mod(l);
    float* mt = (float*)(lds + 86016);
    const int m0 = modrow(min((int)(blockIdx.x * NWV) * rpw, nrows - 1));
    for (int i = tid; i < 2 * 3 * 256; i += NTHR) {
        const int c4 = (i & 255) * 4, v = (i >> 8) % 3, mm = i / 768, m = min(m0 + mm, 8);
        *(float4*)(mt + (mm * 3 + v) * 1024 + c4) = *(const float4*)(md + (size_t)m * 6144 + 2048 + v * 1024 + c4);
    }
    __syncthreads();
    const float* lng = p.in[23] + l * D; const float* lnb = p.in[24] + l * D;
    const float brg0 = p.in[26][l * 4 + 0], brg1 = p.in[26][l * 4 + 1], brg2 = p.in[26][l * 4 + 2], brg3 = p.in[26][l * 4 + 3];
    float bre[16];
#pragma unroll
    for (int i = 0; i < 16; ++i) bre[i] = p.in[28][l * 16 + i];
    int k_cls = 0, k_row = 0, nkeep = 0; float k_wlo = 0.f, k_whi = 0.f;
    float4 pg[4], pb[4];
#pragma unroll
    for (int i = 0; i < 4; ++i) { pg[i] = *(const float4*)(lng + i * 256 + lane * 4); pb[i] = *(const float4*)(lnb + i * 256 + lane * 4); }
    for (; row < rend; ++row) {
        bf16_t* R = RBrow(p, row);
        const int m = modrow(row);
        const float* mrow = mt + (m - m0) * 3072 + lane * 4;
        float h[16];
        float4 v[4];
#pragma unroll
        for (int i = 0; i < 4; ++i) {
            const float4 g1 = *(const float4*)(mrow + i * 256); const uint2 yy = yn[i];
            float4 xv;
            if (l == 0) xv = vn[i]; else { uint2 u; u.x = __float_as_uint(vn[i].x); u.y = __float_as_uint(vn[i].y); xv = bf4(u); }
            v[i].x = DN_ALPHA * xv.x + g1.x * bflo(yy.x); v[i].y = DN_ALPHA * xv.y + g1.y * bfhi(yy.x);
            v[i].z = DN_ALPHA * xv.z + g1.z * bflo(yy.y); v[i].w = DN_ALPHA * xv.w + g1.w * bfhi(yy.y);
        }
        if (row + 1 < rend) {
            const int rn = row + 1;
#pragma unroll
            for (int i = 0; i < 4; ++i) {
                if (l == 0) vn[i] = *(const float4*)((rn < NLAT ? p.in[0] + (size_t)rn * D : p.in[2] + (size_t)(rn - NLAT) * D) + i * 256 + lane * 4);
                else { const uint2 u = *(const uint2*)(X1row(p, rn) + i * 256 + lane * 4); vn[i].x = __uint_as_float(u.x); vn[i].y = __uint_as_float(u.y); }
                yn[i] = *(const uint2*)(ybuf + (size_t)rn * D + i * 256 + lane * 4);
            }
        }
        float s = 0.f;
#pragma unroll
        for (int i = 0; i < 4; ++i) s += (v[i].x + v[i].y) + (v[i].z + v[i].w);
        const float mean = wave_sum_fast(s) * (1.0f / 1024.0f);
        float q = 0.f;
#pragma unroll
        for (int i = 0; i < 4; ++i) { const float a = v[i].x - mean, b = v[i].y - mean, c = v[i].z - mean, d = v[i].w - mean; q += (a * a + b * b) + (c * c + d * d); }
        const float rs = rsqrtf(wave_sum_fast(q) * (1.0f / 1024.0f) + LN_EPS);
#pragma unroll
        for (int i = 0; i < 4; ++i) {
            const int col = i * 256 + lane * 4;
            const float4 g = pg[i], b = pb[i], sh = *(const float4*)(mrow + 1024 + i * 256), sc = *(const float4*)(mrow + 2048 + i * 256);
            float4 x;
            x.x = (v[i].x - mean) * rs * g.x + b.x; x.y = (v[i].y - mean) * rs * g.y + b.y; x.z = (v[i].z - mean) * rs * g.z + b.z; x.w = (v[i].w - mean) * rs * g.w + b.w;
            { uint2 xo; xo.x = pack2(x.x, x.y); xo.y = pack2(x.z, x.w); *(uint2*)(R + col) = xo; }
            h[i * 4 + 0] = x.x * (1.f + sc.x) + sh.x; h[i * 4 + 1] = x.y * (1.f + sc.y) + sh.y; h[i * 4 + 2] = x.z * (1.f + sc.z) + sh.z; h[i * 4 + 3] = x.w * (1.f + sc.w) + sh.w;
            uint2 o; o.x = pack2(h[i * 4 + 0], h[i * 4 + 1]); o.y = pack2(h[i * 4 + 2], h[i * 4 + 3]);
            *(uint2*)(w.hb() + (size_t)row * D + col) = o;
        }
        {
        float gl[4];
        {
            float a0 = 0.f, a1 = 0.f, a2 = 0.f, a3 = 0.f;
#pragma unroll
            for (int e = 0; e < 16; ++e) {
                const float4 wv = *(const float4*)(wl + (e * 64 + lane) * 4);
                a0 += h[e] * wv.x; a1 += h[e] * wv.y; a2 += h[e] * wv.z; a3 += h[e] * wv.w;
            }
            gl[0] = wave_sum_fast(a0) + brg0; gl[1] = wave_sum_fast(a1) + brg1; gl[2] = wave_sum_fast(a2) + brg2; gl[3] = wave_sum_fast(a3) + brg3;
        }
        {
            int gi = 0; float gm = gl[0];
#pragma unroll
            for (int i = 1; i < 4; ++i) if (gl[i] > gm) { gm = gl[i]; gi = i; }
            gi = __builtin_amdgcn_readfirstlane(gi);
            float den = 0.f;
#pragma unroll
            for (int i = 0; i < 4; ++i) den += __expf(gl[i] - gm);
            const float gw = 1.0f / den;
            float el[4];
            {
                const float* wg = wl + (size_t)(1 + gi) * 4096;
                float a0 = 0.f, a1 = 0.f, a2 = 0.f, a3 = 0.f;
#pragma unroll
                for (int e = 0; e < 16; ++e) {
                    const float4 wv = *(const float4*)(wg + (e * 64 + lane) * 4);
                    a0 += h[e] * wv.x; a1 += h[e] * wv.y; a2 += h[e] * wv.z; a3 += h[e] * wv.w;
                }
                const float b0 = gi == 0 ? bre[0] : (gi == 1 ? bre[4] : (gi == 2 ? bre[8] : bre[12]));
                const float b1 = gi == 0 ? bre[1] : (gi == 1 ? bre[5] : (gi == 2 ? bre[9] : bre[13]));
                const float b2 = gi == 0 ? bre[2] : (gi == 1 ? bre[6] : (gi == 2 ? bre[10] : bre[14]));
                const float b3 = gi == 0 ? bre[3] : (gi == 1 ? bre[7] : (gi == 2 ? bre[11] : bre[15]));
                el[0] = wave_sum_fast(a0) + b0; el[1] = wave_sum_fast(a1) + b1; el[2] = wave_sum_fast(a2) + b2; el[3] = wave_sum_fast(a3) + b3;
            }
            int i1 = 0; float m1 = el[0];
#pragma unroll
            for (int i = 1; i < 4; ++i) if (el[i] > m1) { m1 = el[i]; i1 = i; }
            int i2 = -1; float m2 = -3.0e38f;
#pragma unroll
            for (int i = 0; i < 4; ++i) if (i != i1 && el[i] > m2) { m2 = el[i]; i2 = i; }
            const float e2 = __expf(m2 - m1);
            const float w1 = gw / (1.0f + e2), w2 = gw * e2 / (1.0f + e2);
            const int lo = i1 < i2 ? i1 : i2, hi = i1 < i2 ? i2 : i1;
            const float wlo = i1 < i2 ? w1 : w2, whi = i1 < i2 ? w2 : w1;
            const int pair = lo == 0 ? (hi - 1) : (lo == 1 ? (hi + 1) : 5);
            const int cls = gi * 6 + pair;
            if (lane == nkeep) { k_cls = cls; k_row = row; k_wlo = wlo; k_whi = whi; }
            ++nkeep;
        }
        }
        if (nkeep == 64) {
            { const int pos = atomicAdd(w.cnt(l) + k_cls, 1); w.list()[(size_t)k_cls * LISTCAP + pos] = k_row; w.lw()[(size_t)k_cls * LISTCAP + pos] = make_float2(k_wlo, k_whi); }
            nkeep = 0;
        }
    }
    {
        int* hist = (int*)(lds + 81920);
        int* hbase = hist + 32;
        __syncthreads();
        if (tid < 64) hist[tid] = 0;
        __syncthreads();
        int rk = 0;
        if (lane < nkeep) rk = atomicAdd(&hist[k_cls], 1);
        __syncthreads();
        if (tid < NCLS) { const int c = hist[tid]; hbase[tid] = c > 0 ? atomicAdd(w.cnt(l) + tid, c) : 0; }
        __syncthreads();
        if (lane < nkeep) {
            const int pos = hbase[k_cls] + rk;
            w.list()[(size_t)k_cls * LISTCAP + pos] = k_row;
            w.lw()[(size_t)k_cls * LISTCAP + pos] = make_float2(k_wlo, k_whi);
        }
    }
}

__device__ __forceinline__ void cls_experts(int cls, int& elo, int& ehi) {
    const int g = cls / 6, pr = cls % 6;
    const int lo = pr < 3 ? 0 : (pr < 5 ? 1 : 2);
    const int hi = pr < 3 ? pr + 1 : (pr < 5 ? pr - 1 : 3);
    elo = g * 4 + lo; ehi = g * 4 + hi;
}

struct EpiGU {
    bf16_t* act; float wt; int orow0, half, fcol0;
    __device__ __forceinline__ void operator()(const f32x16 (&acc)[1][2], int r0, int c0) const {
        const int up = (c0 >> 2) & 1, wn64 = c0 & 64;
        const int rl = r0;
#pragma unroll
        for (int nt = 0; nt < 2; ++nt) {
            uint2 o[2];
#pragma unroll
            for (int qp = 0; qp < 2; ++qp) {
                const int qg = qp * 2, qu = qp * 2 + 1;
                const float a0 = siluf_(acc[0][nt][qg * 4 + 0]) * acc[0][nt][qu * 4 + 0] * wt;
                const float a1 = siluf_(acc[0][nt][qg * 4 + 1]) * acc[0][nt][qu * 4 + 1] * wt;
                const float a2 = siluf_(acc[0][nt][qg * 4 + 2]) * acc[0][nt][qu * 4 + 2] * wt;
                const float a3 = siluf_(acc[0][nt][qg * 4 + 3]) * acc[0][nt][qu * 4 + 3] * wt;
                o[qp].x = pack2(a0, a1); o[qp].y = pack2(a2, a3);
            }
            const auto sx = __builtin_amdgcn_permlane32_swap(o[0].x, o[1].x, false, false); o[0].x = sx[0]; o[1].x = sx[1];
            const auto sy = __builtin_amdgcn_permlane32_swap(o[0].y, o[1].y, false, false); o[0].y = sy[0]; o[1].y = sy[1];
            const int f = fcol0 + ((wn64 + nt * 32) >> 1) + up * 8;
            *(uint4*)(act + (size_t)(orow0 + rl) * 512 + half * 256 + f) = make_uint4(o[0].x, o[0].y, o[1].x, o[1].y);
        }
    }
};
__device__ __forceinline__ void phase_moe_gu(const Params& p, unsigned char* lds, int l) {
    const WS w{p.ws};
    const XcdIter xi = xcd_iter();
    int ntl[NCLS]; int tot = 0;
#pragma unroll
    for (int c = 0; c < NCLS; ++c) { ntl[c] = (w.cnt(l)[c] + 127) >> 7; tot += ntl[c]; }
    const int nmg = (tot + xi.nx - 1) / xi.nx, nunit = nmg * 8;
    const int lr = threadIdx.x >> 3, lc = (threadIdx.x & 7) ^ ((lr >> 1) & 7);
    auto get = [&](int i, SrcA& A, SrcB& B, EpiGU& ep) -> bool {
        const int u = xi.local + i * xi.nloc;
        if (u >= nunit) return false;
        const int mg = xi.xcd * nmg + (u >> 3), nt = u & 7;
        if (mg >= tot) return false;
        int cls = 0, mt = 0, run = 0;
#pragma unroll
        for (int c = 0; c < NCLS; ++c) { if (mg >= run && mg < run + ntl[c]) { cls = c; mt = mg - run; } run += ntl[c]; }
        const int cnt = w.cnt(l)[cls];
        int elo, ehi; cls_experts(cls, elo, ehi);
        const int half = nt >> 2, e = half ? ehi : elo;
        const int* lst = w.list() + (size_t)cls * LISTCAP;
#pragma unroll
        for (int j = 0; j < 2; ++j) {
            int pos = mt * 128 + lr + 64 * j; if (pos >= cnt) pos = 0;
            const int tok = lst[pos];
            A.p0[j] = w.hb() + (size_t)tok * D + lc * 8; A.p1[j] = A.p0[j];
        }
        A.split = 1 << 30;
        src_plain<2>(B, w.wt_gu(l, e), (nt & 3) * 128, D);
        float wt = 0.f;
        { const int pos = mt * 128 + (threadIdx.x >> 7) * 32 + (threadIdx.x & 31);
          if (pos < cnt) wt = ((const float*)(w.lw() + (size_t)cls * LISTCAP + pos))[half]; }
        ep = EpiGU{w.act(), wt, mg * 128, half, (nt & 3) * 64};
        return true;
    };
    gemm_stream<1, EpiGU>(lds, D, get);
}

struct EpiDown {
    bf16_t* y; bf16_t* sink; int tok0, tok1, n0;
    __device__ __forceinline__ void operator()(const f32x16 (&acc)[1][2], int r0, int c0) const {
        epi_store16<1>(acc, r0, c0,
            [&](int, int, float v0, float v1, float v2, float v3) { uint2 o; o.x = pack2(v0, v1); o.y = pack2(v2, v3); return o; },
            [&](int rl, int c8) -> bf16_t* { const int tok = (rl & 1) ? tok1 : tok0; return tok >= 0 ? y + (size_t)tok * D + n0 + c8 : sink + (threadIdx.x & 511) * 8; });
    }
};
__device__ __forceinline__ void phase_moe_dn(const Params& p, unsigned char* lds, int l) {
    const WS w{p.ws};
    const XcdIter xi = xcd_iter();
    int ntl[NCLS]; int tot = 0;
#pragma unroll
    for (int c = 0; c < NCLS; ++c) { ntl[c] = (w.cnt(l)[c] + 127) >> 7; tot += ntl[c]; }
    const int nmg = (tot + xi.nx - 1) / xi.nx, nunit = nmg * 8;
    auto get = [&](int i, SrcA& A, SrcB& B, EpiDown& ep) -> bool {
        const int u = xi.local + i * xi.nloc;
        if (u >= nunit) return false;
        const int mg = xi.xcd * nmg + (u >> 3), nt = u & 7;
        if (mg >= tot) return false;
        int cls = 0, mt = 0, run = 0;
#pragma unroll
        for (int c = 0; c < NCLS; ++c) { if (mg >= run && mg < run + ntl[c]) { cls = c; mt = mg - run; } run += ntl[c]; }
        const int cnt = w.cnt(l)[cls];
        int elo, ehi; cls_experts(cls, elo, ehi);
        src_plain<2>(A, w.act(), mg * 128, 512);
        src_split<2>(B, w.wt_dn(l, elo), 256, w.wt_dn(l, ehi), 256, nt * 128, 256);
        int tok0 = -1, tok1 = -1;
        { const int* lst = w.list() + (size_t)cls * LISTCAP;
          const int pos = mt * 128 + (((threadIdx.x >> 7) * 32 + (threadIdx.x & 31)) & ~1);
          if (pos < cnt) tok0 = lst[pos];
          if (pos + 1 < cnt) tok1 = lst[pos + 1]; }
        ep = EpiDown{w.zr(), (bf16_t*)(p.ws + OFF_SINK), tok0, tok1, nt * 128};
        return true;
    };
    gemm_stream<1, EpiDown>(lds, 512, get);
}

__device__ __forceinline__ void phase_ln2(const Params& p, int l) {
    const WS w{p.ws};
    const int tid = threadIdx.x, lane = tid & 63, wid = tid >> 6;
    const int nrows = l == 0 ? NROW : NLAT;
    const float* lng = p.in[32] + l * D; const float* lnb = p.in[33] + l * D;
    const float* mdn = w.mod(1); const float* mdc = w.mod(l);
    const bf16_t* ybuf = w.zr();
    const int nwv = gridDim.x * NWV, rpw = (nrows + nwv - 1) / nwv;
    int row = (blockIdx.x * NWV + wid) * rpw;
    const int rend = min(nrows, row + rpw);
    float4 pg[4], pb[4], psh[4], psc[4], pg2[4];
#pragma unroll
    for (int i = 0; i < 4; ++i) { pg[i] = *(const float4*)(lng + i * 256 + lane * 4); pb[i] = *(const float4*)(lnb + i * 256 + lane * 4); psh[i] = pg[i]; psc[i] = pg[i]; pg2[i] = pg[i]; }
    int mcur = -1;
    uint2 vq[2][4], yq[2][4];
    auto prefetch = [&](int r, uint2 (&vb)[4], uint2 (&yb)[4]) {
        const bf16_t* Rn = RBrow(p, r);
#pragma unroll
        for (int i = 0; i < 4; ++i) { vb[i] = *(const uint2*)(Rn + i * 256 + lane * 4); yb[i] = *(const uint2*)(ybuf + (size_t)r * D + i * 256 + lane * 4); }
    };
    if (row < rend) prefetch(row, vq[0], yq[0]);
    if (row + 1 < rend) prefetch(row + 1, vq[1], yq[1]);
    auto body = [&](int row, uint2 (&vb)[4], uint2 (&yb)[4]) {
        const int m = modrow(row);
        if (m != mcur) {
            mcur = m;
#pragma unroll
            for (int i = 0; i < 4; ++i) {
                pg2[i] = *(const float4*)(mdc + (size_t)m * 6144 + 5120 + i * 256 + lane * 4);
                if (l == 0) { psh[i] = *(const float4*)(mdn + (size_t)m * 6144 + i * 256 + lane * 4); psc[i] = *(const float4*)(mdn + (size_t)m * 6144 + 1024 + i * 256 + lane * 4); }
            }
        }
        float4 v[4];
#pragma unroll
        for (int i = 0; i < 4; ++i) {
            const float4 g2 = pg2[i], vn = bf4(vb[i]); const uint2 yy = yb[i];
            v[i].x = DN_ALPHA * vn.x + g2.x * bflo(yy.x); v[i].y = DN_ALPHA * vn.y + g2.y * bfhi(yy.x);
            v[i].z = DN_ALPHA * vn.z + g2.z * bflo(yy.y); v[i].w = DN_ALPHA * vn.w + g2.w * bfhi(yy.y);
        }
        if (row + 2 < rend) prefetch(row + 2, vb, yb);
        float s = 0.f;
#pragma unroll
        for (int i = 0; i < 4; ++i) s += (v[i].x + v[i].y) + (v[i].z + v[i].w);
        const float mean = wave_sum_fast(s) * (1.0f / 1024.0f);
        float q = 0.f;
#pragma unroll
        for (int i = 0; i < 4; ++i) { const float a = v[i].x - mean, b = v[i].y - mean, c = v[i].z - mean, d = v[i].w - mean; q += (a * a + b * b) + (c * c + d * d); }
        const float rs = rsqrtf(wave_sum_fast(q) * (1.0f / 1024.0f) + LN_EPS);
#pragma unroll
        for (int i = 0; i < 4; ++i) {
            const int col = i * 256 + lane * 4;
            const float4 g = pg[i], b = pb[i];
            float4 x;
            x.x = (v[i].x - mean) * rs * g.x + b.x; x.y = (v[i].y - mean) * rs * g.y + b.y; x.z = (v[i].z - mean) * rs * g.z + b.z; x.w = (v[i].w - mean) * rs * g.w + b.w;
            if (l == 1) *(float4*)(p.out + (size_t)row * D + col) = x;
            else if (row < NLAT) { typedef unsigned ntu2 __attribute__((ext_vector_type(2))); const ntu2 xo = {pack2(x.x, x.y), pack2(x.z, x.w)}; __builtin_nontemporal_store(xo, (ntu2*)(X1row(p, row) + col)); }
            if (l == 0) {
                const float4 sh = psh[i], sc = psc[i];
                uint2 o; o.x = pack2(x.x * (1.f + sc.x) + sh.x, x.y * (1.f + sc.y) + sh.y); o.y = pack2(x.z * (1.f + sc.z) + sh.z, x.w * (1.f + sc.w) + sh.w);
                *(uint2*)(w.hb() + (size_t)row * D + col) = o;
            }
        }
    };
    for (; row < rend; row += 2) {
        body(row, vq[0], yq[0]);
        if (row + 1 < rend) body(row + 1, vq[1], yq[1]);
    }
}

#define XB_TMO      128
#define XB_XCNT(j)  (256  + 64 * (j))
#define XB_XSUB(j)  (1280 + 64 * (j))
#define XB_XGEN(j)  (2304 + 64 * (j))
#define XB_TOP      3328
#define XB_TOPGEN   3392
#define XB_SPIN_CAP (1u << 20)
__device__ __forceinline__ unsigned xb_ld(unsigned* p)              { return __hip_atomic_load(p, __ATOMIC_RELAXED, __HIP_MEMORY_SCOPE_AGENT); }
__device__ __forceinline__ unsigned xb_add(unsigned* p, unsigned v) { return __hip_atomic_fetch_add(p, v, __ATOMIC_RELAXED, __HIP_MEMORY_SCOPE_AGENT); }
__device__ __forceinline__ unsigned xb_xcc_id() { return (unsigned)__builtin_amdgcn_s_getreg((3 << 11) | 20) & 0xFu; }
#define XB_SPIN(cond, bar) do { unsigned _sp = 0; while (cond) { __builtin_amdgcn_s_sleep(1); \
    if ((++_sp & 255u) == 0u) { if (xb_ld(&(bar)[XB_TMO])) break; if (_sp > XB_SPIN_CAP) { atomicAdd(&(bar)[XB_TMO], 1u); break; } } } } while (0)
struct XcdBarrier { unsigned* bar; unsigned x, nloc, nx; };
__device__ __forceinline__ void xcd_barrier_post(XcdBarrier& b, unsigned* bar) {
    b.bar = bar; b.x = xb_xcc_id(); b.nloc = 0u; b.nx = 0u;
    if (threadIdx.x == 0) (void)xb_add(&bar[XB_XCNT(b.x)], 1u);
}
__device__ __forceinline__ void xcd_barrier_complete(unsigned* bar, unsigned x, unsigned& nloc, unsigned& nx) {
    const unsigned G = gridDim.x;
    unsigned sum, cnt, mine, sp = 0u;
    for (;;) {
        sum = 0u; cnt = 0u; mine = 0u;
#pragma unroll
        for (unsigned j = 0; j < 16; ++j) { const unsigned c = xb_ld(&bar[XB_XCNT(j)]); sum += c; cnt += (c > 0u) ? 1u : 0u; mine = (j == x) ? c : mine; }
        if (sum == G) break;
        __builtin_amdgcn_s_sleep(1);
        if ((++sp & 255u) == 0u) { if (xb_ld(&bar[XB_TMO])) break; if (sp > XB_SPIN_CAP) { atomicAdd(&bar[XB_TMO], 1u); break; } }
    }
    nloc = mine > 0u ? mine : 1u; nx = cnt > 0u ? cnt : 1u;
}
__device__ __forceinline__ void xcd_barrier(XcdBarrier& b) {
    asm volatile("s_waitcnt vmcnt(0)" ::: "memory");
    __syncthreads();
    if (threadIdx.x == 0) {
        unsigned* bar = b.bar;
        __builtin_amdgcn_s_waitcnt(0);
        if (b.nloc == 0u) xcd_barrier_complete(bar, b.x, b.nloc, b.nx);
        const unsigned nloc = b.nloc, nx = b.nx;
        const unsigned old = xb_add(&bar[XB_XSUB(b.x)], 1u);
        const unsigned gen = old / nloc;
        if (old + 1u == (gen + 1u) * nloc) {
            __builtin_amdgcn_fence(__ATOMIC_RELEASE, "agent");
            asm volatile("s_waitcnt vmcnt(0)" ::: "memory");
            const unsigned og = xb_add(&bar[XB_TOP], 1u);
            const unsigned tg = og / nx;
            if (og + 1u == (tg + 1u) * nx) xb_add(&bar[XB_TOPGEN], 1u);
            else XB_SPIN(xb_ld(&bar[XB_TOPGEN]) == tg, bar);
            __builtin_amdgcn_fence(__ATOMIC_ACQUIRE, "agent");
            xb_add(&bar[XB_XGEN(b.x)], 1u);
            asm volatile("s_waitcnt vmcnt(0)" ::: "memory");
        } else {
            XB_SPIN(xb_ld(&bar[XB_XGEN(b.x)]) == gen, bar);
            __builtin_amdgcn_fence(__ATOMIC_ACQUIRE, "agent");
            asm volatile("s_waitcnt vmcnt(0)" ::: "memory");
        }
    }
    __syncthreads();
}

constexpr int NPHASE = 2 + 2 * 8;
__global__ void __launch_bounds__(NTHR, 2) mega(Params p, int ph_lo, int ph_hi) {
    extern __shared__ __attribute__((aligned(16))) unsigned char lds[];
    XcdBarrier xb; xcd_barrier_post(xb, (unsigned*)(p.ws + OFF_BAR));
#define RUN(idx, ...) if (ph_lo <= (idx) && (idx) < ph_hi) { __VA_ARGS__; if ((idx) + 1 < ph_hi) xcd_barrier(xb); }
    RUN(0, phase_pro_a(p, lds))
    RUN(1, phase_pro_b(p, lds))
#define LAYER(l) \
    RUN(2 + 8 * l + 0, phase_inproj(p, lds, l); if (l == 0) w2_toeplitz_fill(p, 0, defer_ok() ? 1 : 2, blockIdx.x * NTHR + threadIdx.x, gridDim.x * NTHR)) \
    RUN(2 + 8 * l + 1, phase_s12(p, lds, l)) \
    RUN(2 + 8 * l + 2, phase_glu(p, lds, l)) \
    RUN(2 + 8 * l + 3, phase_outproj(p, lds, l)) \
    RUN(2 + 8 * l + 4, phase_ln1(p, lds, l)) \
    RUN(2 + 8 * l + 5, phase_moe_gu(p, lds, l)) \
    RUN(2 + 8 * l + 6, phase_moe_dn(p, lds, l)) \
    RUN(2 + 8 * l + 7, phase_ln2(p, l))
    LAYER(0)
    LAYER(1)
#undef LAYER
#undef RUN
}

extern "C" void kernel_launch(void* const* d_in, const int* in_sizes, int n_in, void* d_out, int out_size, void* d_ws, size_t ws_size, hipStream_t stream) {
    static int grid_blocks = 0;
    if (grid_blocks == 0) {
        if (n_in != 34 || out_size != NLAT * D || ws_size < WS_END) {
            fprintf(stderr, "kernel_launch: unexpected shapes (n_in %d out %d ws %zu need %zu)\n", n_in, out_size, ws_size, (size_t)WS_END);
            grid_blocks = -1; return;
        }
        int dev = 0, cus = 0, per_cu = 0;
        hipGetDevice(&dev);
        hipDeviceGetAttribute(&cus, hipDeviceAttributeMultiprocessorCount, dev);
        if (hipFuncSetAttribute((const void*)mega, hipFuncAttributeMaxDynamicSharedMemorySize, LDS_BYTES) != hipSuccess) fprintf(stderr, "kernel_launch: hipFuncSetAttribute failed\n");
        hipOccupancyMaxActiveBlocksPerMultiprocessor(&per_cu, (const void*)mega, NTHR, LDS_BYTES);
        if (per_cu < 1) per_cu = 1;
        if (per_cu > 1) per_cu = 1;
        grid_blocks = cus * per_cu;
        if (grid_blocks < 16) { fprintf(stderr, "kernel_launch: grid %d too small (LN1 keeps two conditioning rows per workgroup: needs < 2048 tokens per workgroup)\n", grid_blocks); grid_blocks = -1; return; }
        fprintf(stderr, "kernel_launch: cus %d per_cu %d grid %d ws need %zu have %zu\n", cus, per_cu, grid_blocks, (size_t)WS_END, ws_size);
    }
    if (grid_blocks < 0) return;
    Params p{};
    for (int i = 0; i < 34; ++i) p.in[i] = (const float*)d_in[i];
    p.out = (float*)d_out; p.ws = (unsigned char*)d_ws;
    if (hipMemsetAsync((unsigned char*)d_ws + OFF_BAR, 0, SZ_BAR, stream) != hipSuccess) fprintf(stderr, "memset failed\n");
#if FUSED
    int lo = 0, hi = NPHASE;
    void* args[] = {&p, &lo, &hi};
    hipError_t e = hipLaunchCooperativeKernel((const void*)mega, dim3(grid_blocks), dim3(NTHR), args, LDS_BYTES, stream);
    if (e != hipSuccess) fprintf(stderr, "cooperative launch failed: %s (grid %d)\n", hipGetErrorString(e), grid_blocks);
#else
    for (int ph = 0; ph < NPHASE; ++ph) hipLaunchKernelGGL(mega, dim3(grid_blocks), dim3(NTHR), LDS_BYTES, stream, p, ph, ph + 1);
#endif
}
```
